# Optimizing an MI355X kernel written in HIP

```python
import jax
import jax.numpy as jnp
from jax import lax
import numpy as np

D_MODEL = 1024
BATCH = 16
SEQ = 2048
DEPTH = 2

GRID_W = 64
CTX_LEN = 256
HEAD_DIM = 64
ATT_HEADS = 8
ATT_KV_HEADS = 2
RWKV_HEADS = 8
NA_HEADS = 8
D_BRANCH = 512
D_KV = ATT_KV_HEADS * HEAD_DIM
DECAY_LORA = 64
ICLR_LORA = 64
GATE_LORA = 128
D_FF = 2816
N_BRANCH = 3
N_MOD = 9
Q_BLOCK = 128
NA_KH_MAX = 8
NA_KW = 16
ROPE_THETA = 10000.0
LN_EPS = 1e-5
RMS_EPS = 1e-6
GN_EPS = 64e-5
ALPHA = (2 * DEPTH) ** 0.25
BETA = (8 * DEPTH) ** -0.25

D_RWKV_IN = 3 * D_BRANCH + 2 * DECAY_LORA + 2 * ICLR_LORA + GATE_LORA
RWKV_SPLITS = (D_BRANCH, 2 * D_BRANCH, 3 * D_BRANCH, 3 * D_BRANCH + 2 * DECAY_LORA, 3 * D_BRANCH + 2 * DECAY_LORA + 2 * ICLR_LORA)
IN_SPLITS = (D_BRANCH, D_BRANCH + D_KV, D_BRANCH + 2 * D_KV, D_BRANCH + 2 * D_KV + D_RWKV_IN, 2 * D_BRANCH + 2 * D_KV + D_RWKV_IN, 3 * D_BRANCH + 2 * D_KV + D_RWKV_IN, 4 * D_BRANCH + 2 * D_KV + D_RWKV_IN)
D_IN = IN_SPLITS[-1] + N_BRANCH * D_MODEL

kernel_name = 'hybrid_gated_mixer_diffusion_block'


def layer_norm(x, g, b):
    xf = x.astype(jnp.float32)
    mu = jnp.mean(xf, -1, keepdims=True)
    var = jnp.mean(jnp.square(xf - mu), -1, keepdims=True)
    return ((xf - mu) * lax.rsqrt(var + LN_EPS)).astype(x.dtype) * g + b


def rms_norm(x, g):
    xf = x.astype(jnp.float32)
    return (xf * lax.rsqrt(jnp.mean(jnp.square(xf), -1, keepdims=True) + RMS_EPS)).astype(x.dtype) * g


def modulate(x, shift, scale):
    return x * (1 + scale) + shift


def post_norm(x, y, g, b):
    return layer_norm(ALPHA * x + y, g, b)


def swiglu(u, wi, wo):
    gate, up = jnp.split(u @ wi, 2, axis=-1)
    return (jax.nn.silu(gate) * up) @ wo


def heads(t, n):
    return t.reshape(t.shape[0], t.shape[1], n, HEAD_DIM)


def axial_rope_tables(n_tok):
    t = jnp.arange(n_tok)
    row = (t // GRID_W).astype(jnp.float32)
    col = (t % GRID_W).astype(jnp.float32)
    half = HEAD_DIM // 2
    inv = ROPE_THETA ** (-jnp.arange(0, half, 2, dtype=jnp.float32) / half)
    ang = jnp.stack([row[:, None] * inv, col[:, None] * inv], 1)
    return jnp.cos(ang), jnp.sin(ang)


def apply_axial_rope(x, cos, sin):
    B, T, H, d = x.shape
    xr = x.reshape(B, T, H, 2, 2, d // 4)
    x1, x2 = xr[..., 0, :], xr[..., 1, :]
    c = cos[:, None].astype(x.dtype)
    s = sin[:, None].astype(x.dtype)
    return jnp.stack([x1 * c - x2 * s, x2 * c + x1 * s], axis=-2).reshape(B, T, H, d)


def attend_grouped(q, k, v):
    s = jnp.einsum('blkgd,bskd->bkgls', q, k).astype(jnp.float32) * (HEAD_DIM ** -0.5)
    p = jax.nn.softmax(s, axis=-1).astype(v.dtype)
    return jnp.einsum('bkgls,bskd->blkgd', p, v)


def gqa_branch(q, k, v, qc, kc, vc, q_gain, k_gain, need_ctx):
    B, T = q.shape[:2]
    C = qc.shape[1]
    G = ATT_HEADS // ATT_KV_HEADS
    cos, sin = axial_rope_tables(T)
    q = apply_axial_rope(rms_norm(q, q_gain), cos, sin)
    k = apply_axial_rope(rms_norm(k, k_gain), cos, sin)
    kc = rms_norm(kc, k_gain)
    keys = jnp.concatenate([k, kc], 1)
    vals = jnp.concatenate([v, vc], 1)
    n_blk = T // Q_BLOCK
    qb = q.reshape(B, n_blk, Q_BLOCK, ATT_KV_HEADS, G, HEAD_DIM).transpose(1, 0, 2, 3, 4, 5)
    ob = lax.map(lambda blk: attend_grouped(blk, keys, vals), qb)
    y = ob.transpose(1, 0, 2, 3, 4, 5).reshape(B, T, D_BRANCH)
    y_c = None
    if need_ctx:
        qc = rms_norm(qc, q_gain).reshape(B, C, ATT_KV_HEADS, G, HEAD_DIM)
        y_c = attend_grouped(qc, kc, vc).reshape(B, C, D_BRANCH)
    return y, y_c


def na_branch(q, k, v, qc, kc, vc, rpb, need_ctx):
    B, T = q.shape[:2]
    C = qc.shape[1]
    rows = T // GRID_W
    kh = min(NA_KH_MAX, rows)
    scale = HEAD_DIM ** -0.5
    qg = jnp.moveaxis(q.reshape(B, rows, GRID_W, NA_HEADS, HEAD_DIM), 1, 0)
    kg = k.reshape(B, rows, GRID_W, NA_HEADS, HEAD_DIM)
    vg = v.reshape(B, rows, GRID_W, NA_HEADS, HEAD_DIM)
    cols = jnp.arange(GRID_W)
    c0 = jnp.clip(cols - NA_KW // 2, 0, GRID_W - NA_KW)
    col_idx = c0[:, None] + jnp.arange(NA_KW)[None, :]
    rpb_cols = rpb[:, :, col_idx - cols[:, None] + (NA_KW - 1)]

    def one_row(args):
        r, q_row = args
        r0 = jnp.clip(r - kh // 2, 0, rows - kh)
        k_win = lax.dynamic_slice_in_dim(kg, r0, kh, axis=1)[:, :, col_idx]
        v_win = lax.dynamic_slice_in_dim(vg, r0, kh, axis=1)[:, :, col_idx]
        bias = rpb_cols[:, r0 + jnp.arange(kh) - r + (NA_KH_MAX - 1)]
        s_win = jnp.einsum('bqhd,bkqjhd->bhqkj', q_row, k_win).astype(jnp.float32) * scale + jnp.transpose(bias, (0, 2, 1, 3))
        s_ctx = jnp.einsum('bqhd,bshd->bhqs', q_row, kc).astype(jnp.float32) * scale
        s = jnp.concatenate([s_win.reshape(B, NA_HEADS, GRID_W, kh * NA_KW), s_ctx], -1)
        p = jax.nn.softmax(s, axis=-1).astype(v.dtype)
        p_win = p[..., :kh * NA_KW].reshape(B, NA_HEADS, GRID_W, kh, NA_KW)
        return jnp.einsum('bhqkj,bkqjhd->bqhd', p_win, v_win) + jnp.einsum('bhqs,bshd->bqhd', p[..., kh * NA_KW:], vc)

    out = lax.map(one_row, (jnp.arange(rows), qg))
    y = jnp.moveaxis(out, 0, 1).reshape(B, T, D_BRANCH)
    y_c = None
    if need_ctx:
        y_c = attend_grouped(qc.reshape(B, C, NA_HEADS, 1, HEAD_DIM), kc, vc).reshape(B, C, D_BRANCH)
    return y, y_c


def token_shift_centred(y, mu):
    prev = jnp.pad(y, ((0, 0), (1, 0), (0, 0)))[:, :-1]
    nxt = jnp.pad(y, ((0, 0), (0, 1), (0, 0)))[:, 1:]
    return y + mu[0] * (prev - y) + mu[1] * (nxt - y)


def to_scan_layout(t):
    t = jnp.stack([t[:, :, 0], jnp.flip(t[:, :, 1], 1)], 0)
    Z, B, T, _ = t.shape
    return t.reshape(Z, B, T, RWKV_HEADS, HEAD_DIM).transpose(2, 0, 1, 3, 4)


def from_scan_layout(o):
    o = o.transpose(1, 2, 0, 3, 4)
    return o[0] + jnp.flip(o[1], 1)


def rwkv_inputs(y, mu, w0, w2, a0, a2, g2, k_k, k_a):
    B, T, _ = y.shape
    y = token_shift_centred(y, mu)
    r, k, v, wd, ad, gd = jnp.split(y, RWKV_SPLITS, axis=-1)
    wd = wd.reshape(B, T, 2, DECAY_LORA)
    ad = ad.reshape(B, T, 2, ICLR_LORA)
    w_log = -jax.nn.softplus(-(w0 + jnp.einsum('btzr,zrc->btzc', jnp.tanh(wd), w2))) - 0.5
    decay = jnp.exp(-jnp.exp(w_log.astype(jnp.float32)))
    iclr = jax.nn.sigmoid(a0 + jnp.einsum('btzr,zrc->btzc', ad, a2))
    g = jax.nn.sigmoid(gd) @ g2
    kk = (k * k_k).reshape(B, T, RWKV_HEADS, HEAD_DIM)
    kkf = kk.astype(jnp.float32)
    kk = (kkf * lax.rsqrt(jnp.sum(jnp.square(kkf), -1, keepdims=True) + 1e-12)).astype(k.dtype).reshape(B, T, D_BRANCH)
    k_dir = k[:, :, None] * (1 + (iclr - 1) * k_a)
    a_dir = jnp.broadcast_to(-kk[:, :, None], iclr.shape)
    b_dir = kk[:, :, None] * iclr
    r_dir = jnp.broadcast_to(r[:, :, None], iclr.shape)
    v_dir = jnp.broadcast_to(v[:, :, None], iclr.shape)
    xs = (to_scan_layout(r_dir), to_scan_layout(decay), to_scan_layout(k_dir),
          to_scan_layout(v_dir), to_scan_layout(a_dir), to_scan_layout(b_dir))
    return xs, r, k, v, g


def rwkv_scan(state0, xs, emit):
    def step(state, inp):
        r_t, w_t, k_t, v_t, a_t, b_t = inp
        sa = jnp.einsum('zbhvk,zbhk->zbhv', state, a_t)
        state = state * w_t[..., None, :] + sa[..., :, None] * b_t[..., None, :] + v_t[..., :, None] * k_t[..., None, :]
        out = jnp.einsum('zbhvk,zbhk->zbhv', state, r_t) if emit else None
        return state, out
    return lax.scan(step, state0, xs)


def rwkv_readout(o, r, k, v, g, r_k, gn_g, gn_b):
    B, T, _ = r.shape
    o = from_scan_layout(o)
    mu = jnp.mean(o, -1, keepdims=True)
    var = jnp.mean(jnp.square(o - mu), -1, keepdims=True)
    o = ((o - mu) * lax.rsqrt(var + GN_EPS)).reshape(B, T, D_BRANCH).astype(r.dtype) * gn_g + gn_b
    rh, kh, vh = heads(r, RWKV_HEADS), heads(k, RWKV_HEADS), heads(v, RWKV_HEADS)
    bonus = (jnp.sum(rh * kh * r_k, -1, keepdims=True) * vh).reshape(B, T, D_BRANCH)
    return (o + bonus) * g


def rwkv_branch(y_lat, y_ctx, mu, w0, w2, a0, a2, g2, k_k, k_a, r_k, gn_g, gn_b, need_ctx):
    B = y_lat.shape[0]
    xs_l, r_l, k_l, v_l, g_l = rwkv_inputs(y_lat, mu, w0, w2, a0, a2, g2, k_k, k_a)
    xs_c, r_c, k_c, v_c, g_c = rwkv_inputs(y_ctx, mu, w0, w2, a0, a2, g2, k_k, k_a)
    state0 = jnp.zeros((2, B, RWKV_HEADS, HEAD_DIM, HEAD_DIM), jnp.float32)
    state_ctx, o_c = rwkv_scan(state0, xs_c, need_ctx)
    _, o_l = rwkv_scan(state_ctx, xs_l, True)
    y = rwkv_readout(o_l, r_l, k_l, v_l, g_l, r_k, gn_g, gn_b).astype(y_lat.dtype)
    y_c = None
    if need_ctx:
        y_c = rwkv_readout(o_c, r_c, k_c, v_c, g_c, r_k, gn_g, gn_b).astype(y_ctx.dtype)
    return y, y_c


def merge_branches(ya, yr, yn, gate_logits, w_branch, w_out):
    B, T, _ = ya.shape
    ys = jnp.stack([ya, yr, yn], 2)
    proj = jnp.einsum('btzc,zcd->btzd', ys, w_branch)
    gates = jax.nn.sigmoid(gate_logits.reshape(B, T, N_BRANCH, D_MODEL))
    return jnp.sum(gates * proj, 2) @ w_out


def hybrid_mixer(ux, uc, w_in, q_gain, k_gain, mu, w0, w2, a0, a2, g2, k_k, k_a, r_k, gn_g, gn_b, rpb, w_branch, w_out, need_ctx):
    px = jnp.split(ux @ w_in, IN_SPLITS, axis=-1)
    pc = jnp.split(uc @ w_in, IN_SPLITS, axis=-1)
    ya, ya_c = gqa_branch(heads(px[0], ATT_HEADS), heads(px[1], ATT_KV_HEADS), heads(px[2], ATT_KV_HEADS),
                          heads(pc[0], ATT_HEADS), heads(pc[1], ATT_KV_HEADS), heads(pc[2], ATT_KV_HEADS),
                          q_gain, k_gain, need_ctx)
    yr, yr_c = rwkv_branch(px[3], pc[3], mu, w0, w2, a0, a2, g2, k_k, k_a, r_k, gn_g, gn_b, need_ctx)
    yn, yn_c = na_branch(heads(px[4], NA_HEADS), heads(px[5], NA_HEADS), heads(px[6], NA_HEADS),
                         heads(pc[4], NA_HEADS), heads(pc[5], NA_HEADS), heads(pc[6], NA_HEADS), rpb, need_ctx)
    y_x = merge_branches(ya, yr, yn, px[7], w_branch, w_out)
    y_c = merge_branches(ya_c, yr_c, yn_c, pc[7], w_branch, w_out) if need_ctx else None
    return y_x, y_c


def setup_inputs(seed: int = 0) -> dict:
    key = jax.random.key(seed)
    ks = iter(jax.random.split(key, 40))
    L = DEPTH

    def nrm(shape, s):
        return s * jax.random.normal(next(ks), shape, jnp.float32)

    def unif(shape, lo, hi):
        return jax.random.uniform(next(ks), shape, jnp.float32, lo, hi)

    return {
        'x': nrm((BATCH, SEQ, D_MODEL), 1.0),
        'c': nrm((BATCH, D_MODEL), 1.0),
        'ctx': nrm((BATCH, CTX_LEN, D_MODEL), 1.0),
        'c_ctx': nrm((D_MODEL,), 1.0),
        'w_ada': nrm((L, D_MODEL, N_MOD * D_MODEL), 0.5 * D_MODEL ** -0.5),
        'b_ada': nrm((L, N_MOD * D_MODEL), 0.01),
        'ffn1_wi': nrm((L, D_MODEL, 2 * D_FF), D_MODEL ** -0.5),
        'ffn1_wo': nrm((L, D_FF, D_MODEL), BETA * D_FF ** -0.5),
        'ffn2_wi': nrm((L, D_MODEL, 2 * D_FF), D_MODEL ** -0.5),
        'ffn2_wo': nrm((L, D_FF, D_MODEL), BETA * D_FF ** -0.5),
        'ln_g': 1.0 + nrm((L, 3, D_MODEL), 0.02),
        'ln_b': nrm((L, 3, D_MODEL), 0.02),
        'w_in': nrm((L, D_MODEL, D_IN), D_MODEL ** -0.5),
        'att_q_gain': 1.0 + nrm((L, HEAD_DIM), 0.02),
        'att_k_gain': 1.0 + nrm((L, HEAD_DIM), 0.02),
        'rwkv_mu': unif((L, 2, D_RWKV_IN), 0.0, 0.5),
        'rwkv_w0': unif((L, 2, D_BRANCH), -6.0, 0.0),
        'rwkv_w2': nrm((L, 2, DECAY_LORA, D_BRANCH), 0.5 * DECAY_LORA ** -0.5),
        'rwkv_a0': nrm((L, 2, D_BRANCH), 0.1),
        'rwkv_a2': nrm((L, 2, ICLR_LORA, D_BRANCH), 0.5 * ICLR_LORA ** -0.5),
        'rwkv_g2': nrm((L, GATE_LORA, D_BRANCH), GATE_LORA ** -0.5),
        'rwkv_k_k': 0.85 + nrm((L, D_BRANCH), 0.02),
        'rwkv_k_a': 1.0 + nrm((L, D_BRANCH), 0.02),
        'rwkv_r_k': nrm((L, RWKV_HEADS, HEAD_DIM), 0.1),
        'rwkv_gn_g': 1.0 + nrm((L, D_BRANCH), 0.02),
        'rwkv_gn_b': nrm((L, D_BRANCH), 0.02),
        'na_rpb': nrm((L, NA_HEADS, 2 * NA_KH_MAX - 1, 2 * NA_KW - 1), 0.05),
        'w_branch': nrm((L, N_BRANCH, D_BRANCH, D_MODEL), D_BRANCH ** -0.5),
        'w_out': nrm((L, D_MODEL, D_MODEL), BETA * D_MODEL ** -0.5),
    }


def reference(x, c, ctx, c_ctx, w_ada, b_ada, ffn1_wi, ffn1_wo, ffn2_wi, ffn2_wo, ln_g, ln_b, w_in,
              att_q_gain, att_k_gain, rwkv_mu, rwkv_w0, rwkv_w2, rwkv_a0, rwkv_a2, rwkv_g2, rwkv_k_k,
              rwkv_k_a, rwkv_r_k, rwkv_gn_g, rwkv_gn_b, na_rpb, w_branch, w_out):
    for l in range(DEPTH):
        last = l == DEPTH - 1
        m_x = jnp.split((jax.nn.silu(c) @ w_ada[l] + b_ada[l])[:, None, :], N_MOD, axis=-1)
        m_c = jnp.split((jax.nn.silu(c_ctx) @ w_ada[l] + b_ada[l])[None, None, :], N_MOD, axis=-1)

        x = post_norm(x, 0.5 * m_x[2] * swiglu(modulate(x, m_x[0], m_x[1]), ffn1_wi[l], ffn1_wo[l]), ln_g[l, 0], ln_b[l, 0])
        ctx = post_norm(ctx, 0.5 * m_c[2] * swiglu(modulate(ctx, m_c[0], m_c[1]), ffn1_wi[l], ffn1_wo[l]), ln_g[l, 0], ln_b[l, 0])

        y_x, y_c = hybrid_mixer(modulate(x, m_x[3], m_x[4]), modulate(ctx, m_c[3], m_c[4]), w_in[l],
                                att_q_gain[l], att_k_gain[l], rwkv_mu[l], rwkv_w0[l], rwkv_w2[l], rwkv_a0[l],
                                rwkv_a2[l], rwkv_g2[l], rwkv_k_k[l], rwkv_k_a[l], rwkv_r_k[l], rwkv_gn_g[l],
                                rwkv_gn_b[l], na_rpb[l], w_branch[l], w_out[l], not last)
        x = post_norm(x, m_x[5] * y_x, ln_g[l, 1], ln_b[l, 1])
        if not last:
            ctx = post_norm(ctx, m_c[5] * y_c, ln_g[l, 1], ln_b[l, 1])
            ctx = post_norm(ctx, 0.5 * m_c[8] * swiglu(modulate(ctx, m_c[6], m_c[7]), ffn2_wi[l], ffn2_wo[l]), ln_g[l, 2], ln_b[l, 2])

        x = post_norm(x, 0.5 * m_x[8] * swiglu(modulate(x, m_x[6], m_x[7]), ffn2_wi[l], ffn2_wo[l]), ln_g[l, 2], ln_b[l, 2])
    return x
```

```cpp
#include <hip/hip_runtime.h>
#include <hip/hip_cooperative_groups.h>
#include <cstdio>
#include <cstdint>
namespace cg = cooperative_groups;

#define DI __device__ __forceinline__
typedef unsigned short bf16_t;
typedef short bf16x8 __attribute__((ext_vector_type(8)));
typedef short s16x4 __attribute__((ext_vector_type(4)));
typedef float f32x2 __attribute__((ext_vector_type(2)));
typedef float f32x4 __attribute__((ext_vector_type(4)));
typedef float f32x16 __attribute__((ext_vector_type(16)));
typedef unsigned u32x2 __attribute__((ext_vector_type(2)));
typedef unsigned u32x4 __attribute__((ext_vector_type(4)));
typedef __bf16 nbf16x2 __attribute__((ext_vector_type(2)));

constexpr int DM = 1024, NB = 16, TL = 2048, TC = 256;
constexpr int NTL = NB * TL, NTC = NB * TC, NTOK = NTL + NTC;
constexpr int DFF = 2816, DIN = 7296, DPROJ = 4224;
constexpr int NMOD = 9 * DM;
constexpr float LOG2E = 1.4426950408889634f;
constexpr float QSCALE = 0.125f * LOG2E;
constexpr float ALPHA = 1.4142135623730951f;
constexpr int LDS_BYTES = 40960;
constexpr int NTHREADS = 256;

struct Params {
  const float *x_in, *c, *ctx_in, *c_ctx, *w_ada, *b_ada, *ffn1_wi, *ffn1_wo, *ffn2_wi, *ffn2_wo, *ln_g, *ln_b, *w_in,
      *q_gain, *k_gain, *mu, *w0, *w2, *a0, *a2, *g2, *k_k, *k_a, *r_k, *gn_g, *gn_b, *rpb, *w_branch, *w_out;
  float* out;
  float* mods;
  float* rope;
  float* ctxx;
  unsigned* counters;
  bf16_t *U, *H, *P, *Os, *yr, *Mg, *sg;
};

DI int tid_() { int t = threadIdx.x; asm volatile("" : "+v"(t)); return t; }
DI unsigned pk2(float a, float b) { f32x2 v = {a, b}; nbf16x2 r = __builtin_convertvector(v, nbf16x2); return __builtin_bit_cast(unsigned, r); }
DI bf16_t f2bf(float a) { return (bf16_t)(pk2(a, 0.f) & 0xffffu); }
DI float bflo(unsigned u) { return __uint_as_float(u << 16); }
DI float bfhi(unsigned u) { return __uint_as_float(u & 0xffff0000u); }
DI f32x4 ld4bf(const bf16_t* p) { u32x2 v = *(const u32x2*)p; return (f32x4){bflo(v.x), bfhi(v.x), bflo(v.y), bfhi(v.y)}; }
DI void st4bf(bf16_t* p, f32x4 v) { u32x2 o; o.x = pk2(v[0], v[1]); o.y = pk2(v[2], v[3]); *(u32x2*)p = o; }
DI float sigmoidf_(float x) { return 1.f / (1.f + __expf(-x)); }
DI float siluf_(float x) { return x / (1.f + __expf(-x)); }
DI int mod_row(int row) { return row < NTL ? (row >> 11) : 16; }

constexpr int LDT = 72;

struct MapPlain { DI int operator()(int tn, int cl) const { return tn * 128 + cl; } };
struct MapGateUp { DI int operator()(int tn, int cl) const { int sub = cl >> 4, j = cl & 15; return ((sub & 1) ? DFF : 0) + tn * 64 + (sub >> 1) * 16 + j; } };

template <class BMap>
DI void gemm_mainloop(const bf16_t* __restrict__ A, int lda, const float* __restrict__ B, int ldb, int K, int tn, BMap bmap,
                      f32x4 (&acc)[4][4], char* lds) {
  bf16_t* As = (bf16_t*)lds;
  bf16_t* Bs = As + 128 * LDT;
  const int tid = tid_(), lane = tid & 63, wid = tid >> 6, wr = wid >> 1, wc = wid & 1;
  const int fr = lane & 15, fq = lane >> 4;
  const int arow = tid >> 3, akc = tid & 7;
  const int kg = tid >> 5, ng = tid & 31;
  const bf16_t* ap = A + (size_t)arow * lda + akc * 8;
  const float* bp = B + (size_t)(kg * 8) * ldb + bmap(tn, ng * 4);
  u32x4 ra[4];
  f32x4 rb[8];
  const int nk = K >> 6;
#pragma unroll
  for (int i = 0; i < 4; ++i) ra[i] = *(const u32x4*)(ap + (size_t)(i * 32) * lda);
#pragma unroll
  for (int i = 0; i < 8; ++i) rb[i] = *(const f32x4*)(bp + (size_t)i * ldb);
#pragma unroll 1
  for (int kt = 0; kt < nk; ++kt) {
    __syncthreads();
#pragma unroll
    for (int i = 0; i < 4; ++i) *(u32x4*)(As + (arow + i * 32) * LDT + akc * 8) = ra[i];
#pragma unroll
    for (int jn = 0; jn < 4; ++jn) {
      u32x4 w;
      w.x = pk2(rb[0][jn], rb[1][jn]); w.y = pk2(rb[2][jn], rb[3][jn]); w.z = pk2(rb[4][jn], rb[5][jn]); w.w = pk2(rb[6][jn], rb[7][jn]);
      *(u32x4*)(Bs + (ng * 4 + jn) * LDT + kg * 8) = w;
    }
    __syncthreads();
    if (kt + 1 < nk) {
      const bf16_t* ap2 = ap + (kt + 1) * 64;
      const float* bp2 = bp + (size_t)((kt + 1) * 64) * ldb;
#pragma unroll
      for (int i = 0; i < 4; ++i) ra[i] = *(const u32x4*)(ap2 + (size_t)(i * 32) * lda);
#pragma unroll
      for (int i = 0; i < 8; ++i) rb[i] = *(const f32x4*)(bp2 + (size_t)i * ldb);
    }
#pragma unroll
    for (int ks = 0; ks < 2; ++ks) {
      bf16x8 af[4], bfr[4];
#pragma unroll
      for (int mi = 0; mi < 4; ++mi) af[mi] = *(const bf16x8*)(As + (wr * 64 + mi * 16 + fr) * LDT + ks * 32 + fq * 8);
#pragma unroll
      for (int ni = 0; ni < 4; ++ni) bfr[ni] = *(const bf16x8*)(Bs + (wc * 64 + ni * 16 + fr) * LDT + ks * 32 + fq * 8);
#pragma unroll
      for (int mi = 0; mi < 4; ++mi)
#pragma unroll
        for (int ni = 0; ni < 4; ++ni) acc[mi][ni] = __builtin_amdgcn_mfma_f32_16x16x32_bf16(bfr[ni], af[mi], acc[mi][ni], 0, 0, 0);
    }
  }
  __syncthreads();
}

DI void zero_acc(f32x4 (&acc)[4][4]) {
#pragma unroll
  for (int mi = 0; mi < 4; ++mi)
#pragma unroll
    for (int ni = 0; ni < 4; ++ni) acc[mi][ni] = (f32x4){0.f, 0.f, 0.f, 0.f};
}

DI void tile_coords(int tile, int ntm, int ntn, int& tm, int& tn) {
  const int per = 8 * ntn;
  const int g = tile / per, rem = tile - g * per;
  const int gsz = (ntm - g * 8) < 8 ? (ntm - g * 8) : 8;
  tm = g * 8 + rem % gsz;
  tn = rem / gsz;
}

template <class BMap, class Epi>
DI void gemm_phase(const bf16_t* A, int lda, int M, const float* B, int ldb, int K, int N, BMap bmap, const Epi& epi, char* lds) {
  const int ntm = M >> 7, ntn = N >> 7, nt = ntm * ntn;
  const int lane = tid_() & 63, wid = tid_() >> 6;
  for (int tile = blockIdx.x; tile < nt; tile += gridDim.x) {
    int tm, tn;
    tile_coords(tile, ntm, ntn, tm, tn);
    f32x4 acc[4][4];
    zero_acc(acc);
    gemm_mainloop(A + (size_t)tm * 128 * lda, lda, B, ldb, K, tn, bmap, acc, lds);
    epi(tm, tn, wid >> 1, wid & 1, lane, acc);
  }
}

struct EpiAct {
  bf16_t* H;
  DI void operator()(int tm, int tn, int wr, int wc, int lane, f32x4 (&acc)[4][4]) const {
    const int fr = lane & 15, fq = lane >> 4;
#pragma unroll
    for (int mi = 0; mi < 4; ++mi) {
      const int row = tm * 128 + wr * 64 + mi * 16 + fr;
#pragma unroll
      for (int pr = 0; pr < 2; ++pr) {
        f32x4 g = acc[mi][2 * pr], u = acc[mi][2 * pr + 1], h;
#pragma unroll
        for (int j = 0; j < 4; ++j) h[j] = siluf_(g[j]) * u[j];
        st4bf(H + (size_t)row * DFF + tn * 64 + (wc * 2 + pr) * 16 + fq * 4, h);
      }
    }
  }
};

struct EpiResid {
  const float *src_lat, *src_ctx;
  float *dst_lat, *dst_ctx;
  const float* gate;
  float gmul;
  DI void operator()(int tm, int tn, int wr, int wc, int lane, f32x4 (&acc)[4][4]) const {
    const int fr = lane & 15, fq = lane >> 4;
    const int r0 = tm * 128;
    const bool lat = r0 < NTL;
    const float* s = lat ? src_lat + (size_t)r0 * DM : src_ctx + (size_t)(r0 - NTL) * DM;
    float* d = lat ? dst_lat + (size_t)r0 * DM : dst_ctx + (size_t)(r0 - NTL) * DM;
    const float* g = gate + (size_t)mod_row(r0) * NMOD;
#pragma unroll
    for (int ni = 0; ni < 4; ++ni) {
      const int col = tn * 128 + wc * 64 + ni * 16 + fq * 4;
      const f32x4 gv = *(const f32x4*)(g + col) * gmul;
#pragma unroll
      for (int mi = 0; mi < 4; ++mi) {
        const int rl = wr * 64 + mi * 16 + fr;
        const f32x4 xv = *(const f32x4*)(s + (size_t)rl * DM + col);
        *(f32x4*)(d + (size_t)rl * DM + col) = xv * ALPHA + gv * acc[mi][ni];
      }
    }
  }
};

struct EpiProj {
  const Params* p;
  int l;
  DI void operator()(int tm, int tn, int wr, int wc, int lane, f32x4 (&acc)[4][4]) const {
    const int fr = lane & 15, fq = lane >> 4;
    const int col0 = tn * 128 + wc * 64;
    const bool lat = tm * 128 < NTL;
    bf16_t* P = p->P;
    if (tn < 5) {
      const float* gain = (tn < 4 ? p->q_gain : p->k_gain) + l * 64;
      const float mult = tn < 4 ? QSCALE : 1.f;
      f32x4 gv[4];
#pragma unroll
      for (int ni = 0; ni < 4; ++ni) gv[ni] = *(const f32x4*)(gain + ni * 16 + fq * 4);
#pragma unroll
      for (int mi = 0; mi < 4; ++mi) {
        const int row = tm * 128 + wr * 64 + mi * 16 + fr;
        float ss = 0.f;
#pragma unroll
        for (int ni = 0; ni < 4; ++ni)
#pragma unroll
          for (int j = 0; j < 4; ++j) ss += acc[mi][ni][j] * acc[mi][ni][j];
        ss += __shfl_xor(ss, 16);
        ss += __shfl_xor(ss, 32);
        const float rinv = rsqrtf(ss * (1.f / 64.f) + 1e-6f);
        f32x4 v[4];
#pragma unroll
        for (int ni = 0; ni < 4; ++ni) v[ni] = acc[mi][ni] * rinv * gv[ni];
        if (lat) {
          const int t = row & (TL - 1);
          const int pr = t >> 6, pc = t & 63;
#pragma unroll
          for (int a = 0; a < 2; ++a) {
            const float* rt = p->rope + (size_t)((a ? pc : pr) * 16 + fq * 4) * 2;
            const f32x4 cs0 = *(const f32x4*)rt, cs1 = *(const f32x4*)(rt + 4);
            const float cc[4] = {cs0[0], cs0[2], cs1[0], cs1[2]};
            const float sn[4] = {cs0[1], cs0[3], cs1[1], cs1[3]};
#pragma unroll
            for (int j = 0; j < 4; ++j) {
              const float x1 = v[2 * a][j], x2 = v[2 * a + 1][j];
              v[2 * a][j] = x1 * cc[j] - x2 * sn[j];
              v[2 * a + 1][j] = x2 * cc[j] + x1 * sn[j];
            }
          }
        }
#pragma unroll
        for (int ni = 0; ni < 4; ++ni) st4bf(P + (size_t)row * DPROJ + col0 + ni * 16 + fq * 4, v[ni] * mult);
      }
    } else {
      const float mult = (tn >= 21 && tn < 25) ? QSCALE : 1.f;
#pragma unroll
      for (int mi = 0; mi < 4; ++mi) {
        const int row = tm * 128 + wr * 64 + mi * 16 + fr;
#pragma unroll
        for (int ni = 0; ni < 4; ++ni) st4bf(P + (size_t)row * DPROJ + col0 + ni * 16 + fq * 4, acc[mi][ni] * mult);
      }
    }
  }
};

DI f32x4 shifted4(const bf16_t* P, int row, bool hp, bool hn, int colidx, const float* mu_l) {
  const bf16_t* q = P + (size_t)row * DPROJ + 768 + colidx;
  const f32x4 x = ld4bf(q);
  const f32x4 xm = hp ? ld4bf(q - DPROJ) : (f32x4){0.f, 0.f, 0.f, 0.f};
  const f32x4 xp = hn ? ld4bf(q + DPROJ) : (f32x4){0.f, 0.f, 0.f, 0.f};
  const f32x4 m0 = *(const f32x4*)(mu_l + colidx), m1 = *(const f32x4*)(mu_l + 1920 + colidx);
  return x + m0 * (xm - x) + m1 * (xp - x);
}

struct EpiReadout {
  const Params* p;
  int l;
  DI void operator()(int tm, int tn, int wr, int wc, int lane, f32x4 (&acc)[4][4]) const {
    const int fr = lane & 15, fq = lane >> 4;
    const int head = tn * 2 + wc, colh = head * 64;
    const float* mu_l = p->mu + (size_t)l * 2 * 1920;
    const float* rk = p->r_k + l * 512 + colh;
    const float* gg = p->gn_g + l * 512 + colh;
    const float* gb = p->gn_b + l * 512 + colh;
    const bf16_t* Of = p->Os;
    const bf16_t* Ob = p->Os + (size_t)NTOK * 512;
    u32x2 gp[4][4];
#pragma unroll
    for (int mi = 0; mi < 4; ++mi)
#pragma unroll
      for (int ni = 0; ni < 4; ++ni) { gp[mi][ni].x = pk2(acc[mi][ni][0], acc[mi][ni][1]); gp[mi][ni].y = pk2(acc[mi][ni][2], acc[mi][ni][3]); }
#pragma unroll
    for (int mi = 0; mi < 4; ++mi) {
      const int row = tm * 128 + wr * 64 + mi * 16 + fr;
      int t, L;
      if (row < NTL) { t = row & (TL - 1); L = TL; } else { t = (row - NTL) & (TC - 1); L = TC; }
      const bool hp = t > 0, hn = t < L - 1;
      f32x4 o[4];
      float s = 0.f, bs = 0.f;
#pragma unroll
      for (int ni = 0; ni < 4; ++ni) {
        const int c = ni * 16 + fq * 4;
        o[ni] = ld4bf(Of + (size_t)row * 512 + colh + c) + ld4bf(Ob + (size_t)row * 512 + colh + c);
        s += (o[ni][0] + o[ni][1]) + (o[ni][2] + o[ni][3]);
      }
#pragma unroll 1
      for (int ni = 0; ni < 4; ++ni) {
        const int c = ni * 16 + fq * 4;
        const f32x4 r4 = shifted4(p->P, row, hp, hn, colh + c, mu_l);
        const f32x4 k4 = shifted4(p->P, row, hp, hn, 512 + colh + c, mu_l);
        const f32x4 rk4 = *(const f32x4*)(rk + c);
        const f32x4 pr = r4 * k4 * rk4;
        bs += (pr[0] + pr[1]) + (pr[2] + pr[3]);
      }
      s += __shfl_xor(s, 16); s += __shfl_xor(s, 32);
      bs += __shfl_xor(bs, 16); bs += __shfl_xor(bs, 32);
      const float mean = s * (1.f / 64.f);
      float q = 0.f;
#pragma unroll
      for (int ni = 0; ni < 4; ++ni) {
        const f32x4 d = o[ni] - mean;
        q += (d[0] * d[0] + d[1] * d[1]) + (d[2] * d[2] + d[3] * d[3]);
      }
      q += __shfl_xor(q, 16); q += __shfl_xor(q, 32);
      const float rstd = rsqrtf(q * (1.f / 64.f) + 64e-5f);
#pragma unroll
      for (int ni = 0; ni < 4; ++ni) {
        const int c = ni * 16 + fq * 4;
        const f32x4 g4 = *(const f32x4*)(gg + c), b4 = *(const f32x4*)(gb + c);
        const f32x4 vv = shifted4(p->P, row, hp, hn, 1024 + colh + c, mu_l);
        const f32x4 gate = {bflo(gp[mi][ni].x), bfhi(gp[mi][ni].x), bflo(gp[mi][ni].y), bfhi(gp[mi][ni].y)};
        const f32x4 y = ((o[ni] - mean) * rstd * g4 + b4 + vv * bs) * gate;
        st4bf(p->yr + (size_t)row * 512 + colh + c, y);
      }
    }
  }
};

DI float wave_sum(float v) {
#pragma unroll
  for (int o = 32; o > 0; o >>= 1) v += __shfl_xor(v, o);
  return v;
}

DI void ln_phase(float* xl, float* xc, int M, const float* g, const float* b, const float* mods_l, int shift_idx, bf16_t* U) {
  const int lane = tid_() & 63, wid = tid_() >> 6;
  for (int row = blockIdx.x * 4 + wid; row < M; row += gridDim.x * 4) {
    float* xr = row < NTL ? xl + (size_t)row * DM : xc + (size_t)(row - NTL) * DM;
    f32x4 v[4];
    float s = 0.f;
#pragma unroll
    for (int i = 0; i < 4; ++i) { v[i] = *(const f32x4*)(xr + i * 256 + lane * 4); s += (v[i][0] + v[i][1]) + (v[i][2] + v[i][3]); }
    const float mean = wave_sum(s) * (1.f / 1024.f);
    float q = 0.f;
#pragma unroll
    for (int i = 0; i < 4; ++i) { const f32x4 d = v[i] - mean; q += (d[0] * d[0] + d[1] * d[1]) + (d[2] * d[2] + d[3] * d[3]); }
    const float rstd = rsqrtf(wave_sum(q) * (1.f / 1024.f) + 1e-5f);
    const float* mr = mods_l + (size_t)mod_row(row) * NMOD + shift_idx * DM;
#pragma unroll
    for (int i = 0; i < 4; ++i) {
      const int c = i * 256 + lane * 4;
      const f32x4 y = (v[i] - mean) * rstd * *(const f32x4*)(g + c) + *(const f32x4*)(b + c);
      *(f32x4*)(xr + c) = y;
      if (U) {
        const f32x4 sh = *(const f32x4*)(mr + c), sc = *(const f32x4*)(mr + DM + c);
        st4bf(U + (size_t)row * DM + c, y * (sc + 1.f) + sh);
      }
    }
  }
}

DI void u0_phase(const Params& p) {
  const int lane = tid_() & 63, wid = tid_() >> 6;
  for (int row = blockIdx.x * 4 + wid; row < NTOK; row += gridDim.x * 4) {
    const float* xr = row < NTL ? p.x_in + (size_t)row * DM : p.ctx_in + (size_t)(row - NTL) * DM;
    const float* mr = p.mods + (size_t)mod_row(row) * NMOD;
#pragma unroll
    for (int i = 0; i < 4; ++i) {
      const int c = i * 256 + lane * 4;
      const f32x4 y = *(const f32x4*)(xr + c);
      const f32x4 sh = *(const f32x4*)(mr + c), sc = *(const f32x4*)(mr + DM + c);
      st4bf(p.U + (size_t)row * DM + c, y * (sc + 1.f) + sh);
    }
  }
}

DI void mods_phase(const Params& p, char* lds) {
  float* sc = (float*)lds;
  float* red = sc + 256 * 20;
  const int tid = tid_(), lane = tid & 63, wid = tid >> 6;
  if (blockIdx.x == 0) {
    if (tid < 64) p.counters[tid] = 0u;
    for (int i = tid; i < 1024; i += NTHREADS) {
      const int pos = i >> 4, k = i & 15;
      const float inv = exp2f(-(float)k * (1.f / 16.f) * 13.287712379549449f);
      const float ang = (float)pos * inv;
      p.rope[i * 2] = cosf(ang);
      p.rope[i * 2 + 1] = sinf(ang);
    }
  }
  for (int tile = blockIdx.x; tile < 288; tile += gridDim.x) {
    const int l = tile / 144, col0 = (tile % 144) * 64;
    float acc[17];
#pragma unroll
    for (int r = 0; r < 17; ++r) acc[r] = 0.f;
    for (int kc = 0; kc < 4; ++kc) {
      __syncthreads();
      for (int i = tid; i < 17 * 256; i += NTHREADS) {
        const int r = i >> 8, kk = i & 255;
        const float v = r < 16 ? p.c[r * DM + kc * 256 + kk] : p.c_ctx[kc * 256 + kk];
        sc[kk * 20 + r] = siluf_(v);
      }
      __syncthreads();
      const float* wp = p.w_ada + ((size_t)l * DM + kc * 256 + wid * 64) * NMOD + col0 + lane;
      for (int kk = 0; kk < 64; ++kk) {
        const float wv = wp[(size_t)kk * NMOD];
        const float* s = sc + (wid * 64 + kk) * 20;
#pragma unroll
        for (int r = 0; r < 17; ++r) acc[r] += s[r] * wv;
      }
    }
    __syncthreads();
#pragma unroll
    for (int r = 0; r < 17; ++r) red[(wid * 17 + r) * 64 + lane] = acc[r];
    __syncthreads();
    for (int i = tid; i < 17 * 64; i += NTHREADS) {
      const int r = i >> 6, cl = i & 63;
      const float s = red[(0 * 17 + r) * 64 + cl] + red[(1 * 17 + r) * 64 + cl] + red[(2 * 17 + r) * 64 + cl] + red[(3 * 17 + r) * 64 + cl];
      p.mods[((size_t)l * 17 + r) * NMOD + col0 + cl] = s + p.b_ada[l * NMOD + col0 + cl];
    }
  }
  __syncthreads();
}

DI void sg_phase(const Params& p, int l) {
  const int lane = tid_() & 63, wid = tid_() >> 6;
  const float* mu_l = p.mu + (size_t)l * 2 * 1920;
  for (int idx = blockIdx.x * NTHREADS + tid_(); idx < NTOK * 32; idx += gridDim.x * NTHREADS) {
    const int row = idx >> 5, c = (idx & 31) * 4;
    int t, L;
    if (row < NTL) { t = row & (TL - 1); L = TL; } else { t = (row - NTL) & (TC - 1); L = TC; }
    const f32x4 x = shifted4(p.P, row, t > 0, t < L - 1, 1792 + c, mu_l);
    f32x4 y;
#pragma unroll
    for (int j = 0; j < 4; ++j) y[j] = sigmoidf_(x[j]);
    st4bf(p.sg + (size_t)row * 128 + c, y);
  }
  (void)lane; (void)wid;
}

constexpr int KLD = 72;
constexpr int VLD = 68;

struct NoMask { DI void operator()(f32x16 (&st)[2]) const {} };

struct NaMask {
  const float* rp;
  int c;
  int c0;
  int h;
  DI void operator()(f32x16 (&st)[2]) const {
#pragma unroll
    for (int u = 0; u < 2; ++u)
#pragma unroll
      for (int i = 0; i < 16; ++i) {
        const int kc = u * 32 + (i & 3) + 8 * (i >> 2) + 4 * h;
        const bool ok = (kc >= c0) && (kc < c0 + 16);
        const int bi = ok ? (kc - c + 15) : 15;
        const float bias = rp[bi];
        st[u][i] = ok ? st[u][i] + bias : -1e30f;
      }
  }
};

template <class Mask>
DI void attn_tile(const bf16_t* Ks, const bf16_t* Vt, const bf16x8 (&qf)[4], f32x16 (&ot)[2], float& m, float& l, const Mask& mask, int lane) {
  const int r = lane & 31, h = lane >> 5;
  f32x16 st[2];
#pragma unroll
  for (int u = 0; u < 2; ++u) {
#pragma unroll
    for (int i = 0; i < 16; ++i) st[u][i] = 0.f;
#pragma unroll
    for (int s = 0; s < 4; ++s) {
      const bf16x8 kf = *(const bf16x8*)(Ks + (u * 32 + r) * KLD + s * 16 + h * 8);
      st[u] = __builtin_amdgcn_mfma_f32_32x32x16_bf16(kf, qf[s], st[u], 0, 0, 0);
    }
  }
  mask(st);
  float mx = st[0][0];
#pragma unroll
  for (int u = 0; u < 2; ++u)
#pragma unroll
    for (int i = 0; i < 16; ++i) mx = fmaxf(mx, st[u][i]);
  mx = fmaxf(mx, __shfl_xor(mx, 32));
  const float mnew = fmaxf(m, mx);
  const float alpha = exp2f(m - mnew);
  m = mnew;
  float ls = 0.f;
#pragma unroll
  for (int u = 0; u < 2; ++u)
#pragma unroll
    for (int i = 0; i < 16; ++i) { st[u][i] = exp2f(st[u][i] - mnew); ls += st[u][i]; }
  l = l * alpha + ls;
#pragma unroll
  for (int dt = 0; dt < 2; ++dt)
#pragma unroll
    for (int i = 0; i < 16; ++i) ot[dt][i] *= alpha;
#pragma unroll
  for (int u = 0; u < 2; ++u)
#pragma unroll
    for (int s = 0; s < 2; ++s) {
      u32x4 pw;
      pw.x = pk2(st[u][8 * s + 0], st[u][8 * s + 1]); pw.y = pk2(st[u][8 * s + 2], st[u][8 * s + 3]);
      pw.z = pk2(st[u][8 * s + 4], st[u][8 * s + 5]); pw.w = pk2(st[u][8 * s + 6], st[u][8 * s + 7]);
      const bf16x8 pb = __builtin_bit_cast(bf16x8, pw);
#pragma unroll
      for (int dt = 0; dt < 2; ++dt) {
        const bf16_t* vp = Vt + (dt * 32 + r) * VLD + u * 32 + 16 * s + 4 * h;
        const s16x4 lo = *(const s16x4*)vp, hi = *(const s16x4*)(vp + 8);
        const bf16x8 va = __builtin_shufflevector(lo, hi, 0, 1, 2, 3, 4, 5, 6, 7);
        ot[dt] = __builtin_amdgcn_mfma_f32_32x32x16_bf16(va, pb, ot[dt], 0, 0, 0);
      }
    }
}

template <int NHB>
DI void kv_load(const bf16_t* kb, const bf16_t* vb, u32x4 (&kr)[NHB * 2], u32x4 (&vr)[NHB * 2]) {
#pragma unroll
  for (int i = 0; i < NHB * 2; ++i) {
    const int c = tid_() + i * NTHREADS;
    const int hh = c >> 9, cc = c & 511, key = cc >> 3, dc = cc & 7;
    const size_t off = (size_t)key * DPROJ + hh * 64 + dc * 8;
    kr[i] = *(const u32x4*)(kb + off);
    vr[i] = *(const u32x4*)(vb + off);
  }
}
template <int NHB>
DI void kv_store(bf16_t* Ks, bf16_t* Vt, const u32x4 (&kr)[NHB * 2], const u32x4 (&vr)[NHB * 2]) {
#pragma unroll
  for (int i = 0; i < NHB * 2; ++i) {
    const int c = tid_() + i * NTHREADS;
    const int hh = c >> 9, cc = c & 511, key = cc >> 3, dc = cc & 7;
    *(u32x4*)(Ks + hh * 64 * KLD + key * KLD + dc * 8) = kr[i];
    bf16_t* vt = Vt + hh * 64 * VLD + (dc * 8) * VLD + key;
    vt[0 * VLD] = (bf16_t)(vr[i].x & 0xffff); vt[1 * VLD] = (bf16_t)(vr[i].x >> 16);
    vt[2 * VLD] = (bf16_t)(vr[i].y & 0xffff); vt[3 * VLD] = (bf16_t)(vr[i].y >> 16);
    vt[4 * VLD] = (bf16_t)(vr[i].z & 0xffff); vt[5 * VLD] = (bf16_t)(vr[i].z >> 16);
    vt[6 * VLD] = (bf16_t)(vr[i].w & 0xffff); vt[7 * VLD] = (bf16_t)(vr[i].w >> 16);
  }
}

DI void attn_finish(bf16_t* outp  , f32x16 (&ot)[2], float l, int lane) {
  const int h = lane >> 5;
  l += __shfl_xor(l, 32);
  const float inv = 1.f / l;
#pragma unroll
  for (int dt = 0; dt < 2; ++dt)
#pragma unroll
    for (int g = 0; g < 4; ++g) {
      f32x4 v = {ot[dt][4 * g] * inv, ot[dt][4 * g + 1] * inv, ot[dt][4 * g + 2] * inv, ot[dt][4 * g + 3] * inv};
      st4bf(outp + dt * 32 + 8 * g + 4 * h, v);
    }
}

DI void dense_item(const Params& p, int qrow0, int qcol, int krow_lat0, int ntl, int krow_ctx0, int kcol, int vcol, char* lds) {
  bf16_t* Ks = (bf16_t*)lds;
  bf16_t* Vt = Ks + 2 * 64 * KLD;
  const int lane = tid_() & 63, wid = tid_() >> 6, r = lane & 31, h = lane >> 5;
  bf16_t* qp = p.P + (size_t)(qrow0 + wid * 32 + r) * DPROJ + qcol;
  bf16x8 qf[4];
#pragma unroll
  for (int s = 0; s < 4; ++s) qf[s] = *(const bf16x8*)(qp + s * 16 + h * 8);
  f32x16 ot[2];
#pragma unroll
  for (int dt = 0; dt < 2; ++dt)
#pragma unroll
    for (int i = 0; i < 16; ++i) ot[dt][i] = 0.f;
  float m = -1e30f, l = 0.f;
  const int nt = ntl + 4;
  u32x4 kr[2], vr[2];
  auto tile_row = [&](int jt) { return jt < ntl ? krow_lat0 + jt * 64 : krow_ctx0 + (jt - ntl) * 64; };
  {
    const bf16_t* base = p.P + (size_t)tile_row(0) * DPROJ;
    kv_load<1>(base + kcol, base + vcol, kr, vr);
  }
  for (int jt = 0; jt < nt; ++jt) {
    __syncthreads();
    kv_store<1>(Ks, Vt, kr, vr);
    __syncthreads();
    if (jt + 1 < nt) {
      const bf16_t* base = p.P + (size_t)tile_row(jt + 1) * DPROJ;
      kv_load<1>(base + kcol, base + vcol, kr, vr);
    }
    attn_tile(Ks, Vt, qf, ot, m, l, NoMask(), lane);
  }
  attn_finish(qp, ot, l, lane);
  __syncthreads();
}

DI void na_item(const Params& p, int lyr, int b, int gr, int hp, char* lds) {
  bf16_t* Ks = (bf16_t*)lds;
  bf16_t* Vt = Ks + 2 * 64 * KLD;
  float* rpl = (float*)(Vt + 2 * 64 * VLD);
  const int tid = tid_(), lane = tid & 63, wid = tid >> 6, r = lane & 31, h = lane >> 5;
  const int hl = wid >> 1, head = hp * 2 + hl, qh = wid & 1;
  const int r0 = gr - 4 < 0 ? 0 : (gr - 4 > 24 ? 24 : gr - 4);
  __syncthreads();
  for (int i = tid; i < 2 * 465; i += NTHREADS) {
    const int hh = i / 465, e = i - hh * 465;
    rpl[i] = p.rpb[((size_t)lyr * 8 + hp * 2 + hh) * 465 + e] * LOG2E;
  }
  const int c = qh * 32 + r;
  const int c0 = c - 8 < 0 ? 0 : (c - 8 > 48 ? 48 : c - 8);
  bf16_t* qp = p.P + (size_t)(b * TL + gr * 64 + c) * DPROJ + 2688 + head * 64;
  bf16x8 qf[4];
#pragma unroll
  for (int s = 0; s < 4; ++s) qf[s] = *(const bf16x8*)(qp + s * 16 + h * 8);
  f32x16 ot[2];
#pragma unroll
  for (int dt = 0; dt < 2; ++dt)
#pragma unroll
    for (int i = 0; i < 16; ++i) ot[dt][i] = 0.f;
  float m = -1e30f, l = 0.f;
  u32x4 kr[4], vr[4];
  auto tile_row = [&](int jt) { return jt < 8 ? b * TL + (r0 + jt) * 64 : NTL + b * TC + (jt - 8) * 64; };
  const int kcol = 3200 + hp * 128, vcol = 3712 + hp * 128;
  {
    const bf16_t* base = p.P + (size_t)tile_row(0) * DPROJ;
    kv_load<2>(base + kcol, base + vcol, kr, vr);
  }
  for (int jt = 0; jt < 12; ++jt) {
    __syncthreads();
    kv_store<2>(Ks, Vt, kr, vr);
    __syncthreads();
    if (jt + 1 < 12) {
      const bf16_t* base = p.P + (size_t)tile_row(jt + 1) * DPROJ;
      kv_load<2>(base + kcol, base + vcol, kr, vr);
    }
    if (jt < 8) {
      NaMask mk;
      mk.rp = rpl + hl * 465 + (r0 + jt - gr + 7) * 31;
      mk.c = c; mk.c0 = c0; mk.h = h;
      attn_tile(Ks + hl * 64 * KLD, Vt + hl * 64 * VLD, qf, ot, m, l, mk, lane);
    } else {
      attn_tile(Ks + hl * 64 * KLD, Vt + hl * 64 * VLD, qf, ot, m, l, NoMask(), lane);
    }
  }
  attn_finish(qp, ot, l, lane);
  __syncthreads();
}

template <int CTRL>
DI float dpp_f(float x) { return __int_as_float(__builtin_amdgcn_update_dpp(0, __float_as_int(x), CTRL, 0xF, 0xF, true)); }
DI float red8(float x) {
  x += dpp_f<0xB1>(x);
  x += dpp_f<0x4E>(x);
  x += dpp_f<0x141>(x);
  return x;
}

struct ScanOps { f32x4 w[2], kk[2], b[2], kd[2], r[2]; f32x2 v; };
DI void scan_load(ScanOps& o, const float* base, int kg, int row0) {
#pragma unroll
  for (int i = 0; i < 2; ++i) {
    o.w[i] = *(const f32x4*)(base + kg * 8 + i * 4);
    o.kk[i] = *(const f32x4*)(base + 64 + kg * 8 + i * 4);
    o.b[i] = *(const f32x4*)(base + 128 + kg * 8 + i * 4);
    o.kd[i] = *(const f32x4*)(base + 192 + kg * 8 + i * 4);
    o.r[i] = *(const f32x4*)(base + 256 + kg * 8 + i * 4);
  }
  o.v = *(const f32x2*)(base + 320 + row0);
}

DI void scan_block(const Params& p, int lyr, int sidx, bool need_ctx, char* lds) {
  const int dir = sidx & 1, hd = (sidx >> 1) & 7, b = sidx >> 4;
  const int tid = tid_(), lane = tid & 63, w = tid >> 6;
  float* rec = (float*)lds;
  float* obuf = rec + 16 * 384;
  float* cst = obuf + 16 * 64;
  bf16_t* Aw = (bf16_t*)(cst + 14 * 64);
  bf16_t* Aa = Aw + 16 * 72;
  __syncthreads();
  for (int i = tid; i < 320; i += NTHREADS) {
    const int g = i >> 6, c = i & 63;
    const int colidx = (g < 3 ? g * 512 + hd * 64 : (g == 3 ? 1536 + dir * 64 : 1664 + dir * 64)) + c;
    cst[i] = p.mu[(size_t)lyr * 3840 + colidx];
    cst[320 + i] = p.mu[(size_t)lyr * 3840 + 1920 + colidx];
  }
  if (tid < 64) {
    cst[640 + tid] = p.w0[(lyr * 2 + dir) * 512 + hd * 64 + tid];
    cst[704 + tid] = p.a0[(lyr * 2 + dir) * 512 + hd * 64 + tid];
    cst[768 + tid] = p.k_k[lyr * 512 + hd * 64 + tid];
    cst[832 + tid] = p.k_a[lyr * 512 + hd * 64 + tid];
  }
  const int fr = lane & 15, fq = lane >> 4;
  bf16x8 bw[2], ba[2];
  {
    const float* w2p = p.w2 + (size_t)(lyr * 2 + dir) * 64 * 512 + hd * 64 + 16 * w + fr;
    const float* a2p = p.a2 + (size_t)(lyr * 2 + dir) * 64 * 512 + hd * 64 + 16 * w + fr;
#pragma unroll
    for (int ks = 0; ks < 2; ++ks) {
      u32x4 tw, ta;
      float xw[8], xa[8];
#pragma unroll
      for (int j = 0; j < 8; ++j) { xw[j] = w2p[(size_t)(ks * 32 + fq * 8 + j) * 512]; xa[j] = a2p[(size_t)(ks * 32 + fq * 8 + j) * 512]; }
      tw.x = pk2(xw[0], xw[1]); tw.y = pk2(xw[2], xw[3]); tw.z = pk2(xw[4], xw[5]); tw.w = pk2(xw[6], xw[7]);
      ta.x = pk2(xa[0], xa[1]); ta.y = pk2(xa[2], xa[3]); ta.z = pk2(xa[4], xa[5]); ta.w = pk2(xa[6], xa[7]);
      bw[ks] = __builtin_bit_cast(bf16x8, tw);
      ba[ks] = __builtin_bit_cast(bf16x8, ta);
    }
  }
  f32x4 S[2][2];
#pragma unroll
  for (int a = 0; a < 2; ++a)
#pragma unroll
    for (int i = 0; i < 2; ++i) S[a][i] = (f32x4){0.f, 0.f, 0.f, 0.f};
  const int kg = lane & 7, rp = lane >> 3, row0 = 16 * w + rp * 2;
  const int pj = tid >> 4, pcg = tid & 15;
  int goff[5] = {hd * 64, 512 + hd * 64, 1024 + hd * 64, 1536 + dir * 64, 1664 + dir * 64};
  u32x2 raw[5][3];
  auto chunk_tok = [&](int ch, int j, int& rowbase, int& t, int& L) {
    int n0;
    if (ch < 16) { L = TC; n0 = ch * 16; rowbase = NTL + b * TC; } else { L = TL; n0 = (ch - 16) * 16; rowbase = b * TL; }
    const int n = n0 + j;
    t = dir ? L - 1 - n : n;
  };
  auto prefetch = [&](int ch) {
    int rowbase, t, L;
    chunk_tok(ch, pj, rowbase, t, L);
    const bf16_t* q = p.P + (size_t)(rowbase + t) * DPROJ + 768 + pcg * 4;
#pragma unroll
    for (int g = 0; g < 5; ++g) {
      raw[g][1] = *(const u32x2*)(q + goff[g]);
      raw[g][0] = t > 0 ? *(const u32x2*)(q + goff[g] - DPROJ) : (u32x2){0u, 0u};
      raw[g][2] = t < L - 1 ? *(const u32x2*)(q + goff[g] + DPROJ) : (u32x2){0u, 0u};
    }
  };
  prefetch(0);
  __syncthreads();
  for (int ch = 0; ch < 144; ++ch) {
    {
      f32x4 xs[5];
#pragma unroll
      for (int g = 0; g < 5; ++g) {
        const f32x4 x = {bflo(raw[g][1].x), bfhi(raw[g][1].x), bflo(raw[g][1].y), bfhi(raw[g][1].y)};
        const f32x4 xm = {bflo(raw[g][0].x), bfhi(raw[g][0].x), bflo(raw[g][0].y), bfhi(raw[g][0].y)};
        const f32x4 xp = {bflo(raw[g][2].x), bfhi(raw[g][2].x), bflo(raw[g][2].y), bfhi(raw[g][2].y)};
        const f32x4 m0 = *(const f32x4*)(cst + g * 64 + pcg * 4), m1 = *(const f32x4*)(cst + 320 + g * 64 + pcg * 4);
        xs[g] = x + m0 * (xm - x) + m1 * (xp - x);
      }
      float* rj = rec + pj * 384;
      *(f32x4*)(rj + 256 + pcg * 4) = xs[0];
      *(f32x4*)(rj + 320 + pcg * 4) = xs[2];
      const f32x4 kx = xs[1] * *(const f32x4*)(cst + 768 + pcg * 4);
      float ss = (kx[0] * kx[0] + kx[1] * kx[1]) + (kx[2] * kx[2] + kx[3] * kx[3]);
      ss += __shfl_xor(ss, 1); ss += __shfl_xor(ss, 2); ss += __shfl_xor(ss, 4); ss += __shfl_xor(ss, 8);
      const float rn = rsqrtf(ss + 1e-12f);
      *(f32x4*)(rj + 64 + pcg * 4) = kx * rn;
      *(f32x4*)(rj + 192 + pcg * 4) = xs[1];
      f32x4 tw;
#pragma unroll
      for (int j = 0; j < 4; ++j) tw[j] = tanhf(xs[3][j]);
      st4bf(Aw + pj * 72 + pcg * 4, tw);
      st4bf(Aa + pj * 72 + pcg * 4, xs[4]);
    }
    __syncthreads();
    {
      f32x4 aw = {0.f, 0.f, 0.f, 0.f}, aa = {0.f, 0.f, 0.f, 0.f};
#pragma unroll
      for (int ks = 0; ks < 2; ++ks) {
        const bf16x8 fw = *(const bf16x8*)(Aw + fr * 72 + ks * 32 + fq * 8);
        const bf16x8 fa = *(const bf16x8*)(Aa + fr * 72 + ks * 32 + fq * 8);
        aw = __builtin_amdgcn_mfma_f32_16x16x32_bf16(bw[ks], fw, aw, 0, 0, 0);
        aa = __builtin_amdgcn_mfma_f32_16x16x32_bf16(ba[ks], fa, aa, 0, 0, 0);
      }
      const int c = 16 * w + fq * 4;
      float* rj = rec + fr * 384;
      const f32x4 w0v = *(const f32x4*)(cst + 640 + c), a0v = *(const f32x4*)(cst + 704 + c), kav = *(const f32x4*)(cst + 832 + c);
      const f32x4 kkv = *(const f32x4*)(rj + 64 + c), kpv = *(const f32x4*)(rj + 192 + c);
      f32x4 dec, bb, kd;
#pragma unroll
      for (int j = 0; j < 4; ++j) {
        const float z = -(w0v[j] + aw[j]);
        const float sp = fmaxf(z, 0.f) + log1pf(__expf(-fabsf(z)));
        const float wl = -sp - 0.5f;
        dec[j] = __expf(-__expf(wl));
        const float ic = sigmoidf_(a0v[j] + aa[j]);
        bb[j] = kkv[j] * ic;
        kd[j] = kpv[j] * (1.f + (ic - 1.f) * kav[j]);
      }
      *(f32x4*)(rj + c) = dec;
      *(f32x4*)(rj + 128 + c) = bb;
      *(f32x4*)(rj + 192 + c) = kd;
    }
    __syncthreads();
    if (ch + 1 < 144) prefetch(ch + 1);
    {
      ScanOps cur, nxt;
      scan_load(cur, rec, kg, row0);
#pragma unroll 2
      for (int j = 0; j < 16; ++j) {
        if (j + 1 < 16) scan_load(nxt, rec + (j + 1) * 384, kg, row0);
#pragma unroll
        for (int a = 0; a < 2; ++a) {
          f32x4 t0 = S[a][0] * cur.kk[0] + S[a][1] * cur.kk[1];
          float sap = red8((t0[0] + t0[1]) + (t0[2] + t0[3]));
          const float vv = a ? cur.v.y : cur.v.x;
          S[a][0] = S[a][0] * cur.w[0] - cur.b[0] * sap + cur.kd[0] * vv;
          S[a][1] = S[a][1] * cur.w[1] - cur.b[1] * sap + cur.kd[1] * vv;
          f32x4 t1 = S[a][0] * cur.r[0] + S[a][1] * cur.r[1];
          float o = red8((t1[0] + t1[1]) + (t1[2] + t1[3]));
          if (kg == 0) obuf[j * 64 + row0 + a] = o;
        }
        cur = nxt;
      }
    }
    __syncthreads();
    if (ch >= 16 || need_ctx) {
      int rowbase, t, L;
      chunk_tok(ch, pj, rowbase, t, L);
      const f32x4 ov = *(const f32x4*)(obuf + pj * 64 + pcg * 4);
      st4bf(p.Os + ((size_t)dir * NTOK + rowbase + t) * 512 + hd * 64 + pcg * 4, ov);
    }
  }
  __syncthreads();
}

DI void mixer_phase(const Params& p, int l, bool need_ctx, char* lds) {
  __shared__ int s_item;
  sg_phase(p, l);
  for (int s = blockIdx.x; s < 256; s += gridDim.x) scan_block(p, l, s, need_ctx, lds);
  const int nitems = 4096 + (need_ctx ? 512 : 0);
  while (true) {
    __syncthreads();
    if (tid_() == 0) s_item = (int)atomicAdd(&p.counters[l], 1u);
    __syncthreads();
    const int it = s_item;
    if (it >= nitems) break;
    if (it < 2048) {
      const int b = it >> 7, head = (it >> 4) & 7, qb = it & 15, kvh = head >> 2;
      dense_item(p, b * TL + qb * 128, head * 64, b * TL, 32, NTL + b * TC, 512 + kvh * 64, 640 + kvh * 64, lds);
    } else if (it < 4096) {
      const int i2 = it - 2048;
      const int b = i2 >> 7, gr = (i2 >> 2) & 31, hp = i2 & 3;
      na_item(p, l, b, gr, hp, lds);
    } else if (it < 4352) {
      const int i2 = it - 4096;
      const int b = i2 >> 4, head = (i2 >> 1) & 7, qb = i2 & 1, kvh = head >> 2;
      dense_item(p, NTL + b * TC + qb * 128, head * 64, 0, 0, NTL + b * TC, 512 + kvh * 64, 640 + kvh * 64, lds);
    } else {
      const int i2 = it - 4352;
      const int b = i2 >> 4, head = (i2 >> 1) & 7, qb = i2 & 1;
      dense_item(p, NTL + b * TC + qb * 128, 2688 + head * 64, 0, 0, NTL + b * TC, 3200 + head * 64, 3712 + head * 64, lds);
    }
  }
}

DI void merge_phase(const Params& p, int l, int M, char* lds) {
  const int ntm = M >> 7, ntn = 8, nt = ntm * ntn;
  const int lane = tid_() & 63, wid = tid_() >> 6, wr = wid >> 1, wc = wid & 1, fr = lane & 15, fq = lane >> 4;
  for (int tile = blockIdx.x; tile < nt; tile += gridDim.x) {
    int tm, tn;
    tile_coords(tile, ntm, ntn, tm, tn);
#pragma unroll 1
    for (int z = 0; z < 3; ++z) {
      u32x2 gp[4][4];
      {
        f32x4 acc[4][4];
        zero_acc(acc);
        gemm_mainloop(p.U + (size_t)tm * 128 * DM, DM, p.w_in + (size_t)l * DM * DIN + DPROJ + z * DM, DIN, DM, tn, MapPlain(), acc, lds);
#pragma unroll
        for (int mi = 0; mi < 4; ++mi)
#pragma unroll
          for (int ni = 0; ni < 4; ++ni) {
            gp[mi][ni].x = pk2(sigmoidf_(acc[mi][ni][0]), sigmoidf_(acc[mi][ni][1]));
            gp[mi][ni].y = pk2(sigmoidf_(acc[mi][ni][2]), sigmoidf_(acc[mi][ni][3]));
          }
      }
      {
        f32x4 acc[4][4];
        zero_acc(acc);
        const bf16_t* Ya = z == 1 ? p.yr : (z == 0 ? p.P : p.P + 2688);
        const int lda = z == 1 ? 512 : DPROJ;
        gemm_mainloop(Ya + (size_t)tm * 128 * lda, lda, p.w_branch + (size_t)(l * 3 + z) * 512 * DM, DM, 512, tn, MapPlain(), acc, lds);
#pragma unroll
        for (int mi = 0; mi < 4; ++mi)
#pragma unroll
          for (int ni = 0; ni < 4; ++ni) asm volatile("" : "+v"(gp[mi][ni].x), "+v"(gp[mi][ni].y));
#pragma unroll
        for (int mi = 0; mi < 4; ++mi) {
          const int row = tm * 128 + wr * 64 + mi * 16 + fr;
#pragma unroll
          for (int ni = 0; ni < 4; ++ni) {
            bf16_t* mp = p.Mg + (size_t)row * DM + tn * 128 + wc * 64 + ni * 16 + fq * 4;
            const f32x4 g = {bflo(gp[mi][ni].x), bfhi(gp[mi][ni].x), bflo(gp[mi][ni].y), bfhi(gp[mi][ni].y)};
            f32x4 mn = g * acc[mi][ni];
            if (z > 0) mn += ld4bf(mp);
            st4bf(mp, mn);
          }
        }
      }
    }
  }
}

template <int S>
DI void layer_step(const Params& p, int l, char* lds) {
  const bool last = l == 1;
  const bool need_ctx = !last;
  const int Mall = NTOK, Mx = need_ctx ? NTOK : NTL;
  const float* mods_l = p.mods + (size_t)l * 17 * NMOD;
  const float* src_lat = l == 0 ? p.x_in : p.out;
  const float* src_ctx = l == 0 ? p.ctx_in : p.ctxx;
  if constexpr (S == 0) {
    EpiAct e; e.H = p.H;
    gemm_phase(p.U, DM, Mall, p.ffn1_wi + (size_t)l * DM * 2 * DFF, 2 * DFF, DM, 2 * DFF, MapGateUp(), e, lds);
  } else if constexpr (S == 1) {
    EpiResid e; e.src_lat = src_lat; e.src_ctx = src_ctx; e.dst_lat = p.out; e.dst_ctx = p.ctxx; e.gate = mods_l + 2 * DM; e.gmul = 0.5f;
    gemm_phase(p.H, DFF, Mall, p.ffn1_wo + (size_t)l * DFF * DM, DM, DFF, DM, MapPlain(), e, lds);
  } else if constexpr (S == 2) {
    ln_phase(p.out, p.ctxx, Mall, p.ln_g + (l * 3 + 0) * DM, p.ln_b + (l * 3 + 0) * DM, mods_l, 3, p.U);
  } else if constexpr (S == 3) {
    EpiProj e; e.p = &p; e.l = l;
    gemm_phase(p.U, DM, Mall, p.w_in + (size_t)l * DM * DIN, DIN, DM, DPROJ, MapPlain(), e, lds);
  } else if constexpr (S == 4) {
    mixer_phase(p, l, need_ctx, lds);
  } else if constexpr (S == 5) {
    EpiReadout e; e.p = &p; e.l = l;
    gemm_phase(p.sg, 128, Mx, p.g2 + (size_t)l * 128 * 512, 512, 128, 512, MapPlain(), e, lds);
  } else if constexpr (S == 6) {
    merge_phase(p, l, Mx, lds);
  } else if constexpr (S == 7) {
    EpiResid e; e.src_lat = p.out; e.src_ctx = p.ctxx; e.dst_lat = p.out; e.dst_ctx = p.ctxx; e.gate = mods_l + 5 * DM; e.gmul = 1.f;
    gemm_phase(p.Mg, DM, Mx, p.w_out + (size_t)l * DM * DM, DM, DM, DM, MapPlain(), e, lds);
  } else if constexpr (S == 8) {
    ln_phase(p.out, p.ctxx, Mx, p.ln_g + (l * 3 + 1) * DM, p.ln_b + (l * 3 + 1) * DM, mods_l, 6, p.U);
  } else if constexpr (S == 9) {
    EpiAct e; e.H = p.H;
    gemm_phase(p.U, DM, Mx, p.ffn2_wi + (size_t)l * DM * 2 * DFF, 2 * DFF, DM, 2 * DFF, MapGateUp(), e, lds);
  } else if constexpr (S == 10) {
    EpiResid e; e.src_lat = p.out; e.src_ctx = p.ctxx; e.dst_lat = p.out; e.dst_ctx = p.ctxx; e.gate = mods_l + 8 * DM; e.gmul = 0.5f;
    gemm_phase(p.H, DFF, Mx, p.ffn2_wo + (size_t)l * DFF * DM, DM, DFF, DM, MapPlain(), e, lds);
  } else {
    ln_phase(p.out, p.ctxx, Mx, p.ln_g + (l * 3 + 2) * DM, p.ln_b + (l * 3 + 2) * DM, p.mods + (size_t)(last ? 0 : 1) * 17 * NMOD, 0, last ? nullptr : p.U);
  }
}

__global__ void __launch_bounds__(NTHREADS, 2) fwd_megakernel(Params p) {
  __shared__ __attribute__((aligned(16))) char lds[LDS_BYTES];
  cg::grid_group grid = cg::this_grid();
  mods_phase(p, lds);
  grid.sync();
  u0_phase(p);
  grid.sync();
#pragma unroll 1
  for (int l = 0; l < 2; ++l) {
    layer_step<0>(p, l, lds); grid.sync();
    layer_step<1>(p, l, lds); grid.sync();
    layer_step<2>(p, l, lds); grid.sync();
    layer_step<3>(p, l, lds); grid.sync();
    layer_step<4>(p, l, lds); grid.sync();
    layer_step<5>(p, l, lds); grid.sync();
    layer_step<6>(p, l, lds); grid.sync();
    layer_step<7>(p, l, lds); grid.sync();
    layer_step<8>(p, l, lds); grid.sync();
    layer_step<9>(p, l, lds); grid.sync();
    layer_step<10>(p, l, lds); grid.sync();
    layer_step<11>(p, l, lds);
    if (l == 0) grid.sync();
  }
}

extern "C" void kernel_launch(void* const* d_in, const int* in_sizes, int n_in, void* d_out, int out_size, void* d_ws, size_t ws_size,
                              hipStream_t stream) {
  static int grid_blocks = 0;
  if (!grid_blocks) {
    int dev = 0, cus = 0, per_cu = 0;
    hipGetDevice(&dev);
    hipDeviceGetAttribute(&cus, hipDeviceAttributeMultiprocessorCount, dev);
    hipOccupancyMaxActiveBlocksPerMultiprocessor(&per_cu, fwd_megakernel, NTHREADS, 0);
    if (per_cu < 1) per_cu = 1;
    grid_blocks = cus * per_cu;
  }
  Params p{};
  const float* const* in = (const float* const*)d_in;
  p.x_in = in[0]; p.c = in[1]; p.ctx_in = in[2]; p.c_ctx = in[3]; p.w_ada = in[4]; p.b_ada = in[5];
  p.ffn1_wi = in[6]; p.ffn1_wo = in[7]; p.ffn2_wi = in[8]; p.ffn2_wo = in[9]; p.ln_g = in[10]; p.ln_b = in[11]; p.w_in = in[12];
  p.q_gain = in[13]; p.k_gain = in[14]; p.mu = in[15]; p.w0 = in[16]; p.w2 = in[17]; p.a0 = in[18]; p.a2 = in[19]; p.g2 = in[20];
  p.k_k = in[21]; p.k_a = in[22]; p.r_k = in[23]; p.gn_g = in[24]; p.gn_b = in[25]; p.rpb = in[26]; p.w_branch = in[27]; p.w_out = in[28];
  p.out = (float*)d_out;
  char* ws = (char*)d_ws;
  const size_t MiB = 1ull << 20;
  p.counters = (unsigned*)ws;
  p.rope = (float*)(ws + 4096);
  p.mods = (float*)(ws + 65536);
  p.ctxx = (float*)(ws + 2 * MiB);
  p.U = (bf16_t*)(ws + 18 * MiB);
  p.H = (bf16_t*)(ws + 90 * MiB);
  p.P = (bf16_t*)(ws + 90 * MiB);
  p.Os = (bf16_t*)(ws + 387 * MiB);
  p.Mg = (bf16_t*)(ws + 387 * MiB);
  p.yr = (bf16_t*)(ws + 459 * MiB);
  p.sg = (bf16_t*)(ws + 495 * MiB);
  if (ws_size < 504 * MiB) fprintf(stderr, "workspace too small: %zu\n", ws_size);
  void* args[] = {&p};
  hipError_t e = hipLaunchCooperativeKernel((void*)fwd_megakernel, dim3(grid_blocks), dim3(NTHREADS), args, 0, stream);
  if (e != hipSuccess) fprintf(stderr, "cooperative launch failed: %s (grid %d)\n", hipGetErrorString(e), grid_blocks);
}
```

```cpp
#include <hip/hip_runtime.h>
#include <hip/hip_cooperative_groups.h>
#include <cstdio>
#include <cstdint>
namespace cg = cooperative_groups;

#define DI __device__ __forceinline__
typedef unsigned short bf16_t;
typedef short bf16x8 __attribute__((ext_vector_type(8)));
typedef short s16x4 __attribute__((ext_vector_type(4)));
typedef float f32x2 __attribute__((ext_vector_type(2)));
typedef float f32x4 __attribute__((ext_vector_type(4)));
typedef float f32x16 __attribute__((ext_vector_type(16)));
typedef unsigned u32x2 __attribute__((ext_vector_type(2)));
typedef unsigned u32x4 __attribute__((ext_vector_type(4)));
typedef __bf16 nbf16x2 __attribute__((ext_vector_type(2)));

constexpr int DM = 1024, NB = 16, TL = 2048, TC = 256;
constexpr int NTL = NB * TL, NTC = NB * TC, NTOK = NTL + NTC;
constexpr int DFF = 2816, DIN = 7296, DPROJ = 4224;
constexpr int NMOD = 9 * DM;
constexpr float LOG2E = 1.4426950408889634f;
constexpr float QSCALE = 0.125f * LOG2E;
constexpr float ALPHA = 1.4142135623730951f;
constexpr int LDS_BYTES = 65536;
constexpr size_t WM_IN = 0, WM_BR = (size_t)7296 * 1024, WM_OUT = WM_BR + 3 * 1024 * 512, WM_STRIDE = WM_OUT + 1024 * 1024;
constexpr size_t WF_WO = (size_t)2 * 2816 * 1024;
constexpr int NTHREADS = 256;

struct Params {
  const float *x_in, *c, *ctx_in, *c_ctx, *w_ada, *b_ada, *ffn1_wi, *ffn1_wo, *ffn2_wi, *ffn2_wo, *ln_g, *ln_b, *w_in,
      *q_gain, *k_gain, *mu, *w0, *w2, *a0, *a2, *g2, *k_k, *k_a, *r_k, *gn_g, *gn_b, *rpb, *w_branch, *w_out;
  float* out;
  float* mods;
  float* rope;
  float* ctxx;
  unsigned* counters;
  bf16_t *U, *H, *P, *Os, *yr, *Mg, *sg, *WF, *WM;
};

DI int tid_() { int t = threadIdx.x; asm volatile("" : "+v"(t)); return t; }
DI unsigned pk2(float a, float b) { f32x2 v = {a, b}; nbf16x2 r = __builtin_convertvector(v, nbf16x2); return __builtin_bit_cast(unsigned, r); }
DI bf16_t f2bf(float a) { return (bf16_t)(pk2(a, 0.f) & 0xffffu); }
DI float bflo(unsigned u) { return __uint_as_float(u << 16); }
DI float bfhi(unsigned u) { return __uint_as_float(u & 0xffff0000u); }
DI f32x4 ld4bf(const bf16_t* p) { u32x2 v = *(const u32x2*)p; return (f32x4){bflo(v.x), bfhi(v.x), bflo(v.y), bfhi(v.y)}; }
DI void st4bf(bf16_t* p, f32x4 v) { u32x2 o; o.x = pk2(v[0], v[1]); o.y = pk2(v[2], v[3]); *(u32x2*)p = o; }
DI float sigmoidf_(float x) { return 1.f / (1.f + __expf(-x)); }
DI float siluf_(float x) { return x / (1.f + __expf(-x)); }
DI int mod_row(int row) { return row < NTL ? (row >> 11) : 16; }

constexpr int LDT = 72;

struct MapPlain { DI int operator()(int tn, int cl) const { return tn * 128 + cl; } };
struct MapGateUp { DI int operator()(int tn, int cl) const { int sub = cl >> 4, j = cl & 15; return ((sub & 1) ? DFF : 0) + tn * 64 + (sub >> 1) * 16 + j; } };

template <class BMap>
DI void gemm_mainloop(const bf16_t* __restrict__ A, int lda, const float* __restrict__ B, int ldb, int K, int tn, BMap bmap,
                      f32x4 (&acc)[4][4], char* lds) {
  bf16_t* As = (bf16_t*)lds;
  bf16_t* Bs = As + 128 * LDT;
  const int tid = tid_(), lane = tid & 63, wid = tid >> 6, wr = wid >> 1, wc = wid & 1;
  const int fr = lane & 15, fq = lane >> 4;
  const int arow = tid >> 3, akc = tid & 7;
  const int kg = tid >> 5, ng = tid & 31;
  const bf16_t* ap = A + (size_t)arow * lda + akc * 8;
  const float* bp = B + (size_t)(kg * 8) * ldb + bmap(tn, ng * 4);
  u32x4 ra[4];
  f32x4 rb[8];
  const int nk = K >> 6;
#pragma unroll
  for (int i = 0; i < 4; ++i) ra[i] = *(const u32x4*)(ap + (size_t)(i * 32) * lda);
#pragma unroll
  for (int i = 0; i < 8; ++i) rb[i] = *(const f32x4*)(bp + (size_t)i * ldb);
#pragma unroll 1
  for (int kt = 0; kt < nk; ++kt) {
    __syncthreads();
#pragma unroll
    for (int i = 0; i < 4; ++i) *(u32x4*)(As + (arow + i * 32) * LDT + akc * 8) = ra[i];
#pragma unroll
    for (int jn = 0; jn < 4; ++jn) {
      u32x4 w;
      w.x = pk2(rb[0][jn], rb[1][jn]); w.y = pk2(rb[2][jn], rb[3][jn]); w.z = pk2(rb[4][jn], rb[5][jn]); w.w = pk2(rb[6][jn], rb[7][jn]);
      *(u32x4*)(Bs + (ng * 4 + jn) * LDT + kg * 8) = w;
    }
    __syncthreads();
    if (kt + 1 < nk) {
      const bf16_t* ap2 = ap + (kt + 1) * 64;
      const float* bp2 = bp + (size_t)((kt + 1) * 64) * ldb;
#pragma unroll
      for (int i = 0; i < 4; ++i) ra[i] = *(const u32x4*)(ap2 + (size_t)(i * 32) * lda);
#pragma unroll
      for (int i = 0; i < 8; ++i) rb[i] = *(const f32x4*)(bp2 + (size_t)i * ldb);
    }
#pragma unroll
    for (int ks = 0; ks < 2; ++ks) {
      bf16x8 af[4], bfr[4];
#pragma unroll
      for (int mi = 0; mi < 4; ++mi) af[mi] = *(const bf16x8*)(As + (wr * 64 + mi * 16 + fr) * LDT + ks * 32 + fq * 8);
#pragma unroll
      for (int ni = 0; ni < 4; ++ni) bfr[ni] = *(const bf16x8*)(Bs + (wc * 64 + ni * 16 + fr) * LDT + ks * 32 + fq * 8);
#pragma unroll
      for (int mi = 0; mi < 4; ++mi)
#pragma unroll
        for (int ni = 0; ni < 4; ++ni) acc[mi][ni] = __builtin_amdgcn_mfma_f32_16x16x32_bf16(bfr[ni], af[mi], acc[mi][ni], 0, 0, 0);
    }
  }
  __syncthreads();
}

DI void zero_acc(f32x4 (&acc)[4][4]) {
#pragma unroll
  for (int mi = 0; mi < 4; ++mi)
#pragma unroll
    for (int ni = 0; ni < 4; ++ni) acc[mi][ni] = (f32x4){0.f, 0.f, 0.f, 0.f};
}

DI void tile_coords(int tile, int ntm, int ntn, int& tm, int& tn) {
  const int per = 8 * ntn;
  const int g = tile / per, rem = tile - g * per;
  const int gsz = (ntm - g * 8) < 8 ? (ntm - g * 8) : 8;
  tm = g * 8 + rem % gsz;
  tn = rem / gsz;
}

template <class BMap, class Epi>
DI void gemm_phase(const bf16_t* A, int lda, int M, const float* B, int ldb, int K, int N, BMap bmap, const Epi& epi, char* lds) {
  const int ntm = M >> 7, ntn = N >> 7, nt = ntm * ntn;
  const int lane = tid_() & 63, wid = tid_() >> 6;
  for (int tile = blockIdx.x; tile < nt; tile += gridDim.x) {
    int tm, tn;
    tile_coords(tile, ntm, ntn, tm, tn);
    f32x4 acc[4][4];
    zero_acc(acc);
    gemm_mainloop(A + (size_t)tm * 128 * lda, lda, B, ldb, K, tn, bmap, acc, lds);
    epi(tm, tn, wid >> 1, wid & 1, lane, acc);
  }
}

DI int lds_byte(int r, int c) { const int st = (r >> 4) * 2 + (c >> 5), rr = r & 15, cc = c & 31, ob = rr * 64 + cc * 2; return st * 1024 + (ob ^ (((ob >> 9) & 1) << 5)); }
DI void stage_rc(int b, int& R, int& C) { const int st = b >> 10, sb = b & 1023, swz = sb ^ (((sb >> 9) & 1) << 5); R = (st >> 1) * 16 + (swz >> 6); C = (st & 1) * 32 + ((swz & 63) >> 1); }
DI void glds16(const bf16_t* g, char* l) { __builtin_amdgcn_global_load_lds((const unsigned*)g, (__attribute__((address_space(3))) unsigned*)l, 16, 0, 0); }

DI void gemm_mainloop2(const bf16_t* __restrict__ A, int lda, const bf16_t* __restrict__ Bt, int K, f32x4 (&acc)[4][4], char* lds) {
  const int tid = tid_(), lane = tid & 63, wid = tid >> 6, wr = wid >> 1, wc = wid & 1;
  const int fr = lane & 15, fq = lane >> 4;
  const bf16_t* ap[4];
  const bf16_t* bp[4];
#pragma unroll
  for (int i = 0; i < 4; ++i) {
    int R, C;
    stage_rc(tid * 16 + i * 4096, R, C);
    ap[i] = A + (size_t)R * lda + C;
    bp[i] = Bt + (size_t)R * K + C;
  }
  char* lt = lds + tid * 16;
  const int nk = K >> 6;
  __syncthreads();
#pragma unroll
  for (int i = 0; i < 4; ++i) { glds16(ap[i], lt + i * 4096); glds16(bp[i], lt + 16384 + i * 4096); }
  int offA[4], offB[4];
#pragma unroll
  for (int i = 0; i < 4; ++i) { offA[i] = lds_byte(wr * 64 + i * 16 + fr, fq * 8); offB[i] = 16384 + lds_byte(wc * 64 + i * 16 + fr, fq * 8); }
#pragma unroll 1
  for (int kt = 0; kt < nk; ++kt) {
    __syncthreads();
    const char* cur = lds + (kt & 1) * 32768;
    if (kt + 1 < nk) {
      char* nx = lt + ((kt + 1) & 1) * 32768;
      const int ko = (kt + 1) * 64;
#pragma unroll
      for (int i = 0; i < 4; ++i) { glds16(ap[i] + ko, nx + i * 4096); glds16(bp[i] + ko, nx + 16384 + i * 4096); }
    }
#pragma unroll
    for (int ks = 0; ks < 2; ++ks) {
      bf16x8 af[4], bfr[4];
#pragma unroll
      for (int mi = 0; mi < 4; ++mi) af[mi] = *(const bf16x8*)(cur + offA[mi] + ks * 1024);
#pragma unroll
      for (int ni = 0; ni < 4; ++ni) bfr[ni] = *(const bf16x8*)(cur + offB[ni] + ks * 1024);
#pragma unroll
      for (int mi = 0; mi < 4; ++mi)
#pragma unroll
        for (int ni = 0; ni < 4; ++ni) acc[mi][ni] = __builtin_amdgcn_mfma_f32_16x16x32_bf16(bfr[ni], af[mi], acc[mi][ni], 0, 0, 0);
    }
  }
}

template <class Epi>
DI void gemm_phase2(const bf16_t* A, int lda, int M, int tm0, const bf16_t* Bt, int K, int N, const Epi& epi, char* lds) {
  const int ntm = M >> 7, ntn = N >> 7, nt = ntm * ntn;
  const int lane = tid_() & 63, wid = tid_() >> 6;
  for (int tile = blockIdx.x; tile < nt; tile += gridDim.x) {
    int tm, tn;
    tile_coords(tile, ntm, ntn, tm, tn);
    f32x4 acc[4][4];
    zero_acc(acc);
    gemm_mainloop2(A + (size_t)tm * 128 * lda, lda, Bt + (size_t)tn * 128 * K, K, acc, lds);
    epi(tm + tm0, tn, wid >> 1, wid & 1, lane, acc);
  }
}

struct CMapPlain { DI int operator()(int n) const { return n; } };
struct CMapGateUp { DI int operator()(int p) const { const int tn = p >> 7, sub = (p >> 4) & 7, j = p & 15; return ((sub & 1) ? DFF : 0) + tn * 64 + (sub >> 1) * 16 + j; } };
template <class CM>
DI void convert_T(const float* __restrict__ W, int ldw, int K, int N, bf16_t* __restrict__ Wt, CM cm, char* lds) {
  float* tl = (float*)lds;
  const int tid = tid_();
  const int nkt = K >> 6, nnt = N >> 6;
  for (int t = blockIdx.x; t < nkt * nnt; t += gridDim.x) {
    const int kt = t % nkt, nt = t / nkt;
    __syncthreads();
    const int n4 = (tid & 15) * 4;
    const int sc = cm(nt * 64 + n4);
#pragma unroll
    for (int ps = 0; ps < 4; ++ps) {
      const int kk = ps * 16 + (tid >> 4);
      const f32x4 v = *(const f32x4*)(W + (size_t)(kt * 64 + kk) * ldw + sc);
#pragma unroll
      for (int e = 0; e < 4; ++e) tl[kk * 65 + n4 + e] = v[e];
    }
    __syncthreads();
    const int nn = tid >> 2, kc = (tid & 3) * 16;
    u32x4 o0, o1;
    const float* q = tl + kc * 65 + nn;
    o0.x = pk2(q[0 * 65], q[1 * 65]); o0.y = pk2(q[2 * 65], q[3 * 65]); o0.z = pk2(q[4 * 65], q[5 * 65]); o0.w = pk2(q[6 * 65], q[7 * 65]);
    o1.x = pk2(q[8 * 65], q[9 * 65]); o1.y = pk2(q[10 * 65], q[11 * 65]); o1.z = pk2(q[12 * 65], q[13 * 65]); o1.w = pk2(q[14 * 65], q[15 * 65]);
    bf16_t* d = Wt + (size_t)(nt * 64 + nn) * K + kt * 64 + kc;
    *(u32x4*)d = o0;
    *(u32x4*)(d + 8) = o1;
  }
  __syncthreads();
}
DI void convert_ffn(const Params& p, const float* wi, const float* wo, char* lds) {
  convert_T(wi, 2 * DFF, DM, 2 * DFF, p.WF, CMapGateUp(), lds);
  convert_T(wo, DM, DFF, DM, p.WF + WF_WO, CMapPlain(), lds);
}
DI void convert_mixer(const Params& p, int l, char* lds) {
  bf16_t* wm = p.WM + (size_t)l * WM_STRIDE;
  convert_T(p.w_in + (size_t)l * DM * DIN, DIN, DM, DIN, wm + WM_IN, CMapPlain(), lds);
  for (int z = 0; z < 3; ++z) convert_T(p.w_branch + (size_t)(l * 3 + z) * 512 * DM, DM, 512, DM, wm + WM_BR + (size_t)z * 1024 * 512, CMapPlain(), lds);
  convert_T(p.w_out + (size_t)l * DM * DM, DM, DM, DM, wm + WM_OUT, CMapPlain(), lds);
}

struct EpiAct {
  bf16_t* H;
  DI void operator()(int tm, int tn, int wr, int wc, int lane, f32x4 (&acc)[4][4]) const {
    const int fr = lane & 15, fq = lane >> 4;
#pragma unroll
    for (int mi = 0; mi < 4; ++mi) {
      const int row = tm * 128 + wr * 64 + mi * 16 + fr;
#pragma unroll
      for (int pr = 0; pr < 2; ++pr) {
        f32x4 g = acc[mi][2 * pr], u = acc[mi][2 * pr + 1], h;
#pragma unroll
        for (int j = 0; j < 4; ++j) h[j] = siluf_(g[j]) * u[j];
        st4bf(H + (size_t)row * DFF + tn * 64 + (wc * 2 + pr) * 16 + fq * 4, h);
      }
    }
  }
};

struct EpiResid {
  const float *src_lat, *src_ctx;
  float *dst_lat, *dst_ctx;
  const float* gate;
  float gmul;
  DI void operator()(int tm, int tn, int wr, int wc, int lane, f32x4 (&acc)[4][4]) const {
    const int fr = lane & 15, fq = lane >> 4;
    const int r0 = tm * 128;
    const bool lat = r0 < NTL;
    const float* s = lat ? src_lat + (size_t)r0 * DM : src_ctx + (size_t)(r0 - NTL) * DM;
    float* d = lat ? dst_lat + (size_t)r0 * DM : dst_ctx + (size_t)(r0 - NTL) * DM;
    const float* g = gate + (size_t)mod_row(r0) * NMOD;
#pragma unroll
    for (int ni = 0; ni < 4; ++ni) {
      const int col = tn * 128 + wc * 64 + ni * 16 + fq * 4;
      const f32x4 gv = *(const f32x4*)(g + col) * gmul;
#pragma unroll
      for (int mi = 0; mi < 4; ++mi) {
        const int rl = wr * 64 + mi * 16 + fr;
        const f32x4 xv = *(const f32x4*)(s + (size_t)rl * DM + col);
        *(f32x4*)(d + (size_t)rl * DM + col) = xv * ALPHA + gv * acc[mi][ni];
      }
    }
  }
};

struct EpiProj {
  const Params* p;
  int l;
  DI void operator()(int tm, int tn, int wr, int wc, int lane, f32x4 (&acc)[4][4]) const {
    const int fr = lane & 15, fq = lane >> 4;
    const int col0 = tn * 128 + wc * 64;
    const bool lat = tm * 128 < NTL;
    bf16_t* P = p->P;
    if (tn < 5) {
      const float* gain = (tn < 4 ? p->q_gain : p->k_gain) + l * 64;
      const float mult = tn < 4 ? QSCALE : 1.f;
      f32x4 gv[4];
#pragma unroll
      for (int ni = 0; ni < 4; ++ni) gv[ni] = *(const f32x4*)(gain + ni * 16 + fq * 4);
#pragma unroll
      for (int mi = 0; mi < 4; ++mi) {
        const int row = tm * 128 + wr * 64 + mi * 16 + fr;
        float ss = 0.f;
#pragma unroll
        for (int ni = 0; ni < 4; ++ni)
#pragma unroll
          for (int j = 0; j < 4; ++j) ss += acc[mi][ni][j] * acc[mi][ni][j];
        ss += __shfl_xor(ss, 16);
        ss += __shfl_xor(ss, 32);
        const float rinv = rsqrtf(ss * (1.f / 64.f) + 1e-6f);
        f32x4 v[4];
#pragma unroll
        for (int ni = 0; ni < 4; ++ni) v[ni] = acc[mi][ni] * rinv * gv[ni];
        if (lat) {
          const int t = row & (TL - 1);
          const int pr = t >> 6, pc = t & 63;
#pragma unroll
          for (int a = 0; a < 2; ++a) {
            const float* rt = p->rope + (size_t)((a ? pc : pr) * 16 + fq * 4) * 2;
            const f32x4 cs0 = *(const f32x4*)rt, cs1 = *(const f32x4*)(rt + 4);
            const float cc[4] = {cs0[0], cs0[2], cs1[0], cs1[2]};
            const float sn[4] = {cs0[1], cs0[3], cs1[1], cs1[3]};
#pragma unroll
            for (int j = 0; j < 4; ++j) {
              const float x1 = v[2 * a][j], x2 = v[2 * a + 1][j];
              v[2 * a][j] = x1 * cc[j] - x2 * sn[j];
              v[2 * a + 1][j] = x2 * cc[j] + x1 * sn[j];
            }
          }
        }
#pragma unroll
        for (int ni = 0; ni < 4; ++ni) st4bf(P + (size_t)row * DPROJ + col0 + ni * 16 + fq * 4, v[ni] * mult);
      }
    } else {
      const float mult = (tn >= 21 && tn < 25) ? QSCALE : 1.f;
#pragma unroll
      for (int mi = 0; mi < 4; ++mi) {
        const int row = tm * 128 + wr * 64 + mi * 16 + fr;
#pragma unroll
        for (int ni = 0; ni < 4; ++ni) st4bf(P + (size_t)row * DPROJ + col0 + ni * 16 + fq * 4, acc[mi][ni] * mult);
      }
    }
  }
};

DI f32x4 shifted4(const bf16_t* P, int row, bool hp, bool hn, int colidx, const float* mu_l) {
  const bf16_t* q = P + (size_t)row * DPROJ + 768 + colidx;
  const f32x4 x = ld4bf(q);
  const f32x4 xm = hp ? ld4bf(q - DPROJ) : (f32x4){0.f, 0.f, 0.f, 0.f};
  const f32x4 xp = hn ? ld4bf(q + DPROJ) : (f32x4){0.f, 0.f, 0.f, 0.f};
  const f32x4 m0 = *(const f32x4*)(mu_l + colidx), m1 = *(const f32x4*)(mu_l + 1920 + colidx);
  return x + m0 * (xm - x) + m1 * (xp - x);
}

struct EpiReadout {
  const Params* p;
  int l;
  DI void operator()(int tm, int tn, int wr, int wc, int lane, f32x4 (&acc)[4][4]) const {
    const int fr = lane & 15, fq = lane >> 4;
    const int head = tn * 2 + wc, colh = head * 64;
    const float* mu_l = p->mu + (size_t)l * 2 * 1920;
    const float* rk = p->r_k + l * 512 + colh;
    const float* gg = p->gn_g + l * 512 + colh;
    const float* gb = p->gn_b + l * 512 + colh;
    const bf16_t* Of = p->Os;
    const bf16_t* Ob = p->Os + (size_t)NTOK * 512;
    u32x2 gp[4][4];
#pragma unroll
    for (int mi = 0; mi < 4; ++mi)
#pragma unroll
      for (int ni = 0; ni < 4; ++ni) { gp[mi][ni].x = pk2(acc[mi][ni][0], acc[mi][ni][1]); gp[mi][ni].y = pk2(acc[mi][ni][2], acc[mi][ni][3]); }
#pragma unroll
    for (int mi = 0; mi < 4; ++mi) {
      const int row = tm * 128 + wr * 64 + mi * 16 + fr;
      int t, L;
      if (row < NTL) { t = row & (TL - 1); L = TL; } else { t = (row - NTL) & (TC - 1); L = TC; }
      const bool hp = t > 0, hn = t < L - 1;
      f32x4 o[4];
      float s = 0.f, bs = 0.f;
#pragma unroll
      for (int ni = 0; ni < 4; ++ni) {
        const int c = ni * 16 + fq * 4;
        o[ni] = ld4bf(Of + (size_t)row * 512 + colh + c) + ld4bf(Ob + (size_t)row * 512 + colh + c);
        s += (o[ni][0] + o[ni][1]) + (o[ni][2] + o[ni][3]);
      }
#pragma unroll 1
      for (int ni = 0; ni < 4; ++ni) {
        const int c = ni * 16 + fq * 4;
        const f32x4 r4 = shifted4(p->P, row, hp, hn, colh + c, mu_l);
        const f32x4 k4 = shifted4(p->P, row, hp, hn, 512 + colh + c, mu_l);
        const f32x4 rk4 = *(const f32x4*)(rk + c);
        const f32x4 pr = r4 * k4 * rk4;
        bs += (pr[0] + pr[1]) + (pr[2] + pr[3]);
      }
      s += __shfl_xor(s, 16); s += __shfl_xor(s, 32);
      bs += __shfl_xor(bs, 16); bs += __shfl_xor(bs, 32);
      const float mean = s * (1.f / 64.f);
      float q = 0.f;
#pragma unroll
      for (int ni = 0; ni < 4; ++ni) {
        const f32x4 d = o[ni] - mean;
        q += (d[0] * d[0] + d[1] * d[1]) + (d[2] * d[2] + d[3] * d[3]);
      }
      q += __shfl_xor(q, 16); q += __shfl_xor(q, 32);
      const float rstd = rsqrtf(q * (1.f / 64.f) + 64e-5f);
#pragma unroll
      for (int ni = 0; ni < 4; ++ni) {
        const int c = ni * 16 + fq * 4;
        const f32x4 g4 = *(const f32x4*)(gg + c), b4 = *(const f32x4*)(gb + c);
        const f32x4 vv = shifted4(p->P, row, hp, hn, 1024 + colh + c, mu_l);
        const f32x4 gate = {bflo(gp[mi][ni].x), bfhi(gp[mi][ni].x), bflo(gp[mi][ni].y), bfhi(gp[mi][ni].y)};
        const f32x4 y = ((o[ni] - mean) * rstd * g4 + b4 + vv * bs) * gate;
        st4bf(p->yr + (size_t)row * 512 + colh + c, y);
      }
    }
  }
};

DI float wave_sum(float v) {
#pragma unroll
  for (int o = 32; o > 0; o >>= 1) v += __shfl_xor(v, o);
  return v;
}

DI void ln_phase(float* xl, float* xc, int M, const float* g, const float* b, const float* mods_l, int shift_idx, bf16_t* U) {
  const int lane = tid_() & 63, wid = tid_() >> 6;
  for (int row = blockIdx.x * 4 + wid; row < M; row += gridDim.x * 4) {
    float* xr = row < NTL ? xl + (size_t)row * DM : xc + (size_t)(row - NTL) * DM;
    f32x4 v[4];
    float s = 0.f;
#pragma unroll
    for (int i = 0; i < 4; ++i) { v[i] = *(const f32x4*)(xr + i * 256 + lane * 4); s += (v[i][0] + v[i][1]) + (v[i][2] + v[i][3]); }
    const float mean = wave_sum(s) * (1.f / 1024.f);
    float q = 0.f;
#pragma unroll
    for (int i = 0; i < 4; ++i) { const f32x4 d = v[i] - mean; q += (d[0] * d[0] + d[1] * d[1]) + (d[2] * d[2] + d[3] * d[3]); }
    const float rstd = rsqrtf(wave_sum(q) * (1.f / 1024.f) + 1e-5f);
    const float* mr = mods_l + (size_t)mod_row(row) * NMOD + shift_idx * DM;
#pragma unroll
    for (int i = 0; i < 4; ++i) {
      const int c = i * 256 + lane * 4;
      const f32x4 y = (v[i] - mean) * rstd * *(const f32x4*)(g + c) + *(const f32x4*)(b + c);
      *(f32x4*)(xr + c) = y;
      if (U) {
        const f32x4 sh = *(const f32x4*)(mr + c), sc = *(const f32x4*)(mr + DM + c);
        st4bf(U + (size_t)row * DM + c, y * (sc + 1.f) + sh);
      }
    }
  }
}

DI void u0_phase(const Params& p) {
  const int lane = tid_() & 63, wid = tid_() >> 6;
  for (int row = blockIdx.x * 4 + wid; row < NTOK; row += gridDim.x * 4) {
    const float* xr = row < NTL ? p.x_in + (size_t)row * DM : p.ctx_in + (size_t)(row - NTL) * DM;
    const float* mr = p.mods + (size_t)mod_row(row) * NMOD;
#pragma unroll
    for (int i = 0; i < 4; ++i) {
      const int c = i * 256 + lane * 4;
      const f32x4 y = *(const f32x4*)(xr + c);
      const f32x4 sh = *(const f32x4*)(mr + c), sc = *(const f32x4*)(mr + DM + c);
      st4bf(p.U + (size_t)row * DM + c, y * (sc + 1.f) + sh);
    }
  }
}

DI void mods_phase(const Params& p, char* lds) {
  float* sc = (float*)lds;
  float* red = sc + 256 * 20;
  const int tid = tid_(), lane = tid & 63, wid = tid >> 6;
  if (blockIdx.x == 0) {
    if (tid < 64) p.counters[tid] = 0u;
    for (int i = tid; i < 1024; i += NTHREADS) {
      const int pos = i >> 4, k = i & 15;
      const float inv = exp2f(-(float)k * (1.f / 16.f) * 13.287712379549449f);
      const float ang = (float)pos * inv;
      p.rope[i * 2] = cosf(ang);
      p.rope[i * 2 + 1] = sinf(ang);
    }
  }
  for (int tile = blockIdx.x; tile < 288; tile += gridDim.x) {
    const int l = tile / 144, col0 = (tile % 144) * 64;
    float acc[17];
#pragma unroll
    for (int r = 0; r < 17; ++r) acc[r] = 0.f;
    for (int kc = 0; kc < 4; ++kc) {
      __syncthreads();
      for (int i = tid; i < 17 * 256; i += NTHREADS) {
        const int r = i >> 8, kk = i & 255;
        const float v = r < 16 ? p.c[r * DM + kc * 256 + kk] : p.c_ctx[kc * 256 + kk];
        sc[kk * 20 + r] = siluf_(v);
      }
      __syncthreads();
      const float* wp = p.w_ada + ((size_t)l * DM + kc * 256 + wid * 64) * NMOD + col0 + lane;
      for (int kk = 0; kk < 64; ++kk) {
        const float wv = wp[(size_t)kk * NMOD];
        const float* s = sc + (wid * 64 + kk) * 20;
#pragma unroll
        for (int r = 0; r < 17; ++r) acc[r] += s[r] * wv;
      }
    }
    __syncthreads();
#pragma unroll
    for (int r = 0; r < 17; ++r) red[(wid * 17 + r) * 64 + lane] = acc[r];
    __syncthreads();
    for (int i = tid; i < 17 * 64; i += NTHREADS) {
      const int r = i >> 6, cl = i & 63;
      const float s = red[(0 * 17 + r) * 64 + cl] + red[(1 * 17 + r) * 64 + cl] + red[(2 * 17 + r) * 64 + cl] + red[(3 * 17 + r) * 64 + cl];
      p.mods[((size_t)l * 17 + r) * NMOD + col0 + cl] = s + p.b_ada[l * NMOD + col0 + cl];
    }
  }
  __syncthreads();
}

DI void sg_phase(const Params& p, int l) {
  const int lane = tid_() & 63, wid = tid_() >> 6;
  const float* mu_l = p.mu + (size_t)l * 2 * 1920;
  for (int idx = blockIdx.x * NTHREADS + tid_(); idx < NTOK * 32; idx += gridDim.x * NTHREADS) {
    const int row = idx >> 5, c = (idx & 31) * 4;
    int t, L;
    if (row < NTL) { t = row & (TL - 1); L = TL; } else { t = (row - NTL) & (TC - 1); L = TC; }
    const f32x4 x = shifted4(p.P, row, t > 0, t < L - 1, 1792 + c, mu_l);
    f32x4 y;
#pragma unroll
    for (int j = 0; j < 4; ++j) y[j] = sigmoidf_(x[j]);
    st4bf(p.sg + (size_t)row * 128 + c, y);
  }
  (void)lane; (void)wid;
}

constexpr int KLD = 72;
constexpr int VLD = 68;

struct NoMask { DI void operator()(f32x16 (&st)[2]) const {} };

struct NaMask {
  const float* rp;
  int c;
  int c0;
  int h;
  DI void operator()(f32x16 (&st)[2]) const {
#pragma unroll
    for (int u = 0; u < 2; ++u)
#pragma unroll
      for (int i = 0; i < 16; ++i) {
        const int kc = u * 32 + (i & 3) + 8 * (i >> 2) + 4 * h;
        const bool ok = (kc >= c0) && (kc < c0 + 16);
        const int bi = ok ? (kc - c + 15) : 15;
        const float bias = rp[bi];
        st[u][i] = ok ? st[u][i] + bias : -1e30f;
      }
  }
};

template <class Mask>
DI void attn_tile(const bf16_t* Ks, const bf16_t* Vt, const bf16x8 (&qf)[4], f32x16 (&ot)[2], float& m, float& l, const Mask& mask, int lane) {
  const int r = lane & 31, h = lane >> 5;
  f32x16 st[2];
#pragma unroll
  for (int u = 0; u < 2; ++u) {
#pragma unroll
    for (int i = 0; i < 16; ++i) st[u][i] = 0.f;
#pragma unroll
    for (int s = 0; s < 4; ++s) {
      const bf16x8 kf = *(const bf16x8*)(Ks + (u * 32 + r) * KLD + s * 16 + h * 8);
      st[u] = __builtin_amdgcn_mfma_f32_32x32x16_bf16(kf, qf[s], st[u], 0, 0, 0);
    }
  }
  mask(st);
  float mx = st[0][0];
#pragma unroll
  for (int u = 0; u < 2; ++u)
#pragma unroll
    for (int i = 0; i < 16; ++i) mx = fmaxf(mx, st[u][i]);
  mx = fmaxf(mx, __shfl_xor(mx, 32));
  const float mnew = fmaxf(m, mx);
  const float alpha = exp2f(m - mnew);
  m = mnew;
  float ls = 0.f;
#pragma unroll
  for (int u = 0; u < 2; ++u)
#pragma unroll
    for (int i = 0; i < 16; ++i) { st[u][i] = exp2f(st[u][i] - mnew); ls += st[u][i]; }
  l = l * alpha + ls;
#pragma unroll
  for (int dt = 0; dt < 2; ++dt)
#pragma unroll
    for (int i = 0; i < 16; ++i) ot[dt][i] *= alpha;
#pragma unroll
  for (int u = 0; u < 2; ++u)
#pragma unroll
    for (int s = 0; s < 2; ++s) {
      u32x4 pw;
      pw.x = pk2(st[u][8 * s + 0], st[u][8 * s + 1]); pw.y = pk2(st[u][8 * s + 2], st[u][8 * s + 3]);
      pw.z = pk2(st[u][8 * s + 4], st[u][8 * s + 5]); pw.w = pk2(st[u][8 * s + 6], st[u][8 * s + 7]);
      const bf16x8 pb = __builtin_bit_cast(bf16x8, pw);
#pragma unroll
      for (int dt = 0; dt < 2; ++dt) {
        const bf16_t* vp = Vt + (dt * 32 + r) * VLD + u * 32 + 16 * s + 4 * h;
        const s16x4 lo = *(const s16x4*)vp, hi = *(const s16x4*)(vp + 8);
        const bf16x8 va = __builtin_shufflevector(lo, hi, 0, 1, 2, 3, 4, 5, 6, 7);
        ot[dt] = __builtin_amdgcn_mfma_f32_32x32x16_bf16(va, pb, ot[dt], 0, 0, 0);
      }
    }
}

template <int NHB>
DI void kv_load(const bf16_t* kb, const bf16_t* vb, u32x4 (&kr)[NHB * 2], u32x4 (&vr)[NHB * 2]) {
#pragma unroll
  for (int i = 0; i < NHB * 2; ++i) {
    const int c = tid_() + i * NTHREADS;
    const int hh = c >> 9, cc = c & 511, key = cc >> 3, dc = cc & 7;
    const size_t off = (size_t)key * DPROJ + hh * 64 + dc * 8;
    kr[i] = *(const u32x4*)(kb + off);
    vr[i] = *(const u32x4*)(vb + off);
  }
}
template <int NHB>
DI void kv_store(bf16_t* Ks, bf16_t* Vt, const u32x4 (&kr)[NHB * 2], const u32x4 (&vr)[NHB * 2]) {
#pragma unroll
  for (int i = 0; i < NHB * 2; ++i) {
    const int c = tid_() + i * NTHREADS;
    const int hh = c >> 9, cc = c & 511, key = cc >> 3, dc = cc & 7;
    *(u32x4*)(Ks + hh * 64 * KLD + key * KLD + dc * 8) = kr[i];
    bf16_t* vt = Vt + hh * 64 * VLD + (dc * 8) * VLD + key;
    vt[0 * VLD] = (bf16_t)(vr[i].x & 0xffff); vt[1 * VLD] = (bf16_t)(vr[i].x >> 16);
    vt[2 * VLD] = (bf16_t)(vr[i].y & 0xffff); vt[3 * VLD] = (bf16_t)(vr[i].y >> 16);
    vt[4 * VLD] = (bf16_t)(vr[i].z & 0xffff); vt[5 * VLD] = (bf16_t)(vr[i].z >> 16);
    vt[6 * VLD] = (bf16_t)(vr[i].w & 0xffff); vt[7 * VLD] = (bf16_t)(vr[i].w >> 16);
  }
}

DI void attn_finish(bf16_t* outp  , f32x16 (&ot)[2], float l, int lane) {
  const int h = lane >> 5;
  l += __shfl_xor(l, 32);
  const float inv = 1.f / l;
#pragma unroll
  for (int dt = 0; dt < 2; ++dt)
#pragma unroll
    for (int g = 0; g < 4; ++g) {
      f32x4 v = {ot[dt][4 * g] * inv, ot[dt][4 * g + 1] * inv, ot[dt][4 * g + 2] * inv, ot[dt][4 * g + 3] * inv};
      st4bf(outp + dt * 32 + 8 * g + 4 * h, v);
    }
}

DI void dense_item(const Params& p, int qrow0, int qcol, int krow_lat0, int ntl, int krow_ctx0, int kcol, int vcol, char* lds) {
  bf16_t* Ks = (bf16_t*)lds;
  bf16_t* Vt = Ks + 2 * 64 * KLD;
  const int lane = tid_() & 63, wid = tid_() >> 6, r = lane & 31, h = lane >> 5;
  bf16_t* qp = p.P + (size_t)(qrow0 + wid * 32 + r) * DPROJ + qcol;
  bf16x8 qf[4];
#pragma unroll
  for (int s = 0; s < 4; ++s) qf[s] = *(const bf16x8*)(qp + s * 16 + h * 8);
  f32x16 ot[2];
#pragma unroll
  for (int dt = 0; dt < 2; ++dt)
#pragma unroll
    for (int i = 0; i < 16; ++i) ot[dt][i] = 0.f;
  float m = -1e30f, l = 0.f;
  const int nt = ntl + 4;
  u32x4 kr[2], vr[2];
  auto tile_row = [&](int jt) { return jt < ntl ? krow_lat0 + jt * 64 : krow_ctx0 + (jt - ntl) * 64; };
  {
    const bf16_t* base = p.P + (size_t)tile_row(0) * DPROJ;
    kv_load<1>(base + kcol, base + vcol, kr, vr);
  }
  for (int jt = 0; jt < nt; ++jt) {
    __syncthreads();
    kv_store<1>(Ks, Vt, kr, vr);
    __syncthreads();
    if (jt + 1 < nt) {
      const bf16_t* base = p.P + (size_t)tile_row(jt + 1) * DPROJ;
      kv_load<1>(base + kcol, base + vcol, kr, vr);
    }
    attn_tile(Ks, Vt, qf, ot, m, l, NoMask(), lane);
  }
  attn_finish(qp, ot, l, lane);
  __syncthreads();
}

DI void na_item(const Params& p, int lyr, int b, int gr, int hp, char* lds) {
  bf16_t* Ks = (bf16_t*)lds;
  bf16_t* Vt = Ks + 2 * 64 * KLD;
  float* rpl = (float*)(Vt + 2 * 64 * VLD);
  const int tid = tid_(), lane = tid & 63, wid = tid >> 6, r = lane & 31, h = lane >> 5;
  const int hl = wid >> 1, head = hp * 2 + hl, qh = wid & 1;
  const int r0 = gr - 4 < 0 ? 0 : (gr - 4 > 24 ? 24 : gr - 4);
  __syncthreads();
  for (int i = tid; i < 2 * 465; i += NTHREADS) {
    const int hh = i / 465, e = i - hh * 465;
    rpl[i] = p.rpb[((size_t)lyr * 8 + hp * 2 + hh) * 465 + e] * LOG2E;
  }
  const int c = qh * 32 + r;
  const int c0 = c - 8 < 0 ? 0 : (c - 8 > 48 ? 48 : c - 8);
  bf16_t* qp = p.P + (size_t)(b * TL + gr * 64 + c) * DPROJ + 2688 + head * 64;
  bf16x8 qf[4];
#pragma unroll
  for (int s = 0; s < 4; ++s) qf[s] = *(const bf16x8*)(qp + s * 16 + h * 8);
  f32x16 ot[2];
#pragma unroll
  for (int dt = 0; dt < 2; ++dt)
#pragma unroll
    for (int i = 0; i < 16; ++i) ot[dt][i] = 0.f;
  float m = -1e30f, l = 0.f;
  u32x4 kr[4], vr[4];
  auto tile_row = [&](int jt) { return jt < 8 ? b * TL + (r0 + jt) * 64 : NTL + b * TC + (jt - 8) * 64; };
  const int kcol = 3200 + hp * 128, vcol = 3712 + hp * 128;
  {
    const bf16_t* base = p.P + (size_t)tile_row(0) * DPROJ;
    kv_load<2>(base + kcol, base + vcol, kr, vr);
  }
  for (int jt = 0; jt < 12; ++jt) {
    __syncthreads();
    kv_store<2>(Ks, Vt, kr, vr);
    __syncthreads();
    if (jt + 1 < 12) {
      const bf16_t* base = p.P + (size_t)tile_row(jt + 1) * DPROJ;
      kv_load<2>(base + kcol, base + vcol, kr, vr);
    }
    if (jt < 8) {
      NaMask mk;
      mk.rp = rpl + hl * 465 + (r0 + jt - gr + 7) * 31;
      mk.c = c; mk.c0 = c0; mk.h = h;
      attn_tile(Ks + hl * 64 * KLD, Vt + hl * 64 * VLD, qf, ot, m, l, mk, lane);
    } else {
      attn_tile(Ks + hl * 64 * KLD, Vt + hl * 64 * VLD, qf, ot, m, l, NoMask(), lane);
    }
  }
  attn_finish(qp, ot, l, lane);
  __syncthreads();
}

template <int CTRL>
DI float dpp_f(float x) { return __int_as_float(__builtin_amdgcn_update_dpp(0, __float_as_int(x), CTRL, 0xF, 0xF, true)); }
DI float red8(float x) {
  x += dpp_f<0xB1>(x);
  x += dpp_f<0x4E>(x);
  x += dpp_f<0x141>(x);
  return x;
}

struct ScanOps { f32x4 w[2], kk[2], b[2], kd[2], r[2]; f32x2 v; };
DI void scan_load(ScanOps& o, const float* base, int kg, int row0) {
#pragma unroll
  for (int i = 0; i < 2; ++i) {
    o.w[i] = *(const f32x4*)(base + kg * 8 + i * 4);
    o.kk[i] = *(const f32x4*)(base + 64 + kg * 8 + i * 4);
    o.b[i] = *(const f32x4*)(base + 128 + kg * 8 + i * 4);
    o.kd[i] = *(const f32x4*)(base + 192 + kg * 8 + i * 4);
    o.r[i] = *(const f32x4*)(base + 256 + kg * 8 + i * 4);
  }
  o.v = *(const f32x2*)(base + 320 + row0);
}

DI void scan_block(const Params& p, int lyr, int sidx, bool need_ctx, char* lds) {
  const int dir = sidx & 1, hd = (sidx >> 1) & 7, b = sidx >> 4;
  const int tid = tid_(), lane = tid & 63, w = tid >> 6;
  float* rec = (float*)lds;
  float* obuf = rec + 16 * 384;
  float* cst = obuf + 16 * 64;
  bf16_t* Aw = (bf16_t*)(cst + 14 * 64);
  bf16_t* Aa = Aw + 16 * 72;
  __syncthreads();
  for (int i = tid; i < 320; i += NTHREADS) {
    const int g = i >> 6, c = i & 63;
    const int colidx = (g < 3 ? g * 512 + hd * 64 : (g == 3 ? 1536 + dir * 64 : 1664 + dir * 64)) + c;
    cst[i] = p.mu[(size_t)lyr * 3840 + colidx];
    cst[320 + i] = p.mu[(size_t)lyr * 3840 + 1920 + colidx];
  }
  if (tid < 64) {
    cst[640 + tid] = p.w0[(lyr * 2 + dir) * 512 + hd * 64 + tid];
    cst[704 + tid] = p.a0[(lyr * 2 + dir) * 512 + hd * 64 + tid];
    cst[768 + tid] = p.k_k[lyr * 512 + hd * 64 + tid];
    cst[832 + tid] = p.k_a[lyr * 512 + hd * 64 + tid];
  }
  const int fr = lane & 15, fq = lane >> 4;
  bf16x8 bw[2], ba[2];
  {
    const float* w2p = p.w2 + (size_t)(lyr * 2 + dir) * 64 * 512 + hd * 64 + 16 * w + fr;
    const float* a2p = p.a2 + (size_t)(lyr * 2 + dir) * 64 * 512 + hd * 64 + 16 * w + fr;
#pragma unroll
    for (int ks = 0; ks < 2; ++ks) {
      u32x4 tw, ta;
      float xw[8], xa[8];
#pragma unroll
      for (int j = 0; j < 8; ++j) { xw[j] = w2p[(size_t)(ks * 32 + fq * 8 + j) * 512]; xa[j] = a2p[(size_t)(ks * 32 + fq * 8 + j) * 512]; }
      tw.x = pk2(xw[0], xw[1]); tw.y = pk2(xw[2], xw[3]); tw.z = pk2(xw[4], xw[5]); tw.w = pk2(xw[6], xw[7]);
      ta.x = pk2(xa[0], xa[1]); ta.y = pk2(xa[2], xa[3]); ta.z = pk2(xa[4], xa[5]); ta.w = pk2(xa[6], xa[7]);
      bw[ks] = __builtin_bit_cast(bf16x8, tw);
      ba[ks] = __builtin_bit_cast(bf16x8, ta);
    }
  }
  f32x4 S[2][2];
#pragma unroll
  for (int a = 0; a < 2; ++a)
#pragma unroll
    for (int i = 0; i < 2; ++i) S[a][i] = (f32x4){0.f, 0.f, 0.f, 0.f};
  const int kg = lane & 7, rp = lane >> 3, row0 = 16 * w + rp * 2;
  const int pj = tid >> 4, pcg = tid & 15;
  int goff[5] = {hd * 64, 512 + hd * 64, 1024 + hd * 64, 1536 + dir * 64, 1664 + dir * 64};
  u32x2 raw[5][3];
  auto chunk_tok = [&](int ch, int j, int& rowbase, int& t, int& L) {
    int n0;
    if (ch < 16) { L = TC; n0 = ch * 16; rowbase = NTL + b * TC; } else { L = TL; n0 = (ch - 16) * 16; rowbase = b * TL; }
    const int n = n0 + j;
    t = dir ? L - 1 - n : n;
  };
  auto prefetch = [&](int ch) {
    int rowbase, t, L;
    chunk_tok(ch, pj, rowbase, t, L);
    const bf16_t* q = p.P + (size_t)(rowbase + t) * DPROJ + 768 + pcg * 4;
#pragma unroll
    for (int g = 0; g < 5; ++g) {
      raw[g][1] = *(const u32x2*)(q + goff[g]);
      raw[g][0] = t > 0 ? *(const u32x2*)(q + goff[g] - DPROJ) : (u32x2){0u, 0u};
      raw[g][2] = t < L - 1 ? *(const u32x2*)(q + goff[g] + DPROJ) : (u32x2){0u, 0u};
    }
  };
  prefetch(0);
  __syncthreads();
  for (int ch = 0; ch < 144; ++ch) {
    {
      f32x4 xs[5];
#pragma unroll
      for (int g = 0; g < 5; ++g) {
        const f32x4 x = {bflo(raw[g][1].x), bfhi(raw[g][1].x), bflo(raw[g][1].y), bfhi(raw[g][1].y)};
        const f32x4 xm = {bflo(raw[g][0].x), bfhi(raw[g][0].x), bflo(raw[g][0].y), bfhi(raw[g][0].y)};
        const f32x4 xp = {bflo(raw[g][2].x), bfhi(raw[g][2].x), bflo(raw[g][2].y), bfhi(raw[g][2].y)};
        const f32x4 m0 = *(const f32x4*)(cst + g * 64 + pcg * 4), m1 = *(const f32x4*)(cst + 320 + g * 64 + pcg * 4);
        xs[g] = x + m0 * (xm - x) + m1 * (xp - x);
      }
      float* rj = rec + pj * 384;
      *(f32x4*)(rj + 256 + pcg * 4) = xs[0];
      *(f32x4*)(rj + 320 + pcg * 4) = xs[2];
      const f32x4 kx = xs[1] * *(const f32x4*)(cst + 768 + pcg * 4);
      float ss = (kx[0] * kx[0] + kx[1] * kx[1]) + (kx[2] * kx[2] + kx[3] * kx[3]);
      ss += __shfl_xor(ss, 1); ss += __shfl_xor(ss, 2); ss += __shfl_xor(ss, 4); ss += __shfl_xor(ss, 8);
      const float rn = rsqrtf(ss + 1e-12f);
      *(f32x4*)(rj + 64 + pcg * 4) = kx * rn;
      *(f32x4*)(rj + 192 + pcg * 4) = xs[1];
      f32x4 tw;
#pragma unroll
      for (int j = 0; j < 4; ++j) tw[j] = tanhf(xs[3][j]);
      st4bf(Aw + pj * 72 + pcg * 4, tw);
      st4bf(Aa + pj * 72 + pcg * 4, xs[4]);
    }
    __syncthreads();
    {
      f32x4 aw = {0.f, 0.f, 0.f, 0.f}, aa = {0.f, 0.f, 0.f, 0.f};
#pragma unroll
      for (int ks = 0; ks < 2; ++ks) {
        const bf16x8 fw = *(const bf16x8*)(Aw + fr * 72 + ks * 32 + fq * 8);
        const bf16x8 fa = *(const bf16x8*)(Aa + fr * 72 + ks * 32 + fq * 8);
        aw = __builtin_amdgcn_mfma_f32_16x16x32_bf16(bw[ks], fw, aw, 0, 0, 0);
        aa = __builtin_amdgcn_mfma_f32_16x16x32_bf16(ba[ks], fa, aa, 0, 0, 0);
      }
      const int c = 16 * w + fq * 4;
      float* rj = rec + fr * 384;
      const f32x4 w0v = *(const f32x4*)(cst + 640 + c), a0v = *(const f32x4*)(cst + 704 + c), kav = *(const f32x4*)(cst + 832 + c);
      const f32x4 kkv = *(const f32x4*)(rj + 64 + c), kpv = *(const f32x4*)(rj + 192 + c);
      f32x4 dec, bb, kd;
#pragma unroll
      for (int j = 0; j < 4; ++j) {
        const float z = -(w0v[j] + aw[j]);
        const float sp = fmaxf(z, 0.f) + log1pf(__expf(-fabsf(z)));
        const float wl = -sp - 0.5f;
        dec[j] = __expf(-__expf(wl));
        const float ic = sigmoidf_(a0v[j] + aa[j]);
        bb[j] = kkv[j] * ic;
        kd[j] = kpv[j] * (1.f + (ic - 1.f) * kav[j]);
      }
      *(f32x4*)(rj + c) = dec;
      *(f32x4*)(rj + 128 + c) = bb;
      *(f32x4*)(rj + 192 + c) = kd;
    }
    __syncthreads();
    if (ch + 1 < 144) prefetch(ch + 1);
    {
      ScanOps cur, nxt;
      scan_load(cur, rec, kg, row0);
#pragma unroll 2
      for (int j = 0; j < 16; ++j) {
        if (j + 1 < 16) scan_load(nxt, rec + (j + 1) * 384, kg, row0);
#pragma unroll
        for (int a = 0; a < 2; ++a) {
          f32x4 t0 = S[a][0] * cur.kk[0] + S[a][1] * cur.kk[1];
          float sap = red8((t0[0] + t0[1]) + (t0[2] + t0[3]));
          const float vv = a ? cur.v.y : cur.v.x;
          S[a][0] = S[a][0] * cur.w[0] - cur.b[0] * sap + cur.kd[0] * vv;
          S[a][1] = S[a][1] * cur.w[1] - cur.b[1] * sap + cur.kd[1] * vv;
          f32x4 t1 = S[a][0] * cur.r[0] + S[a][1] * cur.r[1];
          float o = red8((t1[0] + t1[1]) + (t1[2] + t1[3]));
          if (kg == 0) obuf[j * 64 + row0 + a] = o;
        }
        cur = nxt;
      }
    }
    __syncthreads();
    if (ch >= 16 || need_ctx) {
      int rowbase, t, L;
      chunk_tok(ch, pj, rowbase, t, L);
      const f32x4 ov = *(const f32x4*)(obuf + pj * 64 + pcg * 4);
      st4bf(p.Os + ((size_t)dir * NTOK + rowbase + t) * 512 + hd * 64 + pcg * 4, ov);
    }
  }
  __syncthreads();
}

DI void mixer_phase(const Params& p, int l, bool need_ctx, char* lds) {
  __shared__ int s_item;
  sg_phase(p, l);
  for (int s = blockIdx.x; s < 256; s += gridDim.x) scan_block(p, l, s, need_ctx, lds);
  const int nitems = 4096 + (need_ctx ? 512 : 0);
  while (true) {
    __syncthreads();
    if (tid_() == 0) s_item = (int)atomicAdd(&p.counters[l], 1u);
    __syncthreads();
    const int it = s_item;
    if (it >= nitems) break;
    if (it < 2048) {
      const int b = it >> 7, head = (it >> 4) & 7, qb = it & 15, kvh = head >> 2;
      dense_item(p, b * TL + qb * 128, head * 64, b * TL, 32, NTL + b * TC, 512 + kvh * 64, 640 + kvh * 64, lds);
    } else if (it < 4096) {
      const int i2 = it - 2048;
      const int b = i2 >> 7, gr = (i2 >> 2) & 31, hp = i2 & 3;
      na_item(p, l, b, gr, hp, lds);
    } else if (it < 4352) {
      const int i2 = it - 4096;
      const int b = i2 >> 4, head = (i2 >> 1) & 7, qb = i2 & 1, kvh = head >> 2;
      dense_item(p, NTL + b * TC + qb * 128, head * 64, 0, 0, NTL + b * TC, 512 + kvh * 64, 640 + kvh * 64, lds);
    } else {
      const int i2 = it - 4352;
      const int b = i2 >> 4, head = (i2 >> 1) & 7, qb = i2 & 1;
      dense_item(p, NTL + b * TC + qb * 128, 2688 + head * 64, 0, 0, NTL + b * TC, 3200 + head * 64, 3712 + head * 64, lds);
    }
  }
}

DI void merge_phase(const Params& p, int l, int row0, int M, char* lds) {
  const int ntm = M >> 7, ntn = 8, nt = ntm * ntn;
  const int lane = tid_() & 63, wid = tid_() >> 6, wr = wid >> 1, wc = wid & 1, fr = lane & 15, fq = lane >> 4;
  const bf16_t* wm = p.WM + (size_t)l * WM_STRIDE;
  for (int tile = blockIdx.x; tile < nt; tile += gridDim.x) {
    int tm, tn;
    tile_coords(tile, ntm, ntn, tm, tn);
    const size_t grow = (size_t)row0 + tm * 128;
#pragma unroll 1
    for (int z = 0; z < 3; ++z) {
      u32x2 gp[4][4];
      {
        f32x4 acc[4][4];
        zero_acc(acc);
        gemm_mainloop2(p.U + grow * DM, DM, wm + WM_IN + (size_t)(DPROJ + z * DM + tn * 128) * DM, DM, acc, lds);
#pragma unroll
        for (int mi = 0; mi < 4; ++mi)
#pragma unroll
          for (int ni = 0; ni < 4; ++ni) {
            gp[mi][ni].x = pk2(sigmoidf_(acc[mi][ni][0]), sigmoidf_(acc[mi][ni][1]));
            gp[mi][ni].y = pk2(sigmoidf_(acc[mi][ni][2]), sigmoidf_(acc[mi][ni][3]));
          }
      }
      {
        f32x4 acc[4][4];
        zero_acc(acc);
        const bf16_t* Ya = z == 1 ? p.yr : (z == 0 ? p.P : p.P + 2688);
        const int lda = z == 1 ? 512 : DPROJ;
        gemm_mainloop2(Ya + grow * lda, lda, wm + WM_BR + (size_t)z * 1024 * 512 + (size_t)tn * 128 * 512, 512, acc, lds);
#pragma unroll
        for (int mi = 0; mi < 4; ++mi)
#pragma unroll
          for (int ni = 0; ni < 4; ++ni) asm volatile("" : "+v"(gp[mi][ni].x), "+v"(gp[mi][ni].y));
#pragma unroll
        for (int mi = 0; mi < 4; ++mi) {
          const int row = tm * 128 + wr * 64 + mi * 16 + fr;
#pragma unroll
          for (int ni = 0; ni < 4; ++ni) {
            bf16_t* mp = p.Mg + (size_t)row * DM + tn * 128 + wc * 64 + ni * 16 + fq * 4;
            const f32x4 g = {bflo(gp[mi][ni].x), bfhi(gp[mi][ni].x), bflo(gp[mi][ni].y), bfhi(gp[mi][ni].y)};
            f32x4 mn = g * acc[mi][ni];
            if (z > 0) mn += ld4bf(mp);
            st4bf(mp, mn);
          }
        }
      }
    }
  }
}

template <int S>
DI void layer_step(const Params& p, int l, char* lds) {
  const bool last = l == 1;
  const bool need_ctx = !last;
  const int Mall = NTOK, Mx = need_ctx ? NTOK : NTL;
  const float* mods_l = p.mods + (size_t)l * 17 * NMOD;
  const float* src_lat = l == 0 ? p.x_in : p.out;
  const float* src_ctx = l == 0 ? p.ctx_in : p.ctxx;
  const bf16_t* wm = p.WM + (size_t)l * WM_STRIDE;
  if constexpr (S == 0) {
    EpiAct e; e.H = p.H;
    gemm_phase2(p.U, DM, Mall, 0, p.WF, DM, 2 * DFF, e, lds);
  } else if constexpr (S == 1) {
    EpiResid e; e.src_lat = src_lat; e.src_ctx = src_ctx; e.dst_lat = p.out; e.dst_ctx = p.ctxx; e.gate = mods_l + 2 * DM; e.gmul = 0.5f;
    gemm_phase2(p.H, DFF, Mall, 0, p.WF + WF_WO, DFF, DM, e, lds);
  } else if constexpr (S == 2) {
    ln_phase(p.out, p.ctxx, Mall, p.ln_g + (l * 3 + 0) * DM, p.ln_b + (l * 3 + 0) * DM, mods_l, 3, p.U);
  } else if constexpr (S == 3) {
    EpiProj e; e.p = &p; e.l = l;
    gemm_phase2(p.U, DM, Mall, 0, wm + WM_IN, DM, DPROJ, e, lds);
  } else if constexpr (S == 4) {
    mixer_phase(p, l, need_ctx, lds);
  } else if constexpr (S == 5) {
    EpiReadout e; e.p = &p; e.l = l;
    gemm_phase(p.sg, 128, Mx, p.g2 + (size_t)l * 128 * 512, 512, 128, 512, MapPlain(), e, lds);
  } else if constexpr (S == 8) {
    ln_phase(p.out, p.ctxx, Mx, p.ln_g + (l * 3 + 1) * DM, p.ln_b + (l * 3 + 1) * DM, mods_l, 6, p.U);
    convert_ffn(p, p.ffn2_wi + (size_t)l * DM * 2 * DFF, p.ffn2_wo + (size_t)l * DFF * DM, lds);
  } else if constexpr (S == 9) {
    EpiAct e; e.H = p.H;
    gemm_phase2(p.U, DM, Mx, 0, p.WF, DM, 2 * DFF, e, lds);
  } else if constexpr (S == 10) {
    EpiResid e; e.src_lat = p.out; e.src_ctx = p.ctxx; e.dst_lat = p.out; e.dst_ctx = p.ctxx; e.gate = mods_l + 8 * DM; e.gmul = 0.5f;
    gemm_phase2(p.H, DFF, Mx, 0, p.WF + WF_WO, DFF, DM, e, lds);
  } else {
    ln_phase(p.out, p.ctxx, Mx, p.ln_g + (l * 3 + 2) * DM, p.ln_b + (l * 3 + 2) * DM, p.mods + (size_t)(last ? 0 : 1) * 17 * NMOD, 0, last ? nullptr : p.U);
    if (!last) convert_ffn(p, p.ffn1_wi + (size_t)(l + 1) * DM * 2 * DFF, p.ffn1_wo + (size_t)(l + 1) * DFF * DM, lds);
  }
}

template <int S>
DI void merge_step(const Params& p, int l, int half, char* lds) {
  const int Mx = l == 0 ? NTOK : NTL, Mh = Mx >> 1, row0 = half * Mh;
  const bf16_t* wm = p.WM + (size_t)l * WM_STRIDE;
  if constexpr (S == 0) {
    merge_phase(p, l, row0, Mh, lds);
  } else {
    const float* mods_l = p.mods + (size_t)l * 17 * NMOD;
    EpiResid e; e.src_lat = p.out; e.src_ctx = p.ctxx; e.dst_lat = p.out; e.dst_ctx = p.ctxx; e.gate = mods_l + 5 * DM; e.gmul = 1.f;
    gemm_phase2(p.Mg, DM, Mh, row0 >> 7, wm + WM_OUT, DM, DM, e, lds);
  }
}

__global__ void __launch_bounds__(NTHREADS, 2) fwd_megakernel(Params p) {
  __shared__ __attribute__((aligned(16))) char lds[LDS_BYTES];
  cg::grid_group grid = cg::this_grid();
  mods_phase(p, lds);
  convert_ffn(p, p.ffn1_wi, p.ffn1_wo, lds);
  convert_mixer(p, 0, lds);
  convert_mixer(p, 1, lds);
  grid.sync();
  u0_phase(p);
  grid.sync();
#pragma unroll 1
  for (int l = 0; l < 2; ++l) {
    layer_step<0>(p, l, lds); grid.sync();
    layer_step<1>(p, l, lds); grid.sync();
    layer_step<2>(p, l, lds); grid.sync();
    layer_step<3>(p, l, lds); grid.sync();
    layer_step<4>(p, l, lds); grid.sync();
    layer_step<5>(p, l, lds); grid.sync();
#pragma unroll 1
    for (int half = 0; half < 2; ++half) {
      merge_step<0>(p, l, half, lds); grid.sync();
      merge_step<1>(p, l, half, lds); grid.sync();
    }
    layer_step<8>(p, l, lds); grid.sync();
    layer_step<9>(p, l, lds); grid.sync();
    layer_step<10>(p, l, lds); grid.sync();
    layer_step<11>(p, l, lds);
    if (l == 0) grid.sync();
  }
}

extern "C" void kernel_launch(void* const* d_in, const int* in_sizes, int n_in, void* d_out, int out_size, void* d_ws, size_t ws_size,
                              hipStream_t stream) {
  static int grid_blocks = 0;
  if (!grid_blocks) {
    int dev = 0, cus = 0, per_cu = 0;
    hipGetDevice(&dev);
    hipDeviceGetAttribute(&cus, hipDeviceAttributeMultiprocessorCount, dev);
    hipOccupancyMaxActiveBlocksPerMultiprocessor(&per_cu, fwd_megakernel, NTHREADS, 0);
    if (per_cu < 1) per_cu = 1;
    grid_blocks = cus * per_cu;
  }
  Params p{};
  const float* const* in = (const float* const*)d_in;
  p.x_in = in[0]; p.c = in[1]; p.ctx_in = in[2]; p.c_ctx = in[3]; p.w_ada = in[4]; p.b_ada = in[5];
  p.ffn1_wi = in[6]; p.ffn1_wo = in[7]; p.ffn2_wi = in[8]; p.ffn2_wo = in[9]; p.ln_g = in[10]; p.ln_b = in[11]; p.w_in = in[12];
  p.q_gain = in[13]; p.k_gain = in[14]; p.mu = in[15]; p.w0 = in[16]; p.w2 = in[17]; p.a0 = in[18]; p.a2 = in[19]; p.g2 = in[20];
  p.k_k = in[21]; p.k_a = in[22]; p.r_k = in[23]; p.gn_g = in[24]; p.gn_b = in[25]; p.rpb = in[26]; p.w_branch = in[27]; p.w_out = in[28];
  p.out = (float*)d_out;
  char* ws = (char*)d_ws;
  const size_t MiB = 1ull << 20;
  p.counters = (unsigned*)ws;
  p.rope = (float*)(ws + 4096);
  p.mods = (float*)(ws + 65536);
  p.ctxx = (float*)(ws + 2 * MiB);
  p.U = (bf16_t*)(ws + 18 * MiB);
  p.H = (bf16_t*)(ws + 90 * MiB);
  p.P = (bf16_t*)(ws + 90 * MiB);
  p.Os = (bf16_t*)(ws + 387 * MiB);
  p.yr = (bf16_t*)(ws + 387 * MiB);
  p.Mg = (bf16_t*)(ws + 423 * MiB);
  p.sg = (bf16_t*)(ws + 459 * MiB);
  p.WM = (bf16_t*)(ws + 468 * MiB);
  p.WF = (bf16_t*)(ws + 288 * MiB);
  if (ws_size < 507 * MiB) fprintf(stderr, "workspace too small: %zu\n", ws_size);
  void* args[] = {&p};
  hipError_t e = hipLaunchCooperativeKernel((void*)fwd_megakernel, dim3(grid_blocks), dim3(NTHREADS), args, 0, stream);
  if (e != hipSuccess) fprintf(stderr, "cooperative launch failed: %s (grid %d)\n", hipGetErrorString(e), grid_blocks);
}
```

```cpp
#include <hip/hip_runtime.h>
#include <hip/hip_cooperative_groups.h>
#include <cstdio>
#include <cstdint>
namespace cg = cooperative_groups;
#ifndef PROBE_MASK
#define PROBE_MASK 0
#endif

#define DI __device__ __forceinline__
typedef unsigned short bf16_t;
typedef short bf16x8 __attribute__((ext_vector_type(8)));
typedef short s16x4 __attribute__((ext_vector_type(4)));
typedef float f32x2 __attribute__((ext_vector_type(2)));
typedef float f32x4 __attribute__((ext_vector_type(4)));
typedef float f32x16 __attribute__((ext_vector_type(16)));
typedef unsigned u32x2 __attribute__((ext_vector_type(2)));
typedef unsigned u32x4 __attribute__((ext_vector_type(4)));
typedef __bf16 nbf16x2 __attribute__((ext_vector_type(2)));

constexpr int DM = 1024, NB = 16, TL = 2048, TC = 256;
constexpr int NTL = NB * TL, NTC = NB * TC, NTOK = NTL + NTC;
constexpr int DFF = 2816, DIN = 7296, DPROJ = 4224;
constexpr int NMOD = 9 * DM;
constexpr float LOG2E = 1.4426950408889634f;
constexpr float QSCALE = 0.125f * LOG2E;
constexpr float ALPHA = 1.4142135623730951f;
constexpr int LDS_WORK = 73728;
constexpr int LDS_BYTES = LDS_WORK + 64;
constexpr size_t WM_IN = 0, WM_BR = (size_t)7296 * 1024, WM_OUT = WM_BR + 3 * 1024 * 512, WM_STRIDE = WM_OUT + 1024 * 1024;
constexpr size_t WF_WO = (size_t)2 * 2816 * 1024, WF_SLOT = (size_t)17 * 1024 * 1024 / 2;
constexpr int NTHREADS = 256;

struct Params {
  const float *x_in, *c, *ctx_in, *c_ctx, *w_ada, *b_ada, *ffn1_wi, *ffn1_wo, *ffn2_wi, *ffn2_wo, *ln_g, *ln_b, *w_in,
      *q_gain, *k_gain, *mu, *w0, *w2, *a0, *a2, *g2, *k_k, *k_a, *r_k, *gn_g, *gn_b, *rpb, *w_branch, *w_out;
  float* out;
  float* mods;
  float* rope;
  float* ctxx;
  unsigned* counters;
  bf16_t *U, *H, *P, *Os, *yr, *Mg, *sg, *WF, *WM;
  float* stats;
  unsigned* lncnt;
  unsigned* bar;
};

DI int tid_() { int t = threadIdx.x; asm volatile("" : "+v"(t)); return t; }
DI unsigned pk2(float a, float b) { f32x2 v = {a, b}; nbf16x2 r = __builtin_convertvector(v, nbf16x2); return __builtin_bit_cast(unsigned, r); }
DI bf16_t f2bf(float a) { return (bf16_t)(pk2(a, 0.f) & 0xffffu); }
DI float bflo(unsigned u) { return __uint_as_float(u << 16); }
DI float bfhi(unsigned u) { return __uint_as_float(u & 0xffff0000u); }
DI f32x4 ld4bf(const bf16_t* p) { u32x2 v = *(const u32x2*)p; return (f32x4){bflo(v.x), bfhi(v.x), bflo(v.y), bfhi(v.y)}; }
DI void st4bf(bf16_t* p, f32x4 v) { u32x2 o; o.x = pk2(v[0], v[1]); o.y = pk2(v[2], v[3]); *(u32x2*)p = o; }
DI float sigmoidf_(float x) { return __builtin_amdgcn_rcpf(1.f + __expf(-x)); }
DI float siluf_(float x) { return x * __builtin_amdgcn_rcpf(1.f + __expf(-x)); }
DI int mod_row(int row) { return row < NTL ? (row >> 11) : 16; }

constexpr int LDT = 72;

struct MapPlain { DI int operator()(int tn, int cl) const { return tn * 128 + cl; } };
struct MapHeadPerm { DI int operator()(int tn, int cl) const { return tn * 128 + (cl & 64) + ((cl >> 2) & 3) * 16 + ((cl >> 4) & 3) * 4; } };
struct MapGateUp { DI int operator()(int tn, int cl) const { int sub = cl >> 4, j = cl & 15; return ((sub & 1) ? DFF : 0) + tn * 64 + (sub >> 1) * 16 + j; } };

template <class BMap>
DI void gemm_mainloop(const bf16_t* __restrict__ A, int lda, const float* __restrict__ B, int ldb, int K, int tn, BMap bmap,
                      f32x4 (&acc)[4][4], char* lds) {
  bf16_t* As = (bf16_t*)lds;
  bf16_t* Bs = As + 128 * LDT;
  const int tid = tid_(), lane = tid & 63, wid = tid >> 6, wr = wid >> 1, wc = wid & 1;
  const int fr = lane & 15, fq = lane >> 4;
  const int arow = tid >> 3, akc = tid & 7;
  const int kg = tid >> 5, ng = tid & 31;
  const bf16_t* ap = A + (size_t)arow * lda + akc * 8;
  const float* bp = B + (size_t)(kg * 8) * ldb + bmap(tn, ng * 4);
  u32x4 ra[4];
  f32x4 rb[8];
  const int nk = K >> 6;
#pragma unroll
  for (int i = 0; i < 4; ++i) ra[i] = *(const u32x4*)(ap + (size_t)(i * 32) * lda);
#pragma unroll
  for (int i = 0; i < 8; ++i) rb[i] = *(const f32x4*)(bp + (size_t)i * ldb);
#pragma unroll 1
  for (int kt = 0; kt < nk; ++kt) {
    __syncthreads();
#pragma unroll
    for (int i = 0; i < 4; ++i) *(u32x4*)(As + (arow + i * 32) * LDT + akc * 8) = ra[i];
#pragma unroll
    for (int jn = 0; jn < 4; ++jn) {
      u32x4 w;
      w.x = pk2(rb[0][jn], rb[1][jn]); w.y = pk2(rb[2][jn], rb[3][jn]); w.z = pk2(rb[4][jn], rb[5][jn]); w.w = pk2(rb[6][jn], rb[7][jn]);
      *(u32x4*)(Bs + (ng * 4 + jn) * LDT + kg * 8) = w;
    }
    __syncthreads();
    if (kt + 1 < nk) {
      const bf16_t* ap2 = ap + (kt + 1) * 64;
      const float* bp2 = bp + (size_t)((kt + 1) * 64) * ldb;
#pragma unroll
      for (int i = 0; i < 4; ++i) ra[i] = *(const u32x4*)(ap2 + (size_t)(i * 32) * lda);
#pragma unroll
      for (int i = 0; i < 8; ++i) rb[i] = *(const f32x4*)(bp2 + (size_t)i * ldb);
    }
#pragma unroll
    for (int ks = 0; ks < 2; ++ks) {
      bf16x8 af[4], bfr[4];
#pragma unroll
      for (int mi = 0; mi < 4; ++mi) af[mi] = *(const bf16x8*)(As + (wr * 64 + mi * 16 + fr) * LDT + ks * 32 + fq * 8);
#pragma unroll
      for (int ni = 0; ni < 4; ++ni) bfr[ni] = *(const bf16x8*)(Bs + (wc * 64 + ni * 16 + fr) * LDT + ks * 32 + fq * 8);
#pragma unroll
      for (int mi = 0; mi < 4; ++mi)
#pragma unroll
        for (int ni = 0; ni < 4; ++ni) acc[mi][ni] = __builtin_amdgcn_mfma_f32_16x16x32_bf16(bfr[ni], af[mi], acc[mi][ni], 0, 0, 0);
    }
  }
  __syncthreads();
}

DI void zero_acc(f32x4 (&acc)[4][4]) {
#pragma unroll
  for (int mi = 0; mi < 4; ++mi)
#pragma unroll
    for (int ni = 0; ni < 4; ++ni) acc[mi][ni] = (f32x4){0.f, 0.f, 0.f, 0.f};
}

DI void tile_coords(int tile, int ntm, int ntn, int& tm, int& tn) {
  const int per = 8 * ntn;
  const int g = tile / per, rem = tile - g * per;
  const int gsz = (ntm - g * 8) < 8 ? (ntm - g * 8) : 8;
  tm = g * 8 + rem % gsz;
  tn = rem / gsz;
}

template <class BMap, class Epi>
DI void gemm_phase(const bf16_t* A, int lda, int M, const float* B, int ldb, int K, int N, BMap bmap, const Epi& epi, char* lds) {
  const int ntm = M >> 7, ntn = N >> 7, nt = ntm * ntn;
  const int lane = tid_() & 63, wid = tid_() >> 6;
  for (int tile = blockIdx.x; tile < nt; tile += gridDim.x) {
    int tm, tn;
    tile_coords(tile, ntm, ntn, tm, tn);
    f32x4 acc[4][4];
    zero_acc(acc);
    gemm_mainloop(A + (size_t)tm * 128 * lda, lda, B, ldb, K, tn, bmap, acc, lds);
    epi(tm, tn, wid >> 1, wid & 1, lane, acc);
  }
}

DI int lds_byte(int r, int c) { const int st = (r >> 4) * 2 + (c >> 5), rr = r & 15, cc = c & 31, ob = rr * 64 + cc * 2; return st * 1024 + (ob ^ (((ob >> 9) & 1) << 5)); }
DI void stage_rc(int b, int& R, int& C) { const int st = b >> 10, sb = b & 1023, swz = sb ^ (((sb >> 9) & 1) << 5); R = (st >> 1) * 16 + (swz >> 6); C = (st & 1) * 32 + ((swz & 63) >> 1); }
#define LAS __attribute__((address_space(3)))
DI void glds16(const bf16_t* g, LAS char* l) { __builtin_amdgcn_global_load_lds((const unsigned*)g, (LAS unsigned*)l, 16, 0, 0); }

DI int lds_byte32(int r, int c) { const int ob = (r & 15) * 64 + c * 2; return (r >> 4) * 1024 + (ob ^ (((ob >> 9) & 1) << 5)); }
DI void stage_rc32(int b, int& R, int& C) { const int st = b >> 10, sb = b & 1023, swz = sb ^ (((sb >> 9) & 1) << 5); R = st * 16 + (swz >> 6); C = (swz & 63) >> 1; }

template <int MI>
DI void gemm_mainloopT(const bf16_t* __restrict__ A, int lda, const bf16_t* __restrict__ Bt, int K, f32x4 (&acc)[MI][4], char* lds_generic) {
  static_assert(MI == 4 || MI == 6 || MI == 8, "MI");
  constexpr int NA = MI / 2;
  constexpr int G = NA + 2;
  constexpr int NST = MI == 4 ? 4 : 3;
  constexpr int ABYTES = MI * 2048, SBYTES = ABYTES + 8192;
  LAS char* lds = (LAS char*)lds_generic;
  const int tid = tid_(), lane = tid & 63, wid = tid >> 6, wr = wid >> 1, wc = wid & 1;
  const int fr = lane & 15, fq = lane >> 4;
  const bf16_t* ap[NA];
  const bf16_t* bp[2];
#pragma unroll
  for (int i = 0; i < NA; ++i) { int R, C; stage_rc32(tid * 16 + i * 4096, R, C); ap[i] = A + (size_t)R * lda + C; }
#pragma unroll
  for (int i = 0; i < 2; ++i) { int R, C; stage_rc32(tid * 16 + i * 4096, R, C); bp[i] = Bt + (size_t)R * K + C; }
  LAS char* lt = lds + tid * 16;
  const int nk = K >> 5;
  __syncthreads();
#pragma unroll
  for (int s = 0; s < NST - 1; ++s) {
#pragma unroll
    for (int i = 0; i < NA; ++i) glds16(ap[i] + s * 32, lt + s * SBYTES + i * 4096);
#pragma unroll
    for (int i = 0; i < 2; ++i) glds16(bp[i] + s * 32, lt + s * SBYTES + ABYTES + i * 4096);
  }
  int offA[MI], offB[4];
#pragma unroll
  for (int i = 0; i < MI; ++i) offA[i] = lds_byte32(wr * MI * 16 + i * 16 + fr, fq * 8);
#pragma unroll
  for (int i = 0; i < 4; ++i) offB[i] = ABYTES + lds_byte32(wc * 64 + i * 16 + fr, fq * 8);
  int st_cur = 0, st_nx = NST - 1;
#pragma unroll 1
  for (int kt = 0; kt < nk; ++kt) {
    if (NST == 4) {
      if (kt + 2 < nk) asm volatile("s_waitcnt vmcnt(8)" ::: "memory");
      else if (kt + 1 < nk) asm volatile("s_waitcnt vmcnt(4)" ::: "memory");
      else asm volatile("s_waitcnt vmcnt(0)" ::: "memory");
    } else {
      if (kt + 1 < nk) { if (G == 6) asm volatile("s_waitcnt vmcnt(6)" ::: "memory"); else asm volatile("s_waitcnt vmcnt(5)" ::: "memory"); }
      else asm volatile("s_waitcnt vmcnt(0)" ::: "memory");
    }
    __builtin_amdgcn_s_barrier();
    asm volatile("" ::: "memory");
    if (kt + NST - 1 < nk) {
      LAS char* nx = lt + st_nx * SBYTES;
      const int ko = (kt + NST - 1) * 32;
#pragma unroll
      for (int i = 0; i < NA; ++i) glds16(ap[i] + ko, nx + i * 4096);
#pragma unroll
      for (int i = 0; i < 2; ++i) glds16(bp[i] + ko, nx + ABYTES + i * 4096);
    }
    const LAS char* cur = lds + st_cur * SBYTES;
    st_cur = st_cur + 1 == NST ? 0 : st_cur + 1;
    st_nx = st_nx + 1 == NST ? 0 : st_nx + 1;
    bf16x8 af[MI], bfr[4];
#pragma unroll
    for (int ni = 0; ni < 4; ++ni) bfr[ni] = *(const LAS bf16x8*)(cur + offB[ni]);
#pragma unroll
    for (int mi = 0; mi < MI; ++mi) af[mi] = *(const LAS bf16x8*)(cur + offA[mi]);
    __builtin_amdgcn_s_setprio(1);
#pragma unroll
    for (int mi = 0; mi < MI; ++mi)
#pragma unroll
      for (int ni = 0; ni < 4; ++ni) acc[mi][ni] = __builtin_amdgcn_mfma_f32_16x16x32_bf16(bfr[ni], af[mi], acc[mi][ni], 0, 0, 0);
    __builtin_amdgcn_s_setprio(0);
  }
}
DI void gemm_mainloop2(const bf16_t* __restrict__ A, int lda, const bf16_t* __restrict__ Bt, int K, f32x4 (&acc)[4][4], char* lds) {
  gemm_mainloopT<4>(A, lda, Bt, K, acc, lds);
}

template <int SM, int SN>
DI bool xcd_tile(int it, int ntm, int ntn, int& tm, int& tn) {
  const int xcd = blockIdx.x & 7, j = blockIdx.x >> 3, per_xcd = gridDim.x >> 3;
  const int nsn = ntn / SN, ns = (ntm / SM) * nsn;
  const int idx = it * per_xcd + j;
  const int sl = idx / (SM * SN), w = idx - sl * (SM * SN);
  const int s = sl * 8 + xcd;
  if (s >= ns) return false;
  const int sm = s / nsn, sn = s - sm * nsn;
  tm = sm * SM + w % SM;
  tn = sn * SN + w / SM;
  return true;
}

template <int MI, int SM, int SN, bool REV = false, class Epi>
DI void gemm_phaseT(const bf16_t* A, int lda, int M, int tm0, const bf16_t* Bt, int K, int N, const Epi& epi, char* lds) {
  const int ntm = M / (MI * 32), ntn = N >> 7;
  const int lane = tid_() & 63, wid = tid_() >> 6;
  int tm, tn;
  for (int it = 0; xcd_tile<SM, SN>(it, ntm, ntn, tm, tn); ++it) {
    if (REV) tm = ntm - 1 - tm;
    f32x4 acc[MI][4];
#pragma unroll
    for (int mi = 0; mi < MI; ++mi)
#pragma unroll
      for (int ni = 0; ni < 4; ++ni) acc[mi][ni] = (f32x4){0.f, 0.f, 0.f, 0.f};
    gemm_mainloopT<MI>(A + (size_t)tm * (MI * 32) * lda, lda, Bt + (size_t)tn * 128 * K, K, acc, lds);
    epi(tm + tm0, tn, wid >> 1, wid & 1, lane, acc);
  }
}
template <int SM, int SN, class Epi>
DI void gemm_phase2(const bf16_t* A, int lda, int M, int tm0, const bf16_t* Bt, int K, int N, const Epi& epi, char* lds) {
  gemm_phaseT<4, SM, SN>(A, lda, M, tm0, Bt, K, N, epi, lds);
}

struct CMapPlain { DI int operator()(int n) const { return n; } };
struct CMapGateUp { DI int operator()(int p) const { const int tn = p >> 7, sub = (p >> 4) & 7, j = p & 15; return ((sub & 1) ? DFF : 0) + tn * 64 + (sub >> 1) * 16 + j; } };
template <class CM>
DI void convert_T(const float* __restrict__ W, int ldw, int K, int N, bf16_t* __restrict__ Wt, CM cm, char* lds) {
  float* tl = (float*)lds;
  const int tid = tid_();
  const int nkt = K >> 6, nnt = N >> 6;
  for (int t = blockIdx.x; t < nkt * nnt; t += gridDim.x) {
    const int kt = t % nkt, nt = t / nkt;
    __syncthreads();
    const int n4 = (tid & 15) * 4;
    const int sc = cm(nt * 64 + n4);
#pragma unroll
    for (int ps = 0; ps < 4; ++ps) {
      const int kk = ps * 16 + (tid >> 4);
      const f32x4 v = *(const f32x4*)(W + (size_t)(kt * 64 + kk) * ldw + sc);
#pragma unroll
      for (int e = 0; e < 4; ++e) tl[kk * 65 + n4 + e] = v[e];
    }
    __syncthreads();
    const int nn = tid >> 2, kc = (tid & 3) * 16;
    u32x4 o0, o1;
    const float* q = tl + kc * 65 + nn;
    o0.x = pk2(q[0 * 65], q[1 * 65]); o0.y = pk2(q[2 * 65], q[3 * 65]); o0.z = pk2(q[4 * 65], q[5 * 65]); o0.w = pk2(q[6 * 65], q[7 * 65]);
    o1.x = pk2(q[8 * 65], q[9 * 65]); o1.y = pk2(q[10 * 65], q[11 * 65]); o1.z = pk2(q[12 * 65], q[13 * 65]); o1.w = pk2(q[14 * 65], q[15 * 65]);
    bf16_t* d = Wt + (size_t)(nt * 64 + nn) * K + kt * 64 + kc;
    *(u32x4*)d = o0;
    *(u32x4*)(d + 8) = o1;
  }
  __syncthreads();
}
DI void convert_ffn(const Params& p, int slot, const float* wi, const float* wo, char* lds) {
  bf16_t* wf = p.WF + slot * WF_SLOT;
  convert_T(wi, 2 * DFF, DM, 2 * DFF, wf, CMapGateUp(), lds);
  convert_T(wo, DM, DFF, DM, wf + WF_WO, CMapPlain(), lds);
}
DI void convert_mixer(const Params& p, int l, char* lds) {
  bf16_t* wm = p.WM + (size_t)l * WM_STRIDE;
  convert_T(p.w_in + (size_t)l * DM * DIN, DIN, DM, DIN, wm + WM_IN, CMapPlain(), lds);
  for (int z = 0; z < 3; ++z) convert_T(p.w_branch + (size_t)(l * 3 + z) * 512 * DM, DM, 512, DM, wm + WM_BR + (size_t)z * 1024 * 512, CMapPlain(), lds);
  convert_T(p.w_out + (size_t)l * DM * DM, DM, DM, DM, wm + WM_OUT, CMapPlain(), lds);
}

template <int MI>
struct EpiAct {
  bf16_t* H;
  DI void operator()(int tm, int tn, int wr, int wc, int lane, f32x4 (&acc)[MI][4]) const {
    const int fr = lane & 15, fq = lane >> 4;
#pragma unroll
    for (int mi = 0; mi < MI; ++mi) {
      const int row = tm * (MI * 32) + wr * (MI * 16) + mi * 16 + fr;
#pragma unroll
      for (int pr = 0; pr < 2; ++pr) {
        f32x4 g = acc[mi][2 * pr], u = acc[mi][2 * pr + 1], h;
#pragma unroll
        for (int j = 0; j < 4; ++j) h[j] = siluf_(g[j]) * u[j];
        st4bf(H + (size_t)row * DFF + tn * 64 + (wc * 2 + pr) * 16 + fq * 4, h);
      }
    }
  }
};

struct EpiResid {
  const float *src_lat, *src_ctx;
  float *dst_lat, *dst_ctx;
  const float* gate;
  float gmul;
  DI void operator()(int tm, int tn, int wr, int wc, int lane, f32x4 (&acc)[4][4]) const {
    const int fr = lane & 15, fq = lane >> 4;
    const int r0 = tm * 128;
    const bool lat = r0 < NTL;
    const float* s = lat ? src_lat + (size_t)r0 * DM : src_ctx + (size_t)(r0 - NTL) * DM;
    float* d = lat ? dst_lat + (size_t)r0 * DM : dst_ctx + (size_t)(r0 - NTL) * DM;
    const float* g = gate + (size_t)mod_row(r0) * NMOD;
#pragma unroll
    for (int ni = 0; ni < 4; ++ni) {
      const int col = tn * 128 + wc * 64 + ni * 16 + fq * 4;
      const f32x4 gv = *(const f32x4*)(g + col) * gmul;
#pragma unroll
      for (int mi = 0; mi < 4; ++mi) {
        const int rl = wr * 64 + mi * 16 + fr;
        const f32x4 xv = *(const f32x4*)(s + (size_t)rl * DM + col);
        *(f32x4*)(d + (size_t)rl * DM + col) = xv * ALPHA + gv * acc[mi][ni];
      }
    }
  }
};

template <int MI>
struct EpiResidLN {
  const float *src_lat, *src_ctx;
  float *dst_lat, *dst_ctx;
  const float* gate;
  const float *lng, *lnb;
  const float* mods_next;
  bf16_t* U;
  float* stats;
  unsigned* cnt;
  float gmul;
  int shift_idx;
  DI void operator()(int tm, int tn, int wr, int wc, int lane, f32x4 (&acc)[MI][4]) const {
    const int fr = lane & 15, fq = lane >> 4;
    const int rw = tm * (MI * 32) + wr * (MI * 16);
#pragma unroll
    for (int mi = 0; mi < MI; ++mi) {
      const int rg = rw + mi * 16;
      const bool lat = rg < NTL;
      const float* s = (lat ? src_lat + (size_t)rg * DM : src_ctx + (size_t)(rg - NTL) * DM) + (size_t)fr * DM;
      const float* g = gate + (size_t)mod_row(rg) * NMOD;
#pragma unroll
      for (int ni = 0; ni < 4; ++ni) {
        const int col = tn * 128 + wc * 64 + ni * 16 + fq * 4;
        const f32x4 gv = *(const f32x4*)(g + col) * gmul;
        const f32x4 xv = *(const f32x4*)(s + col);
        acc[mi][ni] = xv * ALPHA + gv * acc[mi][ni];
      }
      float sm = 0.f;
#pragma unroll
      for (int ni = 0; ni < 4; ++ni) sm += (acc[mi][ni][0] + acc[mi][ni][1]) + (acc[mi][ni][2] + acc[mi][ni][3]);
      sm += __shfl_xor(sm, 16); sm += __shfl_xor(sm, 32);
      const float mean_i = sm * (1.f / 64.f);
      float q = 0.f;
#pragma unroll
      for (int ni = 0; ni < 4; ++ni) { const f32x4 dd = acc[mi][ni] - mean_i; q += (dd[0] * dd[0] + dd[1] * dd[1]) + (dd[2] * dd[2] + dd[3] * dd[3]); }
      q += __shfl_xor(q, 16); q += __shfl_xor(q, 32);
      if (fq == 0) {
        const unsigned long long pk = ((unsigned long long)__float_as_uint(q) << 32) | (unsigned long long)__float_as_uint(sm);
        __hip_atomic_store((unsigned long long*)(stats + ((size_t)(rg + fr) * 16 + tn * 2 + wc) * 2), pk, __ATOMIC_RELAXED, __HIP_MEMORY_SCOPE_AGENT);
      }
      asm volatile("" ::: "memory");
    }
    asm volatile("s_waitcnt vmcnt(0)" ::: "memory");
    __syncthreads();
    if (tid_() == 0) {
      __hip_atomic_fetch_add(cnt + tm, 1u, __ATOMIC_RELAXED, __HIP_MEMORY_SCOPE_AGENT);
      while (__hip_atomic_load(cnt + tm, __ATOMIC_RELAXED, __HIP_MEMORY_SCOPE_AGENT) < 8u) __builtin_amdgcn_s_sleep(1);
    }
    __syncthreads();
#pragma unroll
    for (int mi = 0; mi < MI; ++mi) {
      const int rg = rw + mi * 16;
      const bool lat = rg < NTL;
      float* d = (lat ? dst_lat + (size_t)rg * DM : dst_ctx + (size_t)(rg - NTL) * DM) + (size_t)fr * DM;
      const float* mr = mods_next + (size_t)mod_row(rg) * NMOD + shift_idx * DM;
      const unsigned long long* sq = (const unsigned long long*)(stats + ((size_t)(rg + fr) * 16 + fq * 4) * 2);
      const unsigned long long u0 = __hip_atomic_load(sq + 0, __ATOMIC_RELAXED, __HIP_MEMORY_SCOPE_AGENT), u1 = __hip_atomic_load(sq + 1, __ATOMIC_RELAXED, __HIP_MEMORY_SCOPE_AGENT);
      const unsigned long long u2 = __hip_atomic_load(sq + 2, __ATOMIC_RELAXED, __HIP_MEMORY_SCOPE_AGENT), u3 = __hip_atomic_load(sq + 3, __ATOMIC_RELAXED, __HIP_MEMORY_SCOPE_AGENT);
      const f32x4 p0 = {__uint_as_float((unsigned)u0), __uint_as_float((unsigned)(u0 >> 32)), __uint_as_float((unsigned)u1), __uint_as_float((unsigned)(u1 >> 32))};
      const f32x4 p1 = {__uint_as_float((unsigned)u2), __uint_as_float((unsigned)(u2 >> 32)), __uint_as_float((unsigned)u3), __uint_as_float((unsigned)(u3 >> 32))};
      float ts = (p0[0] + p0[2]) + (p1[0] + p1[2]);
      ts += __shfl_xor(ts, 16); ts += __shfl_xor(ts, 32);
      const float mean = ts * (1.f / 1024.f);
      const float d0 = p0[0] * (1.f / 64.f) - mean, d1 = p0[2] * (1.f / 64.f) - mean, d2 = p1[0] * (1.f / 64.f) - mean, d3 = p1[2] * (1.f / 64.f) - mean;
      float m2 = (p0[1] + p0[3]) + (p1[1] + p1[3]) + 64.f * ((d0 * d0 + d1 * d1) + (d2 * d2 + d3 * d3));
      m2 += __shfl_xor(m2, 16); m2 += __shfl_xor(m2, 32);
      const float rstd = rsqrtf(m2 * (1.f / 1024.f) + 1e-5f);
#pragma unroll
      for (int ni = 0; ni < 4; ++ni) {
        const int col = tn * 128 + wc * 64 + ni * 16 + fq * 4;
        const f32x4 y = (acc[mi][ni] - mean) * rstd * *(const f32x4*)(lng + col) + *(const f32x4*)(lnb + col);
        *(f32x4*)(d + col) = y;
        if (U) {
          const f32x4 sh = *(const f32x4*)(mr + col), sc = *(const f32x4*)(mr + DM + col);
          st4bf(U + (size_t)(rg + fr) * DM + col, y * (sc + 1.f) + sh);
        }
      }
      asm volatile("" ::: "memory");
    }
  }
};

template <int MI>
struct EpiProj {
  const Params* p;
  int l;
  DI void operator()(int tm, int tn, int wr, int wc, int lane, f32x4 (&acc)[MI][4]) const {
    const int fr = lane & 15, fq = lane >> 4;
    const int col0 = tn * 128 + wc * 64;
    const bool lat = tm * (MI * 32) < NTL;
    bf16_t* P = p->P;
    if (tn < 5) {
      const float* gain = (tn < 4 ? p->q_gain : p->k_gain) + l * 64;
      const float mult = tn < 4 ? QSCALE : 1.f;
      f32x4 gv[4];
#pragma unroll
      for (int ni = 0; ni < 4; ++ni) gv[ni] = *(const f32x4*)(gain + ni * 16 + fq * 4);
#pragma unroll
      for (int mi = 0; mi < MI; ++mi) {
        const int row = tm * (MI * 32) + wr * (MI * 16) + mi * 16 + fr;
        float ss = 0.f;
#pragma unroll
        for (int ni = 0; ni < 4; ++ni)
#pragma unroll
          for (int j = 0; j < 4; ++j) ss += acc[mi][ni][j] * acc[mi][ni][j];
        ss += __shfl_xor(ss, 16);
        ss += __shfl_xor(ss, 32);
        const float rinv = rsqrtf(ss * (1.f / 64.f) + 1e-6f);
        f32x4 v[4];
#pragma unroll
        for (int ni = 0; ni < 4; ++ni) v[ni] = acc[mi][ni] * rinv * gv[ni];
        if (lat) {
          const int t = row & (TL - 1);
          const int pr = t >> 6, pc = t & 63;
#pragma unroll
          for (int a = 0; a < 2; ++a) {
            const float* rt = p->rope + (size_t)((a ? pc : pr) * 16 + fq * 4) * 2;
            const f32x4 cs0 = *(const f32x4*)rt, cs1 = *(const f32x4*)(rt + 4);
            const float cc[4] = {cs0[0], cs0[2], cs1[0], cs1[2]};
            const float sn[4] = {cs0[1], cs0[3], cs1[1], cs1[3]};
#pragma unroll
            for (int j = 0; j < 4; ++j) {
              const float x1 = v[2 * a][j], x2 = v[2 * a + 1][j];
              v[2 * a][j] = x1 * cc[j] - x2 * sn[j];
              v[2 * a + 1][j] = x2 * cc[j] + x1 * sn[j];
            }
          }
        }
#pragma unroll
        for (int ni = 0; ni < 4; ++ni) st4bf(P + (size_t)row * DPROJ + col0 + ni * 16 + fq * 4, v[ni] * mult);
      }
    } else {
      const float mult = (tn >= 21 && tn < 25) ? QSCALE : 1.f;
#pragma unroll
      for (int mi = 0; mi < MI; ++mi) {
        const int row = tm * (MI * 32) + wr * (MI * 16) + mi * 16 + fr;
#pragma unroll
        for (int ni = 0; ni < 4; ++ni) st4bf(P + (size_t)row * DPROJ + col0 + ni * 16 + fq * 4, acc[mi][ni] * mult);
      }
    }
  }
};

DI f32x4 shifted4(const bf16_t* P, int row, bool hp, bool hn, int colidx, const float* mu_l) {
  const bf16_t* q = P + (size_t)row * DPROJ + 768 + colidx;
  const f32x4 x = ld4bf(q);
  const f32x4 xm = hp ? ld4bf(q - DPROJ) : (f32x4){0.f, 0.f, 0.f, 0.f};
  const f32x4 xp = hn ? ld4bf(q + DPROJ) : (f32x4){0.f, 0.f, 0.f, 0.f};
  const f32x4 m0 = *(const f32x4*)(mu_l + colidx), m1 = *(const f32x4*)(mu_l + 1920 + colidx);
  return x + m0 * (xm - x) + m1 * (xp - x);
}

struct EpiReadout {
  const Params* p;
  int l;
  DI void operator()(int tm, int tn, int wr, int wc, int lane, f32x4 (&acc)[4][4]) const {
    const int fr = lane & 15, fq = lane >> 4;
    const int head = tn * 2 + wc, colh = head * 64;
    const float* mu_l = p->mu + (size_t)l * 2 * 1920;
    const float* rk = p->r_k + l * 512 + colh;
    const float* gg = p->gn_g + l * 512 + colh;
    const float* gb = p->gn_b + l * 512 + colh;
    const bf16_t* Of = p->Os;
    const bf16_t* Ob = p->Os + (size_t)NTOK * 512;
    u32x2 gp[4][4];
#pragma unroll
    for (int mi = 0; mi < 4; ++mi)
#pragma unroll
      for (int ni = 0; ni < 4; ++ni) { gp[mi][ni].x = pk2(acc[mi][ni][0], acc[mi][ni][1]); gp[mi][ni].y = pk2(acc[mi][ni][2], acc[mi][ni][3]); }
#pragma unroll
    for (int mi = 0; mi < 4; ++mi) {
      const int row = tm * 128 + wr * 64 + mi * 16 + fr;
      int t, L;
      if (row < NTL) { t = row & (TL - 1); L = TL; } else { t = (row - NTL) & (TC - 1); L = TC; }
      const bool hp = t > 0, hn = t < L - 1;
      f32x4 o[4];
      float s = 0.f, bs = 0.f;
#pragma unroll
      for (int ni = 0; ni < 4; ++ni) {
        const int c = fq * 16 + ni * 4;
        o[ni] = ld4bf(Of + (size_t)row * 512 + colh + c) + ld4bf(Ob + (size_t)row * 512 + colh + c);
        s += (o[ni][0] + o[ni][1]) + (o[ni][2] + o[ni][3]);
      }
#pragma unroll 2
      for (int ni = 0; ni < 4; ++ni) {
        const int c = fq * 16 + ni * 4;
        const f32x4 r4 = shifted4(p->P, row, hp, hn, colh + c, mu_l);
        const f32x4 k4 = shifted4(p->P, row, hp, hn, 512 + colh + c, mu_l);
        const f32x4 rk4 = *(const f32x4*)(rk + c);
        const f32x4 pr = r4 * k4 * rk4;
        bs += (pr[0] + pr[1]) + (pr[2] + pr[3]);
      }
      s += __shfl_xor(s, 16); s += __shfl_xor(s, 32);
      bs += __shfl_xor(bs, 16); bs += __shfl_xor(bs, 32);
      const float mean = s * (1.f / 64.f);
      float q = 0.f;
#pragma unroll
      for (int ni = 0; ni < 4; ++ni) {
        const f32x4 d = o[ni] - mean;
        q += (d[0] * d[0] + d[1] * d[1]) + (d[2] * d[2] + d[3] * d[3]);
      }
      q += __shfl_xor(q, 16); q += __shfl_xor(q, 32);
      const float rstd = rsqrtf(q * (1.f / 64.f) + 64e-5f);
#pragma unroll
      for (int ni = 0; ni < 4; ++ni) {
        const int c = fq * 16 + ni * 4;
        const f32x4 g4 = *(const f32x4*)(gg + c), b4 = *(const f32x4*)(gb + c);
        const f32x4 vv = shifted4(p->P, row, hp, hn, 1024 + colh + c, mu_l);
        const f32x4 gate = {bflo(gp[mi][ni].x), bfhi(gp[mi][ni].x), bflo(gp[mi][ni].y), bfhi(gp[mi][ni].y)};
        const f32x4 y = ((o[ni] - mean) * rstd * g4 + b4 + vv * bs) * gate;
        st4bf(p->yr + (size_t)row * 512 + colh + c, y);
      }
      asm volatile("" ::: "memory");
    }
  }
};

DI float wave_sum(float v) {
#pragma unroll
  for (int o = 32; o > 0; o >>= 1) v += __shfl_xor(v, o);
  return v;
}

DI void ln_phase(float* xl, float* xc, int M, const float* g, const float* b, const float* mods_l, int shift_idx, bf16_t* U) {
  const int lane = tid_() & 63, wid = tid_() >> 6;
  for (int row = blockIdx.x * 4 + wid; row < M; row += gridDim.x * 4) {
    float* xr = row < NTL ? xl + (size_t)row * DM : xc + (size_t)(row - NTL) * DM;
    f32x4 v[4];
    float s = 0.f;
#pragma unroll
    for (int i = 0; i < 4; ++i) { v[i] = *(const f32x4*)(xr + i * 256 + lane * 4); s += (v[i][0] + v[i][1]) + (v[i][2] + v[i][3]); }
    const float mean = wave_sum(s) * (1.f / 1024.f);
    float q = 0.f;
#pragma unroll
    for (int i = 0; i < 4; ++i) { const f32x4 d = v[i] - mean; q += (d[0] * d[0] + d[1] * d[1]) + (d[2] * d[2] + d[3] * d[3]); }
    const float rstd = rsqrtf(wave_sum(q) * (1.f / 1024.f) + 1e-5f);
    const float* mr = mods_l + (size_t)mod_row(row) * NMOD + shift_idx * DM;
#pragma unroll
    for (int i = 0; i < 4; ++i) {
      const int c = i * 256 + lane * 4;
      const f32x4 y = (v[i] - mean) * rstd * *(const f32x4*)(g + c) + *(const f32x4*)(b + c);
      *(f32x4*)(xr + c) = y;
      if (U) {
        const f32x4 sh = *(const f32x4*)(mr + c), sc = *(const f32x4*)(mr + DM + c);
        st4bf(U + (size_t)row * DM + c, y * (sc + 1.f) + sh);
      }
    }
  }
}

DI void u0_phase(const Params& p) {
  const int lane = tid_() & 63, wid = tid_() >> 6;
  for (int row = blockIdx.x * 4 + wid; row < NTOK; row += gridDim.x * 4) {
    const float* xr = row < NTL ? p.x_in + (size_t)row * DM : p.ctx_in + (size_t)(row - NTL) * DM;
    const float* mr = p.mods + (size_t)mod_row(row) * NMOD;
#pragma unroll
    for (int i = 0; i < 4; ++i) {
      const int c = i * 256 + lane * 4;
      const f32x4 y = *(const f32x4*)(xr + c);
      const f32x4 sh = *(const f32x4*)(mr + c), sc = *(const f32x4*)(mr + DM + c);
      st4bf(p.U + (size_t)row * DM + c, y * (sc + 1.f) + sh);
    }
  }
}

DI void mods_phase(const Params& p, char* lds) {
  float* sc = (float*)lds;
  float* red = sc + 256 * 20;
  const int tid = tid_(), lane = tid & 63, wid = tid >> 6;
  if (blockIdx.x == 0) {
    if (tid < 64) p.counters[tid] = 0u;
    for (int i = tid; i < 6 * 288; i += NTHREADS) p.lncnt[i] = 0u;
    for (int i = tid; i < 1024; i += NTHREADS) {
      const int pos = i >> 4, k = i & 15;
      const float inv = exp2f(-(float)k * (1.f / 16.f) * 13.287712379549449f);
      const float ang = (float)pos * inv;
      p.rope[i * 2] = cosf(ang);
      p.rope[i * 2 + 1] = sinf(ang);
    }
  }
  for (int tile = blockIdx.x; tile < 288; tile += gridDim.x) {
    const int l = tile / 144, col0 = (tile % 144) * 64;
    float acc[17];
#pragma unroll
    for (int r = 0; r < 17; ++r) acc[r] = 0.f;
    for (int kc = 0; kc < 4; ++kc) {
      __syncthreads();
      for (int i = tid; i < 17 * 256; i += NTHREADS) {
        const int r = i >> 8, kk = i & 255;
        const float v = r < 16 ? p.c[r * DM + kc * 256 + kk] : p.c_ctx[kc * 256 + kk];
        sc[kk * 20 + r] = siluf_(v);
      }
      __syncthreads();
      const float* wp = p.w_ada + ((size_t)l * DM + kc * 256 + wid * 64) * NMOD + col0 + lane;
      for (int kk = 0; kk < 64; ++kk) {
        const float wv = wp[(size_t)kk * NMOD];
        const float* s = sc + (wid * 64 + kk) * 20;
#pragma unroll
        for (int r = 0; r < 17; ++r) acc[r] += s[r] * wv;
      }
    }
    __syncthreads();
#pragma unroll
    for (int r = 0; r < 17; ++r) red[(wid * 17 + r) * 64 + lane] = acc[r];
    __syncthreads();
    for (int i = tid; i < 17 * 64; i += NTHREADS) {
      const int r = i >> 6, cl = i & 63;
      const float s = red[(0 * 17 + r) * 64 + cl] + red[(1 * 17 + r) * 64 + cl] + red[(2 * 17 + r) * 64 + cl] + red[(3 * 17 + r) * 64 + cl];
      p.mods[((size_t)l * 17 + r) * NMOD + col0 + cl] = s + p.b_ada[l * NMOD + col0 + cl];
    }
  }
  __syncthreads();
}

DI void sg_phase(const Params& p, int l) {
  const int lane = tid_() & 63, wid = tid_() >> 6;
  const float* mu_l = p.mu + (size_t)l * 2 * 1920;
  for (int idx = blockIdx.x * NTHREADS + tid_(); idx < NTOK * 32; idx += gridDim.x * NTHREADS) {
    const int row = idx >> 5, c = (idx & 31) * 4;
    int t, L;
    if (row < NTL) { t = row & (TL - 1); L = TL; } else { t = (row - NTL) & (TC - 1); L = TC; }
    const f32x4 x = shifted4(p.P, row, t > 0, t < L - 1, 1792 + c, mu_l);
    f32x4 y;
#pragma unroll
    for (int j = 0; j < 4; ++j) y[j] = sigmoidf_(x[j]);
    st4bf(p.sg + (size_t)row * 128 + c, y);
  }
  (void)lane; (void)wid;
}

constexpr int KLD = 72;
constexpr int VLD = 68;

struct NoMask { DI void operator()(f32x16 (&st)[2]) const {} };

struct NaMask {
  const float* rp;
  int c;
  int c0;
  int h;
  DI void operator()(f32x16 (&st)[2]) const {
#pragma unroll
    for (int u = 0; u < 2; ++u)
#pragma unroll
      for (int i = 0; i < 16; ++i) {
        const int kc = u * 32 + (i & 3) + 8 * (i >> 2) + 4 * h;
        const bool ok = (kc >= c0) && (kc < c0 + 16);
        const int bi = ok ? (kc - c + 15) : 15;
        const float bias = rp[bi];
        st[u][i] = ok ? st[u][i] + bias : -1e30f;
      }
  }
};

template <class Mask>
DI void attn_tile(const bf16_t* Ks, const bf16_t* Vt, const bf16x8 (&qf)[4], f32x16 (&ot)[2], float& m, float& l, const Mask& mask, int lane) {
  const int r = lane & 31, h = lane >> 5;
  f32x16 st[2];
#pragma unroll
  for (int u = 0; u < 2; ++u) {
#pragma unroll
    for (int i = 0; i < 16; ++i) st[u][i] = 0.f;
#pragma unroll
    for (int s = 0; s < 4; ++s) {
      const bf16x8 kf = *(const bf16x8*)(Ks + (u * 32 + r) * KLD + s * 16 + h * 8);
      st[u] = __builtin_amdgcn_mfma_f32_32x32x16_bf16(kf, qf[s], st[u], 0, 0, 0);
    }
  }
  mask(st);
  float mx = st[0][0];
#pragma unroll
  for (int u = 0; u < 2; ++u)
#pragma unroll
    for (int i = 0; i < 16; ++i) mx = fmaxf(mx, st[u][i]);
  mx = fmaxf(mx, __shfl_xor(mx, 32));
  const float mnew = fmaxf(m, mx);
  const float alpha = __builtin_amdgcn_exp2f(m - mnew);
  m = mnew;
  float ls = 0.f;
#pragma unroll
  for (int u = 0; u < 2; ++u)
#pragma unroll
    for (int i = 0; i < 16; ++i) { st[u][i] = __builtin_amdgcn_exp2f(st[u][i] - mnew); ls += st[u][i]; }
  l = l * alpha + ls;
#pragma unroll
  for (int dt = 0; dt < 2; ++dt)
#pragma unroll
    for (int i = 0; i < 16; ++i) ot[dt][i] *= alpha;
#pragma unroll
  for (int u = 0; u < 2; ++u)
#pragma unroll
    for (int s = 0; s < 2; ++s) {
      u32x4 pw;
      pw.x = pk2(st[u][8 * s + 0], st[u][8 * s + 1]); pw.y = pk2(st[u][8 * s + 2], st[u][8 * s + 3]);
      pw.z = pk2(st[u][8 * s + 4], st[u][8 * s + 5]); pw.w = pk2(st[u][8 * s + 6], st[u][8 * s + 7]);
      const bf16x8 pb = __builtin_bit_cast(bf16x8, pw);
#pragma unroll
      for (int dt = 0; dt < 2; ++dt) {
        const bf16_t* vp = Vt + (dt * 32 + r) * VLD + u * 32 + 16 * s + 4 * h;
        const s16x4 lo = *(const s16x4*)vp, hi = *(const s16x4*)(vp + 8);
        const bf16x8 va = __builtin_shufflevector(lo, hi, 0, 1, 2, 3, 4, 5, 6, 7);
        ot[dt] = __builtin_amdgcn_mfma_f32_32x32x16_bf16(va, pb, ot[dt], 0, 0, 0);
      }
    }
}

template <int NHB>
DI void kv_load(const bf16_t* kb, const bf16_t* vb, u32x4 (&kr)[NHB * 2], u32x4 (&vr)[NHB * 2]) {
#pragma unroll
  for (int i = 0; i < NHB * 2; ++i) {
    const int c = tid_() + i * NTHREADS;
    const int hh = c >> 9, cc = c & 511, key = cc >> 3, dc = cc & 7;
    const size_t off = (size_t)key * DPROJ + hh * 64 + dc * 8;
    kr[i] = *(const u32x4*)(kb + off);
    vr[i] = *(const u32x4*)(vb + off);
  }
}
template <int NHB>
DI void kv_store(bf16_t* Ks, bf16_t* Vt, const u32x4 (&kr)[NHB * 2], const u32x4 (&vr)[NHB * 2]) {
#pragma unroll
  for (int i = 0; i < NHB * 2; ++i) {
    const int c = tid_() + i * NTHREADS;
    const int hh = c >> 9, cc = c & 511, key = cc >> 3, dc = cc & 7;
    *(u32x4*)(Ks + hh * 64 * KLD + key * KLD + dc * 8) = kr[i];
    bf16_t* vt = Vt + hh * 64 * VLD + (dc * 8) * VLD + key;
    vt[0 * VLD] = (bf16_t)(vr[i].x & 0xffff); vt[1 * VLD] = (bf16_t)(vr[i].x >> 16);
    vt[2 * VLD] = (bf16_t)(vr[i].y & 0xffff); vt[3 * VLD] = (bf16_t)(vr[i].y >> 16);
    vt[4 * VLD] = (bf16_t)(vr[i].z & 0xffff); vt[5 * VLD] = (bf16_t)(vr[i].z >> 16);
    vt[6 * VLD] = (bf16_t)(vr[i].w & 0xffff); vt[7 * VLD] = (bf16_t)(vr[i].w >> 16);
  }
}

DI void attn_finish(bf16_t* outp  , f32x16 (&ot)[2], float l, int lane) {
  const int h = lane >> 5;
  l += __shfl_xor(l, 32);
  const float inv = __builtin_amdgcn_rcpf(l);
#pragma unroll
  for (int dt = 0; dt < 2; ++dt)
#pragma unroll
    for (int g = 0; g < 4; ++g) {
      f32x4 v = {ot[dt][4 * g] * inv, ot[dt][4 * g + 1] * inv, ot[dt][4 * g + 2] * inv, ot[dt][4 * g + 3] * inv};
      st4bf(outp + dt * 32 + 8 * g + 4 * h, v);
    }
}

DI void dense_item(const Params& p, int qrow0, int qcol, int krow_lat0, int ntl, int krow_ctx0, int kcol, int vcol, char* lds) {
  bf16_t* Ks = (bf16_t*)lds;
  bf16_t* Vt = Ks + 2 * 64 * KLD;
  const int lane = tid_() & 63, wid = tid_() >> 6, r = lane & 31, h = lane >> 5;
  bf16_t* qp = p.P + (size_t)(qrow0 + wid * 32 + r) * DPROJ + qcol;
  bf16x8 qf[4];
#pragma unroll
  for (int s = 0; s < 4; ++s) qf[s] = *(const bf16x8*)(qp + s * 16 + h * 8);
  f32x16 ot[2];
#pragma unroll
  for (int dt = 0; dt < 2; ++dt)
#pragma unroll
    for (int i = 0; i < 16; ++i) ot[dt][i] = 0.f;
  float m = -1e30f, l = 0.f;
  const int nt = ntl + 4;
  u32x4 kr[2], vr[2];
  auto tile_row = [&](int jt) { return jt < ntl ? krow_lat0 + jt * 64 : krow_ctx0 + (jt - ntl) * 64; };
  {
    const bf16_t* base = p.P + (size_t)tile_row(0) * DPROJ;
    kv_load<1>(base + kcol, base + vcol, kr, vr);
  }
  for (int jt = 0; jt < nt; ++jt) {
    __syncthreads();
    kv_store<1>(Ks, Vt, kr, vr);
    __syncthreads();
    if (jt + 1 < nt) {
      const bf16_t* base = p.P + (size_t)tile_row(jt + 1) * DPROJ;
      kv_load<1>(base + kcol, base + vcol, kr, vr);
    }
    attn_tile(Ks, Vt, qf, ot, m, l, NoMask(), lane);
  }
  attn_finish(qp, ot, l, lane);
  __syncthreads();
}

DI void na_item(const Params& p, int lyr, int b, int gr, int hp, char* lds) {
  bf16_t* Ks = (bf16_t*)lds;
  bf16_t* Vt = Ks + 2 * 64 * KLD;
  float* rpl = (float*)(Vt + 2 * 64 * VLD);
  const int tid = tid_(), lane = tid & 63, wid = tid >> 6, r = lane & 31, h = lane >> 5;
  const int hl = wid >> 1, head = hp * 2 + hl, qh = wid & 1;
  const int r0 = gr - 4 < 0 ? 0 : (gr - 4 > 24 ? 24 : gr - 4);
  __syncthreads();
  for (int i = tid; i < 2 * 465; i += NTHREADS) {
    const int hh = i / 465, e = i - hh * 465;
    rpl[i] = p.rpb[((size_t)lyr * 8 + hp * 2 + hh) * 465 + e] * LOG2E;
  }
  const int c = qh * 32 + r;
  const int c0 = c - 8 < 0 ? 0 : (c - 8 > 48 ? 48 : c - 8);
  bf16_t* qp = p.P + (size_t)(b * TL + gr * 64 + c) * DPROJ + 2688 + head * 64;
  bf16x8 qf[4];
#pragma unroll
  for (int s = 0; s < 4; ++s) qf[s] = *(const bf16x8*)(qp + s * 16 + h * 8);
  f32x16 ot[2];
#pragma unroll
  for (int dt = 0; dt < 2; ++dt)
#pragma unroll
    for (int i = 0; i < 16; ++i) ot[dt][i] = 0.f;
  float m = -1e30f, l = 0.f;
  u32x4 kr[4], vr[4];
  auto tile_row = [&](int jt) { return jt < 8 ? b * TL + (r0 + jt) * 64 : NTL + b * TC + (jt - 8) * 64; };
  const int kcol = 3200 + hp * 128, vcol = 3712 + hp * 128;
  {
    const bf16_t* base = p.P + (size_t)tile_row(0) * DPROJ;
    kv_load<2>(base + kcol, base + vcol, kr, vr);
  }
  for (int jt = 0; jt < 12; ++jt) {
    __syncthreads();
    kv_store<2>(Ks, Vt, kr, vr);
    __syncthreads();
    if (jt + 1 < 12) {
      const bf16_t* base = p.P + (size_t)tile_row(jt + 1) * DPROJ;
      kv_load<2>(base + kcol, base + vcol, kr, vr);
    }
    if (jt < 8) {
      NaMask mk;
      mk.rp = rpl + hl * 465 + (r0 + jt - gr + 7) * 31;
      mk.c = c; mk.c0 = c0; mk.h = h;
      attn_tile(Ks + hl * 64 * KLD, Vt + hl * 64 * VLD, qf, ot, m, l, mk, lane);
    } else {
      attn_tile(Ks + hl * 64 * KLD, Vt + hl * 64 * VLD, qf, ot, m, l, NoMask(), lane);
    }
  }
  attn_finish(qp, ot, l, lane);
  __syncthreads();
}

template <int CTRL>
DI float dpp_f(float x) { return __int_as_float(__builtin_amdgcn_update_dpp(0, __float_as_int(x), CTRL, 0xF, 0xF, true)); }
DI float red8(float x) {
  x += dpp_f<0xB1>(x);
  x += dpp_f<0x4E>(x);
  x += dpp_f<0x141>(x);
  return x;
}

struct ScanOps { f32x4 w[2], kk[2], b[2], kd[2], r[2]; f32x2 v; };
DI void scan_load(ScanOps& o, const float* base, int kg, int row0) {
#pragma unroll
  for (int i = 0; i < 2; ++i) {
    o.w[i] = *(const f32x4*)(base + kg * 8 + i * 4);
    o.kk[i] = *(const f32x4*)(base + 64 + kg * 8 + i * 4);
    o.b[i] = *(const f32x4*)(base + 128 + kg * 8 + i * 4);
    o.kd[i] = *(const f32x4*)(base + 192 + kg * 8 + i * 4);
    o.r[i] = *(const f32x4*)(base + 256 + kg * 8 + i * 4);
  }
  o.v = *(const f32x2*)(base + 320 + row0);
}

DI void scan_block(const Params& p, int lyr, int sidx, bool need_ctx, char* lds) {
  const int dir = sidx & 1, hd = (sidx >> 1) & 7, b = sidx >> 4;
  const int tid = tid_(), lane = tid & 63, w = tid >> 6;
  float* rec = (float*)lds;
  float* obuf = rec + 16 * 384;
  float* cst = obuf + 16 * 64;
  bf16_t* Aw = (bf16_t*)(cst + 14 * 64);
  bf16_t* Aa = Aw + 16 * 72;
  __syncthreads();
  for (int i = tid; i < 320; i += NTHREADS) {
    const int g = i >> 6, c = i & 63;
    const int colidx = (g < 3 ? g * 512 + hd * 64 : (g == 3 ? 1536 + dir * 64 : 1664 + dir * 64)) + c;
    cst[i] = p.mu[(size_t)lyr * 3840 + colidx];
    cst[320 + i] = p.mu[(size_t)lyr * 3840 + 1920 + colidx];
  }
  if (tid < 64) {
    cst[640 + tid] = p.w0[(lyr * 2 + dir) * 512 + hd * 64 + tid];
    cst[704 + tid] = p.a0[(lyr * 2 + dir) * 512 + hd * 64 + tid];
    cst[768 + tid] = p.k_k[lyr * 512 + hd * 64 + tid];
    cst[832 + tid] = p.k_a[lyr * 512 + hd * 64 + tid];
  }
  const int fr = lane & 15, fq = lane >> 4;
  bf16x8 bw[2], ba[2];
  {
    const float* w2p = p.w2 + (size_t)(lyr * 2 + dir) * 64 * 512 + hd * 64 + 16 * w + fr;
    const float* a2p = p.a2 + (size_t)(lyr * 2 + dir) * 64 * 512 + hd * 64 + 16 * w + fr;
#pragma unroll
    for (int ks = 0; ks < 2; ++ks) {
      u32x4 tw, ta;
      float xw[8], xa[8];
#pragma unroll
      for (int j = 0; j < 8; ++j) { xw[j] = w2p[(size_t)(ks * 32 + fq * 8 + j) * 512]; xa[j] = a2p[(size_t)(ks * 32 + fq * 8 + j) * 512]; }
      tw.x = pk2(xw[0], xw[1]); tw.y = pk2(xw[2], xw[3]); tw.z = pk2(xw[4], xw[5]); tw.w = pk2(xw[6], xw[7]);
      ta.x = pk2(xa[0], xa[1]); ta.y = pk2(xa[2], xa[3]); ta.z = pk2(xa[4], xa[5]); ta.w = pk2(xa[6], xa[7]);
      bw[ks] = __builtin_bit_cast(bf16x8, tw);
      ba[ks] = __builtin_bit_cast(bf16x8, ta);
    }
  }
  f32x4 S[2][2];
#pragma unroll
  for (int a = 0; a < 2; ++a)
#pragma unroll
    for (int i = 0; i < 2; ++i) S[a][i] = (f32x4){0.f, 0.f, 0.f, 0.f};
  const int kg = lane & 7, rp = lane >> 3, row0 = 16 * w + rp * 2;
  const int pj = tid >> 4, pcg = tid & 15;
  int goff[5] = {hd * 64, 512 + hd * 64, 1024 + hd * 64, 1536 + dir * 64, 1664 + dir * 64};
  u32x2 raw[5][3];
  auto chunk_tok = [&](int ch, int j, int& rowbase, int& t, int& L) {
    int n0;
    if (ch < 16) { L = TC; n0 = ch * 16; rowbase = NTL + b * TC; } else { L = TL; n0 = (ch - 16) * 16; rowbase = b * TL; }
    const int n = n0 + j;
    t = dir ? L - 1 - n : n;
  };
  auto prefetch = [&](int ch) {
    int rowbase, t, L;
    chunk_tok(ch, pj, rowbase, t, L);
    const bf16_t* q = p.P + (size_t)(rowbase + t) * DPROJ + 768 + pcg * 4;
#pragma unroll
    for (int g = 0; g < 5; ++g) {
      raw[g][1] = *(const u32x2*)(q + goff[g]);
      raw[g][0] = t > 0 ? *(const u32x2*)(q + goff[g] - DPROJ) : (u32x2){0u, 0u};
      raw[g][2] = t < L - 1 ? *(const u32x2*)(q + goff[g] + DPROJ) : (u32x2){0u, 0u};
    }
  };
  prefetch(0);
  __syncthreads();
  for (int ch = 0; ch < 144; ++ch) {
    {
      f32x4 xs[5];
#pragma unroll
      for (int g = 0; g < 5; ++g) {
        const f32x4 x = {bflo(raw[g][1].x), bfhi(raw[g][1].x), bflo(raw[g][1].y), bfhi(raw[g][1].y)};
        const f32x4 xm = {bflo(raw[g][0].x), bfhi(raw[g][0].x), bflo(raw[g][0].y), bfhi(raw[g][0].y)};
        const f32x4 xp = {bflo(raw[g][2].x), bfhi(raw[g][2].x), bflo(raw[g][2].y), bfhi(raw[g][2].y)};
        const f32x4 m0 = *(const f32x4*)(cst + g * 64 + pcg * 4), m1 = *(const f32x4*)(cst + 320 + g * 64 + pcg * 4);
        xs[g] = x + m0 * (xm - x) + m1 * (xp - x);
      }
      float* rj = rec + pj * 384;
      *(f32x4*)(rj + 256 + pcg * 4) = xs[0];
      *(f32x4*)(rj + 320 + pcg * 4) = xs[2];
      const f32x4 kx = xs[1] * *(const f32x4*)(cst + 768 + pcg * 4);
      float ss = (kx[0] * kx[0] + kx[1] * kx[1]) + (kx[2] * kx[2] + kx[3] * kx[3]);
      ss += __shfl_xor(ss, 1); ss += __shfl_xor(ss, 2); ss += __shfl_xor(ss, 4); ss += __shfl_xor(ss, 8);
      const float rn = rsqrtf(ss + 1e-12f);
      *(f32x4*)(rj + 64 + pcg * 4) = kx * rn;
      *(f32x4*)(rj + 192 + pcg * 4) = xs[1];
      f32x4 tw;
#pragma unroll
      for (int j = 0; j < 4; ++j) tw[j] = 1.f - 2.f * __builtin_amdgcn_rcpf(1.f + __expf(2.f * xs[3][j]));
      st4bf(Aw + pj * 72 + pcg * 4, tw);
      st4bf(Aa + pj * 72 + pcg * 4, xs[4]);
    }
    __syncthreads();
    {
      f32x4 aw = {0.f, 0.f, 0.f, 0.f}, aa = {0.f, 0.f, 0.f, 0.f};
#pragma unroll
      for (int ks = 0; ks < 2; ++ks) {
        const bf16x8 fw = *(const bf16x8*)(Aw + fr * 72 + ks * 32 + fq * 8);
        const bf16x8 fa = *(const bf16x8*)(Aa + fr * 72 + ks * 32 + fq * 8);
        aw = __builtin_amdgcn_mfma_f32_16x16x32_bf16(bw[ks], fw, aw, 0, 0, 0);
        aa = __builtin_amdgcn_mfma_f32_16x16x32_bf16(ba[ks], fa, aa, 0, 0, 0);
      }
      const int c = 16 * w + fq * 4;
      float* rj = rec + fr * 384;
      const f32x4 w0v = *(const f32x4*)(cst + 640 + c), a0v = *(const f32x4*)(cst + 704 + c), kav = *(const f32x4*)(cst + 832 + c);
      const f32x4 kkv = *(const f32x4*)(rj + 64 + c), kpv = *(const f32x4*)(rj + 192 + c);
      f32x4 dec, bb, kd;
#pragma unroll
      for (int j = 0; j < 4; ++j) {
        const float z = -(w0v[j] + aw[j]);
        const float sp = fmaxf(z, 0.f) + __logf(1.f + __expf(-fabsf(z)));
        const float wl = -sp - 0.5f;
        dec[j] = __expf(-__expf(wl));
        const float ic = sigmoidf_(a0v[j] + aa[j]);
        bb[j] = kkv[j] * ic;
        kd[j] = kpv[j] * (1.f + (ic - 1.f) * kav[j]);
      }
      *(f32x4*)(rj + c) = dec;
      *(f32x4*)(rj + 128 + c) = bb;
      *(f32x4*)(rj + 192 + c) = kd;
    }
    __syncthreads();
    if (ch + 1 < 144) prefetch(ch + 1);
    {
      ScanOps cur, nxt;
      scan_load(cur, rec, kg, row0);
#pragma unroll 2
      for (int j = 0; j < 16; ++j) {
        if (j + 1 < 16) scan_load(nxt, rec + (j + 1) * 384, kg, row0);
#pragma unroll
        for (int a = 0; a < 2; ++a) {
          f32x4 t0 = S[a][0] * cur.kk[0] + S[a][1] * cur.kk[1];
          float sap = red8((t0[0] + t0[1]) + (t0[2] + t0[3]));
          const float vv = a ? cur.v.y : cur.v.x;
          S[a][0] = S[a][0] * cur.w[0] - cur.b[0] * sap + cur.kd[0] * vv;
          S[a][1] = S[a][1] * cur.w[1] - cur.b[1] * sap + cur.kd[1] * vv;
          f32x4 t1 = S[a][0] * cur.r[0] + S[a][1] * cur.r[1];
          float o = red8((t1[0] + t1[1]) + (t1[2] + t1[3]));
          if (kg == 0) obuf[j * 64 + row0 + a] = o;
        }
        cur = nxt;
      }
    }
    __syncthreads();
    if (ch >= 16 || need_ctx) {
      int rowbase, t, L;
      chunk_tok(ch, pj, rowbase, t, L);
      const f32x4 ov = *(const f32x4*)(obuf + pj * 64 + pcg * 4);
      st4bf(p.Os + ((size_t)dir * NTOK + rowbase + t) * 512 + hd * 64 + pcg * 4, ov);
    }
  }
  __syncthreads();
}

DI bf16x8 pack8(f32x4 a, f32x4 b) {
  u32x4 t; t.x = pk2(a[0], a[1]); t.y = pk2(a[2], a[3]); t.z = pk2(b[0], b[1]); t.w = pk2(b[2], b[3]);
  return __builtin_bit_cast(bf16x8, t);
}
DI bf16x8 pack4z(f32x4 a) {
  u32x4 t; t.x = pk2(a[0], a[1]); t.y = pk2(a[2], a[3]); t.z = 0u; t.w = 0u;
  return __builtin_bit_cast(bf16x8, t);
}
#define MFMA16(a, b, c) __builtin_amdgcn_mfma_f32_16x16x32_bf16((a), (b), (c), 0, 0, 0)

DI void scan_block2(const Params& p, int lyr, int sidx, bool need_ctx, char* lds) {
  const int dir = sidx & 1, hd = (sidx >> 1) & 7, b = sidx >> 4;
  const int tid = tid_(), lane = tid & 63, w = tid >> 6;
  const int fr = lane & 15, fq = lane >> 4;
  float* rec = (float*)lds;
  float* obuf = rec + 16 * 384;
  float* cst = obuf + 16 * 64;
  bf16_t* Aw = (bf16_t*)(cst + 14 * 64);
  bf16_t* Aa = Aw + 16 * 72;
  bf16_t* ARt = Aa + 16 * 72;
  bf16_t* BKm = ARt + 32 * 72;
  bf16_t* BKt = BKm + 32 * 72;
  bf16_t* Vt = BKt + 64 * 40;
  float* WL = (float*)(Vt + 64 * 24);
  float* Gf = WL + 64;
  float* GNt = Gf + 32 * 33;
  float* Yf = GNt + 256;
  __syncthreads();
  for (int i = tid; i < 320; i += NTHREADS) {
    const int g = i >> 6, c = i & 63;
    const int colidx = (g < 3 ? g * 512 + hd * 64 : (g == 3 ? 1536 + dir * 64 : 1664 + dir * 64)) + c;
    cst[i] = p.mu[(size_t)lyr * 3840 + colidx];
    cst[320 + i] = p.mu[(size_t)lyr * 3840 + 1920 + colidx];
  }
  if (tid < 64) {
    cst[640 + tid] = p.w0[(lyr * 2 + dir) * 512 + hd * 64 + tid];
    cst[704 + tid] = p.a0[(lyr * 2 + dir) * 512 + hd * 64 + tid];
    cst[768 + tid] = p.k_k[lyr * 512 + hd * 64 + tid];
    cst[832 + tid] = p.k_a[lyr * 512 + hd * 64 + tid];
  }
  bf16x8 bw[2], ba[2];
  {
    const float* w2p = p.w2 + (size_t)(lyr * 2 + dir) * 64 * 512 + hd * 64 + 16 * w + fr;
    const float* a2p = p.a2 + (size_t)(lyr * 2 + dir) * 64 * 512 + hd * 64 + 16 * w + fr;
#pragma unroll
    for (int ks = 0; ks < 2; ++ks) {
      f32x4 x0, x1, y0, y1;
#pragma unroll
      for (int j = 0; j < 4; ++j) {
        x0[j] = w2p[(size_t)(ks * 32 + fq * 8 + j) * 512]; x1[j] = w2p[(size_t)(ks * 32 + fq * 8 + 4 + j) * 512];
        y0[j] = a2p[(size_t)(ks * 32 + fq * 8 + j) * 512]; y1[j] = a2p[(size_t)(ks * 32 + fq * 8 + 4 + j) * 512];
      }
      bw[ks] = pack8(x0, x1);
      ba[ks] = pack8(y0, y1);
    }
  }
  f32x4 ST[4];
#pragma unroll
  for (int kt = 0; kt < 4; ++kt) ST[kt] = (f32x4){0.f, 0.f, 0.f, 0.f};
  const int pj = tid >> 4, pcg = tid & 15;
  int goff[5] = {hd * 64, 512 + hd * 64, 1024 + hd * 64, 1536 + dir * 64, 1664 + dir * 64};
  u32x2 raw[5][3];
  auto chunk_tok = [&](int ch, int j, int& rowbase, int& t, int& L) {
    int n0;
    if (ch < 16) { L = TC; n0 = ch * 16; rowbase = NTL + b * TC; } else { L = TL; n0 = (ch - 16) * 16; rowbase = b * TL; }
    const int n = n0 + j;
    t = dir ? L - 1 - n : n;
  };
  auto prefetch = [&](int ch) {
    int rowbase, t, L;
    chunk_tok(ch, pj, rowbase, t, L);
    const bf16_t* q = p.P + (size_t)(rowbase + t) * DPROJ + 768 + pcg * 4;
    const bool hp = t > 0, hn = t < L - 1;
    const int om = hp ? -DPROJ : 0, on = hn ? DPROJ : 0;
#pragma unroll
    for (int g = 0; g < 5; ++g) {
      raw[g][1] = *(const u32x2*)(q + goff[g]);
      const u32x2 rm = *(const u32x2*)(q + goff[g] + om), rn = *(const u32x2*)(q + goff[g] + on);
      raw[g][0] = hp ? rm : (u32x2){0u, 0u};
      raw[g][2] = hn ? rn : (u32x2){0u, 0u};
    }
  };
  prefetch(0);
  __syncthreads();
  const bf16x8 zero8 = {0, 0, 0, 0, 0, 0, 0, 0};
#pragma unroll 1
  for (int ch = 0; ch < 144; ++ch) {
    {
      f32x4 xs[5];
#pragma unroll
      for (int g = 0; g < 5; ++g) {
        const f32x4 x = {bflo(raw[g][1].x), bfhi(raw[g][1].x), bflo(raw[g][1].y), bfhi(raw[g][1].y)};
        const f32x4 xm = {bflo(raw[g][0].x), bfhi(raw[g][0].x), bflo(raw[g][0].y), bfhi(raw[g][0].y)};
        const f32x4 xp = {bflo(raw[g][2].x), bfhi(raw[g][2].x), bflo(raw[g][2].y), bfhi(raw[g][2].y)};
        const f32x4 m0 = *(const f32x4*)(cst + g * 64 + pcg * 4), m1 = *(const f32x4*)(cst + 320 + g * 64 + pcg * 4);
        xs[g] = x + m0 * (xm - x) + m1 * (xp - x);
      }
      float* rj = rec + pj * 384;
      *(f32x4*)(rj + 256 + pcg * 4) = xs[0];
#pragma unroll
      for (int e = 0; e < 4; ++e) Vt[(pcg * 4 + e) * 24 + pj] = f2bf(xs[2][e]);
      const f32x4 kx = xs[1] * *(const f32x4*)(cst + 768 + pcg * 4);
      float ss = (kx[0] * kx[0] + kx[1] * kx[1]) + (kx[2] * kx[2] + kx[3] * kx[3]);
      ss = red8(ss); ss += dpp_f<0x140>(ss);
      const float rn = rsqrtf(ss + 1e-12f);
      *(f32x4*)(rj + 64 + pcg * 4) = kx * rn;
      *(f32x4*)(rj + 192 + pcg * 4) = xs[1];
      f32x4 tw;
#pragma unroll
      for (int j = 0; j < 4; ++j) tw[j] = 1.f - 2.f * __builtin_amdgcn_rcpf(1.f + __expf(2.f * xs[3][j]));
      st4bf(Aw + pj * 72 + pcg * 4, tw);
      st4bf(Aa + pj * 72 + pcg * 4, xs[4]);
    }
    if (ch + 1 < 144) prefetch(ch + 1);
    __syncthreads();
    {
      f32x4 aw = {0.f, 0.f, 0.f, 0.f}, aa = {0.f, 0.f, 0.f, 0.f};
#pragma unroll
      for (int ks = 0; ks < 2; ++ks) {
        const bf16x8 fw = *(const bf16x8*)(Aw + fr * 72 + ks * 32 + fq * 8);
        const bf16x8 fa = *(const bf16x8*)(Aa + fr * 72 + ks * 32 + fq * 8);
        aw = MFMA16(bw[ks], fw, aw);
        aa = MFMA16(ba[ks], fa, aa);
      }
      const int c = 16 * w + fq * 4;
      const float* rj = rec + fr * 384;
      const f32x4 w0v = *(const f32x4*)(cst + 640 + c), a0v = *(const f32x4*)(cst + 704 + c), kav = *(const f32x4*)(cst + 832 + c);
      const f32x4 kkv = *(const f32x4*)(rj + 64 + c), kpv = *(const f32x4*)(rj + 192 + c), rpv = *(const f32x4*)(rj + 256 + c);
      f32x4 e, E, ic;
#pragma unroll
      for (int j = 0; j < 4; ++j) {
        const float z = -(w0v[j] + aw[j]);
        const float sp = fmaxf(z, 0.f) + __logf(1.f + __expf(-fabsf(z)));
        e[j] = __expf(-sp - 0.5f);
        ic[j] = sigmoidf_(a0v[j] + aa[j]);
      }
      E = e;
#pragma unroll
      for (int j = 0; j < 4; ++j) {
        E[j] += dpp_f<0x111>(E[j]);
        E[j] += dpp_f<0x112>(E[j]);
        E[j] += dpp_f<0x114>(E[j]);
        E[j] += dpp_f<0x118>(E[j]);
      }
      f32x4 at, rt, bt, kt_;
#pragma unroll
      for (int j = 0; j < 4; ++j) {
        const float wi = __expf(E[j]);
        at[j] = -kkv[j] * __expf(e[j] - E[j]);
        rt[j] = rpv[j] * __expf(-E[j]);
        bt[j] = kkv[j] * ic[j] * wi;
        kt_[j] = kpv[j] * (1.f + (ic[j] - 1.f) * kav[j]) * wi;
      }
      st4bf(ARt + fr * 72 + c, at);
      st4bf(ARt + (16 + fr) * 72 + c, rt);
      st4bf(BKm + fr * 72 + c, bt);
      st4bf(BKm + (16 + fr) * 72 + c, kt_);
#pragma unroll
      for (int j = 0; j < 4; ++j) { BKt[(c + j) * 40 + fr] = f2bf(bt[j]); BKt[(c + j) * 40 + 16 + fr] = f2bf(kt_[j]); }
      if (fr == 15) {
#pragma unroll
        for (int j = 0; j < 4; ++j) WL[c + j] = __expf(-E[j]);
      }
    }
    __syncthreads();
    {
      const int ct = w >> 1, tt = w & 1;
      f32x4 g = {0.f, 0.f, 0.f, 0.f};
#pragma unroll
      for (int ks = 0; ks < 2; ++ks) {
        const bf16x8 A = *(const bf16x8*)(BKm + (ct * 16 + fr) * 72 + ks * 32 + fq * 8);
        const bf16x8 B = *(const bf16x8*)(ARt + (tt * 16 + fr) * 72 + ks * 32 + fq * 8);
        g = MFMA16(A, B, g);
      }
#pragma unroll
      for (int r = 0; r < 4; ++r) Gf[(ct * 16 + fq * 4 + r) * 33 + tt * 16 + fr] = g[r];
      if (w == 0) {
#pragma unroll
        for (int r = 0; r < 4; ++r) GNt[(fq * 4 + r) * 16 + fr] = g[r];
      }
    }
    f32x4 XA = {0.f, 0.f, 0.f, 0.f}, XR = {0.f, 0.f, 0.f, 0.f};
#pragma unroll
    for (int ks = 0; ks < 2; ++ks) {
      const bf16x8 Bs = pack8(ST[2 * ks], ST[2 * ks + 1]);
      {
        const bf16_t* ar = ARt + fr * 72 + fq * 4;
        const s16x4 lo = *(const s16x4*)(ar + (2 * ks) * 16), hi = *(const s16x4*)(ar + (2 * ks + 1) * 16);
        XA = MFMA16(__builtin_shufflevector(lo, hi, 0, 1, 2, 3, 4, 5, 6, 7), Bs, XA);
      }
      {
        const bf16_t* ar = ARt + (16 + fr) * 72 + fq * 4;
        const s16x4 lo = *(const s16x4*)(ar + (2 * ks) * 16), hi = *(const s16x4*)(ar + (2 * ks + 1) * 16);
        XR = MFMA16(__builtin_shufflevector(lo, hi, 0, 1, 2, 3, 4, 5, 6, 7), Bs, XR);
      }
    }
    __syncthreads();
    const bf16x8 vB = fq < 2 ? *(const bf16x8*)(Vt + (16 * w + fr) * 24 + fq * 8) : zero8;
    {
      f32x4 n0, n1;
#pragma unroll
      for (int jj = 0; jj < 4; ++jj) {
        const int i0 = fq * 8 + jj, i1 = fq * 8 + 4 + jj;
        const float g0 = Gf[(16 + (i0 & 15)) * 33 + fr], g1 = Gf[(16 + (i1 & 15)) * 33 + fr];
        n0[jj] = (fq < 2 && i0 < fr) ? g0 : 0.f;
        n1[jj] = (fq < 2 && i1 < fr) ? g1 : 0.f;
      }
      XA = MFMA16(pack8(n0, n1), vB, XA);
    }
    float* yw = Yf + (w * 16 + fr) * 20;
    *(f32x4*)(yw + fq * 4) = XA;
    float u[16];
    {
      const f32x4 y0 = *(const f32x4*)(yw), y1 = *(const f32x4*)(yw + 4), y2 = *(const f32x4*)(yw + 8), y3 = *(const f32x4*)(yw + 12);
#pragma unroll
      for (int j = 0; j < 4; ++j) { u[j] = y0[j]; u[4 + j] = y1[j]; u[8 + j] = y2[j]; u[12 + j] = y3[j]; }
#pragma unroll
      for (int i = 0; i < 15; ++i) {
#pragma unroll
        for (int t4 = (i + 1) / 4; t4 < 4; ++t4) {
          const f32x4 nn = *(const f32x4*)(GNt + i * 16 + t4 * 4);
#pragma unroll
          for (int e2 = 0; e2 < 4; ++e2) if (t4 * 4 + e2 > i) u[t4 * 4 + e2] += u[i] * nn[e2];
        }
      }
    }
    f32x4 uq;
#pragma unroll
    for (int j = 0; j < 4; ++j) uq[j] = fq == 0 ? u[j] : (fq == 1 ? u[4 + j] : (fq == 2 ? u[8 + j] : u[12 + j]));
    const bf16x8 uB = pack4z(uq);
    {
      f32x4 m0, n0, n1;
#pragma unroll
      for (int jj = 0; jj < 4; ++jj) {
        const int i = fq * 4 + jj;
        const float gm = Gf[i * 33 + 16 + fr];
        m0[jj] = i <= fr ? gm : 0.f;
        const int i0 = fq * 8 + jj, i1 = fq * 8 + 4 + jj;
        const float g0 = Gf[(16 + (i0 & 15)) * 33 + 16 + fr], g1 = Gf[(16 + (i1 & 15)) * 33 + 16 + fr];
        n0[jj] = (fq < 2 && i0 <= fr) ? g0 : 0.f;
        n1[jj] = (fq < 2 && i1 <= fr) ? g1 : 0.f;
      }
      XR = MFMA16(pack4z(m0), uB, XR);
      XR = MFMA16(pack8(n0, n1), vB, XR);
#pragma unroll
      for (int r = 0; r < 4; ++r) obuf[(fq * 4 + r) * 64 + 16 * w + fr] = XR[r];
    }
#pragma unroll
    for (int kt = 0; kt < 4; ++kt) {
      const bf16_t* bk = BKt + (kt * 16 + fr) * 40;
      const s16x4 lo = *(const s16x4*)(bk + fq * 4);
      const s16x4 z4 = {0, 0, 0, 0};
      ST[kt] = MFMA16(__builtin_shufflevector(lo, z4, 0, 1, 2, 3, 4, 5, 6, 7), uB, ST[kt]);
      const bf16x8 a5 = fq < 2 ? *(const bf16x8*)(bk + 16 + fq * 8) : zero8;
      ST[kt] = MFMA16(a5, vB, ST[kt]);
      ST[kt] *= *(const f32x4*)(WL + kt * 16 + fq * 4);
    }
    __syncthreads();
    if (ch >= 16 || need_ctx) {
      int rowbase, t, L;
      chunk_tok(ch, pj, rowbase, t, L);
      const f32x4 ov = *(const f32x4*)(obuf + pj * 64 + pcg * 4);
      st4bf(p.Os + ((size_t)dir * NTOK + rowbase + t) * 512 + hd * 64 + pcg * 4, ov);
    }
  }
  __syncthreads();
}

DI void scan_block3(const Params& p, int lyr, int sidx, bool need_ctx, char* lds) {
  const int dir = sidx & 1, hd = (sidx >> 1) & 7, b = sidx >> 4;
  const int tid = tid_(), lane = tid & 63, w = tid >> 6;
  const int fr = lane & 15, fq = lane >> 4;
  float* rec = (float*)lds;
  float* obuf = rec + 16 * 192;
  float* cst = obuf + 16 * 64;
  bf16_t* Aw = (bf16_t*)(cst + 14 * 64);
  bf16_t* Aa = Aw + 16 * 72;
  float* Gf = (float*)(Aa + 16 * 72);
  float* GNt = Gf + 32 * 33;
  float* Yf = GNt + 256;
  bf16_t* OPS = (bf16_t*)(Yf + 4 * 16 * 20);
  constexpr int OPS_STRIDE = 32 * 72 + 32 * 72 + 64 * 40 + 64 * 24 + 128;
  __syncthreads();
  for (int i = tid; i < 320; i += NTHREADS) {
    const int g = i >> 6, c = i & 63;
    const int colidx = (g < 3 ? g * 512 + hd * 64 : (g == 3 ? 1536 + dir * 64 : 1664 + dir * 64)) + c;
    cst[i] = p.mu[(size_t)lyr * 3840 + colidx];
    cst[320 + i] = p.mu[(size_t)lyr * 3840 + 1920 + colidx];
  }
  if (tid < 64) {
    cst[640 + tid] = p.w0[(lyr * 2 + dir) * 512 + hd * 64 + tid];
    cst[704 + tid] = p.a0[(lyr * 2 + dir) * 512 + hd * 64 + tid];
    cst[768 + tid] = p.k_k[lyr * 512 + hd * 64 + tid];
    cst[832 + tid] = p.k_a[lyr * 512 + hd * 64 + tid];
  }
  bf16x8 bw[2], ba[2];
  {
    const float* w2p = p.w2 + (size_t)(lyr * 2 + dir) * 64 * 512 + hd * 64 + 16 * w + fr;
    const float* a2p = p.a2 + (size_t)(lyr * 2 + dir) * 64 * 512 + hd * 64 + 16 * w + fr;
#pragma unroll
    for (int ks = 0; ks < 2; ++ks) {
      f32x4 x0, x1, y0, y1;
#pragma unroll
      for (int j = 0; j < 4; ++j) {
        x0[j] = w2p[(size_t)(ks * 32 + fq * 8 + j) * 512]; x1[j] = w2p[(size_t)(ks * 32 + fq * 8 + 4 + j) * 512];
        y0[j] = a2p[(size_t)(ks * 32 + fq * 8 + j) * 512]; y1[j] = a2p[(size_t)(ks * 32 + fq * 8 + 4 + j) * 512];
      }
      bw[ks] = pack8(x0, x1);
      ba[ks] = pack8(y0, y1);
    }
  }
  f32x4 ST[4];
#pragma unroll
  for (int kt = 0; kt < 4; ++kt) ST[kt] = (f32x4){0.f, 0.f, 0.f, 0.f};
  const int pj = tid >> 4, pcg = tid & 15;
  int goff[5] = {hd * 64, 512 + hd * 64, 1024 + hd * 64, 1536 + dir * 64, 1664 + dir * 64};
  u32x2 raw[5][3];
  auto chunk_tok = [&](int ch, int j, int& rowbase, int& t, int& L) {
    int n0;
    if (ch < 16) { L = TC; n0 = ch * 16; rowbase = NTL + b * TC; } else { L = TL; n0 = (ch - 16) * 16; rowbase = b * TL; }
    const int n = n0 + j;
    t = dir ? L - 1 - n : n;
  };
  auto prefetch = [&](int ch) {
    int rowbase, t, L;
    chunk_tok(ch, pj, rowbase, t, L);
    const bf16_t* q = p.P + (size_t)(rowbase + t) * DPROJ + 768 + pcg * 4;
    const bool hp = t > 0, hn = t < L - 1;
    const int om = hp ? -DPROJ : 0, on = hn ? DPROJ : 0;
#pragma unroll
    for (int g = 0; g < 5; ++g) {
      raw[g][1] = *(const u32x2*)(q + goff[g]);
      const u32x2 rm = *(const u32x2*)(q + goff[g] + om), rn = *(const u32x2*)(q + goff[g] + on);
      raw[g][0] = hp ? rm : (u32x2){0u, 0u};
      raw[g][2] = hn ? rn : (u32x2){0u, 0u};
    }
  };
  const bf16x8 zero8 = {0, 0, 0, 0, 0, 0, 0, 0};
  prefetch(0);
  __syncthreads();
    {
      bf16_t* ARt = OPS + (0) * OPS_STRIDE; bf16_t* BKm = ARt + 32 * 72; bf16_t* BKt = BKm + 32 * 72; bf16_t* Vt = BKt + 64 * 40; float* WL = (float*)(Vt + 64 * 24);
      (void)ARt; (void)BKm; (void)BKt; (void)Vt; (void)WL;
    {
      f32x4 xs[5];
#pragma unroll
      for (int g = 0; g < 5; ++g) {
        const f32x4 x = {bflo(raw[g][1].x), bfhi(raw[g][1].x), bflo(raw[g][1].y), bfhi(raw[g][1].y)};
        const f32x4 xm = {bflo(raw[g][0].x), bfhi(raw[g][0].x), bflo(raw[g][0].y), bfhi(raw[g][0].y)};
        const f32x4 xp = {bflo(raw[g][2].x), bfhi(raw[g][2].x), bflo(raw[g][2].y), bfhi(raw[g][2].y)};
        const f32x4 m0 = *(const f32x4*)(cst + g * 64 + pcg * 4), m1 = *(const f32x4*)(cst + 320 + g * 64 + pcg * 4);
        xs[g] = x + m0 * (xm - x) + m1 * (xp - x);
      }
      float* rj = rec + pj * 192;
      *(f32x4*)(rj + 128 + pcg * 4) = xs[0];
#pragma unroll
      for (int e = 0; e < 4; ++e) Vt[(pcg * 4 + e) * 24 + pj] = f2bf(xs[2][e]);
      const f32x4 kx = xs[1] * *(const f32x4*)(cst + 768 + pcg * 4);
      float ss = (kx[0] * kx[0] + kx[1] * kx[1]) + (kx[2] * kx[2] + kx[3] * kx[3]);
      ss = red8(ss); ss += dpp_f<0x140>(ss);
      const float rn = rsqrtf(ss + 1e-12f);
      *(f32x4*)(rj + 0 + pcg * 4) = kx * rn;
      *(f32x4*)(rj + 64 + pcg * 4) = xs[1];
      f32x4 tw;
#pragma unroll
      for (int j = 0; j < 4; ++j) tw[j] = 1.f - 2.f * __builtin_amdgcn_rcpf(1.f + __expf(2.f * xs[3][j]));
      st4bf(Aw + pj * 72 + pcg * 4, tw);
      st4bf(Aa + pj * 72 + pcg * 4, xs[4]);
    }
    }
  prefetch(1);
  __syncthreads();
    {
      bf16_t* ARt = OPS + (0) * OPS_STRIDE; bf16_t* BKm = ARt + 32 * 72; bf16_t* BKt = BKm + 32 * 72; bf16_t* Vt = BKt + 64 * 40; float* WL = (float*)(Vt + 64 * 24);
      (void)ARt; (void)BKm; (void)BKt; (void)Vt; (void)WL;
    {
      f32x4 aw = {0.f, 0.f, 0.f, 0.f}, aa = {0.f, 0.f, 0.f, 0.f};
#pragma unroll
      for (int ks = 0; ks < 2; ++ks) {
        const bf16x8 fw = *(const bf16x8*)(Aw + fr * 72 + ks * 32 + fq * 8);
        const bf16x8 fa = *(const bf16x8*)(Aa + fr * 72 + ks * 32 + fq * 8);
        aw = MFMA16(bw[ks], fw, aw);
        aa = MFMA16(ba[ks], fa, aa);
      }
      const int c = 16 * w + fq * 4;
      const float* rj = rec + fr * 192;
      const f32x4 w0v = *(const f32x4*)(cst + 640 + c), a0v = *(const f32x4*)(cst + 704 + c), kav = *(const f32x4*)(cst + 832 + c);
      const f32x4 kkv = *(const f32x4*)(rj + 0 + c), kpv = *(const f32x4*)(rj + 64 + c), rpv = *(const f32x4*)(rj + 128 + c);
      f32x4 e, E, ic;
#pragma unroll
      for (int j = 0; j < 4; ++j) {
        const float z = -(w0v[j] + aw[j]);
        const float sp = fmaxf(z, 0.f) + __logf(1.f + __expf(-fabsf(z)));
        e[j] = __expf(-sp - 0.5f);
        ic[j] = sigmoidf_(a0v[j] + aa[j]);
      }
      E = e;
#pragma unroll
      for (int j = 0; j < 4; ++j) {
        E[j] += dpp_f<0x111>(E[j]);
        E[j] += dpp_f<0x112>(E[j]);
        E[j] += dpp_f<0x114>(E[j]);
        E[j] += dpp_f<0x118>(E[j]);
      }
      f32x4 at, rt, bt, kt_;
#pragma unroll
      for (int j = 0; j < 4; ++j) {
        const float wi = __expf(E[j]);
        at[j] = -kkv[j] * __expf(e[j] - E[j]);
        rt[j] = rpv[j] * __expf(-E[j]);
        bt[j] = kkv[j] * ic[j] * wi;
        kt_[j] = kpv[j] * (1.f + (ic[j] - 1.f) * kav[j]) * wi;
      }
      st4bf(ARt + fr * 72 + c, at);
      st4bf(ARt + (16 + fr) * 72 + c, rt);
      st4bf(BKm + fr * 72 + c, bt);
      st4bf(BKm + (16 + fr) * 72 + c, kt_);
#pragma unroll
      for (int j = 0; j < 4; ++j) { BKt[(c + j) * 40 + fr] = f2bf(bt[j]); BKt[(c + j) * 40 + 16 + fr] = f2bf(kt_[j]); }
      if (fr == 15) {
#pragma unroll
        for (int j = 0; j < 4; ++j) WL[c + j] = __expf(-E[j]);
      }
    }
    }
#pragma unroll 1
  for (int ch = 0; ch < 144; ++ch) {
    const int cb = ch & 1, nb = cb ^ 1;
    const bool more = ch + 1 < 144;
    f32x4 XA, XR;
    __syncthreads();
    if (more) {
    {
      bf16_t* ARt = OPS + (nb) * OPS_STRIDE; bf16_t* BKm = ARt + 32 * 72; bf16_t* BKt = BKm + 32 * 72; bf16_t* Vt = BKt + 64 * 40; float* WL = (float*)(Vt + 64 * 24);
      (void)ARt; (void)BKm; (void)BKt; (void)Vt; (void)WL;
    {
      f32x4 xs[5];
#pragma unroll
      for (int g = 0; g < 5; ++g) {
        const f32x4 x = {bflo(raw[g][1].x), bfhi(raw[g][1].x), bflo(raw[g][1].y), bfhi(raw[g][1].y)};
        const f32x4 xm = {bflo(raw[g][0].x), bfhi(raw[g][0].x), bflo(raw[g][0].y), bfhi(raw[g][0].y)};
        const f32x4 xp = {bflo(raw[g][2].x), bfhi(raw[g][2].x), bflo(raw[g][2].y), bfhi(raw[g][2].y)};
        const f32x4 m0 = *(const f32x4*)(cst + g * 64 + pcg * 4), m1 = *(const f32x4*)(cst + 320 + g * 64 + pcg * 4);
        xs[g] = x + m0 * (xm - x) + m1 * (xp - x);
      }
      float* rj = rec + pj * 192;
      *(f32x4*)(rj + 128 + pcg * 4) = xs[0];
#pragma unroll
      for (int e = 0; e < 4; ++e) Vt[(pcg * 4 + e) * 24 + pj] = f2bf(xs[2][e]);
      const f32x4 kx = xs[1] * *(const f32x4*)(cst + 768 + pcg * 4);
      float ss = (kx[0] * kx[0] + kx[1] * kx[1]) + (kx[2] * kx[2] + kx[3] * kx[3]);
      ss = red8(ss); ss += dpp_f<0x140>(ss);
      const float rn = rsqrtf(ss + 1e-12f);
      *(f32x4*)(rj + 0 + pcg * 4) = kx * rn;
      *(f32x4*)(rj + 64 + pcg * 4) = xs[1];
      f32x4 tw;
#pragma unroll
      for (int j = 0; j < 4; ++j) tw[j] = 1.f - 2.f * __builtin_amdgcn_rcpf(1.f + __expf(2.f * xs[3][j]));
      st4bf(Aw + pj * 72 + pcg * 4, tw);
      st4bf(Aa + pj * 72 + pcg * 4, xs[4]);
    }
    }
      if (ch + 2 < 144) prefetch(ch + 2);
    }
    {
      bf16_t* ARt = OPS + (cb) * OPS_STRIDE; bf16_t* BKm = ARt + 32 * 72; bf16_t* BKt = BKm + 32 * 72; bf16_t* Vt = BKt + 64 * 40; float* WL = (float*)(Vt + 64 * 24);
      (void)ARt; (void)BKm; (void)BKt; (void)Vt; (void)WL;
    {
      const int ct = w >> 1, tt = w & 1;
      f32x4 g = {0.f, 0.f, 0.f, 0.f};
#pragma unroll
      for (int ks = 0; ks < 2; ++ks) {
        const bf16x8 A = *(const bf16x8*)(BKm + (ct * 16 + fr) * 72 + ks * 32 + fq * 8);
        const bf16x8 B = *(const bf16x8*)(ARt + (tt * 16 + fr) * 72 + ks * 32 + fq * 8);
        g = MFMA16(A, B, g);
      }
#pragma unroll
      for (int r = 0; r < 4; ++r) Gf[(ct * 16 + fq * 4 + r) * 33 + tt * 16 + fr] = g[r];
      if (w == 0) {
#pragma unroll
        for (int r = 0; r < 4; ++r) GNt[(fq * 4 + r) * 16 + fr] = g[r];
      }
    }
    XA = (f32x4){0.f, 0.f, 0.f, 0.f}; XR = (f32x4){0.f, 0.f, 0.f, 0.f};
#pragma unroll
    for (int ks = 0; ks < 2; ++ks) {
      const bf16x8 Bs = pack8(ST[2 * ks], ST[2 * ks + 1]);
      {
        const bf16_t* ar = ARt + fr * 72 + fq * 4;
        const s16x4 lo = *(const s16x4*)(ar + (2 * ks) * 16), hi = *(const s16x4*)(ar + (2 * ks + 1) * 16);
        XA = MFMA16(__builtin_shufflevector(lo, hi, 0, 1, 2, 3, 4, 5, 6, 7), Bs, XA);
      }
      {
        const bf16_t* ar = ARt + (16 + fr) * 72 + fq * 4;
        const s16x4 lo = *(const s16x4*)(ar + (2 * ks) * 16), hi = *(const s16x4*)(ar + (2 * ks + 1) * 16);
        XR = MFMA16(__builtin_shufflevector(lo, hi, 0, 1, 2, 3, 4, 5, 6, 7), Bs, XR);
      }
    }
    }
    __syncthreads();
    if (more) {
    {
      bf16_t* ARt = OPS + (nb) * OPS_STRIDE; bf16_t* BKm = ARt + 32 * 72; bf16_t* BKt = BKm + 32 * 72; bf16_t* Vt = BKt + 64 * 40; float* WL = (float*)(Vt + 64 * 24);
      (void)ARt; (void)BKm; (void)BKt; (void)Vt; (void)WL;
    {
      f32x4 aw = {0.f, 0.f, 0.f, 0.f}, aa = {0.f, 0.f, 0.f, 0.f};
#pragma unroll
      for (int ks = 0; ks < 2; ++ks) {
        const bf16x8 fw = *(const bf16x8*)(Aw + fr * 72 + ks * 32 + fq * 8);
        const bf16x8 fa = *(const bf16x8*)(Aa + fr * 72 + ks * 32 + fq * 8);
        aw = MFMA16(bw[ks], fw, aw);
        aa = MFMA16(ba[ks], fa, aa);
      }
      const int c = 16 * w + fq * 4;
      const float* rj = rec + fr * 192;
      const f32x4 w0v = *(const f32x4*)(cst + 640 + c), a0v = *(const f32x4*)(cst + 704 + c), kav = *(const f32x4*)(cst + 832 + c);
      const f32x4 kkv = *(const f32x4*)(rj + 0 + c), kpv = *(const f32x4*)(rj + 64 + c), rpv = *(const f32x4*)(rj + 128 + c);
      f32x4 e, E, ic;
#pragma unroll
      for (int j = 0; j < 4; ++j) {
        const float z = -(w0v[j] + aw[j]);
        const float sp = fmaxf(z, 0.f) + __logf(1.f + __expf(-fabsf(z)));
        e[j] = __expf(-sp - 0.5f);
        ic[j] = sigmoidf_(a0v[j] + aa[j]);
      }
      E = e;
#pragma unroll
      for (int j = 0; j < 4; ++j) {
        E[j] += dpp_f<0x111>(E[j]);
        E[j] += dpp_f<0x112>(E[j]);
        E[j] += dpp_f<0x114>(E[j]);
        E[j] += dpp_f<0x118>(E[j]);
      }
      f32x4 at, rt, bt, kt_;
#pragma unroll
      for (int j = 0; j < 4; ++j) {
        const float wi = __expf(E[j]);
        at[j] = -kkv[j] * __expf(e[j] - E[j]);
        rt[j] = rpv[j] * __expf(-E[j]);
        bt[j] = kkv[j] * ic[j] * wi;
        kt_[j] = kpv[j] * (1.f + (ic[j] - 1.f) * kav[j]) * wi;
      }
      st4bf(ARt + fr * 72 + c, at);
      st4bf(ARt + (16 + fr) * 72 + c, rt);
      st4bf(BKm + fr * 72 + c, bt);
      st4bf(BKm + (16 + fr) * 72 + c, kt_);
#pragma unroll
      for (int j = 0; j < 4; ++j) { BKt[(c + j) * 40 + fr] = f2bf(bt[j]); BKt[(c + j) * 40 + 16 + fr] = f2bf(kt_[j]); }
      if (fr == 15) {
#pragma unroll
        for (int j = 0; j < 4; ++j) WL[c + j] = __expf(-E[j]);
      }
    }
    }
    }
    {
      bf16_t* ARt = OPS + (cb) * OPS_STRIDE; bf16_t* BKm = ARt + 32 * 72; bf16_t* BKt = BKm + 32 * 72; bf16_t* Vt = BKt + 64 * 40; float* WL = (float*)(Vt + 64 * 24);
      (void)ARt; (void)BKm; (void)BKt; (void)Vt; (void)WL;
    const bf16x8 vB = fq < 2 ? *(const bf16x8*)(Vt + (16 * w + fr) * 24 + fq * 8) : zero8;
    {
      f32x4 n0, n1;
#pragma unroll
      for (int jj = 0; jj < 4; ++jj) {
        const int i0 = fq * 8 + jj, i1 = fq * 8 + 4 + jj;
        const float g0 = Gf[(16 + (i0 & 15)) * 33 + fr], g1 = Gf[(16 + (i1 & 15)) * 33 + fr];
        n0[jj] = (fq < 2 && i0 < fr) ? g0 : 0.f;
        n1[jj] = (fq < 2 && i1 < fr) ? g1 : 0.f;
      }
      XA = MFMA16(pack8(n0, n1), vB, XA);
    }
    float* yw = Yf + (w * 16 + fr) * 20;
    *(f32x4*)(yw + fq * 4) = XA;
    float u[16];
    {
      const f32x4 y0 = *(const f32x4*)(yw), y1 = *(const f32x4*)(yw + 4), y2 = *(const f32x4*)(yw + 8), y3 = *(const f32x4*)(yw + 12);
#pragma unroll
      for (int j = 0; j < 4; ++j) { u[j] = y0[j]; u[4 + j] = y1[j]; u[8 + j] = y2[j]; u[12 + j] = y3[j]; }
#pragma unroll
      for (int i = 0; i < 15; ++i) {
#pragma unroll
        for (int t4 = (i + 1) / 4; t4 < 4; ++t4) {
          const f32x4 nn = *(const f32x4*)(GNt + i * 16 + t4 * 4);
#pragma unroll
          for (int e2 = 0; e2 < 4; ++e2) if (t4 * 4 + e2 > i) u[t4 * 4 + e2] += u[i] * nn[e2];
        }
      }
    }
    f32x4 uq;
#pragma unroll
    for (int j = 0; j < 4; ++j) uq[j] = fq == 0 ? u[j] : (fq == 1 ? u[4 + j] : (fq == 2 ? u[8 + j] : u[12 + j]));
    const bf16x8 uB = pack4z(uq);
    {
      f32x4 m0, n0, n1;
#pragma unroll
      for (int jj = 0; jj < 4; ++jj) {
        const int i = fq * 4 + jj;
        const float gm = Gf[i * 33 + 16 + fr];
        m0[jj] = i <= fr ? gm : 0.f;
        const int i0 = fq * 8 + jj, i1 = fq * 8 + 4 + jj;
        const float g0 = Gf[(16 + (i0 & 15)) * 33 + 16 + fr], g1 = Gf[(16 + (i1 & 15)) * 33 + 16 + fr];
        n0[jj] = (fq < 2 && i0 <= fr) ? g0 : 0.f;
        n1[jj] = (fq < 2 && i1 <= fr) ? g1 : 0.f;
      }
      XR = MFMA16(pack4z(m0), uB, XR);
      XR = MFMA16(pack8(n0, n1), vB, XR);
#pragma unroll
      for (int r = 0; r < 4; ++r) obuf[(fq * 4 + r) * 64 + 16 * w + fr] = XR[r];
    }
#pragma unroll
    for (int kt = 0; kt < 4; ++kt) {
      const bf16_t* bk = BKt + (kt * 16 + fr) * 40;
      const s16x4 lo = *(const s16x4*)(bk + fq * 4);
      const s16x4 z4 = {0, 0, 0, 0};
      ST[kt] = MFMA16(__builtin_shufflevector(lo, z4, 0, 1, 2, 3, 4, 5, 6, 7), uB, ST[kt]);
      const bf16x8 a5 = fq < 2 ? *(const bf16x8*)(bk + 16 + fq * 8) : zero8;
      ST[kt] = MFMA16(a5, vB, ST[kt]);
      ST[kt] *= *(const f32x4*)(WL + kt * 16 + fq * 4);
    }
    }
    __syncthreads();
    if (ch >= 16 || need_ctx) {
      int rowbase, t, L;
      chunk_tok(ch, pj, rowbase, t, L);
      const f32x4 ov = *(const f32x4*)(obuf + pj * 64 + pcg * 4);
      st4bf(p.Os + ((size_t)dir * NTOK + rowbase + t) * 512 + hd * 64 + pcg * 4, ov);
    }
  }
  __syncthreads();
}

DI void mixer_phase(const Params& p, int l, bool need_ctx, char* lds, long long* scan_t) {
  int& s_item = *(int*)(lds + LDS_WORK + 16);
  sg_phase(p, l);
  { long long t0 = 0; if (PROBE_MASK) t0 = wall_clock64();
    __builtin_amdgcn_s_setprio(3);
    for (int s = blockIdx.x; s < 256; s += gridDim.x) scan_block3(p, l, s, need_ctx, lds);
    __builtin_amdgcn_s_setprio(0);
#ifdef SCAN_ALONE
    if (blockIdx.x < 256) { __syncthreads(); if (tid_() == 0) { __threadfence(); atomicAdd(&p.counters[8 + l], 1u); } }
    else { if (tid_() == 0) { while (atomicAdd(&p.counters[8 + l], 0u) < 256u) __builtin_amdgcn_s_sleep(32); } __syncthreads(); }
#endif
    if ((PROBE_MASK >> 13) & 1) *scan_t += wall_clock64() - t0; }
  const int nitems = 4096 + (need_ctx ? 512 : 0);
  while (true) {
    __syncthreads();
    if (tid_() == 0) s_item = (int)atomicAdd(&p.counters[l], 1u);
    __syncthreads();
    const int it = s_item;
    if (it >= nitems) break;
    if (it < 2048) {
      const int b = it >> 7, head = (it >> 4) & 7, qb = it & 15, kvh = head >> 2;
      dense_item(p, b * TL + qb * 128, head * 64, b * TL, 32, NTL + b * TC, 512 + kvh * 64, 640 + kvh * 64, lds);
    } else if (it < 4096) {
      const int i2 = it - 2048;
      const int b = i2 >> 7, gr = (i2 >> 2) & 31, hp = i2 & 3;
      na_item(p, l, b, gr, hp, lds);
    } else if (it < 4352) {
      const int i2 = it - 4096;
      const int b = i2 >> 4, head = (i2 >> 1) & 7, qb = i2 & 1, kvh = head >> 2;
      dense_item(p, NTL + b * TC + qb * 128, head * 64, 0, 0, NTL + b * TC, 512 + kvh * 64, 640 + kvh * 64, lds);
    } else {
      const int i2 = it - 4352;
      const int b = i2 >> 4, head = (i2 >> 1) & 7, qb = i2 & 1;
      dense_item(p, NTL + b * TC + qb * 128, 2688 + head * 64, 0, 0, NTL + b * TC, 3200 + head * 64, 3712 + head * 64, lds);
    }
  }
}

template <int MI>
DI void merge_phaseT(const Params& p, int l, int M, char* lds) {
  const int ntm = M / (MI * 32), ntn = 8;
  const int lane = tid_() & 63, wid = tid_() >> 6, wr = wid >> 1, wc = wid & 1, fr = lane & 15, fq = lane >> 4;
  const bf16_t* wm = p.WM + (size_t)l * WM_STRIDE;
  int tm, tn;
  for (int it = 0; xcd_tile<2, 8>(it, ntm, ntn, tm, tn); ++it) {
    const size_t grow = (size_t)tm * (MI * 32);
#pragma unroll 1
    for (int z = 0; z < 3; ++z) {
      f32x4 acc[MI][4];
#pragma unroll
      for (int mi = 0; mi < MI; ++mi)
#pragma unroll
        for (int ni = 0; ni < 4; ++ni) acc[mi][ni] = (f32x4){0.f, 0.f, 0.f, 0.f};
      gemm_mainloopT<MI>(p.U + grow * DM, DM, wm + WM_IN + (size_t)(DPROJ + z * DM + tn * 128) * DM, DM, acc, lds);
      {
      bf16_t* prow;
      { const int t2 = tid_(), l2 = t2 & 63, w2 = t2 >> 6; prow = p.P + (grow + (w2 >> 1) * (MI * 16) + (l2 & 15)) * DPROJ + tn * 128 + (w2 & 1) * 64 + (l2 >> 4) * 4; }
#pragma unroll
      for (int mi = 0; mi < MI; ++mi) {
#pragma unroll
        for (int ni = 0; ni < 4; ++ni) {
          f32x4 g;
#pragma unroll
          for (int j = 0; j < 4; ++j) g[j] = sigmoidf_(acc[mi][ni][j]);
          st4bf(prow + (size_t)(mi * 16) * DPROJ + 512 + ni * 16, g);
          acc[mi][ni] = (f32x4){0.f, 0.f, 0.f, 0.f};
        }
        asm volatile("" ::: "memory");
      }
      }
      const bf16_t* Ya = z == 1 ? p.yr : (z == 0 ? p.P : p.P + 2688);
      const int lda = z == 1 ? 512 : DPROJ;
      gemm_mainloopT<MI>(Ya + grow * lda, lda, wm + WM_BR + (size_t)z * 1024 * 512 + (size_t)tn * 128 * 512, 512, acc, lds);
      {
      bf16_t* prow;
      { const int t2 = tid_(), l2 = t2 & 63, w2 = t2 >> 6; prow = p.P + (grow + (w2 >> 1) * (MI * 16) + (l2 & 15)) * DPROJ + tn * 128 + (w2 & 1) * 64 + (l2 >> 4) * 4; }
#pragma unroll
      for (int mi = 0; mi < MI; ++mi) {
#pragma unroll
        for (int ni = 0; ni < 4; ++ni) {
          bf16_t* q = prow + (size_t)(mi * 16) * DPROJ + ni * 16;
          f32x4 mn = ld4bf(q + 512) * acc[mi][ni];
          if (z > 0) mn += ld4bf(q + 3200);
          st4bf(q + 3200, mn);
        }
        asm volatile("" ::: "memory");
      }
      }
    }
  }
}

DI void merge_phase(const Params& p, int l, int row0, int M, char* lds) {
  const int ntm = M >> 7, ntn = 8;
  const int lane = tid_() & 63, wid = tid_() >> 6, wr = wid >> 1, wc = wid & 1, fr = lane & 15, fq = lane >> 4;
  const bf16_t* wm = p.WM + (size_t)l * WM_STRIDE;
  int tm, tn;
  for (int it = 0; xcd_tile<2, 8>(it, ntm, ntn, tm, tn); ++it) {
    const size_t grow = (size_t)row0 + tm * 128;
#pragma unroll 1
    for (int z = 0; z < 3; ++z) {
      u32x2 gp[4][4];
      {
        f32x4 acc[4][4];
        zero_acc(acc);
        gemm_mainloop2(p.U + grow * DM, DM, wm + WM_IN + (size_t)(DPROJ + z * DM + tn * 128) * DM, DM, acc, lds);
#pragma unroll
        for (int mi = 0; mi < 4; ++mi)
#pragma unroll
          for (int ni = 0; ni < 4; ++ni) {
            gp[mi][ni].x = pk2(sigmoidf_(acc[mi][ni][0]), sigmoidf_(acc[mi][ni][1]));
            gp[mi][ni].y = pk2(sigmoidf_(acc[mi][ni][2]), sigmoidf_(acc[mi][ni][3]));
          }
      }
      {
        f32x4 acc[4][4];
        zero_acc(acc);
        const bf16_t* Ya = z == 1 ? p.yr : (z == 0 ? p.P : p.P + 2688);
        const int lda = z == 1 ? 512 : DPROJ;
        gemm_mainloop2(Ya + grow * lda, lda, wm + WM_BR + (size_t)z * 1024 * 512 + (size_t)tn * 128 * 512, 512, acc, lds);
#pragma unroll
        for (int mi = 0; mi < 4; ++mi)
#pragma unroll
          for (int ni = 0; ni < 4; ++ni) asm volatile("" : "+v"(gp[mi][ni].x), "+v"(gp[mi][ni].y));
#pragma unroll
        for (int mi = 0; mi < 4; ++mi) {
          const int row = tm * 128 + wr * 64 + mi * 16 + fr;
#pragma unroll
          for (int ni = 0; ni < 4; ++ni) {
            bf16_t* mp = p.P + (grow + wr * 64 + mi * 16 + fr) * DPROJ + 3200 + tn * 128 + wc * 64 + ni * 16 + fq * 4;
            const f32x4 g = {bflo(gp[mi][ni].x), bfhi(gp[mi][ni].x), bflo(gp[mi][ni].y), bfhi(gp[mi][ni].y)};
            f32x4 mn = g * acc[mi][ni];
            if (z > 0) mn += ld4bf(mp);
            st4bf(mp, mn);
          }
        }
      }
    }
  }
}

#define MAKE_LN_EPI(MI_, e, WHICH, SRC_LAT, SRC_CTX)                                                                    \
  EpiResidLN<MI_> e;                                                                                                        \
  {                                                                                                                    \
    const float* mods_l_ = p.mods + (size_t)l * 17 * NMOD;                                                             \
    e.src_lat = (SRC_LAT); e.src_ctx = (SRC_CTX); e.dst_lat = p.out; e.dst_ctx = p.ctxx;                               \
    e.gate = mods_l_ + ((WHICH) * 3 + 2) * DM;                                                                         \
    e.gmul = (WHICH) == 1 ? 1.f : 0.5f;                                                                                \
    e.lng = p.ln_g + (l * 3 + (WHICH)) * DM; e.lnb = p.ln_b + (l * 3 + (WHICH)) * DM;                                  \
    e.mods_next = (WHICH) < 2 ? mods_l_ : p.mods + (size_t)(l == 0 ? 1 : 0) * 17 * NMOD;                               \
    e.shift_idx = (WHICH) < 2 ? (WHICH) * 3 + 3 : 0;                                                                   \
    e.U = ((WHICH) < 2 || l == 0) ? p.U : nullptr;                                                                     \
    e.stats = p.stats; e.cnt = p.lncnt + (l * 3 + (WHICH)) * 288;                                                      \
  }

template <int S>
DI void layer_step(const Params& p, int l, char* lds, long long* scan_t = nullptr) {
  const bool last = l == 1;
  const bool need_ctx = !last;
  const int Mall = NTOK, Mx = need_ctx ? NTOK : NTL;
  const bf16_t* wm = p.WM + (size_t)l * WM_STRIDE;
  if constexpr (S == 0) {
    EpiAct<8> e; e.H = p.H;
    gemm_phaseT<8, 8, 4>(p.U, DM, Mall, 0, p.WF, DM, 2 * DFF, e, lds);
  } else if constexpr (S == 1) {
    MAKE_LN_EPI(6, e, 0, l == 0 ? p.x_in : p.out, l == 0 ? p.ctx_in : p.ctxx)
    gemm_phaseT<6, 2, 8, true>(p.H, DFF, Mall, 0, p.WF + WF_WO, DFF, DM, e, lds);
  } else if constexpr (S == 3) {
    EpiProj<8> e; e.p = &p; e.l = l;
    gemm_phaseT<8, 8, 3>(p.U, DM, Mall, 0, wm + WM_IN, DM, DPROJ, e, lds);
  } else if constexpr (S == 4) {
    mixer_phase(p, l, need_ctx, lds, scan_t);
  } else if constexpr (S == 5) {
    EpiReadout e; e.p = &p; e.l = l;
    gemm_phase(p.sg, 128, Mx, p.g2 + (size_t)l * 128 * 512, 512, 128, 512, MapHeadPerm(), e, lds);
  } else if constexpr (S == 9) {
    EpiAct<8> e; e.H = p.H;
    gemm_phaseT<8, 8, 4>(p.U, DM, Mx, 0, p.WF + WF_SLOT, DM, 2 * DFF, e, lds);
  } else if constexpr (S == 10) {
    if (need_ctx) {
      MAKE_LN_EPI(6, e, 2, p.out, p.ctxx)
      gemm_phaseT<6, 2, 8, true>(p.H, DFF, NTOK, 0, p.WF + WF_SLOT + WF_WO, DFF, DM, e, lds);
    } else {
      MAKE_LN_EPI(8, e, 2, p.out, p.ctxx)
      gemm_phaseT<8, 2, 8, true>(p.H, DFF, NTL, 0, p.WF + WF_SLOT + WF_WO, DFF, DM, e, lds);
    }
    if (!last) convert_ffn(p, 0, p.ffn1_wi + (size_t)(l + 1) * DM * 2 * DFF, p.ffn1_wo + (size_t)(l + 1) * DFF * DM, lds);
  }
}

template <int S>
DI void merge_step(const Params& p, int l, char* lds) {
  const int Mx = l == 0 ? NTOK : NTL;
  const bf16_t* wm = p.WM + (size_t)l * WM_STRIDE;
  if constexpr (S == 0) {
    if (l == 0) merge_phase(p, l, 0, NTOK, lds); else merge_phaseT<8>(p, l, NTL, lds);
  } else {
    if (l == 0) {
      MAKE_LN_EPI(6, e, 1, p.out, p.ctxx)
      gemm_phaseT<6, 2, 8>(p.P + 3200, DPROJ, NTOK, 0, wm + WM_OUT, DM, DM, e, lds);
    } else {
      MAKE_LN_EPI(8, e, 1, p.out, p.ctxx)
      gemm_phaseT<8, 2, 8>(p.P + 3200, DPROJ, NTL, 0, wm + WM_OUT, DM, DM, e, lds);
    }
    convert_ffn(p, 1, p.ffn2_wi + (size_t)l * DM * 2 * DFF, p.ffn2_wo + (size_t)l * DFF * DM, lds);
  }
}

#define XB_TMO      128
#define XB_XCNT(j)  (256  + 64 * (j))
#define XB_XSUB(j)  (1280 + 64 * (j))
#define XB_XGEN(j)  (2304 + 64 * (j))
#define XB_TOP      3328
#define XB_TOPGEN   3392
#define XCD_BAR_WORDS 3456
#define XB_SPIN_CAP (1u << 18)
DI unsigned xb_ld(unsigned* p) { return __hip_atomic_load(p, __ATOMIC_RELAXED, __HIP_MEMORY_SCOPE_AGENT); }
DI unsigned xb_add(unsigned* p, unsigned v) { return __hip_atomic_fetch_add(p, v, __ATOMIC_RELAXED, __HIP_MEMORY_SCOPE_AGENT); }
DI unsigned xb_xcc_id() { return (unsigned)__builtin_amdgcn_s_getreg((3 << 11) | 20) & 0xFu; }
#define XB_SPIN(cond, bar) do { unsigned _sp = 0; while (cond) { __builtin_amdgcn_s_sleep(1); \
    if ((++_sp & 255u) == 0u) { if (xb_ld(&(bar)[XB_TMO])) break; if (_sp > XB_SPIN_CAP) { atomicAdd(&(bar)[XB_TMO], 1u); break; } } } } while (0)
struct XcdBarrier { unsigned* bar; unsigned x; volatile LAS unsigned* st; };
DI XcdBarrier xcd_barrier_post(unsigned* bar, volatile LAS unsigned* st) {
  XcdBarrier b; b.bar = bar; b.x = xb_xcc_id(); b.st = st;
  if (threadIdx.x == 0) (void)xb_add(&bar[XB_XCNT(b.x)], 1u);
  return b;
}
DI void xcd_barrier_complete(unsigned* bar, unsigned x, unsigned& nloc, unsigned& nx) {
  const unsigned G = gridDim.x * gridDim.y * gridDim.z;
  unsigned sum, cnt, mine, sp = 0u;
  for (;;) {
    sum = 0u; cnt = 0u; mine = 0u;
#pragma unroll
    for (unsigned j = 0; j < 16; ++j) { const unsigned c = xb_ld(&bar[XB_XCNT(j)]); sum += c; cnt += (c > 0u) ? 1u : 0u; mine = (j == x) ? c : mine; }
    if (sum == G) break;
    __builtin_amdgcn_s_sleep(1);
    if ((++sp & 255u) == 0u) { if (xb_ld(&bar[XB_TMO])) break; if (sp > XB_SPIN_CAP) { atomicAdd(&bar[XB_TMO], 1u); break; } }
  }
  nloc = mine > 0u ? mine : 1u; nx = cnt > 0u ? cnt : 1u;
}
DI void xcd_barrier(const XcdBarrier& b) {
  asm volatile("s_waitcnt vmcnt(0)" ::: "memory");
  __syncthreads();
  if (threadIdx.x == 0) {
    unsigned* bar = b.bar;
    __builtin_amdgcn_s_waitcnt(0);
    unsigned nloc = b.st[0], nx = b.st[1];
    if (nloc == 0u) { xcd_barrier_complete(bar, b.x, nloc, nx); b.st[0] = nloc; b.st[1] = nx; }
    const unsigned old = xb_add(&bar[XB_XSUB(b.x)], 1u);
    const unsigned gen = old / nloc;
    if (old + 1u == (gen + 1u) * nloc) {
      __builtin_amdgcn_fence(__ATOMIC_RELEASE, "agent");
      asm volatile("s_waitcnt vmcnt(0)" ::: "memory");
      const unsigned og = xb_add(&bar[XB_TOP], 1u);
      const unsigned tg = og / nx;
      if (og + 1u == (tg + 1u) * nx) xb_add(&bar[XB_TOPGEN], 1u);
      else XB_SPIN(xb_ld(&bar[XB_TOPGEN]) == tg, bar);
      __builtin_amdgcn_fence(__ATOMIC_ACQUIRE, "agent");
      xb_add(&bar[XB_XGEN(b.x)], 1u);
      asm volatile("s_waitcnt vmcnt(0)" ::: "memory");
    } else {
      XB_SPIN(xb_ld(&bar[XB_XGEN(b.x)]) == gen, bar);
      __builtin_amdgcn_fence(__ATOMIC_ACQUIRE, "agent");
      asm volatile("s_waitcnt vmcnt(0)" ::: "memory");
    }
  }
  __syncthreads();
}

#define TIMED(id, ...) { long long _t0 = 0; if (PROBE_MASK) _t0 = wall_clock64(); __VA_ARGS__; if ((PROBE_MASK >> (id)) & 1) probe_t += wall_clock64() - _t0; }
__global__ void __launch_bounds__(NTHREADS, 2) fwd_megakernel(Params p) {
  __shared__ __attribute__((aligned(16))) char lds[LDS_BYTES];
  cg::grid_group grid = cg::this_grid();
  long long probe_t = 0;
  if (threadIdx.x == 0) *(u32x4*)(lds + LDS_WORK) = (u32x4){0u, 0u, 0u, 0u};
  __syncthreads();
  (void)xcd_barrier_post(p.bar, (volatile LAS unsigned*)(LAS char*)(lds + LDS_WORK));
#define GSYNC() do { XcdBarrier xb_; xb_.bar = p.bar; xb_.x = xb_xcc_id(); xb_.st = (volatile LAS unsigned*)(LAS char*)(lds + LDS_WORK); xcd_barrier(xb_); } while (0)
  TIMED(0, mods_phase(p, lds);
  convert_ffn(p, 0, p.ffn1_wi, p.ffn1_wo, lds);
  convert_mixer(p, 0, lds);
  convert_mixer(p, 1, lds);
  if (p.bar == nullptr) grid.sync();
  GSYNC();
  u0_phase(p);
  GSYNC();)
#pragma unroll 1
  for (int l = 0; l < 2; ++l) {
    TIMED(1, layer_step<0>(p, l, lds); GSYNC();)
    TIMED(2, layer_step<1>(p, l, lds); GSYNC();)
    TIMED(4, layer_step<3>(p, l, lds); GSYNC();)
    TIMED(5, layer_step<4>(p, l, lds, &probe_t); GSYNC();)
    TIMED(6, layer_step<5>(p, l, lds); GSYNC();)
    TIMED(7, merge_step<0>(p, l, lds); GSYNC();)
    TIMED(8, merge_step<1>(p, l, lds); GSYNC();)
    TIMED(10, layer_step<9>(p, l, lds); GSYNC();)
    TIMED(11, layer_step<10>(p, l, lds);
    if (l == 0) GSYNC();)
  }
  if (PROBE_MASK) {
    if (blockIdx.x == 0 && threadIdx.x == 0) {
      const long long t1 = wall_clock64();
      while (wall_clock64() - t1 < probe_t) __builtin_amdgcn_s_sleep(8);
    }
  }
}

extern "C" void kernel_launch(void* const* d_in, const int* in_sizes, int n_in, void* d_out, int out_size, void* d_ws, size_t ws_size,
                              hipStream_t stream) {
  static int grid_blocks = 0;
  if (!grid_blocks) {
    int dev = 0, cus = 0, per_cu = 0;
    hipGetDevice(&dev);
    hipDeviceGetAttribute(&cus, hipDeviceAttributeMultiprocessorCount, dev);
    hipOccupancyMaxActiveBlocksPerMultiprocessor(&per_cu, fwd_megakernel, NTHREADS, 0);
    if (per_cu < 1) per_cu = 1;
    grid_blocks = cus * per_cu;
  }
  Params p{};
  const float* const* in = (const float* const*)d_in;
  p.x_in = in[0]; p.c = in[1]; p.ctx_in = in[2]; p.c_ctx = in[3]; p.w_ada = in[4]; p.b_ada = in[5];
  p.ffn1_wi = in[6]; p.ffn1_wo = in[7]; p.ffn2_wi = in[8]; p.ffn2_wo = in[9]; p.ln_g = in[10]; p.ln_b = in[11]; p.w_in = in[12];
  p.q_gain = in[13]; p.k_gain = in[14]; p.mu = in[15]; p.w0 = in[16]; p.w2 = in[17]; p.a0 = in[18]; p.a2 = in[19]; p.g2 = in[20];
  p.k_k = in[21]; p.k_a = in[22]; p.r_k = in[23]; p.gn_g = in[24]; p.gn_b = in[25]; p.rpb = in[26]; p.w_branch = in[27]; p.w_out = in[28];
  p.out = (float*)d_out;
  char* ws = (char*)d_ws;
  const size_t MiB = 1ull << 20;
  p.counters = (unsigned*)ws;
  p.rope = (float*)(ws + 4096);
  p.lncnt = (unsigned*)(ws + 16384);
  p.bar = (unsigned*)(ws + 24576);
  hipMemsetAsync(ws + 24576, 0, XCD_BAR_WORDS * sizeof(unsigned), stream);
  p.stats = (float*)(ws + 507 * MiB);
  p.mods = (float*)(ws + 65536);
  p.ctxx = (float*)(ws + 2 * MiB);
  p.U = (bf16_t*)(ws + 18 * MiB);
  p.H = (bf16_t*)(ws + 90 * MiB);
  p.P = (bf16_t*)(ws + 90 * MiB);
  p.Os = (bf16_t*)(ws + 387 * MiB);
  p.yr = (bf16_t*)(ws + 387 * MiB);
  p.Mg = (bf16_t*)(ws + 423 * MiB);
  p.sg = (bf16_t*)(ws + 459 * MiB);
  p.WM = (bf16_t*)(ws + 468 * MiB);
  p.WF = (bf16_t*)(ws + 423 * MiB);
  if (ws_size < 512 * MiB) fprintf(stderr, "workspace too small: %zu\n", ws_size);
  void* args[] = {&p};
  hipError_t e = hipLaunchCooperativeKernel((void*)fwd_megakernel, dim3(grid_blocks), dim3(NTHREADS), args, 0, stream);
  if (e != hipSuccess) fprintf(stderr, "cooperative launch failed: %s (grid %d)\n", hipGetErrorString(e), grid_blocks);
}
```

```cpp
#include <hip/hip_runtime.h>
#include <hip/hip_cooperative_groups.h>
#include <cstdio>
#include <cstdint>
namespace cg = cooperative_groups;
#ifndef PROBE_MASK
#define PROBE_MASK 0
#endif

#define DI __device__ __forceinline__
typedef unsigned short bf16_t;
typedef short bf16x8 __attribute__((ext_vector_type(8)));
typedef short s16x4 __attribute__((ext_vector_type(4)));
typedef float f32x2 __attribute__((ext_vector_type(2)));
typedef float f32x4 __attribute__((ext_vector_type(4)));
typedef float f32x16 __attribute__((ext_vector_type(16)));
typedef unsigned u32x2 __attribute__((ext_vector_type(2)));
typedef unsigned u32x4 __attribute__((ext_vector_type(4)));
typedef __bf16 nbf16x2 __attribute__((ext_vector_type(2)));

constexpr int DM = 1024, NB = 16, TL = 2048, TC = 256;
constexpr int NTL = NB * TL, NTC = NB * TC, NTOK = NTL + NTC;
constexpr int DFF = 2816, DIN = 7296, DPROJ = 4224;
constexpr int NMOD = 9 * DM;
constexpr float LOG2E = 1.4426950408889634f;
constexpr float QSCALE = 0.125f * LOG2E;
constexpr float ALPHA = 1.4142135623730951f;
constexpr int LDS_WORK = 73728;
constexpr int LDS_BYTES = LDS_WORK + 64;
constexpr size_t WM_IN = 0, WM_BR = (size_t)7296 * 1024, WM_OUT = WM_BR + 3 * 1024 * 512, WM_STRIDE = WM_OUT + 1024 * 1024;
constexpr size_t WF_WO = (size_t)2 * 2816 * 1024, WF_SLOT = (size_t)17 * 1024 * 1024 / 2;
constexpr int NTHREADS = 256;

struct Params {
  const float *x_in, *c, *ctx_in, *c_ctx, *w_ada, *b_ada, *ffn1_wi, *ffn1_wo, *ffn2_wi, *ffn2_wo, *ln_g, *ln_b, *w_in,
      *q_gain, *k_gain, *mu, *w0, *w2, *a0, *a2, *g2, *k_k, *k_a, *r_k, *gn_g, *gn_b, *rpb, *w_branch, *w_out;
  float* out;
  float* mods;
  float* rope;
  float* ctxx;
  unsigned* counters;
  bf16_t *U, *H, *P, *Os, *yr, *Mg, *sg, *WF, *WM;
  float* stats;
  unsigned* lncnt;
  unsigned* bar;
};

DI int tid_() { int t = threadIdx.x; asm volatile("" : "+v"(t)); return t; }
DI unsigned pk2(float a, float b) { f32x2 v = {a, b}; nbf16x2 r = __builtin_convertvector(v, nbf16x2); return __builtin_bit_cast(unsigned, r); }
DI bf16_t f2bf(float a) { return (bf16_t)(pk2(a, 0.f) & 0xffffu); }
DI float bflo(unsigned u) { return __uint_as_float(u << 16); }
DI float bfhi(unsigned u) { return __uint_as_float(u & 0xffff0000u); }
DI f32x4 ld4bf(const bf16_t* p) { u32x2 v = *(const u32x2*)p; return (f32x4){bflo(v.x), bfhi(v.x), bflo(v.y), bfhi(v.y)}; }
DI void st4bf(bf16_t* p, f32x4 v) { u32x2 o; o.x = pk2(v[0], v[1]); o.y = pk2(v[2], v[3]); *(u32x2*)p = o; }
DI float sigmoidf_(float x) { return __builtin_amdgcn_rcpf(1.f + __expf(-x)); }
DI float siluf_(float x) { return x * __builtin_amdgcn_rcpf(1.f + __expf(-x)); }
DI int mod_row(int row) { return row < NTL ? (row >> 11) : 16; }

constexpr int LDT = 72;

struct MapPlain { DI int operator()(int tn, int cl) const { return tn * 128 + cl; } };
struct MapHeadPerm { DI int operator()(int tn, int cl) const { return tn * 128 + (cl & 64) + ((cl >> 2) & 3) * 16 + ((cl >> 4) & 3) * 4; } };
struct MapGateUp { DI int operator()(int tn, int cl) const { int sub = cl >> 4, j = cl & 15; return ((sub & 1) ? DFF : 0) + tn * 64 + (sub >> 1) * 16 + j; } };

template <class BMap>
DI void gemm_mainloop(const bf16_t* __restrict__ A, int lda, const float* __restrict__ B, int ldb, int K, int tn, BMap bmap,
                      f32x4 (&acc)[4][4], char* lds) {
  bf16_t* As = (bf16_t*)lds;
  bf16_t* Bs = As + 128 * LDT;
  const int tid = tid_(), lane = tid & 63, wid = tid >> 6, wr = wid >> 1, wc = wid & 1;
  const int fr = lane & 15, fq = lane >> 4;
  const int arow = tid >> 3, akc = tid & 7;
  const int kg = tid >> 5, ng = tid & 31;
  const bf16_t* ap = A + (size_t)arow * lda + akc * 8;
  const float* bp = B + (size_t)(kg * 8) * ldb + bmap(tn, ng * 4);
  u32x4 ra[4];
  f32x4 rb[8];
  const int nk = K >> 6;
#pragma unroll
  for (int i = 0; i < 4; ++i) ra[i] = *(const u32x4*)(ap + (size_t)(i * 32) * lda);
#pragma unroll
  for (int i = 0; i < 8; ++i) rb[i] = *(const f32x4*)(bp + (size_t)i * ldb);
#pragma unroll 1
  for (int kt = 0; kt < nk; ++kt) {
    __syncthreads();
#pragma unroll
    for (int i = 0; i < 4; ++i) *(u32x4*)(As + (arow + i * 32) * LDT + akc * 8) = ra[i];
#pragma unroll
    for (int jn = 0; jn < 4; ++jn) {
      u32x4 w;
      w.x = pk2(rb[0][jn], rb[1][jn]); w.y = pk2(rb[2][jn], rb[3][jn]); w.z = pk2(rb[4][jn], rb[5][jn]); w.w = pk2(rb[6][jn], rb[7][jn]);
      *(u32x4*)(Bs + (ng * 4 + jn) * LDT + kg * 8) = w;
    }
    __syncthreads();
    if (kt + 1 < nk) {
      const bf16_t* ap2 = ap + (kt + 1) * 64;
      const float* bp2 = bp + (size_t)((kt + 1) * 64) * ldb;
#pragma unroll
      for (int i = 0; i < 4; ++i) ra[i] = *(const u32x4*)(ap2 + (size_t)(i * 32) * lda);
#pragma unroll
      for (int i = 0; i < 8; ++i) rb[i] = *(const f32x4*)(bp2 + (size_t)i * ldb);
    }
#pragma unroll
    for (int ks = 0; ks < 2; ++ks) {
      bf16x8 af[4], bfr[4];
#pragma unroll
      for (int mi = 0; mi < 4; ++mi) af[mi] = *(const bf16x8*)(As + (wr * 64 + mi * 16 + fr) * LDT + ks * 32 + fq * 8);
#pragma unroll
      for (int ni = 0; ni < 4; ++ni) bfr[ni] = *(const bf16x8*)(Bs + (wc * 64 + ni * 16 + fr) * LDT + ks * 32 + fq * 8);
#pragma unroll
      for (int mi = 0; mi < 4; ++mi)
#pragma unroll
        for (int ni = 0; ni < 4; ++ni) acc[mi][ni] = __builtin_amdgcn_mfma_f32_16x16x32_bf16(bfr[ni], af[mi], acc[mi][ni], 0, 0, 0);
    }
  }
  __syncthreads();
}

DI void zero_acc(f32x4 (&acc)[4][4]) {
#pragma unroll
  for (int mi = 0; mi < 4; ++mi)
#pragma unroll
    for (int ni = 0; ni < 4; ++ni) acc[mi][ni] = (f32x4){0.f, 0.f, 0.f, 0.f};
}

DI void tile_coords(int tile, int ntm, int ntn, int& tm, int& tn) {
  const int per = 8 * ntn;
  const int g = tile / per, rem = tile - g * per;
  const int gsz = (ntm - g * 8) < 8 ? (ntm - g * 8) : 8;
  tm = g * 8 + rem % gsz;
  tn = rem / gsz;
}

template <class BMap, class Epi>
DI void gemm_phase(const bf16_t* A, int lda, int M, const float* B, int ldb, int K, int N, BMap bmap, const Epi& epi, char* lds) {
  const int ntm = M >> 7, ntn = N >> 7, nt = ntm * ntn;
  const int lane = tid_() & 63, wid = tid_() >> 6;
  for (int tile = blockIdx.x; tile < nt; tile += gridDim.x) {
    int tm, tn;
    tile_coords(tile, ntm, ntn, tm, tn);
    f32x4 acc[4][4];
    zero_acc(acc);
    gemm_mainloop(A + (size_t)tm * 128 * lda, lda, B, ldb, K, tn, bmap, acc, lds);
    epi(tm, tn, wid >> 1, wid & 1, lane, acc);
  }
}

DI int lds_byte(int r, int c) { const int st = (r >> 4) * 2 + (c >> 5), rr = r & 15, cc = c & 31, ob = rr * 64 + cc * 2; return st * 1024 + (ob ^ (((ob >> 9) & 1) << 5)); }
DI void stage_rc(int b, int& R, int& C) { const int st = b >> 10, sb = b & 1023, swz = sb ^ (((sb >> 9) & 1) << 5); R = (st >> 1) * 16 + (swz >> 6); C = (st & 1) * 32 + ((swz & 63) >> 1); }
#define LAS __attribute__((address_space(3)))
DI void glds16(const bf16_t* g, LAS char* l) { __builtin_amdgcn_global_load_lds((const unsigned*)g, (LAS unsigned*)l, 16, 0, 0); }

DI int lds_byte32(int r, int c) { const int ob = (r & 15) * 64 + c * 2; return (r >> 4) * 1024 + (ob ^ (((ob >> 9) & 1) << 5)); }
DI void stage_rc32(int b, int& R, int& C) { const int st = b >> 10, sb = b & 1023, swz = sb ^ (((sb >> 9) & 1) << 5); R = st * 16 + (swz >> 6); C = (swz & 63) >> 1; }

template <int MI>
DI void gemm_mainloopT(const bf16_t* __restrict__ A, int lda, const bf16_t* __restrict__ Bt, int K, f32x4 (&acc)[MI][4], char* lds_generic) {
  static_assert(MI == 4 || MI == 6 || MI == 8, "MI");
  constexpr int NA = MI / 2;
  constexpr int G = NA + 2;
  constexpr int NST = MI == 4 ? 4 : 3;
  constexpr int ABYTES = MI * 2048, SBYTES = ABYTES + 8192;
  LAS char* lds = (LAS char*)lds_generic;
  const int tid = tid_(), lane = tid & 63, wid = tid >> 6, wr = wid >> 1, wc = wid & 1;
  const int fr = lane & 15, fq = lane >> 4;
  const bf16_t* ap[NA];
  const bf16_t* bp[2];
#pragma unroll
  for (int i = 0; i < NA; ++i) { int R, C; stage_rc32(tid * 16 + i * 4096, R, C); ap[i] = A + (size_t)R * lda + C; }
#pragma unroll
  for (int i = 0; i < 2; ++i) { int R, C; stage_rc32(tid * 16 + i * 4096, R, C); bp[i] = Bt + (size_t)R * K + C; }
  LAS char* lt = lds + tid * 16;
  const int nk = K >> 5;
  __syncthreads();
#pragma unroll
  for (int s = 0; s < NST - 1; ++s) {
#pragma unroll
    for (int i = 0; i < NA; ++i) glds16(ap[i] + s * 32, lt + s * SBYTES + i * 4096);
#pragma unroll
    for (int i = 0; i < 2; ++i) glds16(bp[i] + s * 32, lt + s * SBYTES + ABYTES + i * 4096);
  }
  int offA[MI], offB[4];
#pragma unroll
  for (int i = 0; i < MI; ++i) offA[i] = lds_byte32(wr * MI * 16 + i * 16 + fr, fq * 8);
#pragma unroll
  for (int i = 0; i < 4; ++i) offB[i] = ABYTES + lds_byte32(wc * 64 + i * 16 + fr, fq * 8);
  int st_cur = 0, st_nx = NST - 1;
#pragma unroll 1
  for (int kt = 0; kt < nk; ++kt) {
    if (NST == 4) {
      if (kt + 2 < nk) asm volatile("s_waitcnt vmcnt(8)" ::: "memory");
      else if (kt + 1 < nk) asm volatile("s_waitcnt vmcnt(4)" ::: "memory");
      else asm volatile("s_waitcnt vmcnt(0)" ::: "memory");
    } else {
      if (kt + 1 < nk) { if (G == 6) asm volatile("s_waitcnt vmcnt(6)" ::: "memory"); else asm volatile("s_waitcnt vmcnt(5)" ::: "memory"); }
      else asm volatile("s_waitcnt vmcnt(0)" ::: "memory");
    }
    __builtin_amdgcn_s_barrier();
    asm volatile("" ::: "memory");
    if (kt + NST - 1 < nk) {
      LAS char* nx = lt + st_nx * SBYTES;
      const int ko = (kt + NST - 1) * 32;
#pragma unroll
      for (int i = 0; i < NA; ++i) glds16(ap[i] + ko, nx + i * 4096);
#pragma unroll
      for (int i = 0; i < 2; ++i) glds16(bp[i] + ko, nx + ABYTES + i * 4096);
    }
    const LAS char* cur = lds + st_cur * SBYTES;
    st_cur = st_cur + 1 == NST ? 0 : st_cur + 1;
    st_nx = st_nx + 1 == NST ? 0 : st_nx + 1;
    bf16x8 af[MI], bfr[4];
#pragma unroll
    for (int ni = 0; ni < 4; ++ni) bfr[ni] = *(const LAS bf16x8*)(cur + offB[ni]);
#pragma unroll
    for (int mi = 0; mi < MI; ++mi) af[mi] = *(const LAS bf16x8*)(cur + offA[mi]);
    __builtin_amdgcn_s_setprio(1);
#pragma unroll
    for (int mi = 0; mi < MI; ++mi)
#pragma unroll
      for (int ni = 0; ni < 4; ++ni) acc[mi][ni] = __builtin_amdgcn_mfma_f32_16x16x32_bf16(bfr[ni], af[mi], acc[mi][ni], 0, 0, 0);
    __builtin_amdgcn_s_setprio(0);
  }
}
DI void gemm_mainloop2(const bf16_t* __restrict__ A, int lda, const bf16_t* __restrict__ Bt, int K, f32x4 (&acc)[4][4], char* lds) {
  gemm_mainloopT<4>(A, lda, Bt, K, acc, lds);
}

template <int SM, int SN>
DI bool xcd_tile(int it, int ntm, int ntn, int& tm, int& tn) {
  const int xcd = blockIdx.x & 7, j = blockIdx.x >> 3, per_xcd = gridDim.x >> 3;
  const int nsn = ntn / SN, ns = (ntm / SM) * nsn;
  const int idx = it * per_xcd + j;
  const int sl = idx / (SM * SN), w = idx - sl * (SM * SN);
  const int s = sl * 8 + xcd;
  if (s >= ns) return false;
  const int sm = s / nsn, sn = s - sm * nsn;
  tm = sm * SM + w % SM;
  tn = sn * SN + w / SM;
  return true;
}

template <int MI, int SM, int SN, bool REV = false, class Epi>
DI void gemm_phaseT(const bf16_t* A, int lda, int M, int tm0, const bf16_t* Bt, int K, int N, const Epi& epi, char* lds) {
  const int ntm = M / (MI * 32), ntn = N >> 7;
  const int lane = tid_() & 63, wid = tid_() >> 6;
  int tm, tn;
  for (int it = 0; xcd_tile<SM, SN>(it, ntm, ntn, tm, tn); ++it) {
    if (REV) tm = ntm - 1 - tm;
    f32x4 acc[MI][4];
#pragma unroll
    for (int mi = 0; mi < MI; ++mi)
#pragma unroll
      for (int ni = 0; ni < 4; ++ni) acc[mi][ni] = (f32x4){0.f, 0.f, 0.f, 0.f};
    gemm_mainloopT<MI>(A + (size_t)tm * (MI * 32) * lda, lda, Bt + (size_t)tn * 128 * K, K, acc, lds);
    epi(tm + tm0, tn, wid >> 1, wid & 1, lane, acc);
  }
}
template <int SM, int SN, class Epi>
DI void gemm_phase2(const bf16_t* A, int lda, int M, int tm0, const bf16_t* Bt, int K, int N, const Epi& epi, char* lds) {
  gemm_phaseT<4, SM, SN>(A, lda, M, tm0, Bt, K, N, epi, lds);
}

struct CMapPlain { DI int operator()(int n) const { return n; } };
struct CMapGateUp { DI int operator()(int p) const { const int tn = p >> 7, sub = (p >> 4) & 7, j = p & 15; return ((sub & 1) ? DFF : 0) + tn * 64 + (sub >> 1) * 16 + j; } };
template <class CM>
DI void convert_T(const float* __restrict__ W, int ldw, int K, int N, bf16_t* __restrict__ Wt, CM cm, char* lds) {
  float* tl = (float*)lds;
  const int tid = tid_();
  const int nkt = K >> 6, nnt = N >> 6;
  for (int t = blockIdx.x; t < nkt * nnt; t += gridDim.x) {
    const int kt = t % nkt, nt = t / nkt;
    __syncthreads();
    const int n4 = (tid & 15) * 4;
    const int sc = cm(nt * 64 + n4);
#pragma unroll
    for (int ps = 0; ps < 4; ++ps) {
      const int kk = ps * 16 + (tid >> 4);
      const f32x4 v = *(const f32x4*)(W + (size_t)(kt * 64 + kk) * ldw + sc);
#pragma unroll
      for (int e = 0; e < 4; ++e) tl[kk * 65 + n4 + e] = v[e];
    }
    __syncthreads();
    const int nn = tid >> 2, kc = (tid & 3) * 16;
    u32x4 o0, o1;
    const float* q = tl + kc * 65 + nn;
    o0.x = pk2(q[0 * 65], q[1 * 65]); o0.y = pk2(q[2 * 65], q[3 * 65]); o0.z = pk2(q[4 * 65], q[5 * 65]); o0.w = pk2(q[6 * 65], q[7 * 65]);
    o1.x = pk2(q[8 * 65], q[9 * 65]); o1.y = pk2(q[10 * 65], q[11 * 65]); o1.z = pk2(q[12 * 65], q[13 * 65]); o1.w = pk2(q[14 * 65], q[15 * 65]);
    bf16_t* d = Wt + (size_t)(nt * 64 + nn) * K + kt * 64 + kc;
    *(u32x4*)d = o0;
    *(u32x4*)(d + 8) = o1;
  }
  __syncthreads();
}
DI void convert_ffn(const Params& p, int slot, const float* wi, const float* wo, char* lds) {
  bf16_t* wf = p.WF + slot * WF_SLOT;
  convert_T(wi, 2 * DFF, DM, 2 * DFF, wf, CMapGateUp(), lds);
  convert_T(wo, DM, DFF, DM, wf + WF_WO, CMapPlain(), lds);
}
DI void convert_mixer(const Params& p, int l, char* lds) {
  bf16_t* wm = p.WM + (size_t)l * WM_STRIDE;
  convert_T(p.w_in + (size_t)l * DM * DIN, DIN, DM, DIN, wm + WM_IN, CMapPlain(), lds);
  for (int z = 0; z < 3; ++z) convert_T(p.w_branch + (size_t)(l * 3 + z) * 512 * DM, DM, 512, DM, wm + WM_BR + (size_t)z * 1024 * 512, CMapPlain(), lds);
  convert_T(p.w_out + (size_t)l * DM * DM, DM, DM, DM, wm + WM_OUT, CMapPlain(), lds);
}

template <int MI>
struct EpiAct {
  bf16_t* H;
  DI void operator()(int tm, int tn, int wr, int wc, int lane, f32x4 (&acc)[MI][4]) const {
    const int fr = lane & 15, fq = lane >> 4;
#pragma unroll
    for (int mi = 0; mi < MI; ++mi) {
      const int row = tm * (MI * 32) + wr * (MI * 16) + mi * 16 + fr;
#pragma unroll
      for (int pr = 0; pr < 2; ++pr) {
        f32x4 g = acc[mi][2 * pr], u = acc[mi][2 * pr + 1], h;
#pragma unroll
        for (int j = 0; j < 4; ++j) h[j] = siluf_(g[j]) * u[j];
        st4bf(H + (size_t)row * DFF + tn * 64 + (wc * 2 + pr) * 16 + fq * 4, h);
      }
    }
  }
};

struct EpiResid {
  const float *src_lat, *src_ctx;
  float *dst_lat, *dst_ctx;
  const float* gate;
  float gmul;
  DI void operator()(int tm, int tn, int wr, int wc, int lane, f32x4 (&acc)[4][4]) const {
    const int fr = lane & 15, fq = lane >> 4;
    const int r0 = tm * 128;
    const bool lat = r0 < NTL;
    const float* s = lat ? src_lat + (size_t)r0 * DM : src_ctx + (size_t)(r0 - NTL) * DM;
    float* d = lat ? dst_lat + (size_t)r0 * DM : dst_ctx + (size_t)(r0 - NTL) * DM;
    const float* g = gate + (size_t)mod_row(r0) * NMOD;
#pragma unroll
    for (int ni = 0; ni < 4; ++ni) {
      const int col = tn * 128 + wc * 64 + ni * 16 + fq * 4;
      const f32x4 gv = *(const f32x4*)(g + col) * gmul;
#pragma unroll
      for (int mi = 0; mi < 4; ++mi) {
        const int rl = wr * 64 + mi * 16 + fr;
        const f32x4 xv = *(const f32x4*)(s + (size_t)rl * DM + col);
        *(f32x4*)(d + (size_t)rl * DM + col) = xv * ALPHA + gv * acc[mi][ni];
      }
    }
  }
};

template <int MI>
struct EpiResidLN {
  const float *src_lat, *src_ctx;
  float *dst_lat, *dst_ctx;
  const float* gate;
  const float *lng, *lnb;
  const float* mods_next;
  bf16_t* U;
  float* stats;
  unsigned* cnt;
  float gmul;
  int shift_idx;
  DI void operator()(int tm, int tn, int wr, int wc, int lane, f32x4 (&acc)[MI][4]) const {
    const int fr = lane & 15, fq = lane >> 4;
    const int rw = tm * (MI * 32) + wr * (MI * 16);
#pragma unroll
    for (int mi = 0; mi < MI; ++mi) {
      const int rg = rw + mi * 16;
      const bool lat = rg < NTL;
      const float* s = (lat ? src_lat + (size_t)rg * DM : src_ctx + (size_t)(rg - NTL) * DM) + (size_t)fr * DM;
      const float* g = gate + (size_t)mod_row(rg) * NMOD;
#pragma unroll
      for (int ni = 0; ni < 4; ++ni) {
        const int col = tn * 128 + wc * 64 + ni * 16 + fq * 4;
        const f32x4 gv = *(const f32x4*)(g + col) * gmul;
        const f32x4 xv = *(const f32x4*)(s + col);
        acc[mi][ni] = xv * ALPHA + gv * acc[mi][ni];
      }
      float sm = 0.f;
#pragma unroll
      for (int ni = 0; ni < 4; ++ni) sm += (acc[mi][ni][0] + acc[mi][ni][1]) + (acc[mi][ni][2] + acc[mi][ni][3]);
      sm += __shfl_xor(sm, 16); sm += __shfl_xor(sm, 32);
      const float mean_i = sm * (1.f / 64.f);
      float q = 0.f;
#pragma unroll
      for (int ni = 0; ni < 4; ++ni) { const f32x4 dd = acc[mi][ni] - mean_i; q += (dd[0] * dd[0] + dd[1] * dd[1]) + (dd[2] * dd[2] + dd[3] * dd[3]); }
      q += __shfl_xor(q, 16); q += __shfl_xor(q, 32);
      if (fq == 0) {
        const unsigned long long pk = ((unsigned long long)__float_as_uint(q) << 32) | (unsigned long long)__float_as_uint(sm);
        __hip_atomic_store((unsigned long long*)(stats + ((size_t)(rg + fr) * 16 + tn * 2 + wc) * 2), pk, __ATOMIC_RELAXED, __HIP_MEMORY_SCOPE_AGENT);
      }
      asm volatile("" ::: "memory");
    }
    asm volatile("s_waitcnt vmcnt(0)" ::: "memory");
    __syncthreads();
    if (tid_() == 0) {
      __hip_atomic_fetch_add(cnt + tm, 1u, __ATOMIC_RELAXED, __HIP_MEMORY_SCOPE_AGENT);
      while (__hip_atomic_load(cnt + tm, __ATOMIC_RELAXED, __HIP_MEMORY_SCOPE_AGENT) < 8u) __builtin_amdgcn_s_sleep(1);
    }
    __syncthreads();
#pragma unroll
    for (int mi = 0; mi < MI; ++mi) {
      const int rg = rw + mi * 16;
      const bool lat = rg < NTL;
      float* d = (lat ? dst_lat + (size_t)rg * DM : dst_ctx + (size_t)(rg - NTL) * DM) + (size_t)fr * DM;
      const float* mr = mods_next + (size_t)mod_row(rg) * NMOD + shift_idx * DM;
      const unsigned long long* sq = (const unsigned long long*)(stats + ((size_t)(rg + fr) * 16 + fq * 4) * 2);
      const unsigned long long u0 = __hip_atomic_load(sq + 0, __ATOMIC_RELAXED, __HIP_MEMORY_SCOPE_AGENT), u1 = __hip_atomic_load(sq + 1, __ATOMIC_RELAXED, __HIP_MEMORY_SCOPE_AGENT);
      const unsigned long long u2 = __hip_atomic_load(sq + 2, __ATOMIC_RELAXED, __HIP_MEMORY_SCOPE_AGENT), u3 = __hip_atomic_load(sq + 3, __ATOMIC_RELAXED, __HIP_MEMORY_SCOPE_AGENT);
      const f32x4 p0 = {__uint_as_float((unsigned)u0), __uint_as_float((unsigned)(u0 >> 32)), __uint_as_float((unsigned)u1), __uint_as_float((unsigned)(u1 >> 32))};
      const f32x4 p1 = {__uint_as_float((unsigned)u2), __uint_as_float((unsigned)(u2 >> 32)), __uint_as_float((unsigned)u3), __uint_as_float((unsigned)(u3 >> 32))};
      float ts = (p0[0] + p0[2]) + (p1[0] + p1[2]);
      ts += __shfl_xor(ts, 16); ts += __shfl_xor(ts, 32);
      const float mean = ts * (1.f / 1024.f);
      const float d0 = p0[0] * (1.f / 64.f) - mean, d1 = p0[2] * (1.f / 64.f) - mean, d2 = p1[0] * (1.f / 64.f) - mean, d3 = p1[2] * (1.f / 64.f) - mean;
      float m2 = (p0[1] + p0[3]) + (p1[1] + p1[3]) + 64.f * ((d0 * d0 + d1 * d1) + (d2 * d2 + d3 * d3));
      m2 += __shfl_xor(m2, 16); m2 += __shfl_xor(m2, 32);
      const float rstd = rsqrtf(m2 * (1.f / 1024.f) + 1e-5f);
#pragma unroll
      for (int ni = 0; ni < 4; ++ni) {
        const int col = tn * 128 + wc * 64 + ni * 16 + fq * 4;
        const f32x4 y = (acc[mi][ni] - mean) * rstd * *(const f32x4*)(lng + col) + *(const f32x4*)(lnb + col);
        *(f32x4*)(d + col) = y;
        if (U) {
          const f32x4 sh = *(const f32x4*)(mr + col), sc = *(const f32x4*)(mr + DM + col);
          st4bf(U + (size_t)(rg + fr) * DM + col, y * (sc + 1.f) + sh);
        }
      }
      asm volatile("" ::: "memory");
    }
  }
};

template <int MI>
struct EpiProj {
  const Params* p;
  int l;
  DI void operator()(int tm, int tn, int wr, int wc, int lane, f32x4 (&acc)[MI][4]) const {
    const int fr = lane & 15, fq = lane >> 4;
    const int col0 = tn * 128 + wc * 64;
    const bool lat = tm * (MI * 32) < NTL;
    bf16_t* P = p->P;
    if (tn < 5) {
      const float* gain = (tn < 4 ? p->q_gain : p->k_gain) + l * 64;
      const float mult = tn < 4 ? QSCALE : 1.f;
      f32x4 gv[4];
#pragma unroll
      for (int ni = 0; ni < 4; ++ni) gv[ni] = *(const f32x4*)(gain + ni * 16 + fq * 4);
#pragma unroll
      for (int mi = 0; mi < MI; ++mi) {
        const int row = tm * (MI * 32) + wr * (MI * 16) + mi * 16 + fr;
        float ss = 0.f;
#pragma unroll
        for (int ni = 0; ni < 4; ++ni)
#pragma unroll
          for (int j = 0; j < 4; ++j) ss += acc[mi][ni][j] * acc[mi][ni][j];
        ss += __shfl_xor(ss, 16);
        ss += __shfl_xor(ss, 32);
        const float rinv = rsqrtf(ss * (1.f / 64.f) + 1e-6f);
        f32x4 v[4];
#pragma unroll
        for (int ni = 0; ni < 4; ++ni) v[ni] = acc[mi][ni] * rinv * gv[ni];
        if (lat) {
          const int t = row & (TL - 1);
          const int pr = t >> 6, pc = t & 63;
#pragma unroll
          for (int a = 0; a < 2; ++a) {
            const float* rt = p->rope + (size_t)((a ? pc : pr) * 16 + fq * 4) * 2;
            const f32x4 cs0 = *(const f32x4*)rt, cs1 = *(const f32x4*)(rt + 4);
            const float cc[4] = {cs0[0], cs0[2], cs1[0], cs1[2]};
            const float sn[4] = {cs0[1], cs0[3], cs1[1], cs1[3]};
#pragma unroll
            for (int j = 0; j < 4; ++j) {
              const float x1 = v[2 * a][j], x2 = v[2 * a + 1][j];
              v[2 * a][j] = x1 * cc[j] - x2 * sn[j];
              v[2 * a + 1][j] = x2 * cc[j] + x1 * sn[j];
            }
          }
        }
#pragma unroll
        for (int ni = 0; ni < 4; ++ni) st4bf(P + (size_t)row * DPROJ + col0 + ni * 16 + fq * 4, v[ni] * mult);
      }
    } else {
      const float mult = (tn >= 21 && tn < 25) ? QSCALE : 1.f;
#pragma unroll
      for (int mi = 0; mi < MI; ++mi) {
        const int row = tm * (MI * 32) + wr * (MI * 16) + mi * 16 + fr;
#pragma unroll
        for (int ni = 0; ni < 4; ++ni) st4bf(P + (size_t)row * DPROJ + col0 + ni * 16 + fq * 4, acc[mi][ni] * mult);
      }
    }
  }
};

DI f32x4 shifted4(const bf16_t* P, int row, bool hp, bool hn, int colidx, const float* mu_l) {
  const bf16_t* q = P + (size_t)row * DPROJ + 768 + colidx;
  const f32x4 x = ld4bf(q);
  const f32x4 xm = hp ? ld4bf(q - DPROJ) : (f32x4){0.f, 0.f, 0.f, 0.f};
  const f32x4 xp = hn ? ld4bf(q + DPROJ) : (f32x4){0.f, 0.f, 0.f, 0.f};
  const f32x4 m0 = *(const f32x4*)(mu_l + colidx), m1 = *(const f32x4*)(mu_l + 1920 + colidx);
  return x + m0 * (xm - x) + m1 * (xp - x);
}

struct EpiReadout {
  const Params* p;
  int l;
  DI void operator()(int tm, int tn, int wr, int wc, int lane, f32x4 (&acc)[4][4]) const {
    const int fr = lane & 15, fq = lane >> 4;
    const int head = tn * 2 + wc, colh = head * 64;
    const float* mu_l = p->mu + (size_t)l * 2 * 1920;
    const float* rk = p->r_k + l * 512 + colh;
    const float* gg = p->gn_g + l * 512 + colh;
    const float* gb = p->gn_b + l * 512 + colh;
    const bf16_t* Of = p->Os;
    const bf16_t* Ob = p->Os + (size_t)NTOK * 512;
    u32x2 gp[4][4];
#pragma unroll
    for (int mi = 0; mi < 4; ++mi)
#pragma unroll
      for (int ni = 0; ni < 4; ++ni) { gp[mi][ni].x = pk2(acc[mi][ni][0], acc[mi][ni][1]); gp[mi][ni].y = pk2(acc[mi][ni][2], acc[mi][ni][3]); }
#pragma unroll
    for (int mi = 0; mi < 4; ++mi) {
      const int row = tm * 128 + wr * 64 + mi * 16 + fr;
      int t, L;
      if (row < NTL) { t = row & (TL - 1); L = TL; } else { t = (row - NTL) & (TC - 1); L = TC; }
      const bool hp = t > 0, hn = t < L - 1;
      f32x4 o[4];
      float s = 0.f, bs = 0.f;
#pragma unroll
      for (int ni = 0; ni < 4; ++ni) {
        const int c = fq * 16 + ni * 4;
        o[ni] = ld4bf(Of + (size_t)row * 512 + colh + c) + ld4bf(Ob + (size_t)row * 512 + colh + c);
        s += (o[ni][0] + o[ni][1]) + (o[ni][2] + o[ni][3]);
      }
#pragma unroll 2
      for (int ni = 0; ni < 4; ++ni) {
        const int c = fq * 16 + ni * 4;
        const f32x4 r4 = shifted4(p->P, row, hp, hn, colh + c, mu_l);
        const f32x4 k4 = shifted4(p->P, row, hp, hn, 512 + colh + c, mu_l);
        const f32x4 rk4 = *(const f32x4*)(rk + c);
        const f32x4 pr = r4 * k4 * rk4;
        bs += (pr[0] + pr[1]) + (pr[2] + pr[3]);
      }
      s += __shfl_xor(s, 16); s += __shfl_xor(s, 32);
      bs += __shfl_xor(bs, 16); bs += __shfl_xor(bs, 32);
      const float mean = s * (1.f / 64.f);
      float q = 0.f;
#pragma unroll
      for (int ni = 0; ni < 4; ++ni) {
        const f32x4 d = o[ni] - mean;
        q += (d[0] * d[0] + d[1] * d[1]) + (d[2] * d[2] + d[3] * d[3]);
      }
      q += __shfl_xor(q, 16); q += __shfl_xor(q, 32);
      const float rstd = rsqrtf(q * (1.f / 64.f) + 64e-5f);
#pragma unroll
      for (int ni = 0; ni < 4; ++ni) {
        const int c = fq * 16 + ni * 4;
        const f32x4 g4 = *(const f32x4*)(gg + c), b4 = *(const f32x4*)(gb + c);
        const f32x4 vv = shifted4(p->P, row, hp, hn, 1024 + colh + c, mu_l);
        const f32x4 gate = {bflo(gp[mi][ni].x), bfhi(gp[mi][ni].x), bflo(gp[mi][ni].y), bfhi(gp[mi][ni].y)};
        const f32x4 y = ((o[ni] - mean) * rstd * g4 + b4 + vv * bs) * gate;
        st4bf(p->yr + (size_t)row * 512 + colh + c, y);
      }
      asm volatile("" ::: "memory");
    }
  }
};

DI float wave_sum(float v) {
#pragma unroll
  for (int o = 32; o > 0; o >>= 1) v += __shfl_xor(v, o);
  return v;
}

DI void ln_phase(float* xl, float* xc, int M, const float* g, const float* b, const float* mods_l, int shift_idx, bf16_t* U) {
  const int lane = tid_() & 63, wid = tid_() >> 6;
  for (int row = blockIdx.x * 4 + wid; row < M; row += gridDim.x * 4) {
    float* xr = row < NTL ? xl + (size_t)row * DM : xc + (size_t)(row - NTL) * DM;
    f32x4 v[4];
    float s = 0.f;
#pragma unroll
    for (int i = 0; i < 4; ++i) { v[i] = *(const f32x4*)(xr + i * 256 + lane * 4); s += (v[i][0] + v[i][1]) + (v[i][2] + v[i][3]); }
    const float mean = wave_sum(s) * (1.f / 1024.f);
    float q = 0.f;
#pragma unroll
    for (int i = 0; i < 4; ++i) { const f32x4 d = v[i] - mean; q += (d[0] * d[0] + d[1] * d[1]) + (d[2] * d[2] + d[3] * d[3]); }
    const float rstd = rsqrtf(wave_sum(q) * (1.f / 1024.f) + 1e-5f);
    const float* mr = mods_l + (size_t)mod_row(row) * NMOD + shift_idx * DM;
#pragma unroll
    for (int i = 0; i < 4; ++i) {
      const int c = i * 256 + lane * 4;
      const f32x4 y = (v[i] - mean) * rstd * *(const f32x4*)(g + c) + *(const f32x4*)(b + c);
      *(f32x4*)(xr + c) = y;
      if (U) {
        const f32x4 sh = *(const f32x4*)(mr + c), sc = *(const f32x4*)(mr + DM + c);
        st4bf(U + (size_t)row * DM + c, y * (sc + 1.f) + sh);
      }
    }
  }
}

DI void u0_phase(const Params& p) {
  const int lane = tid_() & 63, wid = tid_() >> 6;
  for (int row = blockIdx.x * 4 + wid; row < NTOK; row += gridDim.x * 4) {
    const float* xr = row < NTL ? p.x_in + (size_t)row * DM : p.ctx_in + (size_t)(row - NTL) * DM;
    const float* mr = p.mods + (size_t)mod_row(row) * NMOD;
#pragma unroll
    for (int i = 0; i < 4; ++i) {
      const int c = i * 256 + lane * 4;
      const f32x4 y = *(const f32x4*)(xr + c);
      const f32x4 sh = *(const f32x4*)(mr + c), sc = *(const f32x4*)(mr + DM + c);
      st4bf(p.U + (size_t)row * DM + c, y * (sc + 1.f) + sh);
    }
  }
}

DI void mods_phase(const Params& p, char* lds) {
  float* sc = (float*)lds;
  float* red = sc + 256 * 20;
  const int tid = tid_(), lane = tid & 63, wid = tid >> 6;
  if (blockIdx.x == 0) {
    if (tid < 64) p.counters[tid] = 0u;
    for (int i = tid; i < 6 * 288; i += NTHREADS) p.lncnt[i] = 0u;
    for (int i = tid; i < 1024; i += NTHREADS) {
      const int pos = i >> 4, k = i & 15;
      const float inv = exp2f(-(float)k * (1.f / 16.f) * 13.287712379549449f);
      const float ang = (float)pos * inv;
      p.rope[i * 2] = cosf(ang);
      p.rope[i * 2 + 1] = sinf(ang);
    }
  }
  for (int tile = blockIdx.x; tile < 288; tile += gridDim.x) {
    const int l = tile / 144, col0 = (tile % 144) * 64;
    float acc[17];
#pragma unroll
    for (int r = 0; r < 17; ++r) acc[r] = 0.f;
    for (int kc = 0; kc < 4; ++kc) {
      __syncthreads();
      for (int i = tid; i < 17 * 256; i += NTHREADS) {
        const int r = i >> 8, kk = i & 255;
        const float v = r < 16 ? p.c[r * DM + kc * 256 + kk] : p.c_ctx[kc * 256 + kk];
        sc[kk * 20 + r] = siluf_(v);
      }
      __syncthreads();
      const float* wp = p.w_ada + ((size_t)l * DM + kc * 256 + wid * 64) * NMOD + col0 + lane;
      for (int kk = 0; kk < 64; ++kk) {
        const float wv = wp[(size_t)kk * NMOD];
        const float* s = sc + (wid * 64 + kk) * 20;
#pragma unroll
        for (int r = 0; r < 17; ++r) acc[r] += s[r] * wv;
      }
    }
    __syncthreads();
#pragma unroll
    for (int r = 0; r < 17; ++r) red[(wid * 17 + r) * 64 + lane] = acc[r];
    __syncthreads();
    for (int i = tid; i < 17 * 64; i += NTHREADS) {
      const int r = i >> 6, cl = i & 63;
      const float s = red[(0 * 17 + r) * 64 + cl] + red[(1 * 17 + r) * 64 + cl] + red[(2 * 17 + r) * 64 + cl] + red[(3 * 17 + r) * 64 + cl];
      p.mods[((size_t)l * 17 + r) * NMOD + col0 + cl] = s + p.b_ada[l * NMOD + col0 + cl];
    }
  }
  __syncthreads();
}

DI void sg_phase(const Params& p, int l) {
  const int lane = tid_() & 63, wid = tid_() >> 6;
  const float* mu_l = p.mu + (size_t)l * 2 * 1920;
  const int b0 = gridDim.x > 256 ? 256 : 0, nb = gridDim.x - b0;
  if ((int)blockIdx.x < b0) return;
  for (int idx = ((int)blockIdx.x - b0) * NTHREADS + tid_(); idx < NTOK * 32; idx += nb * NTHREADS) {
    const int row = idx >> 5, c = (idx & 31) * 4;
    int t, L;
    if (row < NTL) { t = row & (TL - 1); L = TL; } else { t = (row - NTL) & (TC - 1); L = TC; }
    const f32x4 x = shifted4(p.P, row, t > 0, t < L - 1, 1792 + c, mu_l);
    f32x4 y;
#pragma unroll
    for (int j = 0; j < 4; ++j) y[j] = sigmoidf_(x[j]);
    st4bf(p.sg + (size_t)row * 128 + c, y);
  }
  (void)lane; (void)wid;
}

constexpr int KLD = 72;
constexpr int VLD = 68;

struct NoMask { DI void operator()(f32x16 (&st)[2]) const {} };

struct NaMask {
  const float* rp;
  int c;
  int c0;
  int h;
  DI void operator()(f32x16 (&st)[2]) const {
#pragma unroll
    for (int u = 0; u < 2; ++u)
#pragma unroll
      for (int i = 0; i < 16; ++i) {
        const int kc = u * 32 + (i & 3) + 8 * (i >> 2) + 4 * h;
        const bool ok = (kc >= c0) && (kc < c0 + 16);
        const int bi = ok ? (kc - c + 15) : 15;
        const float bias = rp[bi];
        st[u][i] = ok ? st[u][i] + bias : -1e30f;
      }
  }
};

template <class Mask>
DI void attn_tile(const bf16_t* Ks, const bf16_t* Vt, const bf16x8 (&qf)[4], f32x16 (&ot)[2], float& m, float& l, const Mask& mask, int lane) {
  const int r = lane & 31, h = lane >> 5;
  f32x16 st[2];
#pragma unroll
  for (int u = 0; u < 2; ++u) {
#pragma unroll
    for (int i = 0; i < 16; ++i) st[u][i] = 0.f;
#pragma unroll
    for (int s = 0; s < 4; ++s) {
      const bf16x8 kf = *(const bf16x8*)(Ks + (u * 32 + r) * KLD + s * 16 + h * 8);
      st[u] = __builtin_amdgcn_mfma_f32_32x32x16_bf16(kf, qf[s], st[u], 0, 0, 0);
    }
  }
  mask(st);
  float mx = st[0][0];
#pragma unroll
  for (int u = 0; u < 2; ++u)
#pragma unroll
    for (int i = 0; i < 16; ++i) mx = fmaxf(mx, st[u][i]);
  mx = fmaxf(mx, __shfl_xor(mx, 32));
  const float mnew = fmaxf(m, mx);
  const float alpha = __builtin_amdgcn_exp2f(m - mnew);
  m = mnew;
  float ls = 0.f;
#pragma unroll
  for (int u = 0; u < 2; ++u)
#pragma unroll
    for (int i = 0; i < 16; ++i) { st[u][i] = __builtin_amdgcn_exp2f(st[u][i] - mnew); ls += st[u][i]; }
  l = l * alpha + ls;
#pragma unroll
  for (int dt = 0; dt < 2; ++dt)
#pragma unroll
    for (int i = 0; i < 16; ++i) ot[dt][i] *= alpha;
#pragma unroll
  for (int u = 0; u < 2; ++u)
#pragma unroll
    for (int s = 0; s < 2; ++s) {
      u32x4 pw;
      pw.x = pk2(st[u][8 * s + 0], st[u][8 * s + 1]); pw.y = pk2(st[u][8 * s + 2], st[u][8 * s + 3]);
      pw.z = pk2(st[u][8 * s + 4], st[u][8 * s + 5]); pw.w = pk2(st[u][8 * s + 6], st[u][8 * s + 7]);
      const bf16x8 pb = __builtin_bit_cast(bf16x8, pw);
#pragma unroll
      for (int dt = 0; dt < 2; ++dt) {
        const bf16_t* vp = Vt + (dt * 32 + r) * VLD + u * 32 + 16 * s + 4 * h;
        const s16x4 lo = *(const s16x4*)vp, hi = *(const s16x4*)(vp + 8);
        const bf16x8 va = __builtin_shufflevector(lo, hi, 0, 1, 2, 3, 4, 5, 6, 7);
        ot[dt] = __builtin_amdgcn_mfma_f32_32x32x16_bf16(va, pb, ot[dt], 0, 0, 0);
      }
    }
}

template <int NHB>
DI void kv_load(const bf16_t* kb, const bf16_t* vb, u32x4 (&kr)[NHB * 2], u32x4 (&vr)[NHB * 2]) {
#pragma unroll
  for (int i = 0; i < NHB * 2; ++i) {
    const int c = tid_() + i * NTHREADS;
    const int hh = c >> 9, cc = c & 511, key = cc >> 3, dc = cc & 7;
    const size_t off = (size_t)key * DPROJ + hh * 64 + dc * 8;
    kr[i] = *(const u32x4*)(kb + off);
    vr[i] = *(const u32x4*)(vb + off);
  }
}
template <int NHB>
DI void kv_store(bf16_t* Ks, bf16_t* Vt, const u32x4 (&kr)[NHB * 2], const u32x4 (&vr)[NHB * 2]) {
#pragma unroll
  for (int i = 0; i < NHB * 2; ++i) {
    const int c = tid_() + i * NTHREADS;
    const int hh = c >> 9, cc = c & 511, key = cc >> 3, dc = cc & 7;
    *(u32x4*)(Ks + hh * 64 * KLD + key * KLD + dc * 8) = kr[i];
    bf16_t* vt = Vt + hh * 64 * VLD + (dc * 8) * VLD + key;
    vt[0 * VLD] = (bf16_t)(vr[i].x & 0xffff); vt[1 * VLD] = (bf16_t)(vr[i].x >> 16);
    vt[2 * VLD] = (bf16_t)(vr[i].y & 0xffff); vt[3 * VLD] = (bf16_t)(vr[i].y >> 16);
    vt[4 * VLD] = (bf16_t)(vr[i].z & 0xffff); vt[5 * VLD] = (bf16_t)(vr[i].z >> 16);
    vt[6 * VLD] = (bf16_t)(vr[i].w & 0xffff); vt[7 * VLD] = (bf16_t)(vr[i].w >> 16);
  }
}

DI void attn_finish(bf16_t* outp  , f32x16 (&ot)[2], float l, int lane) {
  const int h = lane >> 5;
  l += __shfl_xor(l, 32);
  const float inv = __builtin_amdgcn_rcpf(l);
#pragma unroll
  for (int dt = 0; dt < 2; ++dt)
#pragma unroll
    for (int g = 0; g < 4; ++g) {
      f32x4 v = {ot[dt][4 * g] * inv, ot[dt][4 * g + 1] * inv, ot[dt][4 * g + 2] * inv, ot[dt][4 * g + 3] * inv};
      st4bf(outp + dt * 32 + 8 * g + 4 * h, v);
    }
}

DI void dense_item(const Params& p, int qrow0, int qcol, int krow_lat0, int ntl, int krow_ctx0, int kcol, int vcol, char* lds) {
  bf16_t* Ks = (bf16_t*)lds;
  bf16_t* Vt = Ks + 2 * 64 * KLD;
  const int lane = tid_() & 63, wid = tid_() >> 6, r = lane & 31, h = lane >> 5;
  bf16_t* qp = p.P + (size_t)(qrow0 + wid * 32 + r) * DPROJ + qcol;
  bf16x8 qf[4];
#pragma unroll
  for (int s = 0; s < 4; ++s) qf[s] = *(const bf16x8*)(qp + s * 16 + h * 8);
  f32x16 ot[2];
#pragma unroll
  for (int dt = 0; dt < 2; ++dt)
#pragma unroll
    for (int i = 0; i < 16; ++i) ot[dt][i] = 0.f;
  float m = -1e30f, l = 0.f;
  const int nt = ntl + 4;
  u32x4 kr[2], vr[2];
  auto tile_row = [&](int jt) { return jt < ntl ? krow_lat0 + jt * 64 : krow_ctx0 + (jt - ntl) * 64; };
  {
    const bf16_t* base = p.P + (size_t)tile_row(0) * DPROJ;
    kv_load<1>(base + kcol, base + vcol, kr, vr);
  }
  for (int jt = 0; jt < nt; ++jt) {
    __syncthreads();
    kv_store<1>(Ks, Vt, kr, vr);
    __syncthreads();
    if (jt + 1 < nt) {
      const bf16_t* base = p.P + (size_t)tile_row(jt + 1) * DPROJ;
      kv_load<1>(base + kcol, base + vcol, kr, vr);
    }
    attn_tile(Ks, Vt, qf, ot, m, l, NoMask(), lane);
  }
  attn_finish(qp, ot, l, lane);
  __syncthreads();
}

DI void na_item(const Params& p, int lyr, int b, int gr, int hp, char* lds) {
  bf16_t* Ks = (bf16_t*)lds;
  bf16_t* Vt = Ks + 2 * 64 * KLD;
  float* rpl = (float*)(Vt + 2 * 64 * VLD);
  const int tid = tid_(), lane = tid & 63, wid = tid >> 6, r = lane & 31, h = lane >> 5;
  const int hl = wid >> 1, head = hp * 2 + hl, qh = wid & 1;
  const int r0 = gr - 4 < 0 ? 0 : (gr - 4 > 24 ? 24 : gr - 4);
  __syncthreads();
  for (int i = tid; i < 2 * 465; i += NTHREADS) {
    const int hh = i / 465, e = i - hh * 465;
    rpl[i] = p.rpb[((size_t)lyr * 8 + hp * 2 + hh) * 465 + e] * LOG2E;
  }
  const int c = qh * 32 + r;
  const int c0 = c - 8 < 0 ? 0 : (c - 8 > 48 ? 48 : c - 8);
  bf16_t* qp = p.P + (size_t)(b * TL + gr * 64 + c) * DPROJ + 2688 + head * 64;
  bf16x8 qf[4];
#pragma unroll
  for (int s = 0; s < 4; ++s) qf[s] = *(const bf16x8*)(qp + s * 16 + h * 8);
  f32x16 ot[2];
#pragma unroll
  for (int dt = 0; dt < 2; ++dt)
#pragma unroll
    for (int i = 0; i < 16; ++i) ot[dt][i] = 0.f;
  float m = -1e30f, l = 0.f;
  u32x4 kr[4], vr[4];
  auto tile_row = [&](int jt) { return jt < 8 ? b * TL + (r0 + jt) * 64 : NTL + b * TC + (jt - 8) * 64; };
  const int kcol = 3200 + hp * 128, vcol = 3712 + hp * 128;
  {
    const bf16_t* base = p.P + (size_t)tile_row(0) * DPROJ;
    kv_load<2>(base + kcol, base + vcol, kr, vr);
  }
  for (int jt = 0; jt < 12; ++jt) {
    __syncthreads();
    kv_store<2>(Ks, Vt, kr, vr);
    __syncthreads();
    if (jt + 1 < 12) {
      const bf16_t* base = p.P + (size_t)tile_row(jt + 1) * DPROJ;
      kv_load<2>(base + kcol, base + vcol, kr, vr);
    }
    if (jt < 8) {
      NaMask mk;
      mk.rp = rpl + hl * 465 + (r0 + jt - gr + 7) * 31;
      mk.c = c; mk.c0 = c0; mk.h = h;
      attn_tile(Ks + hl * 64 * KLD, Vt + hl * 64 * VLD, qf, ot, m, l, mk, lane);
    } else {
      attn_tile(Ks + hl * 64 * KLD, Vt + hl * 64 * VLD, qf, ot, m, l, NoMask(), lane);
    }
  }
  attn_finish(qp, ot, l, lane);
  __syncthreads();
}

template <int CTRL>
DI float dpp_f(float x) { return __int_as_float(__builtin_amdgcn_update_dpp(0, __float_as_int(x), CTRL, 0xF, 0xF, true)); }
DI float red8(float x) {
  x += dpp_f<0xB1>(x);
  x += dpp_f<0x4E>(x);
  x += dpp_f<0x141>(x);
  return x;
}

struct ScanOps { f32x4 w[2], kk[2], b[2], kd[2], r[2]; f32x2 v; };
DI void scan_load(ScanOps& o, const float* base, int kg, int row0) {
#pragma unroll
  for (int i = 0; i < 2; ++i) {
    o.w[i] = *(const f32x4*)(base + kg * 8 + i * 4);
    o.kk[i] = *(const f32x4*)(base + 64 + kg * 8 + i * 4);
    o.b[i] = *(const f32x4*)(base + 128 + kg * 8 + i * 4);
    o.kd[i] = *(const f32x4*)(base + 192 + kg * 8 + i * 4);
    o.r[i] = *(const f32x4*)(base + 256 + kg * 8 + i * 4);
  }
  o.v = *(const f32x2*)(base + 320 + row0);
}

DI void scan_block(const Params& p, int lyr, int sidx, bool need_ctx, char* lds) {
  const int dir = sidx & 1, hd = (sidx >> 1) & 7, b = sidx >> 4;
  const int tid = tid_(), lane = tid & 63, w = tid >> 6;
  float* rec = (float*)lds;
  float* obuf = rec + 16 * 384;
  float* cst = obuf + 16 * 64;
  bf16_t* Aw = (bf16_t*)(cst + 14 * 64);
  bf16_t* Aa = Aw + 16 * 72;
  __syncthreads();
  for (int i = tid; i < 320; i += NTHREADS) {
    const int g = i >> 6, c = i & 63;
    const int colidx = (g < 3 ? g * 512 + hd * 64 : (g == 3 ? 1536 + dir * 64 : 1664 + dir * 64)) + c;
    cst[i] = p.mu[(size_t)lyr * 3840 + colidx];
    cst[320 + i] = p.mu[(size_t)lyr * 3840 + 1920 + colidx];
  }
  if (tid < 64) {
    cst[640 + tid] = p.w0[(lyr * 2 + dir) * 512 + hd * 64 + tid];
    cst[704 + tid] = p.a0[(lyr * 2 + dir) * 512 + hd * 64 + tid];
    cst[768 + tid] = p.k_k[lyr * 512 + hd * 64 + tid];
    cst[832 + tid] = p.k_a[lyr * 512 + hd * 64 + tid];
  }
  const int fr = lane & 15, fq = lane >> 4;
  bf16x8 bw[2], ba[2];
  {
    const float* w2p = p.w2 + (size_t)(lyr * 2 + dir) * 64 * 512 + hd * 64 + 16 * w + fr;
    const float* a2p = p.a2 + (size_t)(lyr * 2 + dir) * 64 * 512 + hd * 64 + 16 * w + fr;
#pragma unroll
    for (int ks = 0; ks < 2; ++ks) {
      u32x4 tw, ta;
      float xw[8], xa[8];
#pragma unroll
      for (int j = 0; j < 8; ++j) { xw[j] = w2p[(size_t)(ks * 32 + fq * 8 + j) * 512]; xa[j] = a2p[(size_t)(ks * 32 + fq * 8 + j) * 512]; }
      tw.x = pk2(xw[0], xw[1]); tw.y = pk2(xw[2], xw[3]); tw.z = pk2(xw[4], xw[5]); tw.w = pk2(xw[6], xw[7]);
      ta.x = pk2(xa[0], xa[1]); ta.y = pk2(xa[2], xa[3]); ta.z = pk2(xa[4], xa[5]); ta.w = pk2(xa[6], xa[7]);
      bw[ks] = __builtin_bit_cast(bf16x8, tw);
      ba[ks] = __builtin_bit_cast(bf16x8, ta);
    }
  }
  f32x4 S[2][2];
#pragma unroll
  for (int a = 0; a < 2; ++a)
#pragma unroll
    for (int i = 0; i < 2; ++i) S[a][i] = (f32x4){0.f, 0.f, 0.f, 0.f};
  const int kg = lane & 7, rp = lane >> 3, row0 = 16 * w + rp * 2;
  const int pj = tid >> 4, pcg = tid & 15;
  int goff[5] = {hd * 64, 512 + hd * 64, 1024 + hd * 64, 1536 + dir * 64, 1664 + dir * 64};
  u32x2 raw[5][3];
  auto chunk_tok = [&](int ch, int j, int& rowbase, int& t, int& L) {
    int n0;
    if (ch < 16) { L = TC; n0 = ch * 16; rowbase = NTL + b * TC; } else { L = TL; n0 = (ch - 16) * 16; rowbase = b * TL; }
    const int n = n0 + j;
    t = dir ? L - 1 - n : n;
  };
  auto prefetch = [&](int ch) {
    int rowbase, t, L;
    chunk_tok(ch, pj, rowbase, t, L);
    const bf16_t* q = p.P + (size_t)(rowbase + t) * DPROJ + 768 + pcg * 4;
#pragma unroll
    for (int g = 0; g < 5; ++g) {
      raw[g][1] = *(const u32x2*)(q + goff[g]);
      raw[g][0] = t > 0 ? *(const u32x2*)(q + goff[g] - DPROJ) : (u32x2){0u, 0u};
      raw[g][2] = t < L - 1 ? *(const u32x2*)(q + goff[g] + DPROJ) : (u32x2){0u, 0u};
    }
  };
  prefetch(0);
  __syncthreads();
  for (int ch = 0; ch < 144; ++ch) {
    {
      f32x4 xs[5];
#pragma unroll
      for (int g = 0; g < 5; ++g) {
        const f32x4 x = {bflo(raw[g][1].x), bfhi(raw[g][1].x), bflo(raw[g][1].y), bfhi(raw[g][1].y)};
        const f32x4 xm = {bflo(raw[g][0].x), bfhi(raw[g][0].x), bflo(raw[g][0].y), bfhi(raw[g][0].y)};
        const f32x4 xp = {bflo(raw[g][2].x), bfhi(raw[g][2].x), bflo(raw[g][2].y), bfhi(raw[g][2].y)};
        const f32x4 m0 = *(const f32x4*)(cst + g * 64 + pcg * 4), m1 = *(const f32x4*)(cst + 320 + g * 64 + pcg * 4);
        xs[g] = x + m0 * (xm - x) + m1 * (xp - x);
      }
      float* rj = rec + pj * 384;
      *(f32x4*)(rj + 256 + pcg * 4) = xs[0];
      *(f32x4*)(rj + 320 + pcg * 4) = xs[2];
      const f32x4 kx = xs[1] * *(const f32x4*)(cst + 768 + pcg * 4);
      float ss = (kx[0] * kx[0] + kx[1] * kx[1]) + (kx[2] * kx[2] + kx[3] * kx[3]);
      ss += __shfl_xor(ss, 1); ss += __shfl_xor(ss, 2); ss += __shfl_xor(ss, 4); ss += __shfl_xor(ss, 8);
      const float rn = rsqrtf(ss + 1e-12f);
      *(f32x4*)(rj + 64 + pcg * 4) = kx * rn;
      *(f32x4*)(rj + 192 + pcg * 4) = xs[1];
      f32x4 tw;
#pragma unroll
      for (int j = 0; j < 4; ++j) tw[j] = 1.f - 2.f * __builtin_amdgcn_rcpf(1.f + __expf(2.f * xs[3][j]));
      st4bf(Aw + pj * 72 + pcg * 4, tw);
      st4bf(Aa + pj * 72 + pcg * 4, xs[4]);
    }
    __syncthreads();
    {
      f32x4 aw = {0.f, 0.f, 0.f, 0.f}, aa = {0.f, 0.f, 0.f, 0.f};
#pragma unroll
      for (int ks = 0; ks < 2; ++ks) {
        const bf16x8 fw = *(const bf16x8*)(Aw + fr * 72 + ks * 32 + fq * 8);
        const bf16x8 fa = *(const bf16x8*)(Aa + fr * 72 + ks * 32 + fq * 8);
        aw = __builtin_amdgcn_mfma_f32_16x16x32_bf16(bw[ks], fw, aw, 0, 0, 0);
        aa = __builtin_amdgcn_mfma_f32_16x16x32_bf16(ba[ks], fa, aa, 0, 0, 0);
      }
      const int c = 16 * w + fq * 4;
      float* rj = rec + fr * 384;
      const f32x4 w0v = *(const f32x4*)(cst + 640 + c), a0v = *(const f32x4*)(cst + 704 + c), kav = *(const f32x4*)(cst + 832 + c);
      const f32x4 kkv = *(const f32x4*)(rj + 64 + c), kpv = *(const f32x4*)(rj + 192 + c);
      f32x4 dec, bb, kd;
#pragma unroll
      for (int j = 0; j < 4; ++j) {
        const float z = -(w0v[j] + aw[j]);
        const float sp = fmaxf(z, 0.f) + __logf(1.f + __expf(-fabsf(z)));
        const float wl = -sp - 0.5f;
        dec[j] = __expf(-__expf(wl));
        const float ic = sigmoidf_(a0v[j] + aa[j]);
        bb[j] = kkv[j] * ic;
        kd[j] = kpv[j] * (1.f + (ic - 1.f) * kav[j]);
      }
      *(f32x4*)(rj + c) = dec;
      *(f32x4*)(rj + 128 + c) = bb;
      *(f32x4*)(rj + 192 + c) = kd;
    }
    __syncthreads();
    if (ch + 1 < 144) prefetch(ch + 1);
    {
      ScanOps cur, nxt;
      scan_load(cur, rec, kg, row0);
#pragma unroll 2
      for (int j = 0; j < 16; ++j) {
        if (j + 1 < 16) scan_load(nxt, rec + (j + 1) * 384, kg, row0);
#pragma unroll
        for (int a = 0; a < 2; ++a) {
          f32x4 t0 = S[a][0] * cur.kk[0] + S[a][1] * cur.kk[1];
          float sap = red8((t0[0] + t0[1]) + (t0[2] + t0[3]));
          const float vv = a ? cur.v.y : cur.v.x;
          S[a][0] = S[a][0] * cur.w[0] - cur.b[0] * sap + cur.kd[0] * vv;
          S[a][1] = S[a][1] * cur.w[1] - cur.b[1] * sap + cur.kd[1] * vv;
          f32x4 t1 = S[a][0] * cur.r[0] + S[a][1] * cur.r[1];
          float o = red8((t1[0] + t1[1]) + (t1[2] + t1[3]));
          if (kg == 0) obuf[j * 64 + row0 + a] = o;
        }
        cur = nxt;
      }
    }
    __syncthreads();
    if (ch >= 16 || need_ctx) {
      int rowbase, t, L;
      chunk_tok(ch, pj, rowbase, t, L);
      const f32x4 ov = *(const f32x4*)(obuf + pj * 64 + pcg * 4);
      st4bf(p.Os + ((size_t)dir * NTOK + rowbase + t) * 512 + hd * 64 + pcg * 4, ov);
    }
  }
  __syncthreads();
}

DI bf16x8 pack8(f32x4 a, f32x4 b) {
  u32x4 t; t.x = pk2(a[0], a[1]); t.y = pk2(a[2], a[3]); t.z = pk2(b[0], b[1]); t.w = pk2(b[2], b[3]);
  return __builtin_bit_cast(bf16x8, t);
}
DI bf16x8 pack4z(f32x4 a) {
  u32x4 t; t.x = pk2(a[0], a[1]); t.y = pk2(a[2], a[3]); t.z = 0u; t.w = 0u;
  return __builtin_bit_cast(bf16x8, t);
}
#define MFMA16(a, b, c) __builtin_amdgcn_mfma_f32_16x16x32_bf16((a), (b), (c), 0, 0, 0)

DI void scan_block2(const Params& p, int lyr, int sidx, bool need_ctx, char* lds) {
  const int dir = sidx & 1, hd = (sidx >> 1) & 7, b = sidx >> 4;
  const int tid = tid_(), lane = tid & 63, w = tid >> 6;
  const int fr = lane & 15, fq = lane >> 4;
  float* rec = (float*)lds;
  float* obuf = rec + 16 * 384;
  float* cst = obuf + 16 * 64;
  bf16_t* Aw = (bf16_t*)(cst + 14 * 64);
  bf16_t* Aa = Aw + 16 * 72;
  bf16_t* ARt = Aa + 16 * 72;
  bf16_t* BKm = ARt + 32 * 72;
  bf16_t* BKt = BKm + 32 * 72;
  bf16_t* Vt = BKt + 64 * 40;
  float* WL = (float*)(Vt + 64 * 24);
  float* Gf = WL + 64;
  float* GNt = Gf + 32 * 33;
  float* Yf = GNt + 256;
  __syncthreads();
  for (int i = tid; i < 320; i += NTHREADS) {
    const int g = i >> 6, c = i & 63;
    const int colidx = (g < 3 ? g * 512 + hd * 64 : (g == 3 ? 1536 + dir * 64 : 1664 + dir * 64)) + c;
    cst[i] = p.mu[(size_t)lyr * 3840 + colidx];
    cst[320 + i] = p.mu[(size_t)lyr * 3840 + 1920 + colidx];
  }
  if (tid < 64) {
    cst[640 + tid] = p.w0[(lyr * 2 + dir) * 512 + hd * 64 + tid];
    cst[704 + tid] = p.a0[(lyr * 2 + dir) * 512 + hd * 64 + tid];
    cst[768 + tid] = p.k_k[lyr * 512 + hd * 64 + tid];
    cst[832 + tid] = p.k_a[lyr * 512 + hd * 64 + tid];
  }
  bf16x8 bw[2], ba[2];
  {
    const float* w2p = p.w2 + (size_t)(lyr * 2 + dir) * 64 * 512 + hd * 64 + 16 * w + fr;
    const float* a2p = p.a2 + (size_t)(lyr * 2 + dir) * 64 * 512 + hd * 64 + 16 * w + fr;
#pragma unroll
    for (int ks = 0; ks < 2; ++ks) {
      f32x4 x0, x1, y0, y1;
#pragma unroll
      for (int j = 0; j < 4; ++j) {
        x0[j] = w2p[(size_t)(ks * 32 + fq * 8 + j) * 512]; x1[j] = w2p[(size_t)(ks * 32 + fq * 8 + 4 + j) * 512];
        y0[j] = a2p[(size_t)(ks * 32 + fq * 8 + j) * 512]; y1[j] = a2p[(size_t)(ks * 32 + fq * 8 + 4 + j) * 512];
      }
      bw[ks] = pack8(x0, x1);
      ba[ks] = pack8(y0, y1);
    }
  }
  f32x4 ST[4];
#pragma unroll
  for (int kt = 0; kt < 4; ++kt) ST[kt] = (f32x4){0.f, 0.f, 0.f, 0.f};
  const int pj = tid >> 4, pcg = tid & 15;
  int goff[5] = {hd * 64, 512 + hd * 64, 1024 + hd * 64, 1536 + dir * 64, 1664 + dir * 64};
  u32x2 raw[5][3];
  auto chunk_tok = [&](int ch, int j, int& rowbase, int& t, int& L) {
    int n0;
    if (ch < 16) { L = TC; n0 = ch * 16; rowbase = NTL + b * TC; } else { L = TL; n0 = (ch - 16) * 16; rowbase = b * TL; }
    const int n = n0 + j;
    t = dir ? L - 1 - n : n;
  };
  auto prefetch = [&](int ch) {
    int rowbase, t, L;
    chunk_tok(ch, pj, rowbase, t, L);
    const bf16_t* q = p.P + (size_t)(rowbase + t) * DPROJ + 768 + pcg * 4;
    const bool hp = t > 0, hn = t < L - 1;
    const int om = hp ? -DPROJ : 0, on = hn ? DPROJ : 0;
#pragma unroll
    for (int g = 0; g < 5; ++g) {
      raw[g][1] = *(const u32x2*)(q + goff[g]);
      const u32x2 rm = *(const u32x2*)(q + goff[g] + om), rn = *(const u32x2*)(q + goff[g] + on);
      raw[g][0] = hp ? rm : (u32x2){0u, 0u};
      raw[g][2] = hn ? rn : (u32x2){0u, 0u};
    }
  };
  prefetch(0);
  __syncthreads();
  const bf16x8 zero8 = {0, 0, 0, 0, 0, 0, 0, 0};
#pragma unroll 1
  for (int ch = 0; ch < 144; ++ch) {
    {
      f32x4 xs[5];
#pragma unroll
      for (int g = 0; g < 5; ++g) {
        const f32x4 x = {bflo(raw[g][1].x), bfhi(raw[g][1].x), bflo(raw[g][1].y), bfhi(raw[g][1].y)};
        const f32x4 xm = {bflo(raw[g][0].x), bfhi(raw[g][0].x), bflo(raw[g][0].y), bfhi(raw[g][0].y)};
        const f32x4 xp = {bflo(raw[g][2].x), bfhi(raw[g][2].x), bflo(raw[g][2].y), bfhi(raw[g][2].y)};
        const f32x4 m0 = *(const f32x4*)(cst + g * 64 + pcg * 4), m1 = *(const f32x4*)(cst + 320 + g * 64 + pcg * 4);
        xs[g] = x + m0 * (xm - x) + m1 * (xp - x);
      }
      float* rj = rec + pj * 384;
      *(f32x4*)(rj + 256 + pcg * 4) = xs[0];
#pragma unroll
      for (int e = 0; e < 4; ++e) Vt[(pcg * 4 + e) * 24 + pj] = f2bf(xs[2][e]);
      const f32x4 kx = xs[1] * *(const f32x4*)(cst + 768 + pcg * 4);
      float ss = (kx[0] * kx[0] + kx[1] * kx[1]) + (kx[2] * kx[2] + kx[3] * kx[3]);
      ss = red8(ss); ss += dpp_f<0x140>(ss);
      const float rn = rsqrtf(ss + 1e-12f);
      *(f32x4*)(rj + 64 + pcg * 4) = kx * rn;
      *(f32x4*)(rj + 192 + pcg * 4) = xs[1];
      f32x4 tw;
#pragma unroll
      for (int j = 0; j < 4; ++j) tw[j] = 1.f - 2.f * __builtin_amdgcn_rcpf(1.f + __expf(2.f * xs[3][j]));
      st4bf(Aw + pj * 72 + pcg * 4, tw);
      st4bf(Aa + pj * 72 + pcg * 4, xs[4]);
    }
    if (ch + 1 < 144) prefetch(ch + 1);
    __syncthreads();
    {
      f32x4 aw = {0.f, 0.f, 0.f, 0.f}, aa = {0.f, 0.f, 0.f, 0.f};
#pragma unroll
      for (int ks = 0; ks < 2; ++ks) {
        const bf16x8 fw = *(const bf16x8*)(Aw + fr * 72 + ks * 32 + fq * 8);
        const bf16x8 fa = *(const bf16x8*)(Aa + fr * 72 + ks * 32 + fq * 8);
        aw = MFMA16(bw[ks], fw, aw);
        aa = MFMA16(ba[ks], fa, aa);
      }
      const int c = 16 * w + fq * 4;
      const float* rj = rec + fr * 384;
      const f32x4 w0v = *(const f32x4*)(cst + 640 + c), a0v = *(const f32x4*)(cst + 704 + c), kav = *(const f32x4*)(cst + 832 + c);
      const f32x4 kkv = *(const f32x4*)(rj + 64 + c), kpv = *(const f32x4*)(rj + 192 + c), rpv = *(const f32x4*)(rj + 256 + c);
      f32x4 e, E, ic;
#pragma unroll
      for (int j = 0; j < 4; ++j) {
        const float z = -(w0v[j] + aw[j]);
        const float sp = fmaxf(z, 0.f) + __logf(1.f + __expf(-fabsf(z)));
        e[j] = __expf(-sp - 0.5f);
        ic[j] = sigmoidf_(a0v[j] + aa[j]);
      }
      E = e;
#pragma unroll
      for (int j = 0; j < 4; ++j) {
        E[j] += dpp_f<0x111>(E[j]);
        E[j] += dpp_f<0x112>(E[j]);
        E[j] += dpp_f<0x114>(E[j]);
        E[j] += dpp_f<0x118>(E[j]);
      }
      f32x4 at, rt, bt, kt_;
#pragma unroll
      for (int j = 0; j < 4; ++j) {
        const float wi = __expf(E[j]);
        at[j] = -kkv[j] * __expf(e[j] - E[j]);
        rt[j] = rpv[j] * __expf(-E[j]);
        bt[j] = kkv[j] * ic[j] * wi;
        kt_[j] = kpv[j] * (1.f + (ic[j] - 1.f) * kav[j]) * wi;
      }
      st4bf(ARt + fr * 72 + c, at);
      st4bf(ARt + (16 + fr) * 72 + c, rt);
      st4bf(BKm + fr * 72 + c, bt);
      st4bf(BKm + (16 + fr) * 72 + c, kt_);
#pragma unroll
      for (int j = 0; j < 4; ++j) { BKt[(c + j) * 40 + fr] = f2bf(bt[j]); BKt[(c + j) * 40 + 16 + fr] = f2bf(kt_[j]); }
      if (fr == 15) {
#pragma unroll
        for (int j = 0; j < 4; ++j) WL[c + j] = __expf(-E[j]);
      }
    }
    __syncthreads();
    {
      const int ct = w >> 1, tt = w & 1;
      f32x4 g = {0.f, 0.f, 0.f, 0.f};
#pragma unroll
      for (int ks = 0; ks < 2; ++ks) {
        const bf16x8 A = *(const bf16x8*)(BKm + (ct * 16 + fr) * 72 + ks * 32 + fq * 8);
        const bf16x8 B = *(const bf16x8*)(ARt + (tt * 16 + fr) * 72 + ks * 32 + fq * 8);
        g = MFMA16(A, B, g);
      }
#pragma unroll
      for (int r = 0; r < 4; ++r) Gf[(ct * 16 + fq * 4 + r) * 33 + tt * 16 + fr] = g[r];
      if (w == 0) {
#pragma unroll
        for (int r = 0; r < 4; ++r) GNt[(fq * 4 + r) * 16 + fr] = g[r];
      }
    }
    f32x4 XA = {0.f, 0.f, 0.f, 0.f}, XR = {0.f, 0.f, 0.f, 0.f};
#pragma unroll
    for (int ks = 0; ks < 2; ++ks) {
      const bf16x8 Bs = pack8(ST[2 * ks], ST[2 * ks + 1]);
      {
        const bf16_t* ar = ARt + fr * 72 + fq * 4;
        const s16x4 lo = *(const s16x4*)(ar + (2 * ks) * 16), hi = *(const s16x4*)(ar + (2 * ks + 1) * 16);
        XA = MFMA16(__builtin_shufflevector(lo, hi, 0, 1, 2, 3, 4, 5, 6, 7), Bs, XA);
      }
      {
        const bf16_t* ar = ARt + (16 + fr) * 72 + fq * 4;
        const s16x4 lo = *(const s16x4*)(ar + (2 * ks) * 16), hi = *(const s16x4*)(ar + (2 * ks + 1) * 16);
        XR = MFMA16(__builtin_shufflevector(lo, hi, 0, 1, 2, 3, 4, 5, 6, 7), Bs, XR);
      }
    }
    __syncthreads();
    const bf16x8 vB = fq < 2 ? *(const bf16x8*)(Vt + (16 * w + fr) * 24 + fq * 8) : zero8;
    {
      f32x4 n0, n1;
#pragma unroll
      for (int jj = 0; jj < 4; ++jj) {
        const int i0 = fq * 8 + jj, i1 = fq * 8 + 4 + jj;
        const float g0 = Gf[(16 + (i0 & 15)) * 33 + fr], g1 = Gf[(16 + (i1 & 15)) * 33 + fr];
        n0[jj] = (fq < 2 && i0 < fr) ? g0 : 0.f;
        n1[jj] = (fq < 2 && i1 < fr) ? g1 : 0.f;
      }
      XA = MFMA16(pack8(n0, n1), vB, XA);
    }
    float* yw = Yf + (w * 16 + fr) * 20;
    *(f32x4*)(yw + fq * 4) = XA;
    float u[16];
    {
      const f32x4 y0 = *(const f32x4*)(yw), y1 = *(const f32x4*)(yw + 4), y2 = *(const f32x4*)(yw + 8), y3 = *(const f32x4*)(yw + 12);
#pragma unroll
      for (int j = 0; j < 4; ++j) { u[j] = y0[j]; u[4 + j] = y1[j]; u[8 + j] = y2[j]; u[12 + j] = y3[j]; }
#pragma unroll
      for (int i = 0; i < 15; ++i) {
#pragma unroll
        for (int t4 = (i + 1) / 4; t4 < 4; ++t4) {
          const f32x4 nn = *(const f32x4*)(GNt + i * 16 + t4 * 4);
#pragma unroll
          for (int e2 = 0; e2 < 4; ++e2) if (t4 * 4 + e2 > i) u[t4 * 4 + e2] += u[i] * nn[e2];
        }
      }
    }
    f32x4 uq;
#pragma unroll
    for (int j = 0; j < 4; ++j) uq[j] = fq == 0 ? u[j] : (fq == 1 ? u[4 + j] : (fq == 2 ? u[8 + j] : u[12 + j]));
    const bf16x8 uB = pack4z(uq);
    {
      f32x4 m0, n0, n1;
#pragma unroll
      for (int jj = 0; jj < 4; ++jj) {
        const int i = fq * 4 + jj;
        const float gm = Gf[i * 33 + 16 + fr];
        m0[jj] = i <= fr ? gm : 0.f;
        const int i0 = fq * 8 + jj, i1 = fq * 8 + 4 + jj;
        const float g0 = Gf[(16 + (i0 & 15)) * 33 + 16 + fr], g1 = Gf[(16 + (i1 & 15)) * 33 + 16 + fr];
        n0[jj] = (fq < 2 && i0 <= fr) ? g0 : 0.f;
        n1[jj] = (fq < 2 && i1 <= fr) ? g1 : 0.f;
      }
      XR = MFMA16(pack4z(m0), uB, XR);
      XR = MFMA16(pack8(n0, n1), vB, XR);
#pragma unroll
      for (int r = 0; r < 4; ++r) obuf[(fq * 4 + r) * 64 + 16 * w + fr] = XR[r];
    }
#pragma unroll
    for (int kt = 0; kt < 4; ++kt) {
      const bf16_t* bk = BKt + (kt * 16 + fr) * 40;
      const s16x4 lo = *(const s16x4*)(bk + fq * 4);
      const s16x4 z4 = {0, 0, 0, 0};
      ST[kt] = MFMA16(__builtin_shufflevector(lo, z4, 0, 1, 2, 3, 4, 5, 6, 7), uB, ST[kt]);
      const bf16x8 a5 = fq < 2 ? *(const bf16x8*)(bk + 16 + fq * 8) : zero8;
      ST[kt] = MFMA16(a5, vB, ST[kt]);
      ST[kt] *= *(const f32x4*)(WL + kt * 16 + fq * 4);
    }
    __syncthreads();
    if (ch >= 16 || need_ctx) {
      int rowbase, t, L;
      chunk_tok(ch, pj, rowbase, t, L);
      const f32x4 ov = *(const f32x4*)(obuf + pj * 64 + pcg * 4);
      st4bf(p.Os + ((size_t)dir * NTOK + rowbase + t) * 512 + hd * 64 + pcg * 4, ov);
    }
  }
  __syncthreads();
}

DI void scan_block3(const Params& p, int lyr, int sidx, bool need_ctx, char* lds) {
  const int dir = sidx & 1, hd = (sidx >> 1) & 7, b = sidx >> 4;
  const int tid = tid_(), lane = tid & 63, w = tid >> 6;
  const int fr = lane & 15, fq = lane >> 4;
  float* rec = (float*)lds;
  float* obuf = rec + 16 * 192;
  float* cst = obuf + 16 * 64;
  bf16_t* Aw = (bf16_t*)(cst + 14 * 64);
  bf16_t* Aa = Aw + 16 * 72;
  float* Gf = (float*)(Aa + 16 * 72);
  float* GNt = Gf + 32 * 33;
  float* Yf = GNt + 256;
  bf16_t* OPS = (bf16_t*)(Yf + 4 * 16 * 20);
  constexpr int OPS_STRIDE = 32 * 72 + 32 * 72 + 64 * 40 + 64 * 24 + 128;
  __syncthreads();
  for (int i = tid; i < 320; i += NTHREADS) {
    const int g = i >> 6, c = i & 63;
    const int colidx = (g < 3 ? g * 512 + hd * 64 : (g == 3 ? 1536 + dir * 64 : 1664 + dir * 64)) + c;
    cst[i] = p.mu[(size_t)lyr * 3840 + colidx];
    cst[320 + i] = p.mu[(size_t)lyr * 3840 + 1920 + colidx];
  }
  if (tid < 64) {
    cst[640 + tid] = p.w0[(lyr * 2 + dir) * 512 + hd * 64 + tid];
    cst[704 + tid] = p.a0[(lyr * 2 + dir) * 512 + hd * 64 + tid];
    cst[768 + tid] = p.k_k[lyr * 512 + hd * 64 + tid];
    cst[832 + tid] = p.k_a[lyr * 512 + hd * 64 + tid];
  }
  bf16x8 bw[2], ba[2];
  {
    const float* w2p = p.w2 + (size_t)(lyr * 2 + dir) * 64 * 512 + hd * 64 + 16 * w + fr;
    const float* a2p = p.a2 + (size_t)(lyr * 2 + dir) * 64 * 512 + hd * 64 + 16 * w + fr;
#pragma unroll
    for (int ks = 0; ks < 2; ++ks) {
      f32x4 x0, x1, y0, y1;
#pragma unroll
      for (int j = 0; j < 4; ++j) {
        x0[j] = w2p[(size_t)(ks * 32 + fq * 8 + j) * 512]; x1[j] = w2p[(size_t)(ks * 32 + fq * 8 + 4 + j) * 512];
        y0[j] = a2p[(size_t)(ks * 32 + fq * 8 + j) * 512]; y1[j] = a2p[(size_t)(ks * 32 + fq * 8 + 4 + j) * 512];
      }
      bw[ks] = pack8(x0, x1);
      ba[ks] = pack8(y0, y1);
    }
  }
  f32x4 ST[4];
#pragma unroll
  for (int kt = 0; kt < 4; ++kt) ST[kt] = (f32x4){0.f, 0.f, 0.f, 0.f};
  const int pj = tid >> 4, pcg = tid & 15;
  int goff[5] = {hd * 64, 512 + hd * 64, 1024 + hd * 64, 1536 + dir * 64, 1664 + dir * 64};
  u32x2 raw[5][3];
  auto chunk_tok = [&](int ch, int j, int& rowbase, int& t, int& L) {
    int n0;
    if (ch < 16) { L = TC; n0 = ch * 16; rowbase = NTL + b * TC; } else { L = TL; n0 = (ch - 16) * 16; rowbase = b * TL; }
    const int n = n0 + j;
    t = dir ? L - 1 - n : n;
  };
  auto prefetch = [&](int ch) {
    int rowbase, t, L;
    chunk_tok(ch, pj, rowbase, t, L);
    const bf16_t* q = p.P + (size_t)(rowbase + t) * DPROJ + 768 + pcg * 4;
    const bool hp = t > 0, hn = t < L - 1;
    const int om = hp ? -DPROJ : 0, on = hn ? DPROJ : 0;
#pragma unroll
    for (int g = 0; g < 5; ++g) {
      raw[g][1] = *(const u32x2*)(q + goff[g]);
      const u32x2 rm = *(const u32x2*)(q + goff[g] + om), rn = *(const u32x2*)(q + goff[g] + on);
      raw[g][0] = hp ? rm : (u32x2){0u, 0u};
      raw[g][2] = hn ? rn : (u32x2){0u, 0u};
    }
  };
  const bf16x8 zero8 = {0, 0, 0, 0, 0, 0, 0, 0};
  prefetch(0);
  __syncthreads();
    {
      bf16_t* ARt = OPS + (0) * OPS_STRIDE; bf16_t* BKm = ARt + 32 * 72; bf16_t* BKt = BKm + 32 * 72; bf16_t* Vt = BKt + 64 * 40; float* WL = (float*)(Vt + 64 * 24);
      (void)ARt; (void)BKm; (void)BKt; (void)Vt; (void)WL;
    {
      f32x4 xs[5];
#pragma unroll
      for (int g = 0; g < 5; ++g) {
        const f32x4 x = {bflo(raw[g][1].x), bfhi(raw[g][1].x), bflo(raw[g][1].y), bfhi(raw[g][1].y)};
        const f32x4 xm = {bflo(raw[g][0].x), bfhi(raw[g][0].x), bflo(raw[g][0].y), bfhi(raw[g][0].y)};
        const f32x4 xp = {bflo(raw[g][2].x), bfhi(raw[g][2].x), bflo(raw[g][2].y), bfhi(raw[g][2].y)};
        const f32x4 m0 = *(const f32x4*)(cst + g * 64 + pcg * 4), m1 = *(const f32x4*)(cst + 320 + g * 64 + pcg * 4);
        xs[g] = x + m0 * (xm - x) + m1 * (xp - x);
      }
      float* rj = rec + pj * 192;
      *(f32x4*)(rj + 128 + pcg * 4) = xs[0];
#pragma unroll
      for (int e = 0; e < 4; ++e) Vt[(pcg * 4 + e) * 24 + pj] = f2bf(xs[2][e]);
      const f32x4 kx = xs[1] * *(const f32x4*)(cst + 768 + pcg * 4);
      float ss = (kx[0] * kx[0] + kx[1] * kx[1]) + (kx[2] * kx[2] + kx[3] * kx[3]);
      ss = red8(ss); ss += dpp_f<0x140>(ss);
      const float rn = rsqrtf(ss + 1e-12f);
      *(f32x4*)(rj + 0 + pcg * 4) = kx * rn;
      *(f32x4*)(rj + 64 + pcg * 4) = xs[1];
      f32x4 tw;
#pragma unroll
      for (int j = 0; j < 4; ++j) tw[j] = 1.f - 2.f * __builtin_amdgcn_rcpf(1.f + __expf(2.f * xs[3][j]));
      st4bf(Aw + pj * 72 + pcg * 4, tw);
      st4bf(Aa + pj * 72 + pcg * 4, xs[4]);
    }
    }
  prefetch(1);
  __syncthreads();
    {
      bf16_t* ARt = OPS + (0) * OPS_STRIDE; bf16_t* BKm = ARt + 32 * 72; bf16_t* BKt = BKm + 32 * 72; bf16_t* Vt = BKt + 64 * 40; float* WL = (float*)(Vt + 64 * 24);
      (void)ARt; (void)BKm; (void)BKt; (void)Vt; (void)WL;
    {
      f32x4 aw = {0.f, 0.f, 0.f, 0.f}, aa = {0.f, 0.f, 0.f, 0.f};
#pragma unroll
      for (int ks = 0; ks < 2; ++ks) {
        const bf16x8 fw = *(const bf16x8*)(Aw + fr * 72 + ks * 32 + fq * 8);
        const bf16x8 fa = *(const bf16x8*)(Aa + fr * 72 + ks * 32 + fq * 8);
        aw = MFMA16(bw[ks], fw, aw);
        aa = MFMA16(ba[ks], fa, aa);
      }
      const int c = 16 * w + fq * 4;
      const float* rj = rec + fr * 192;
      const f32x4 w0v = *(const f32x4*)(cst + 640 + c), a0v = *(const f32x4*)(cst + 704 + c), kav = *(const f32x4*)(cst + 832 + c);
      const f32x4 kkv = *(const f32x4*)(rj + 0 + c), kpv = *(const f32x4*)(rj + 64 + c), rpv = *(const f32x4*)(rj + 128 + c);
      f32x4 e, E, ic;
#pragma unroll
      for (int j = 0; j < 4; ++j) {
        const float z = -(w0v[j] + aw[j]);
        const float sp = fmaxf(z, 0.f) + __logf(1.f + __expf(-fabsf(z)));
        e[j] = __expf(-sp - 0.5f);
        ic[j] = sigmoidf_(a0v[j] + aa[j]);
      }
      E = e;
#pragma unroll
      for (int j = 0; j < 4; ++j) {
        E[j] += dpp_f<0x111>(E[j]);
        E[j] += dpp_f<0x112>(E[j]);
        E[j] += dpp_f<0x114>(E[j]);
        E[j] += dpp_f<0x118>(E[j]);
      }
      f32x4 at, rt, bt, kt_;
#pragma unroll
      for (int j = 0; j < 4; ++j) {
        const float wi = __expf(E[j]);
        at[j] = -kkv[j] * __expf(e[j] - E[j]);
        rt[j] = rpv[j] * __expf(-E[j]);
        bt[j] = kkv[j] * ic[j] * wi;
        kt_[j] = kpv[j] * (1.f + (ic[j] - 1.f) * kav[j]) * wi;
      }
      st4bf(ARt + fr * 72 + c, at);
      st4bf(ARt + (16 + fr) * 72 + c, rt);
      st4bf(BKm + fr * 72 + c, bt);
      st4bf(BKm + (16 + fr) * 72 + c, kt_);
#pragma unroll
      for (int j = 0; j < 4; ++j) { BKt[(c + j) * 40 + fr] = f2bf(bt[j]); BKt[(c + j) * 40 + 16 + fr] = f2bf(kt_[j]); }
      if (fr == 15) {
#pragma unroll
        for (int j = 0; j < 4; ++j) WL[c + j] = __expf(-E[j]);
      }
    }
    }
#pragma unroll 1
  for (int ch = 0; ch < 144; ++ch) {
    const int cb = ch & 1, nb = cb ^ 1;
    const bool more = ch + 1 < 144;
    f32x4 XA, XR;
    __syncthreads();
    if (more) {
    {
      bf16_t* ARt = OPS + (nb) * OPS_STRIDE; bf16_t* BKm = ARt + 32 * 72; bf16_t* BKt = BKm + 32 * 72; bf16_t* Vt = BKt + 64 * 40; float* WL = (float*)(Vt + 64 * 24);
      (void)ARt; (void)BKm; (void)BKt; (void)Vt; (void)WL;
    {
      f32x4 xs[5];
#pragma unroll
      for (int g = 0; g < 5; ++g) {
        const f32x4 x = {bflo(raw[g][1].x), bfhi(raw[g][1].x), bflo(raw[g][1].y), bfhi(raw[g][1].y)};
        const f32x4 xm = {bflo(raw[g][0].x), bfhi(raw[g][0].x), bflo(raw[g][0].y), bfhi(raw[g][0].y)};
        const f32x4 xp = {bflo(raw[g][2].x), bfhi(raw[g][2].x), bflo(raw[g][2].y), bfhi(raw[g][2].y)};
        const f32x4 m0 = *(const f32x4*)(cst + g * 64 + pcg * 4), m1 = *(const f32x4*)(cst + 320 + g * 64 + pcg * 4);
        xs[g] = x + m0 * (xm - x) + m1 * (xp - x);
      }
      float* rj = rec + pj * 192;
      *(f32x4*)(rj + 128 + pcg * 4) = xs[0];
#pragma unroll
      for (int e = 0; e < 4; ++e) Vt[(pcg * 4 + e) * 24 + pj] = f2bf(xs[2][e]);
      const f32x4 kx = xs[1] * *(const f32x4*)(cst + 768 + pcg * 4);
      float ss = (kx[0] * kx[0] + kx[1] * kx[1]) + (kx[2] * kx[2] + kx[3] * kx[3]);
      ss = red8(ss); ss += dpp_f<0x140>(ss);
      const float rn = rsqrtf(ss + 1e-12f);
      *(f32x4*)(rj + 0 + pcg * 4) = kx * rn;
      *(f32x4*)(rj + 64 + pcg * 4) = xs[1];
      f32x4 tw;
#pragma unroll
      for (int j = 0; j < 4; ++j) tw[j] = 1.f - 2.f * __builtin_amdgcn_rcpf(1.f + __expf(2.f * xs[3][j]));
      st4bf(Aw + pj * 72 + pcg * 4, tw);
      st4bf(Aa + pj * 72 + pcg * 4, xs[4]);
    }
    }
      if (ch + 2 < 144) prefetch(ch + 2);
    }
    {
      bf16_t* ARt = OPS + (cb) * OPS_STRIDE; bf16_t* BKm = ARt + 32 * 72; bf16_t* BKt = BKm + 32 * 72; bf16_t* Vt = BKt + 64 * 40; float* WL = (float*)(Vt + 64 * 24);
      (void)ARt; (void)BKm; (void)BKt; (void)Vt; (void)WL;
    {
      const int ct = w >> 1, tt = w & 1;
      f32x4 g = {0.f, 0.f, 0.f, 0.f};
#pragma unroll
      for (int ks = 0; ks < 2; ++ks) {
        const bf16x8 A = *(const bf16x8*)(BKm + (ct * 16 + fr) * 72 + ks * 32 + fq * 8);
        const bf16x8 B = *(const bf16x8*)(ARt + (tt * 16 + fr) * 72 + ks * 32 + fq * 8);
        g = MFMA16(A, B, g);
      }
#pragma unroll
      for (int r = 0; r < 4; ++r) Gf[(ct * 16 + fq * 4 + r) * 33 + tt * 16 + fr] = g[r];
      if (w == 0) {
#pragma unroll
        for (int r = 0; r < 4; ++r) GNt[(fq * 4 + r) * 16 + fr] = g[r];
      }
    }
    XA = (f32x4){0.f, 0.f, 0.f, 0.f}; XR = (f32x4){0.f, 0.f, 0.f, 0.f};
#pragma unroll
    for (int ks = 0; ks < 2; ++ks) {
      const bf16x8 Bs = pack8(ST[2 * ks], ST[2 * ks + 1]);
      {
        const bf16_t* ar = ARt + fr * 72 + fq * 4;
        const s16x4 lo = *(const s16x4*)(ar + (2 * ks) * 16), hi = *(const s16x4*)(ar + (2 * ks + 1) * 16);
        XA = MFMA16(__builtin_shufflevector(lo, hi, 0, 1, 2, 3, 4, 5, 6, 7), Bs, XA);
      }
      {
        const bf16_t* ar = ARt + (16 + fr) * 72 + fq * 4;
        const s16x4 lo = *(const s16x4*)(ar + (2 * ks) * 16), hi = *(const s16x4*)(ar + (2 * ks + 1) * 16);
        XR = MFMA16(__builtin_shufflevector(lo, hi, 0, 1, 2, 3, 4, 5, 6, 7), Bs, XR);
      }
    }
    }
    __syncthreads();
    if (more) {
    {
      bf16_t* ARt = OPS + (nb) * OPS_STRIDE; bf16_t* BKm = ARt + 32 * 72; bf16_t* BKt = BKm + 32 * 72; bf16_t* Vt = BKt + 64 * 40; float* WL = (float*)(Vt + 64 * 24);
      (void)ARt; (void)BKm; (void)BKt; (void)Vt; (void)WL;
    {
      f32x4 aw = {0.f, 0.f, 0.f, 0.f}, aa = {0.f, 0.f, 0.f, 0.f};
#pragma unroll
      for (int ks = 0; ks < 2; ++ks) {
        const bf16x8 fw = *(const bf16x8*)(Aw + fr * 72 + ks * 32 + fq * 8);
        const bf16x8 fa = *(const bf16x8*)(Aa + fr * 72 + ks * 32 + fq * 8);
        aw = MFMA16(bw[ks], fw, aw);
        aa = MFMA16(ba[ks], fa, aa);
      }
      const int c = 16 * w + fq * 4;
      const float* rj = rec + fr * 192;
      const f32x4 w0v = *(const f32x4*)(cst + 640 + c), a0v = *(const f32x4*)(cst + 704 + c), kav = *(const f32x4*)(cst + 832 + c);
      const f32x4 kkv = *(const f32x4*)(rj + 0 + c), kpv = *(const f32x4*)(rj + 64 + c), rpv = *(const f32x4*)(rj + 128 + c);
      f32x4 e, E, ic;
#pragma unroll
      for (int j = 0; j < 4; ++j) {
        const float z = -(w0v[j] + aw[j]);
        const float sp = fmaxf(z, 0.f) + __logf(1.f + __expf(-fabsf(z)));
        e[j] = __expf(-sp - 0.5f);
        ic[j] = sigmoidf_(a0v[j] + aa[j]);
      }
      E = e;
#pragma unroll
      for (int j = 0; j < 4; ++j) {
        E[j] += dpp_f<0x111>(E[j]);
        E[j] += dpp_f<0x112>(E[j]);
        E[j] += dpp_f<0x114>(E[j]);
        E[j] += dpp_f<0x118>(E[j]);
      }
      f32x4 at, rt, bt, kt_;
#pragma unroll
      for (int j = 0; j < 4; ++j) {
        const float wi = __expf(E[j]);
        at[j] = -kkv[j] * __expf(e[j] - E[j]);
        rt[j] = rpv[j] * __expf(-E[j]);
        bt[j] = kkv[j] * ic[j] * wi;
        kt_[j] = kpv[j] * (1.f + (ic[j] - 1.f) * kav[j]) * wi;
      }
      st4bf(ARt + fr * 72 + c, at);
      st4bf(ARt + (16 + fr) * 72 + c, rt);
      st4bf(BKm + fr * 72 + c, bt);
      st4bf(BKm + (16 + fr) * 72 + c, kt_);
#pragma unroll
      for (int j = 0; j < 4; ++j) { BKt[(c + j) * 40 + fr] = f2bf(bt[j]); BKt[(c + j) * 40 + 16 + fr] = f2bf(kt_[j]); }
      if (fr == 15) {
#pragma unroll
        for (int j = 0; j < 4; ++j) WL[c + j] = __expf(-E[j]);
      }
    }
    }
    }
    {
      bf16_t* ARt = OPS + (cb) * OPS_STRIDE; bf16_t* BKm = ARt + 32 * 72; bf16_t* BKt = BKm + 32 * 72; bf16_t* Vt = BKt + 64 * 40; float* WL = (float*)(Vt + 64 * 24);
      (void)ARt; (void)BKm; (void)BKt; (void)Vt; (void)WL;
    const bf16x8 vB = fq < 2 ? *(const bf16x8*)(Vt + (16 * w + fr) * 24 + fq * 8) : zero8;
    {
      f32x4 n0, n1;
#pragma unroll
      for (int jj = 0; jj < 4; ++jj) {
        const int i0 = fq * 8 + jj, i1 = fq * 8 + 4 + jj;
        const float g0 = Gf[(16 + (i0 & 15)) * 33 + fr], g1 = Gf[(16 + (i1 & 15)) * 33 + fr];
        n0[jj] = (fq < 2 && i0 < fr) ? g0 : 0.f;
        n1[jj] = (fq < 2 && i1 < fr) ? g1 : 0.f;
      }
      XA = MFMA16(pack8(n0, n1), vB, XA);
    }
    float* yw = Yf + (w * 16 + fr) * 20;
    *(f32x4*)(yw + fq * 4) = XA;
    float u[16];
    {
      const f32x4 y0 = *(const f32x4*)(yw), y1 = *(const f32x4*)(yw + 4), y2 = *(const f32x4*)(yw + 8), y3 = *(const f32x4*)(yw + 12);
#pragma unroll
      for (int j = 0; j < 4; ++j) { u[j] = y0[j]; u[4 + j] = y1[j]; u[8 + j] = y2[j]; u[12 + j] = y3[j]; }
#pragma unroll
      for (int i = 0; i < 15; ++i) {
#pragma unroll
        for (int t4 = (i + 1) / 4; t4 < 4; ++t4) {
          const f32x4 nn = *(const f32x4*)(GNt + i * 16 + t4 * 4);
#pragma unroll
          for (int e2 = 0; e2 < 4; ++e2) if (t4 * 4 + e2 > i) u[t4 * 4 + e2] += u[i] * nn[e2];
        }
      }
    }
    f32x4 uq;
#pragma unroll
    for (int j = 0; j < 4; ++j) uq[j] = fq == 0 ? u[j] : (fq == 1 ? u[4 + j] : (fq == 2 ? u[8 + j] : u[12 + j]));
    const bf16x8 uB = pack4z(uq);
    {
      f32x4 m0, n0, n1;
#pragma unroll
      for (int jj = 0; jj < 4; ++jj) {
        const int i = fq * 4 + jj;
        const float gm = Gf[i * 33 + 16 + fr];
        m0[jj] = i <= fr ? gm : 0.f;
        const int i0 = fq * 8 + jj, i1 = fq * 8 + 4 + jj;
        const float g0 = Gf[(16 + (i0 & 15)) * 33 + 16 + fr], g1 = Gf[(16 + (i1 & 15)) * 33 + 16 + fr];
        n0[jj] = (fq < 2 && i0 <= fr) ? g0 : 0.f;
        n1[jj] = (fq < 2 && i1 <= fr) ? g1 : 0.f;
      }
      XR = MFMA16(pack4z(m0), uB, XR);
      XR = MFMA16(pack8(n0, n1), vB, XR);
#pragma unroll
      for (int r = 0; r < 4; ++r) obuf[(fq * 4 + r) * 64 + 16 * w + fr] = XR[r];
    }
#pragma unroll
    for (int kt = 0; kt < 4; ++kt) {
      const bf16_t* bk = BKt + (kt * 16 + fr) * 40;
      const s16x4 lo = *(const s16x4*)(bk + fq * 4);
      const s16x4 z4 = {0, 0, 0, 0};
      ST[kt] = MFMA16(__builtin_shufflevector(lo, z4, 0, 1, 2, 3, 4, 5, 6, 7), uB, ST[kt]);
      const bf16x8 a5 = fq < 2 ? *(const bf16x8*)(bk + 16 + fq * 8) : zero8;
      ST[kt] = MFMA16(a5, vB, ST[kt]);
      ST[kt] *= *(const f32x4*)(WL + kt * 16 + fq * 4);
    }
    }
    __syncthreads();
    if (ch >= 16 || need_ctx) {
      int rowbase, t, L;
      chunk_tok(ch, pj, rowbase, t, L);
      const f32x4 ov = *(const f32x4*)(obuf + pj * 64 + pcg * 4);
      st4bf(p.Os + ((size_t)dir * NTOK + rowbase + t) * 512 + hd * 64 + pcg * 4, ov);
    }
  }
  __syncthreads();
}

DI void mixer_phase(const Params& p, int l, bool need_ctx, char* lds, long long* scan_t) {
  int& s_item = *(int*)(lds + LDS_WORK + 16);
  sg_phase(p, l);
  { long long t0 = 0; if (PROBE_MASK) t0 = wall_clock64();
    __builtin_amdgcn_s_setprio(3);
    for (int s = blockIdx.x; s < 256; s += gridDim.x) scan_block3(p, l, s, need_ctx, lds);
    __builtin_amdgcn_s_setprio(0);
#ifdef SCAN_ALONE
    if (blockIdx.x < 256) { __syncthreads(); if (tid_() == 0) { __threadfence(); atomicAdd(&p.counters[8 + l], 1u); } }
    else { if (tid_() == 0) { while (atomicAdd(&p.counters[8 + l], 0u) < 256u) __builtin_amdgcn_s_sleep(32); } __syncthreads(); }
#endif
    if ((PROBE_MASK >> 13) & 1) *scan_t += wall_clock64() - t0; }
  const int nitems = 4096 + (need_ctx ? 512 : 0);
  while (true) {
    __syncthreads();
    if (tid_() == 0) s_item = (int)atomicAdd(&p.counters[l], 1u);
    __syncthreads();
    const int it = s_item;
    if (it >= nitems) break;
    if (it < 2048) {
      const int b = it >> 7, head = (it >> 4) & 7, qb = it & 15, kvh = head >> 2;
      dense_item(p, b * TL + qb * 128, head * 64, b * TL, 32, NTL + b * TC, 512 + kvh * 64, 640 + kvh * 64, lds);
    } else if (it < 4096) {
      const int i2 = it - 2048;
      const int b = i2 >> 7, gr = (i2 >> 2) & 31, hp = i2 & 3;
      na_item(p, l, b, gr, hp, lds);
    } else if (it < 4352) {
      const int i2 = it - 4096;
      const int b = i2 >> 4, head = (i2 >> 1) & 7, qb = i2 & 1, kvh = head >> 2;
      dense_item(p, NTL + b * TC + qb * 128, head * 64, 0, 0, NTL + b * TC, 512 + kvh * 64, 640 + kvh * 64, lds);
    } else {
      const int i2 = it - 4352;
      const int b = i2 >> 4, head = (i2 >> 1) & 7, qb = i2 & 1;
      dense_item(p, NTL + b * TC + qb * 128, 2688 + head * 64, 0, 0, NTL + b * TC, 3200 + head * 64, 3712 + head * 64, lds);
    }
  }
}

template <int MI>
DI void merge_phaseT(const Params& p, int l, int M, char* lds) {
  const int ntm = M / (MI * 32), ntn = 8;
  const int lane = tid_() & 63, wid = tid_() >> 6, wr = wid >> 1, wc = wid & 1, fr = lane & 15, fq = lane >> 4;
  const bf16_t* wm = p.WM + (size_t)l * WM_STRIDE;
  int tm, tn;
  for (int it = 0; xcd_tile<2, 8>(it, ntm, ntn, tm, tn); ++it) {
    const size_t grow = (size_t)tm * (MI * 32);
#pragma unroll 1
    for (int z = 0; z < 3; ++z) {
      f32x4 acc[MI][4];
#pragma unroll
      for (int mi = 0; mi < MI; ++mi)
#pragma unroll
        for (int ni = 0; ni < 4; ++ni) acc[mi][ni] = (f32x4){0.f, 0.f, 0.f, 0.f};
      gemm_mainloopT<MI>(p.U + grow * DM, DM, wm + WM_IN + (size_t)(DPROJ + z * DM + tn * 128) * DM, DM, acc, lds);
      {
      bf16_t* prow;
      { const int t2 = tid_(), l2 = t2 & 63, w2 = t2 >> 6; prow = p.P + (grow + (w2 >> 1) * (MI * 16) + (l2 & 15)) * DPROJ + tn * 128 + (w2 & 1) * 64 + (l2 >> 4) * 4; }
#pragma unroll
      for (int mi = 0; mi < MI; ++mi) {
#pragma unroll
        for (int ni = 0; ni < 4; ++ni) {
          f32x4 g;
#pragma unroll
          for (int j = 0; j < 4; ++j) g[j] = sigmoidf_(acc[mi][ni][j]);
          st4bf(prow + (size_t)(mi * 16) * DPROJ + 512 + ni * 16, g);
          acc[mi][ni] = (f32x4){0.f, 0.f, 0.f, 0.f};
        }
        asm volatile("" ::: "memory");
      }
      }
      const bf16_t* Ya = z == 1 ? p.yr : (z == 0 ? p.P : p.P + 2688);
      const int lda = z == 1 ? 512 : DPROJ;
      gemm_mainloopT<MI>(Ya + grow * lda, lda, wm + WM_BR + (size_t)z * 1024 * 512 + (size_t)tn * 128 * 512, 512, acc, lds);
      {
      bf16_t* prow;
      { const int t2 = tid_(), l2 = t2 & 63, w2 = t2 >> 6; prow = p.P + (grow + (w2 >> 1) * (MI * 16) + (l2 & 15)) * DPROJ + tn * 128 + (w2 & 1) * 64 + (l2 >> 4) * 4; }
#pragma unroll
      for (int mi = 0; mi < MI; ++mi) {
#pragma unroll
        for (int ni = 0; ni < 4; ++ni) {
          bf16_t* q = prow + (size_t)(mi * 16) * DPROJ + ni * 16;
          f32x4 mn = ld4bf(q + 512) * acc[mi][ni];
          if (z > 0) mn += ld4bf(q + 3200);
          st4bf(q + 3200, mn);
        }
        asm volatile("" ::: "memory");
      }
      }
    }
  }
}

DI void merge_phase(const Params& p, int l, int row0, int M, char* lds) {
  const int ntm = M >> 7, ntn = 8;
  const int lane = tid_() & 63, wid = tid_() >> 6, wr = wid >> 1, wc = wid & 1, fr = lane & 15, fq = lane >> 4;
  const bf16_t* wm = p.WM + (size_t)l * WM_STRIDE;
  int tm, tn;
  for (int it = 0; xcd_tile<2, 8>(it, ntm, ntn, tm, tn); ++it) {
    const size_t grow = (size_t)row0 + tm * 128;
#pragma unroll 1
    for (int z = 0; z < 3; ++z) {
      u32x2 gp[4][4];
      {
        f32x4 acc[4][4];
        zero_acc(acc);
        gemm_mainloop2(p.U + grow * DM, DM, wm + WM_IN + (size_t)(DPROJ + z * DM + tn * 128) * DM, DM, acc, lds);
#pragma unroll
        for (int mi = 0; mi < 4; ++mi)
#pragma unroll
          for (int ni = 0; ni < 4; ++ni) {
            gp[mi][ni].x = pk2(sigmoidf_(acc[mi][ni][0]), sigmoidf_(acc[mi][ni][1]));
            gp[mi][ni].y = pk2(sigmoidf_(acc[mi][ni][2]), sigmoidf_(acc[mi][ni][3]));
          }
      }
      {
        f32x4 acc[4][4];
        zero_acc(acc);
        const bf16_t* Ya = z == 1 ? p.yr : (z == 0 ? p.P : p.P + 2688);
        const int lda = z == 1 ? 512 : DPROJ;
        gemm_mainloop2(Ya + grow * lda, lda, wm + WM_BR + (size_t)z * 1024 * 512 + (size_t)tn * 128 * 512, 512, acc, lds);
#pragma unroll
        for (int mi = 0; mi < 4; ++mi)
#pragma unroll
          for (int ni = 0; ni < 4; ++ni) asm volatile("" : "+v"(gp[mi][ni].x), "+v"(gp[mi][ni].y));
#pragma unroll
        for (int mi = 0; mi < 4; ++mi) {
          const int row = tm * 128 + wr * 64 + mi * 16 + fr;
#pragma unroll
          for (int ni = 0; ni < 4; ++ni) {
            bf16_t* mp = p.P + (grow + wr * 64 + mi * 16 + fr) * DPROJ + 3200 + tn * 128 + wc * 64 + ni * 16 + fq * 4;
            const f32x4 g = {bflo(gp[mi][ni].x), bfhi(gp[mi][ni].x), bflo(gp[mi][ni].y), bfhi(gp[mi][ni].y)};
            f32x4 mn = g * acc[mi][ni];
            if (z > 0) mn += ld4bf(mp);
            st4bf(mp, mn);
          }
        }
      }
    }
  }
}

#define MAKE_LN_EPI(MI_, e, WHICH, SRC_LAT, SRC_CTX)                                                                    \
  EpiResidLN<MI_> e;                                                                                                        \
  {                                                                                                                    \
    const float* mods_l_ = p.mods + (size_t)l * 17 * NMOD;                                                             \
    e.src_lat = (SRC_LAT); e.src_ctx = (SRC_CTX); e.dst_lat = p.out; e.dst_ctx = p.ctxx;                               \
    e.gate = mods_l_ + ((WHICH) * 3 + 2) * DM;                                                                         \
    e.gmul = (WHICH) == 1 ? 1.f : 0.5f;                                                                                \
    e.lng = p.ln_g + (l * 3 + (WHICH)) * DM; e.lnb = p.ln_b + (l * 3 + (WHICH)) * DM;                                  \
    e.mods_next = (WHICH) < 2 ? mods_l_ : p.mods + (size_t)(l == 0 ? 1 : 0) * 17 * NMOD;                               \
    e.shift_idx = (WHICH) < 2 ? (WHICH) * 3 + 3 : 0;                                                                   \
    e.U = ((WHICH) < 2 || l == 0) ? p.U : nullptr;                                                                     \
    e.stats = p.stats; e.cnt = p.lncnt + (l * 3 + (WHICH)) * 288;                                                      \
  }

template <int S>
DI void layer_step(const Params& p, int l, char* lds, long long* scan_t = nullptr) {
  const bool last = l == 1;
  const bool need_ctx = !last;
  const int Mall = NTOK, Mx = need_ctx ? NTOK : NTL;
  const bf16_t* wm = p.WM + (size_t)l * WM_STRIDE;
  if constexpr (S == 0) {
    EpiAct<8> e; e.H = p.H;
    gemm_phaseT<8, 8, 4>(p.U, DM, Mall, 0, p.WF, DM, 2 * DFF, e, lds);
  } else if constexpr (S == 1) {
    MAKE_LN_EPI(6, e, 0, l == 0 ? p.x_in : p.out, l == 0 ? p.ctx_in : p.ctxx)
    gemm_phaseT<6, 2, 8, true>(p.H, DFF, Mall, 0, p.WF + WF_WO, DFF, DM, e, lds);
  } else if constexpr (S == 3) {
    EpiProj<8> e; e.p = &p; e.l = l;
    gemm_phaseT<8, 8, 3>(p.U, DM, Mall, 0, wm + WM_IN, DM, DPROJ, e, lds);
  } else if constexpr (S == 4) {
    mixer_phase(p, l, need_ctx, lds, scan_t);
  } else if constexpr (S == 5) {
    EpiReadout e; e.p = &p; e.l = l;
    gemm_phase(p.sg, 128, Mx, p.g2 + (size_t)l * 128 * 512, 512, 128, 512, MapHeadPerm(), e, lds);
  } else if constexpr (S == 9) {
    EpiAct<8> e; e.H = p.H;
    gemm_phaseT<8, 8, 4>(p.U, DM, Mx, 0, p.WF + WF_SLOT, DM, 2 * DFF, e, lds);
  } else if constexpr (S == 10) {
    if (need_ctx) {
      MAKE_LN_EPI(6, e, 2, p.out, p.ctxx)
      gemm_phaseT<6, 2, 8, true>(p.H, DFF, NTOK, 0, p.WF + WF_SLOT + WF_WO, DFF, DM, e, lds);
    } else {
      MAKE_LN_EPI(8, e, 2, p.out, p.ctxx)
      gemm_phaseT<8, 2, 8, true>(p.H, DFF, NTL, 0, p.WF + WF_SLOT + WF_WO, DFF, DM, e, lds);
    }
    if (!last) convert_ffn(p, 0, p.ffn1_wi + (size_t)(l + 1) * DM * 2 * DFF, p.ffn1_wo + (size_t)(l + 1) * DFF * DM, lds);
  }
}

template <int S>
DI void merge_step(const Params& p, int l, char* lds) {
  const int Mx = l == 0 ? NTOK : NTL;
  const bf16_t* wm = p.WM + (size_t)l * WM_STRIDE;
  if constexpr (S == 0) {
    if (l == 0) merge_phase(p, l, 0, NTOK, lds); else merge_phaseT<8>(p, l, NTL, lds);
  } else {
    if (l == 0) {
      MAKE_LN_EPI(6, e, 1, p.out, p.ctxx)
      gemm_phaseT<6, 2, 8>(p.P + 3200, DPROJ, NTOK, 0, wm + WM_OUT, DM, DM, e, lds);
    } else {
      MAKE_LN_EPI(8, e, 1, p.out, p.ctxx)
      gemm_phaseT<8, 2, 8>(p.P + 3200, DPROJ, NTL, 0, wm + WM_OUT, DM, DM, e, lds);
    }
    convert_ffn(p, 1, p.ffn2_wi + (size_t)l * DM * 2 * DFF, p.ffn2_wo + (size_t)l * DFF * DM, lds);
  }
}

#define XB_TMO      128
#define XB_XCNT(j)  (256  + 64 * (j))
#define XB_XSUB(j)  (1280 + 64 * (j))
#define XB_XGEN(j)  (2304 + 64 * (j))
#define XB_TOP      3328
#define XB_TOPGEN   3392
#define XCD_BAR_WORDS 3456
#define XB_SPIN_CAP (1u << 18)
DI unsigned xb_ld(unsigned* p) { return __hip_atomic_load(p, __ATOMIC_RELAXED, __HIP_MEMORY_SCOPE_AGENT); }
DI unsigned xb_add(unsigned* p, unsigned v) { return __hip_atomic_fetch_add(p, v, __ATOMIC_RELAXED, __HIP_MEMORY_SCOPE_AGENT); }
DI unsigned xb_xcc_id() { return (unsigned)__builtin_amdgcn_s_getreg((3 << 11) | 20) & 0xFu; }
#define XB_SPIN(cond, bar) do { unsigned _sp = 0; while (cond) { __builtin_amdgcn_s_sleep(1); \
    if ((++_sp & 255u) == 0u) { if (xb_ld(&(bar)[XB_TMO])) break; if (_sp > XB_SPIN_CAP) { atomicAdd(&(bar)[XB_TMO], 1u); break; } } } } while (0)
struct XcdBarrier { unsigned* bar; unsigned x; volatile LAS unsigned* st; };
DI XcdBarrier xcd_barrier_post(unsigned* bar, volatile LAS unsigned* st) {
  XcdBarrier b; b.bar = bar; b.x = xb_xcc_id(); b.st = st;
  if (threadIdx.x == 0) (void)xb_add(&bar[XB_XCNT(b.x)], 1u);
  return b;
}
DI void xcd_barrier_complete(unsigned* bar, unsigned x, unsigned& nloc, unsigned& nx) {
  const unsigned G = gridDim.x * gridDim.y * gridDim.z;
  unsigned sum, cnt, mine, sp = 0u;
  for (;;) {
    sum = 0u; cnt = 0u; mine = 0u;
#pragma unroll
    for (unsigned j = 0; j < 16; ++j) { const unsigned c = xb_ld(&bar[XB_XCNT(j)]); sum += c; cnt += (c > 0u) ? 1u : 0u; mine = (j == x) ? c : mine; }
    if (sum == G) break;
    __builtin_amdgcn_s_sleep(1);
    if ((++sp & 255u) == 0u) { if (xb_ld(&bar[XB_TMO])) break; if (sp > XB_SPIN_CAP) { atomicAdd(&bar[XB_TMO], 1u); break; } }
  }
  nloc = mine > 0u ? mine : 1u; nx = cnt > 0u ? cnt : 1u;
}
DI void xcd_barrier(const XcdBarrier& b) {
  asm volatile("s_waitcnt vmcnt(0)" ::: "memory");
  __syncthreads();
  if (threadIdx.x == 0) {
    unsigned* bar = b.bar;
    __builtin_amdgcn_s_waitcnt(0);
    unsigned nloc = b.st[0], nx = b.st[1];
    if (nloc == 0u) { xcd_barrier_complete(bar, b.x, nloc, nx); b.st[0] = nloc; b.st[1] = nx; }
    const unsigned old = xb_add(&bar[XB_XSUB(b.x)], 1u);
    const unsigned gen = old / nloc;
    if (old + 1u == (gen + 1u) * nloc) {
      __builtin_amdgcn_fence(__ATOMIC_RELEASE, "agent");
      asm volatile("s_waitcnt vmcnt(0)" ::: "memory");
      const unsigned og = xb_add(&bar[XB_TOP], 1u);
      const unsigned tg = og / nx;
      if (og + 1u == (tg + 1u) * nx) xb_add(&bar[XB_TOPGEN], 1u);
      else XB_SPIN(xb_ld(&bar[XB_TOPGEN]) == tg, bar);
      __builtin_amdgcn_fence(__ATOMIC_ACQUIRE, "agent");
      xb_add(&bar[XB_XGEN(b.x)], 1u);
      asm volatile("s_waitcnt vmcnt(0)" ::: "memory");
    } else {
      XB_SPIN(xb_ld(&bar[XB_XGEN(b.x)]) == gen, bar);
      __builtin_amdgcn_fence(__ATOMIC_ACQUIRE, "agent");
      asm volatile("s_waitcnt vmcnt(0)" ::: "memory");
    }
  }
  __syncthreads();
}

#define TIMED(id, ...) { long long _t0 = 0; if (PROBE_MASK) _t0 = wall_clock64(); __VA_ARGS__; if ((PROBE_MASK >> (id)) & 1) probe_t += wall_clock64() - _t0; }
__global__ void __launch_bounds__(NTHREADS, 2) fwd_megakernel(Params p) {
  __shared__ __attribute__((aligned(16))) char lds[LDS_BYTES];
  cg::grid_group grid = cg::this_grid();
  long long probe_t = 0;
  if (threadIdx.x == 0) *(u32x4*)(lds + LDS_WORK) = (u32x4){0u, 0u, 0u, 0u};
  __syncthreads();
  (void)xcd_barrier_post(p.bar, (volatile LAS unsigned*)(LAS char*)(lds + LDS_WORK));
#define GSYNC() do { XcdBarrier xb_; xb_.bar = p.bar; xb_.x = xb_xcc_id(); xb_.st = (volatile LAS unsigned*)(LAS char*)(lds + LDS_WORK); xcd_barrier(xb_); } while (0)
  TIMED(0, mods_phase(p, lds);
  convert_ffn(p, 0, p.ffn1_wi, p.ffn1_wo, lds);
  convert_mixer(p, 0, lds);
  convert_mixer(p, 1, lds);
  if (p.bar == nullptr) grid.sync();
  GSYNC();
  u0_phase(p);
  GSYNC();)
#pragma unroll 1
  for (int l = 0; l < 2; ++l) {
    TIMED(1, layer_step<0>(p, l, lds); GSYNC();)
    TIMED(2, layer_step<1>(p, l, lds); GSYNC();)
    TIMED(4, layer_step<3>(p, l, lds); GSYNC();)
    TIMED(5, layer_step<4>(p, l, lds, &probe_t); GSYNC();)
    TIMED(6, layer_step<5>(p, l, lds); GSYNC();)
    TIMED(7, merge_step<0>(p, l, lds); GSYNC();)
    TIMED(8, merge_step<1>(p, l, lds); GSYNC();)
    TIMED(10, layer_step<9>(p, l, lds); GSYNC();)
    TIMED(11, layer_step<10>(p, l, lds);
    if (l == 0) GSYNC();)
  }
  if (PROBE_MASK) {
    if (blockIdx.x == 0 && threadIdx.x == 0) {
      const long long t1 = wall_clock64();
      while (wall_clock64() - t1 < probe_t) __builtin_amdgcn_s_sleep(8);
    }
  }
}

extern "C" void kernel_launch(void* const* d_in, const int* in_sizes, int n_in, void* d_out, int out_size, void* d_ws, size_t ws_size,
                              hipStream_t stream) {
  static int grid_blocks = 0;
  if (!grid_blocks) {
    int dev = 0, cus = 0, per_cu = 0;
    hipGetDevice(&dev);
    hipDeviceGetAttribute(&cus, hipDeviceAttributeMultiprocessorCount, dev);
    hipOccupancyMaxActiveBlocksPerMultiprocessor(&per_cu, fwd_megakernel, NTHREADS, 0);
    if (per_cu < 1) per_cu = 1;
    grid_blocks = cus * per_cu;
  }
  Params p{};
  const float* const* in = (const float* const*)d_in;
  p.x_in = in[0]; p.c = in[1]; p.ctx_in = in[2]; p.c_ctx = in[3]; p.w_ada = in[4]; p.b_ada = in[5];
  p.ffn1_wi = in[6]; p.ffn1_wo = in[7]; p.ffn2_wi = in[8]; p.ffn2_wo = in[9]; p.ln_g = in[10]; p.ln_b = in[11]; p.w_in = in[12];
  p.q_gain = in[13]; p.k_gain = in[14]; p.mu = in[15]; p.w0 = in[16]; p.w2 = in[17]; p.a0 = in[18]; p.a2 = in[19]; p.g2 = in[20];
  p.k_k = in[21]; p.k_a = in[22]; p.r_k = in[23]; p.gn_g = in[24]; p.gn_b = in[25]; p.rpb = in[26]; p.w_branch = in[27]; p.w_out = in[28];
  p.out = (float*)d_out;
  char* ws = (char*)d_ws;
  const size_t MiB = 1ull << 20;
  p.counters = (unsigned*)ws;
  p.rope = (float*)(ws + 4096);
  p.lncnt = (unsigned*)(ws + 16384);
  p.bar = (unsigned*)(ws + 24576);
  hipMemsetAsync(ws + 24576, 0, XCD_BAR_WORDS * sizeof(unsigned), stream);
  p.stats = (float*)(ws + 507 * MiB);
  p.mods = (float*)(ws + 65536);
  p.ctxx = (float*)(ws + 2 * MiB);
  p.U = (bf16_t*)(ws + 18 * MiB);
  p.H = (bf16_t*)(ws + 90 * MiB);
  p.P = (bf16_t*)(ws + 90 * MiB);
  p.Os = (bf16_t*)(ws + 387 * MiB);
  p.yr = (bf16_t*)(ws + 387 * MiB);
  p.Mg = (bf16_t*)(ws + 423 * MiB);
  p.sg = (bf16_t*)(ws + 459 * MiB);
  p.WM = (bf16_t*)(ws + 468 * MiB);
  p.WF = (bf16_t*)(ws + 423 * MiB);
  if (ws_size < 512 * MiB) fprintf(stderr, "workspace too small: %zu\n", ws_size);
  void* args[] = {&p};
  hipError_t e = hipLaunchCooperativeKernel((void*)fwd_megakernel, dim3(grid_blocks), dim3(NTHREADS), args, 0, stream);
  if (e != hipSuccess) fprintf(stderr, "cooperative launch failed: %s (grid %d)\n", hipGetErrorString(e), grid_blocks);
}
```

```cpp
#include <hip/hip_runtime.h>
#include <hip/hip_cooperative_groups.h>
#include <cstdio>
#include <cstdint>
namespace cg = cooperative_groups;
#ifndef PROBE_MASK
#define PROBE_MASK 0
#endif

#define DI __device__ __forceinline__
typedef unsigned short bf16_t;
typedef short bf16x8 __attribute__((ext_vector_type(8)));
typedef short s16x4 __attribute__((ext_vector_type(4)));
typedef float f32x2 __attribute__((ext_vector_type(2)));
typedef float f32x4 __attribute__((ext_vector_type(4)));
typedef float f32x16 __attribute__((ext_vector_type(16)));
typedef unsigned u32x2 __attribute__((ext_vector_type(2)));
typedef unsigned u32x4 __attribute__((ext_vector_type(4)));
typedef __bf16 nbf16x2 __attribute__((ext_vector_type(2)));

constexpr int DM = 1024, NB = 16, TL = 2048, TC = 256;
constexpr int NTL = NB * TL, NTC = NB * TC, NTOK = NTL + NTC;
constexpr int DFF = 2816, DIN = 7296, DPROJ = 4224;
constexpr int LDH = 2880;
constexpr int NMOD = 9 * DM;
constexpr float LOG2E = 1.4426950408889634f;
constexpr float QSCALE = 0.125f * LOG2E;
constexpr float ALPHA = 1.4142135623730951f;
constexpr int LDS_WORK = 73728;
constexpr int LDS_BYTES = LDS_WORK + 64;
constexpr size_t WM_IN = 0, WM_BR = (size_t)7296 * 1024, WM_OUT = WM_BR + 3 * 1024 * 512, WM_STRIDE = WM_OUT + 1024 * 1024;
constexpr size_t WF_WO = (size_t)2 * 2816 * 1024, WF_SLOT = (size_t)17 * 1024 * 1024 / 2;
constexpr int NTHREADS = 256;

struct Params {
  const float *x_in, *c, *ctx_in, *c_ctx, *w_ada, *b_ada, *ffn1_wi, *ffn1_wo, *ffn2_wi, *ffn2_wo, *ln_g, *ln_b, *w_in,
      *q_gain, *k_gain, *mu, *w0, *w2, *a0, *a2, *g2, *k_k, *k_a, *r_k, *gn_g, *gn_b, *rpb, *w_branch, *w_out;
  float* out;
  float* mods;
  float* rope;
  float* ctxx;
  unsigned* counters;
  bf16_t *U, *H, *P, *Os, *yr, *Mg, *sg, *WF, *WM;
  float* stats;
  unsigned* lncnt;
  unsigned* bar;
};

DI int tid_() { int t = threadIdx.x; asm volatile("" : "+v"(t)); return t; }
DI unsigned pk2(float a, float b) { f32x2 v = {a, b}; nbf16x2 r = __builtin_convertvector(v, nbf16x2); return __builtin_bit_cast(unsigned, r); }
DI bf16_t f2bf(float a) { return (bf16_t)(pk2(a, 0.f) & 0xffffu); }
DI float bflo(unsigned u) { return __uint_as_float(u << 16); }
DI float bfhi(unsigned u) { return __uint_as_float(u & 0xffff0000u); }
DI f32x4 ld4bf(const bf16_t* p) { u32x2 v = *(const u32x2*)p; return (f32x4){bflo(v.x), bfhi(v.x), bflo(v.y), bfhi(v.y)}; }
DI void st4bf(bf16_t* p, f32x4 v) { u32x2 o; o.x = pk2(v[0], v[1]); o.y = pk2(v[2], v[3]); *(u32x2*)p = o; }
DI float sigmoidf_(float x) { return __builtin_amdgcn_rcpf(1.f + __expf(-x)); }
DI float siluf_(float x) { return x * __builtin_amdgcn_rcpf(1.f + __expf(-x)); }
DI int mod_row(int row) { return row < NTL ? (row >> 11) : 16; }

constexpr int LDT = 72;

struct MapPlain { DI int operator()(int tn, int cl) const { return tn * 128 + cl; } };
struct MapHeadPerm { DI int operator()(int tn, int cl) const { return tn * 128 + (cl & 64) + ((cl >> 2) & 3) * 16 + ((cl >> 4) & 3) * 4; } };
struct MapGateUp { DI int operator()(int tn, int cl) const { int sub = cl >> 4, j = cl & 15; return ((sub & 1) ? DFF : 0) + tn * 64 + (sub >> 1) * 16 + j; } };

template <class BMap>
DI void gemm_mainloop(const bf16_t* __restrict__ A, int lda, const float* __restrict__ B, int ldb, int K, int tn, BMap bmap,
                      f32x4 (&acc)[4][4], char* lds) {
  bf16_t* As = (bf16_t*)lds;
  bf16_t* Bs = As + 128 * LDT;
  const int tid = tid_(), lane = tid & 63, wid = tid >> 6, wr = wid >> 1, wc = wid & 1;
  const int fr = lane & 15, fq = lane >> 4;
  const int arow = tid >> 3, akc = tid & 7;
  const int kg = tid >> 5, ng = tid & 31;
  const bf16_t* ap = A + (size_t)arow * lda + akc * 8;
  const float* bp = B + (size_t)(kg * 8) * ldb + bmap(tn, ng * 4);
  u32x4 ra[4];
  f32x4 rb[8];
  const int nk = K >> 6;
#pragma unroll
  for (int i = 0; i < 4; ++i) ra[i] = *(const u32x4*)(ap + (size_t)(i * 32) * lda);
#pragma unroll
  for (int i = 0; i < 8; ++i) rb[i] = *(const f32x4*)(bp + (size_t)i * ldb);
#pragma unroll 1
  for (int kt = 0; kt < nk; ++kt) {
    __syncthreads();
#pragma unroll
    for (int i = 0; i < 4; ++i) *(u32x4*)(As + (arow + i * 32) * LDT + akc * 8) = ra[i];
#pragma unroll
    for (int jn = 0; jn < 4; ++jn) {
      u32x4 w;
      w.x = pk2(rb[0][jn], rb[1][jn]); w.y = pk2(rb[2][jn], rb[3][jn]); w.z = pk2(rb[4][jn], rb[5][jn]); w.w = pk2(rb[6][jn], rb[7][jn]);
      *(u32x4*)(Bs + (ng * 4 + jn) * LDT + kg * 8) = w;
    }
    __syncthreads();
    if (kt + 1 < nk) {
      const bf16_t* ap2 = ap + (kt + 1) * 64;
      const float* bp2 = bp + (size_t)((kt + 1) * 64) * ldb;
#pragma unroll
      for (int i = 0; i < 4; ++i) ra[i] = *(const u32x4*)(ap2 + (size_t)(i * 32) * lda);
#pragma unroll
      for (int i = 0; i < 8; ++i) rb[i] = *(const f32x4*)(bp2 + (size_t)i * ldb);
    }
#pragma unroll
    for (int ks = 0; ks < 2; ++ks) {
      bf16x8 af[4], bfr[4];
#pragma unroll
      for (int mi = 0; mi < 4; ++mi) af[mi] = *(const bf16x8*)(As + (wr * 64 + mi * 16 + fr) * LDT + ks * 32 + fq * 8);
#pragma unroll
      for (int ni = 0; ni < 4; ++ni) bfr[ni] = *(const bf16x8*)(Bs + (wc * 64 + ni * 16 + fr) * LDT + ks * 32 + fq * 8);
#pragma unroll
      for (int mi = 0; mi < 4; ++mi)
#pragma unroll
        for (int ni = 0; ni < 4; ++ni) acc[mi][ni] = __builtin_amdgcn_mfma_f32_16x16x32_bf16(bfr[ni], af[mi], acc[mi][ni], 0, 0, 0);
    }
  }
  __syncthreads();
}

DI void zero_acc(f32x4 (&acc)[4][4]) {
#pragma unroll
  for (int mi = 0; mi < 4; ++mi)
#pragma unroll
    for (int ni = 0; ni < 4; ++ni) acc[mi][ni] = (f32x4){0.f, 0.f, 0.f, 0.f};
}

DI void tile_coords(int tile, int ntm, int ntn, int& tm, int& tn) {
  const int per = 8 * ntn;
  const int g = tile / per, rem = tile - g * per;
  const int gsz = (ntm - g * 8) < 8 ? (ntm - g * 8) : 8;
  tm = g * 8 + rem % gsz;
  tn = rem / gsz;
}

template <class BMap, class Epi>
DI void gemm_phase(const bf16_t* A, int lda, int M, const float* B, int ldb, int K, int N, BMap bmap, const Epi& epi, char* lds) {
  const int ntm = M >> 7, ntn = N >> 7, nt = ntm * ntn;
  const int lane = tid_() & 63, wid = tid_() >> 6;
  for (int tile = blockIdx.x; tile < nt; tile += gridDim.x) {
    int tm, tn;
    tile_coords(tile, ntm, ntn, tm, tn);
    f32x4 acc[4][4];
    zero_acc(acc);
    gemm_mainloop(A + (size_t)tm * 128 * lda, lda, B, ldb, K, tn, bmap, acc, lds);
    epi(tm, tn, wid >> 1, wid & 1, lane, acc);
  }
}

DI int lds_byte(int r, int c) { const int st = (r >> 4) * 2 + (c >> 5), rr = r & 15, cc = c & 31, ob = rr * 64 + cc * 2; return st * 1024 + (ob ^ (((ob >> 9) & 1) << 5)); }
DI void stage_rc(int b, int& R, int& C) { const int st = b >> 10, sb = b & 1023, swz = sb ^ (((sb >> 9) & 1) << 5); R = (st >> 1) * 16 + (swz >> 6); C = (st & 1) * 32 + ((swz & 63) >> 1); }
#define LAS __attribute__((address_space(3)))
DI void glds16(const bf16_t* g, LAS char* l) { __builtin_amdgcn_global_load_lds((const unsigned*)g, (LAS unsigned*)l, 16, 0, 0); }

DI int lds_byte32(int r, int c) { const int ob = (r & 15) * 64 + c * 2; return (r >> 4) * 1024 + (ob ^ (((ob >> 9) & 1) << 5)); }
DI void stage_rc32(int b, int& R, int& C) { const int st = b >> 10, sb = b & 1023, swz = sb ^ (((sb >> 9) & 1) << 5); R = st * 16 + (swz >> 6); C = (swz & 63) >> 1; }

template <int MI>
DI void gemm_mainloopT(const bf16_t* __restrict__ A, int lda, const bf16_t* __restrict__ Bt, int K, f32x4 (&acc)[MI][4], char* lds_generic, int ldb = 0) {
  if (ldb == 0) ldb = K;
  static_assert(MI == 4 || MI == 6 || MI == 8, "MI");
  constexpr int NA = MI / 2;
  constexpr int G = NA + 2;
  constexpr int NST = MI == 4 ? 4 : 3;
  constexpr int ABYTES = MI * 2048, SBYTES = ABYTES + 8192;
  LAS char* lds = (LAS char*)lds_generic;
  const int tid = tid_(), lane = tid & 63, wid = tid >> 6, wr = wid >> 1, wc = wid & 1;
  const int fr = lane & 15, fq = lane >> 4;
  const bf16_t* ap[NA];
  const bf16_t* bp[2];
#pragma unroll
  for (int i = 0; i < NA; ++i) { int R, C; stage_rc32(tid * 16 + i * 4096, R, C); ap[i] = A + (size_t)R * lda + C; }
#pragma unroll
  for (int i = 0; i < 2; ++i) { int R, C; stage_rc32(tid * 16 + i * 4096, R, C); bp[i] = Bt + (size_t)R * ldb + C; }
  LAS char* lt = lds + tid * 16;
  const int nk = K >> 5;
  __syncthreads();
#pragma unroll
  for (int s = 0; s < NST - 1; ++s) {
#pragma unroll
    for (int i = 0; i < NA; ++i) glds16(ap[i] + s * 32, lt + s * SBYTES + i * 4096);
#pragma unroll
    for (int i = 0; i < 2; ++i) glds16(bp[i] + s * 32, lt + s * SBYTES + ABYTES + i * 4096);
  }
  int offA[MI], offB[4];
#pragma unroll
  for (int i = 0; i < MI; ++i) offA[i] = lds_byte32(wr * MI * 16 + i * 16 + fr, fq * 8);
#pragma unroll
  for (int i = 0; i < 4; ++i) offB[i] = ABYTES + lds_byte32(wc * 64 + i * 16 + fr, fq * 8);
  int st_cur = 0, st_nx = NST - 1;
#pragma unroll 1
  for (int kt = 0; kt < nk; ++kt) {
    if (NST == 4) {
      if (kt + 2 < nk) asm volatile("s_waitcnt vmcnt(8)" ::: "memory");
      else if (kt + 1 < nk) asm volatile("s_waitcnt vmcnt(4)" ::: "memory");
      else asm volatile("s_waitcnt vmcnt(0)" ::: "memory");
    } else {
      if (kt + 1 < nk) { if (G == 6) asm volatile("s_waitcnt vmcnt(6)" ::: "memory"); else asm volatile("s_waitcnt vmcnt(5)" ::: "memory"); }
      else asm volatile("s_waitcnt vmcnt(0)" ::: "memory");
    }
    __builtin_amdgcn_s_barrier();
    asm volatile("" ::: "memory");
    if (kt + NST - 1 < nk) {
      LAS char* nx = lt + st_nx * SBYTES;
      const int ko = (kt + NST - 1) * 32;
#pragma unroll
      for (int i = 0; i < NA; ++i) glds16(ap[i] + ko, nx + i * 4096);
#pragma unroll
      for (int i = 0; i < 2; ++i) glds16(bp[i] + ko, nx + ABYTES + i * 4096);
    }
    const LAS char* cur = lds + st_cur * SBYTES;
    st_cur = st_cur + 1 == NST ? 0 : st_cur + 1;
    st_nx = st_nx + 1 == NST ? 0 : st_nx + 1;
    bf16x8 af[MI], bfr[4];
#pragma unroll
    for (int ni = 0; ni < 4; ++ni) bfr[ni] = *(const LAS bf16x8*)(cur + offB[ni]);
#pragma unroll
    for (int mi = 0; mi < MI; ++mi) af[mi] = *(const LAS bf16x8*)(cur + offA[mi]);
    __builtin_amdgcn_s_setprio(1);
#pragma unroll
    for (int mi = 0; mi < MI; ++mi)
#pragma unroll
      for (int ni = 0; ni < 4; ++ni) acc[mi][ni] = __builtin_amdgcn_mfma_f32_16x16x32_bf16(bfr[ni], af[mi], acc[mi][ni], 0, 0, 0);
    __builtin_amdgcn_s_setprio(0);
  }
}
DI void gemm_mainloop2(const bf16_t* __restrict__ A, int lda, const bf16_t* __restrict__ Bt, int K, f32x4 (&acc)[4][4], char* lds) {
  gemm_mainloopT<4>(A, lda, Bt, K, acc, lds);
}

template <int SM_, int SN>
DI bool xcd_tile(int it, int ntm, int ntn, int& tm, int& tn) {
  const int xcd = blockIdx.x & 7, j = blockIdx.x >> 3, per_xcd = gridDim.x >> 3;
  const int SM = (SM_ * SN != 64 || per_xcd % 64 == 0) ? SM_ : 2;
  const int nsn = ntn / SN, ns = (ntm / SM) * nsn;
  const int idx = it * per_xcd + j;
  const int sl = idx / (SM * SN), w = idx - sl * (SM * SN);
  const int s = sl * 8 + xcd;
  if (s >= ns) return false;
  const int sm = s / nsn, sn = s - sm * nsn;
  tm = sm * SM + w % SM;
  tn = sn * SN + w / SM;
  return true;
}

template <int MI, int SM, int SN, bool REV = false, class Epi>
DI void gemm_phaseT(const bf16_t* A, int lda, int M, int tm0, const bf16_t* Bt, int K, int N, const Epi& epi, char* lds, int ldb = 0) {
  if (ldb == 0) ldb = K;
  const int ntm = M / (MI * 32), ntn = N >> 7;
  const int lane = tid_() & 63, wid = tid_() >> 6;
  int tm, tn;
  for (int it = 0; xcd_tile<SM, SN>(it, ntm, ntn, tm, tn); ++it) {
    if (REV) tm = ntm - 1 - tm;
    f32x4 acc[MI][4];
#pragma unroll
    for (int mi = 0; mi < MI; ++mi)
#pragma unroll
      for (int ni = 0; ni < 4; ++ni) acc[mi][ni] = (f32x4){0.f, 0.f, 0.f, 0.f};
    gemm_mainloopT<MI>(A + (size_t)tm * (MI * 32) * lda, lda, Bt + (size_t)tn * 128 * ldb, K, acc, lds, ldb);
    epi(tm + tm0, tn, wid >> 1, wid & 1, lane, acc);
  }
}
template <int SM, int SN, class Epi>
DI void gemm_phase2(const bf16_t* A, int lda, int M, int tm0, const bf16_t* Bt, int K, int N, const Epi& epi, char* lds) {
  gemm_phaseT<4, SM, SN>(A, lda, M, tm0, Bt, K, N, epi, lds);
}

struct CMapPlain { DI int operator()(int n) const { return n; } };
struct CMapGateUp { DI int operator()(int p) const { const int tn = p >> 7, sub = (p >> 4) & 7, j = p & 15; return ((sub & 1) ? DFF : 0) + tn * 64 + (sub >> 1) * 16 + j; } };
template <class CM>
DI void convert_T(const float* __restrict__ W, int ldw, int K, int N, bf16_t* __restrict__ Wt, CM cm, char* lds, int ldo = 0) {
  if (ldo == 0) ldo = K;
  float* tl = (float*)lds;
  const int tid = tid_();
  const int nkt = K >> 6, nnt = N >> 6;
  for (int t = blockIdx.x; t < nkt * nnt; t += gridDim.x) {
    const int kt = t % nkt, nt = t / nkt;
    __syncthreads();
    const int n4 = (tid & 15) * 4;
    const int sc = cm(nt * 64 + n4);
#pragma unroll
    for (int ps = 0; ps < 4; ++ps) {
      const int kk = ps * 16 + (tid >> 4);
      const f32x4 v = *(const f32x4*)(W + (size_t)(kt * 64 + kk) * ldw + sc);
#pragma unroll
      for (int e = 0; e < 4; ++e) tl[kk * 65 + n4 + e] = v[e];
    }
    __syncthreads();
    const int nn = tid >> 2, kc = (tid & 3) * 16;
    u32x4 o0, o1;
    const float* q = tl + kc * 65 + nn;
    o0.x = pk2(q[0 * 65], q[1 * 65]); o0.y = pk2(q[2 * 65], q[3 * 65]); o0.z = pk2(q[4 * 65], q[5 * 65]); o0.w = pk2(q[6 * 65], q[7 * 65]);
    o1.x = pk2(q[8 * 65], q[9 * 65]); o1.y = pk2(q[10 * 65], q[11 * 65]); o1.z = pk2(q[12 * 65], q[13 * 65]); o1.w = pk2(q[14 * 65], q[15 * 65]);
    bf16_t* d = Wt + (size_t)(nt * 64 + nn) * ldo + kt * 64 + kc;
    *(u32x4*)d = o0;
    *(u32x4*)(d + 8) = o1;
  }
  __syncthreads();
}
DI void convert_ffn(const Params& p, int slot, const float* wi, const float* wo, char* lds) {
  bf16_t* wf = p.WF + slot * WF_SLOT;
  convert_T(wi, 2 * DFF, DM, 2 * DFF, wf, CMapGateUp(), lds);
  convert_T(wo, DM, DFF, DM, wf + WF_WO, CMapPlain(), lds, LDH);
}
DI void convert_mixer(const Params& p, int l, char* lds) {
  bf16_t* wm = p.WM + (size_t)l * WM_STRIDE;
  convert_T(p.w_in + (size_t)l * DM * DIN, DIN, DM, DIN, wm + WM_IN, CMapPlain(), lds);
  for (int z = 0; z < 3; ++z) convert_T(p.w_branch + (size_t)(l * 3 + z) * 512 * DM, DM, 512, DM, wm + WM_BR + (size_t)z * 1024 * 512, CMapPlain(), lds);
  convert_T(p.w_out + (size_t)l * DM * DM, DM, DM, DM, wm + WM_OUT, CMapPlain(), lds);
}

template <int MI>
struct EpiAct {
  bf16_t* H;
  DI void operator()(int tm, int tn, int wr, int wc, int lane, f32x4 (&acc)[MI][4]) const {
    const int fr = lane & 15, fq = lane >> 4;
#pragma unroll
    for (int mi = 0; mi < MI; ++mi) {
      const int row = tm * (MI * 32) + wr * (MI * 16) + mi * 16 + fr;
#pragma unroll
      for (int pr = 0; pr < 2; ++pr) {
        f32x4 g = acc[mi][2 * pr], u = acc[mi][2 * pr + 1], h;
#pragma unroll
        for (int j = 0; j < 4; ++j) h[j] = siluf_(g[j]) * u[j];
        st4bf(H + (size_t)row * LDH + tn * 64 + (wc * 2 + pr) * 16 + fq * 4, h);
      }
    }
  }
};

struct EpiResid {
  const float *src_lat, *src_ctx;
  float *dst_lat, *dst_ctx;
  const float* gate;
  float gmul;
  DI void operator()(int tm, int tn, int wr, int wc, int lane, f32x4 (&acc)[4][4]) const {
    const int fr = lane & 15, fq = lane >> 4;
    const int r0 = tm * 128;
    const bool lat = r0 < NTL;
    const float* s = lat ? src_lat + (size_t)r0 * DM : src_ctx + (size_t)(r0 - NTL) * DM;
    float* d = lat ? dst_lat + (size_t)r0 * DM : dst_ctx + (size_t)(r0 - NTL) * DM;
    const float* g = gate + (size_t)mod_row(r0) * NMOD;
#pragma unroll
    for (int ni = 0; ni < 4; ++ni) {
      const int col = tn * 128 + wc * 64 + ni * 16 + fq * 4;
      const f32x4 gv = *(const f32x4*)(g + col) * gmul;
#pragma unroll
      for (int mi = 0; mi < 4; ++mi) {
        const int rl = wr * 64 + mi * 16 + fr;
        const f32x4 xv = *(const f32x4*)(s + (size_t)rl * DM + col);
        *(f32x4*)(d + (size_t)rl * DM + col) = xv * ALPHA + gv * acc[mi][ni];
      }
    }
  }
};

template <int MI>
struct EpiResidLN {
  const float *src_lat, *src_ctx;
  float *dst_lat, *dst_ctx;
  const float* gate;
  const float *lng, *lnb;
  const float* mods_next;
  bf16_t* U;
  float* stats;
  unsigned* cnt;
  float gmul;
  int shift_idx;
  DI void operator()(int tm, int tn, int wr, int wc, int lane, f32x4 (&acc)[MI][4]) const {
    const int fr = lane & 15, fq = lane >> 4;
    const int rw = tm * (MI * 32) + wr * (MI * 16);
#pragma unroll
    for (int mi = 0; mi < MI; ++mi) {
      const int rg = rw + mi * 16;
      const bool lat = rg < NTL;
      const float* s = (lat ? src_lat + (size_t)rg * DM : src_ctx + (size_t)(rg - NTL) * DM) + (size_t)fr * DM;
      const float* g = gate + (size_t)mod_row(rg) * NMOD;
#pragma unroll
      for (int ni = 0; ni < 4; ++ni) {
        const int col = tn * 128 + wc * 64 + ni * 16 + fq * 4;
        const f32x4 gv = *(const f32x4*)(g + col) * gmul;
        const f32x4 xv = *(const f32x4*)(s + col);
        acc[mi][ni] = xv * ALPHA + gv * acc[mi][ni];
      }
      float sm = 0.f;
#pragma unroll
      for (int ni = 0; ni < 4; ++ni) sm += (acc[mi][ni][0] + acc[mi][ni][1]) + (acc[mi][ni][2] + acc[mi][ni][3]);
      sm += __shfl_xor(sm, 16); sm += __shfl_xor(sm, 32);
      const float mean_i = sm * (1.f / 64.f);
      float q = 0.f;
#pragma unroll
      for (int ni = 0; ni < 4; ++ni) { const f32x4 dd = acc[mi][ni] - mean_i; q += (dd[0] * dd[0] + dd[1] * dd[1]) + (dd[2] * dd[2] + dd[3] * dd[3]); }
      q += __shfl_xor(q, 16); q += __shfl_xor(q, 32);
      if (fq == 0) {
        const unsigned long long pk = ((unsigned long long)__float_as_uint(q) << 32) | (unsigned long long)__float_as_uint(sm);
        __hip_atomic_store((unsigned long long*)(stats + ((size_t)(rg + fr) * 16 + tn * 2 + wc) * 2), pk, __ATOMIC_RELAXED, __HIP_MEMORY_SCOPE_AGENT);
      }
      asm volatile("" ::: "memory");
    }
    asm volatile("s_waitcnt vmcnt(0)" ::: "memory");
    __syncthreads();
    if (tid_() == 0) {
      __hip_atomic_fetch_add(cnt + tm, 1u, __ATOMIC_RELAXED, __HIP_MEMORY_SCOPE_AGENT);
      while (__hip_atomic_load(cnt + tm, __ATOMIC_RELAXED, __HIP_MEMORY_SCOPE_AGENT) < 8u) __builtin_amdgcn_s_sleep(1);
    }
    __syncthreads();
#pragma unroll
    for (int mi = 0; mi < MI; ++mi) {
      const int rg = rw + mi * 16;
      const bool lat = rg < NTL;
      float* d = (lat ? dst_lat + (size_t)rg * DM : dst_ctx + (size_t)(rg - NTL) * DM) + (size_t)fr * DM;
      const float* mr = mods_next + (size_t)mod_row(rg) * NMOD + shift_idx * DM;
      const unsigned long long* sq = (const unsigned long long*)(stats + ((size_t)(rg + fr) * 16 + fq * 4) * 2);
      const unsigned long long u0 = __hip_atomic_load(sq + 0, __ATOMIC_RELAXED, __HIP_MEMORY_SCOPE_AGENT), u1 = __hip_atomic_load(sq + 1, __ATOMIC_RELAXED, __HIP_MEMORY_SCOPE_AGENT);
      const unsigned long long u2 = __hip_atomic_load(sq + 2, __ATOMIC_RELAXED, __HIP_MEMORY_SCOPE_AGENT), u3 = __hip_atomic_load(sq + 3, __ATOMIC_RELAXED, __HIP_MEMORY_SCOPE_AGENT);
      const f32x4 p0 = {__uint_as_float((unsigned)u0), __uint_as_float((unsigned)(u0 >> 32)), __uint_as_float((unsigned)u1), __uint_as_float((unsigned)(u1 >> 32))};
      const f32x4 p1 = {__uint_as_float((unsigned)u2), __uint_as_float((unsigned)(u2 >> 32)), __uint_as_float((unsigned)u3), __uint_as_float((unsigned)(u3 >> 32))};
      float ts = (p0[0] + p0[2]) + (p1[0] + p1[2]);
      ts += __shfl_xor(ts, 16); ts += __shfl_xor(ts, 32);
      const float mean = ts * (1.f / 1024.f);
      const float d0 = p0[0] * (1.f / 64.f) - mean, d1 = p0[2] * (1.f / 64.f) - mean, d2 = p1[0] * (1.f / 64.f) - mean, d3 = p1[2] * (1.f / 64.f) - mean;
      float m2 = (p0[1] + p0[3]) + (p1[1] + p1[3]) + 64.f * ((d0 * d0 + d1 * d1) + (d2 * d2 + d3 * d3));
      m2 += __shfl_xor(m2, 16); m2 += __shfl_xor(m2, 32);
      const float rstd = rsqrtf(m2 * (1.f / 1024.f) + 1e-5f);
#pragma unroll
      for (int ni = 0; ni < 4; ++ni) {
        const int col = tn * 128 + wc * 64 + ni * 16 + fq * 4;
        const f32x4 y = (acc[mi][ni] - mean) * rstd * *(const f32x4*)(lng + col) + *(const f32x4*)(lnb + col);
        *(f32x4*)(d + col) = y;
        if (U) {
          const f32x4 sh = *(const f32x4*)(mr + col), sc = *(const f32x4*)(mr + DM + col);
          st4bf(U + (size_t)(rg + fr) * DM + col, y * (sc + 1.f) + sh);
        }
      }
      asm volatile("" ::: "memory");
    }
  }
};

template <int MI>
struct EpiProj {
  const Params* p;
  int l;
  DI void operator()(int tm, int tn, int wr, int wc, int lane, f32x4 (&acc)[MI][4]) const {
    const int fr = lane & 15, fq = lane >> 4;
    const int col0 = tn * 128 + wc * 64;
    const bool lat = tm * (MI * 32) < NTL;
    bf16_t* P = p->P;
    if (tn < 5) {
      const float* gain = (tn < 4 ? p->q_gain : p->k_gain) + l * 64;
      const float mult = tn < 4 ? QSCALE : 1.f;
      f32x4 gv[4];
#pragma unroll
      for (int ni = 0; ni < 4; ++ni) gv[ni] = *(const f32x4*)(gain + ni * 16 + fq * 4);
#pragma unroll
      for (int mi = 0; mi < MI; ++mi) {
        const int row = tm * (MI * 32) + wr * (MI * 16) + mi * 16 + fr;
        float ss = 0.f;
#pragma unroll
        for (int ni = 0; ni < 4; ++ni)
#pragma unroll
          for (int j = 0; j < 4; ++j) ss += acc[mi][ni][j] * acc[mi][ni][j];
        ss += __shfl_xor(ss, 16);
        ss += __shfl_xor(ss, 32);
        const float rinv = rsqrtf(ss * (1.f / 64.f) + 1e-6f);
        f32x4 v[4];
#pragma unroll
        for (int ni = 0; ni < 4; ++ni) v[ni] = acc[mi][ni] * rinv * gv[ni];
        if (lat) {
          const int t = row & (TL - 1);
          const int pr = t >> 6, pc = t & 63;
#pragma unroll
          for (int a = 0; a < 2; ++a) {
            const float* rt = p->rope + (size_t)((a ? pc : pr) * 16 + fq * 4) * 2;
            const f32x4 cs0 = *(const f32x4*)rt, cs1 = *(const f32x4*)(rt + 4);
            const float cc[4] = {cs0[0], cs0[2], cs1[0], cs1[2]};
            const float sn[4] = {cs0[1], cs0[3], cs1[1], cs1[3]};
#pragma unroll
            for (int j = 0; j < 4; ++j) {
              const float x1 = v[2 * a][j], x2 = v[2 * a + 1][j];
              v[2 * a][j] = x1 * cc[j] - x2 * sn[j];
              v[2 * a + 1][j] = x2 * cc[j] + x1 * sn[j];
            }
          }
        }
#pragma unroll
        for (int ni = 0; ni < 4; ++ni) st4bf(P + (size_t)row * DPROJ + col0 + ni * 16 + fq * 4, v[ni] * mult);
      }
    } else {
      const float mult = (tn >= 21 && tn < 25) ? QSCALE : 1.f;
#pragma unroll
      for (int mi = 0; mi < MI; ++mi) {
        const int row = tm * (MI * 32) + wr * (MI * 16) + mi * 16 + fr;
#pragma unroll
        for (int ni = 0; ni < 4; ++ni) st4bf(P + (size_t)row * DPROJ + col0 + ni * 16 + fq * 4, acc[mi][ni] * mult);
      }
    }
  }
};

DI f32x4 shifted4(const bf16_t* P, int row, bool hp, bool hn, int colidx, const float* mu_l) {
  const bf16_t* q = P + (size_t)row * DPROJ + 768 + colidx;
  const f32x4 x = ld4bf(q);
  const f32x4 xm = hp ? ld4bf(q - DPROJ) : (f32x4){0.f, 0.f, 0.f, 0.f};
  const f32x4 xp = hn ? ld4bf(q + DPROJ) : (f32x4){0.f, 0.f, 0.f, 0.f};
  const f32x4 m0 = *(const f32x4*)(mu_l + colidx), m1 = *(const f32x4*)(mu_l + 1920 + colidx);
  return x + m0 * (xm - x) + m1 * (xp - x);
}

struct EpiReadout {
  const Params* p;
  int l;
  DI void operator()(int tm, int tn, int wr, int wc, int lane, f32x4 (&acc)[4][4]) const {
    const int fr = lane & 15, fq = lane >> 4;
    const int head = tn * 2 + wc, colh = head * 64;
    const float* mu_l = p->mu + (size_t)l * 2 * 1920;
    const float* rk = p->r_k + l * 512 + colh;
    const float* gg = p->gn_g + l * 512 + colh;
    const float* gb = p->gn_b + l * 512 + colh;
    const bf16_t* Of = p->Os;
    const bf16_t* Ob = p->Os + (size_t)NTOK * 512;
    u32x2 gp[4][4];
#pragma unroll
    for (int mi = 0; mi < 4; ++mi)
#pragma unroll
      for (int ni = 0; ni < 4; ++ni) { gp[mi][ni].x = pk2(acc[mi][ni][0], acc[mi][ni][1]); gp[mi][ni].y = pk2(acc[mi][ni][2], acc[mi][ni][3]); }
#pragma unroll
    for (int mi = 0; mi < 4; ++mi) {
      const int row = tm * 128 + wr * 64 + mi * 16 + fr;
      int t, L;
      if (row < NTL) { t = row & (TL - 1); L = TL; } else { t = (row - NTL) & (TC - 1); L = TC; }
      const bool hp = t > 0, hn = t < L - 1;
      f32x4 o[4];
      float s = 0.f, bs = 0.f;
#pragma unroll
      for (int ni = 0; ni < 4; ++ni) {
        const int c = fq * 16 + ni * 4;
        o[ni] = ld4bf(Of + (size_t)row * 512 + colh + c) + ld4bf(Ob + (size_t)row * 512 + colh + c);
        s += (o[ni][0] + o[ni][1]) + (o[ni][2] + o[ni][3]);
      }
#pragma unroll 2
      for (int ni = 0; ni < 4; ++ni) {
        const int c = fq * 16 + ni * 4;
        const f32x4 r4 = shifted4(p->P, row, hp, hn, colh + c, mu_l);
        const f32x4 k4 = shifted4(p->P, row, hp, hn, 512 + colh + c, mu_l);
        const f32x4 rk4 = *(const f32x4*)(rk + c);
        const f32x4 pr = r4 * k4 * rk4;
        bs += (pr[0] + pr[1]) + (pr[2] + pr[3]);
      }
      s += __shfl_xor(s, 16); s += __shfl_xor(s, 32);
      bs += __shfl_xor(bs, 16); bs += __shfl_xor(bs, 32);
      const float mean = s * (1.f / 64.f);
      float q = 0.f;
#pragma unroll
      for (int ni = 0; ni < 4; ++ni) {
        const f32x4 d = o[ni] - mean;
        q += (d[0] * d[0] + d[1] * d[1]) + (d[2] * d[2] + d[3] * d[3]);
      }
      q += __shfl_xor(q, 16); q += __shfl_xor(q, 32);
      const float rstd = rsqrtf(q * (1.f / 64.f) + 64e-5f);
#pragma unroll
      for (int ni = 0; ni < 4; ++ni) {
        const int c = fq * 16 + ni * 4;
        const f32x4 g4 = *(const f32x4*)(gg + c), b4 = *(const f32x4*)(gb + c);
        const f32x4 vv = shifted4(p->P, row, hp, hn, 1024 + colh + c, mu_l);
        const f32x4 gate = {bflo(gp[mi][ni].x), bfhi(gp[mi][ni].x), bflo(gp[mi][ni].y), bfhi(gp[mi][ni].y)};
        const f32x4 y = ((o[ni] - mean) * rstd * g4 + b4 + vv * bs) * gate;
        st4bf(p->yr + (size_t)row * 512 + colh + c, y);
      }
      asm volatile("" ::: "memory");
    }
  }
};

DI float wave_sum(float v) {
#pragma unroll
  for (int o = 32; o > 0; o >>= 1) v += __shfl_xor(v, o);
  return v;
}

DI void ln_phase(float* xl, float* xc, int M, const float* g, const float* b, const float* mods_l, int shift_idx, bf16_t* U) {
  const int lane = tid_() & 63, wid = tid_() >> 6;
  for (int row = blockIdx.x * 4 + wid; row < M; row += gridDim.x * 4) {
    float* xr = row < NTL ? xl + (size_t)row * DM : xc + (size_t)(row - NTL) * DM;
    f32x4 v[4];
    float s = 0.f;
#pragma unroll
    for (int i = 0; i < 4; ++i) { v[i] = *(const f32x4*)(xr + i * 256 + lane * 4); s += (v[i][0] + v[i][1]) + (v[i][2] + v[i][3]); }
    const float mean = wave_sum(s) * (1.f / 1024.f);
    float q = 0.f;
#pragma unroll
    for (int i = 0; i < 4; ++i) { const f32x4 d = v[i] - mean; q += (d[0] * d[0] + d[1] * d[1]) + (d[2] * d[2] + d[3] * d[3]); }
    const float rstd = rsqrtf(wave_sum(q) * (1.f / 1024.f) + 1e-5f);
    const float* mr = mods_l + (size_t)mod_row(row) * NMOD + shift_idx * DM;
#pragma unroll
    for (int i = 0; i < 4; ++i) {
      const int c = i * 256 + lane * 4;
      const f32x4 y = (v[i] - mean) * rstd * *(const f32x4*)(g + c) + *(const f32x4*)(b + c);
      *(f32x4*)(xr + c) = y;
      if (U) {
        const f32x4 sh = *(const f32x4*)(mr + c), sc = *(const f32x4*)(mr + DM + c);
        st4bf(U + (size_t)row * DM + c, y * (sc + 1.f) + sh);
      }
    }
  }
}

DI void u0_phase(const Params& p) {
  const int lane = tid_() & 63, wid = tid_() >> 6;
  for (int row = blockIdx.x * 4 + wid; row < NTOK; row += gridDim.x * 4) {
    const float* xr = row < NTL ? p.x_in + (size_t)row * DM : p.ctx_in + (size_t)(row - NTL) * DM;
    const float* mr = p.mods + (size_t)mod_row(row) * NMOD;
#pragma unroll
    for (int i = 0; i < 4; ++i) {
      const int c = i * 256 + lane * 4;
      const f32x4 y = *(const f32x4*)(xr + c);
      const f32x4 sh = *(const f32x4*)(mr + c), sc = *(const f32x4*)(mr + DM + c);
      st4bf(p.U + (size_t)row * DM + c, y * (sc + 1.f) + sh);
    }
  }
}

DI void mods_phase(const Params& p, char* lds) {
  float* sc = (float*)lds;
  float* red = sc + 256 * 20;
  const int tid = tid_(), lane = tid & 63, wid = tid >> 6;
  if (blockIdx.x == 0) {
    if (tid < 64) p.counters[tid] = 0u;
    for (int i = tid; i < 6 * 288; i += NTHREADS) p.lncnt[i] = 0u;
    for (int i = tid; i < 1024; i += NTHREADS) {
      const int pos = i >> 4, k = i & 15;
      const float inv = exp2f(-(float)k * (1.f / 16.f) * 13.287712379549449f);
      const float ang = (float)pos * inv;
      p.rope[i * 2] = cosf(ang);
      p.rope[i * 2 + 1] = sinf(ang);
    }
  }
  for (int tile = blockIdx.x; tile < 288; tile += gridDim.x) {
    const int l = tile / 144, col0 = (tile % 144) * 64;
    float acc[17];
#pragma unroll
    for (int r = 0; r < 17; ++r) acc[r] = 0.f;
    for (int kc = 0; kc < 4; ++kc) {
      __syncthreads();
      for (int i = tid; i < 17 * 256; i += NTHREADS) {
        const int r = i >> 8, kk = i & 255;
        const float v = r < 16 ? p.c[r * DM + kc * 256 + kk] : p.c_ctx[kc * 256 + kk];
        sc[kk * 20 + r] = siluf_(v);
      }
      __syncthreads();
      const float* wp = p.w_ada + ((size_t)l * DM + kc * 256 + wid * 64) * NMOD + col0 + lane;
      for (int kk = 0; kk < 64; ++kk) {
        const float wv = wp[(size_t)kk * NMOD];
        const float* s = sc + (wid * 64 + kk) * 20;
#pragma unroll
        for (int r = 0; r < 17; ++r) acc[r] += s[r] * wv;
      }
    }
    __syncthreads();
#pragma unroll
    for (int r = 0; r < 17; ++r) red[(wid * 17 + r) * 64 + lane] = acc[r];
    __syncthreads();
    for (int i = tid; i < 17 * 64; i += NTHREADS) {
      const int r = i >> 6, cl = i & 63;
      const float s = red[(0 * 17 + r) * 64 + cl] + red[(1 * 17 + r) * 64 + cl] + red[(2 * 17 + r) * 64 + cl] + red[(3 * 17 + r) * 64 + cl];
      p.mods[((size_t)l * 17 + r) * NMOD + col0 + cl] = s + p.b_ada[l * NMOD + col0 + cl];
    }
  }
  __syncthreads();
}

DI void sg_phase(const Params& p, int l) {
  const int lane = tid_() & 63, wid = tid_() >> 6;
  const float* mu_l = p.mu + (size_t)l * 2 * 1920;
  const int b0 = gridDim.x > 256 ? 256 : 0, nb = gridDim.x - b0;
  if ((int)blockIdx.x < b0) return;
  for (int idx = ((int)blockIdx.x - b0) * NTHREADS + tid_(); idx < NTOK * 32; idx += nb * NTHREADS) {
    const int row = idx >> 5, c = (idx & 31) * 4;
    int t, L;
    if (row < NTL) { t = row & (TL - 1); L = TL; } else { t = (row - NTL) & (TC - 1); L = TC; }
    const f32x4 x = shifted4(p.P, row, t > 0, t < L - 1, 1792 + c, mu_l);
    f32x4 y;
#pragma unroll
    for (int j = 0; j < 4; ++j) y[j] = sigmoidf_(x[j]);
    st4bf(p.sg + (size_t)row * 128 + c, y);
  }
  (void)lane; (void)wid;
}

constexpr int KLD = 72;
constexpr int VLD = 68;

struct NoMask { DI void operator()(f32x16 (&st)[2]) const {} };

struct NaMask {
  const float* rp;
  int c;
  int c0;
  int h;
  DI void operator()(f32x16 (&st)[2]) const {
#pragma unroll
    for (int u = 0; u < 2; ++u)
#pragma unroll
      for (int i = 0; i < 16; ++i) {
        const int kc = u * 32 + (i & 3) + 8 * (i >> 2) + 4 * h;
        const bool ok = (kc >= c0) && (kc < c0 + 16);
        const int bi = ok ? (kc - c + 15) : 15;
        const float bias = rp[bi];
        st[u][i] = ok ? st[u][i] + bias : -1e30f;
      }
  }
};

template <class Mask>
DI void attn_tile(const bf16_t* Ks, const bf16_t* Vt, const bf16x8 (&qf)[4], f32x16 (&ot)[2], float& m, float& l, const Mask& mask, int lane) {
  const int r = lane & 31, h = lane >> 5;
  f32x16 st[2];
#pragma unroll
  for (int u = 0; u < 2; ++u) {
#pragma unroll
    for (int i = 0; i < 16; ++i) st[u][i] = 0.f;
#pragma unroll
    for (int s = 0; s < 4; ++s) {
      const bf16x8 kf = *(const bf16x8*)(Ks + (u * 32 + r) * KLD + s * 16 + h * 8);
      st[u] = __builtin_amdgcn_mfma_f32_32x32x16_bf16(kf, qf[s], st[u], 0, 0, 0);
    }
  }
  mask(st);
  float mx = st[0][0];
#pragma unroll
  for (int u = 0; u < 2; ++u)
#pragma unroll
    for (int i = 0; i < 16; ++i) mx = fmaxf(mx, st[u][i]);
  mx = fmaxf(mx, __shfl_xor(mx, 32));
  const float mnew = fmaxf(m, mx);
  const float alpha = __builtin_amdgcn_exp2f(m - mnew);
  m = mnew;
  float ls = 0.f;
#pragma unroll
  for (int u = 0; u < 2; ++u)
#pragma unroll
    for (int i = 0; i < 16; ++i) { st[u][i] = __builtin_amdgcn_exp2f(st[u][i] - mnew); ls += st[u][i]; }
  l = l * alpha + ls;
#pragma unroll
  for (int dt = 0; dt < 2; ++dt)
#pragma unroll
    for (int i = 0; i < 16; ++i) ot[dt][i] *= alpha;
#pragma unroll
  for (int u = 0; u < 2; ++u)
#pragma unroll
    for (int s = 0; s < 2; ++s) {
      u32x4 pw;
      pw.x = pk2(st[u][8 * s + 0], st[u][8 * s + 1]); pw.y = pk2(st[u][8 * s + 2], st[u][8 * s + 3]);
      pw.z = pk2(st[u][8 * s + 4], st[u][8 * s + 5]); pw.w = pk2(st[u][8 * s + 6], st[u][8 * s + 7]);
      const bf16x8 pb = __builtin_bit_cast(bf16x8, pw);
#pragma unroll
      for (int dt = 0; dt < 2; ++dt) {
        const bf16_t* vp = Vt + (dt * 32 + r) * VLD + u * 32 + 16 * s + 4 * h;
        const s16x4 lo = *(const s16x4*)vp, hi = *(const s16x4*)(vp + 8);
        const bf16x8 va = __builtin_shufflevector(lo, hi, 0, 1, 2, 3, 4, 5, 6, 7);
        ot[dt] = __builtin_amdgcn_mfma_f32_32x32x16_bf16(va, pb, ot[dt], 0, 0, 0);
      }
    }
}

template <int NHB>
DI void kv_load(const bf16_t* kb, const bf16_t* vb, u32x4 (&kr)[NHB * 2], u32x4 (&vr)[NHB * 2]) {
#pragma unroll
  for (int i = 0; i < NHB * 2; ++i) {
    const int c = tid_() + i * NTHREADS;
    const int hh = c >> 9, cc = c & 511, key = cc >> 3, dc = cc & 7;
    const size_t off = (size_t)key * DPROJ + hh * 64 + dc * 8;
    kr[i] = *(const u32x4*)(kb + off);
    vr[i] = *(const u32x4*)(vb + off);
  }
}
template <int NHB>
DI void kv_store(bf16_t* Ks, bf16_t* Vt, const u32x4 (&kr)[NHB * 2], const u32x4 (&vr)[NHB * 2]) {
#pragma unroll
  for (int i = 0; i < NHB * 2; ++i) {
    const int c = tid_() + i * NTHREADS;
    const int hh = c >> 9, cc = c & 511, key = cc >> 3, dc = cc & 7;
    *(u32x4*)(Ks + hh * 64 * KLD + key * KLD + dc * 8) = kr[i];
    bf16_t* vt = Vt + hh * 64 * VLD + (dc * 8) * VLD + key;
    vt[0 * VLD] = (bf16_t)(vr[i].x & 0xffff); vt[1 * VLD] = (bf16_t)(vr[i].x >> 16);
    vt[2 * VLD] = (bf16_t)(vr[i].y & 0xffff); vt[3 * VLD] = (bf16_t)(vr[i].y >> 16);
    vt[4 * VLD] = (bf16_t)(vr[i].z & 0xffff); vt[5 * VLD] = (bf16_t)(vr[i].z >> 16);
    vt[6 * VLD] = (bf16_t)(vr[i].w & 0xffff); vt[7 * VLD] = (bf16_t)(vr[i].w >> 16);
  }
}

DI void attn_finish(bf16_t* outp  , f32x16 (&ot)[2], float l, int lane) {
  const int h = lane >> 5;
  l += __shfl_xor(l, 32);
  const float inv = __builtin_amdgcn_rcpf(l);
#pragma unroll
  for (int dt = 0; dt < 2; ++dt)
#pragma unroll
    for (int g = 0; g < 4; ++g) {
      f32x4 v = {ot[dt][4 * g] * inv, ot[dt][4 * g + 1] * inv, ot[dt][4 * g + 2] * inv, ot[dt][4 * g + 3] * inv};
      st4bf(outp + dt * 32 + 8 * g + 4 * h, v);
    }
}

DI void dense_item(const Params& p, int qrow0, int qcol, int krow_lat0, int ntl, int krow_ctx0, int kcol, int vcol, char* lds) {
  bf16_t* Ks = (bf16_t*)lds;
  bf16_t* Vt = Ks + 2 * 64 * KLD;
  const int lane = tid_() & 63, wid = tid_() >> 6, r = lane & 31, h = lane >> 5;
  bf16_t* qp = p.P + (size_t)(qrow0 + wid * 32 + r) * DPROJ + qcol;
  bf16x8 qf[4];
#pragma unroll
  for (int s = 0; s < 4; ++s) qf[s] = *(const bf16x8*)(qp + s * 16 + h * 8);
  f32x16 ot[2];
#pragma unroll
  for (int dt = 0; dt < 2; ++dt)
#pragma unroll
    for (int i = 0; i < 16; ++i) ot[dt][i] = 0.f;
  float m = -1e30f, l = 0.f;
  const int nt = ntl + 4;
  u32x4 kr[2], vr[2];
  auto tile_row = [&](int jt) { return jt < ntl ? krow_lat0 + jt * 64 : krow_ctx0 + (jt - ntl) * 64; };
  {
    const bf16_t* base = p.P + (size_t)tile_row(0) * DPROJ;
    kv_load<1>(base + kcol, base + vcol, kr, vr);
  }
  for (int jt = 0; jt < nt; ++jt) {
    __syncthreads();
    kv_store<1>(Ks, Vt, kr, vr);
    __syncthreads();
    if (jt + 1 < nt) {
      const bf16_t* base = p.P + (size_t)tile_row(jt + 1) * DPROJ;
      kv_load<1>(base + kcol, base + vcol, kr, vr);
    }
    attn_tile(Ks, Vt, qf, ot, m, l, NoMask(), lane);
  }
  attn_finish(qp, ot, l, lane);
  __syncthreads();
}

DI void na_item(const Params& p, int lyr, int b, int gr, int hp, char* lds) {
  bf16_t* Ks = (bf16_t*)lds;
  bf16_t* Vt = Ks + 2 * 64 * KLD;
  float* rpl = (float*)(Vt + 2 * 64 * VLD);
  const int tid = tid_(), lane = tid & 63, wid = tid >> 6, r = lane & 31, h = lane >> 5;
  const int hl = wid >> 1, head = hp * 2 + hl, qh = wid & 1;
  const int r0 = gr - 4 < 0 ? 0 : (gr - 4 > 24 ? 24 : gr - 4);
  __syncthreads();
  for (int i = tid; i < 2 * 465; i += NTHREADS) {
    const int hh = i / 465, e = i - hh * 465;
    rpl[i] = p.rpb[((size_t)lyr * 8 + hp * 2 + hh) * 465 + e] * LOG2E;
  }
  const int c = qh * 32 + r;
  const int c0 = c - 8 < 0 ? 0 : (c - 8 > 48 ? 48 : c - 8);
  bf16_t* qp = p.P + (size_t)(b * TL + gr * 64 + c) * DPROJ + 2688 + head * 64;
  bf16x8 qf[4];
#pragma unroll
  for (int s = 0; s < 4; ++s) qf[s] = *(const bf16x8*)(qp + s * 16 + h * 8);
  f32x16 ot[2];
#pragma unroll
  for (int dt = 0; dt < 2; ++dt)
#pragma unroll
    for (int i = 0; i < 16; ++i) ot[dt][i] = 0.f;
  float m = -1e30f, l = 0.f;
  u32x4 kr[4], vr[4];
  auto tile_row = [&](int jt) { return jt < 8 ? b * TL + (r0 + jt) * 64 : NTL + b * TC + (jt - 8) * 64; };
  const int kcol = 3200 + hp * 128, vcol = 3712 + hp * 128;
  {
    const bf16_t* base = p.P + (size_t)tile_row(0) * DPROJ;
    kv_load<2>(base + kcol, base + vcol, kr, vr);
  }
  for (int jt = 0; jt < 12; ++jt) {
    __syncthreads();
    kv_store<2>(Ks, Vt, kr, vr);
    __syncthreads();
    if (jt + 1 < 12) {
      const bf16_t* base = p.P + (size_t)tile_row(jt + 1) * DPROJ;
      kv_load<2>(base + kcol, base + vcol, kr, vr);
    }
    if (jt < 8) {
      NaMask mk;
      mk.rp = rpl + hl * 465 + (r0 + jt - gr + 7) * 31;
      mk.c = c; mk.c0 = c0; mk.h = h;
      attn_tile(Ks + hl * 64 * KLD, Vt + hl * 64 * VLD, qf, ot, m, l, mk, lane);
    } else {
      attn_tile(Ks + hl * 64 * KLD, Vt + hl * 64 * VLD, qf, ot, m, l, NoMask(), lane);
    }
  }
  attn_finish(qp, ot, l, lane);
  __syncthreads();
}

template <int CTRL>
DI float dpp_f(float x) { return __int_as_float(__builtin_amdgcn_update_dpp(0, __float_as_int(x), CTRL, 0xF, 0xF, true)); }
DI float red8(float x) {
  x += dpp_f<0xB1>(x);
  x += dpp_f<0x4E>(x);
  x += dpp_f<0x141>(x);
  return x;
}

struct ScanOps { f32x4 w[2], kk[2], b[2], kd[2], r[2]; f32x2 v; };
DI void scan_load(ScanOps& o, const float* base, int kg, int row0) {
#pragma unroll
  for (int i = 0; i < 2; ++i) {
    o.w[i] = *(const f32x4*)(base + kg * 8 + i * 4);
    o.kk[i] = *(const f32x4*)(base + 64 + kg * 8 + i * 4);
    o.b[i] = *(const f32x4*)(base + 128 + kg * 8 + i * 4);
    o.kd[i] = *(const f32x4*)(base + 192 + kg * 8 + i * 4);
    o.r[i] = *(const f32x4*)(base + 256 + kg * 8 + i * 4);
  }
  o.v = *(const f32x2*)(base + 320 + row0);
}

DI void scan_block(const Params& p, int lyr, int sidx, bool need_ctx, char* lds) {
  const int dir = sidx & 1, hd = (sidx >> 1) & 7, b = sidx >> 4;
  const int tid = tid_(), lane = tid & 63, w = tid >> 6;
  float* rec = (float*)lds;
  float* obuf = rec + 16 * 384;
  float* cst = obuf + 16 * 64;
  bf16_t* Aw = (bf16_t*)(cst + 14 * 64);
  bf16_t* Aa = Aw + 16 * 72;
  __syncthreads();
  for (int i = tid; i < 320; i += NTHREADS) {
    const int g = i >> 6, c = i & 63;
    const int colidx = (g < 3 ? g * 512 + hd * 64 : (g == 3 ? 1536 + dir * 64 : 1664 + dir * 64)) + c;
    cst[i] = p.mu[(size_t)lyr * 3840 + colidx];
    cst[320 + i] = p.mu[(size_t)lyr * 3840 + 1920 + colidx];
  }
  if (tid < 64) {
    cst[640 + tid] = p.w0[(lyr * 2 + dir) * 512 + hd * 64 + tid];
    cst[704 + tid] = p.a0[(lyr * 2 + dir) * 512 + hd * 64 + tid];
    cst[768 + tid] = p.k_k[lyr * 512 + hd * 64 + tid];
    cst[832 + tid] = p.k_a[lyr * 512 + hd * 64 + tid];
  }
  const int fr = lane & 15, fq = lane >> 4;
  bf16x8 bw[2], ba[2];
  {
    const float* w2p = p.w2 + (size_t)(lyr * 2 + dir) * 64 * 512 + hd * 64 + 16 * w + fr;
    const float* a2p = p.a2 + (size_t)(lyr * 2 + dir) * 64 * 512 + hd * 64 + 16 * w + fr;
#pragma unroll
    for (int ks = 0; ks < 2; ++ks) {
      u32x4 tw, ta;
      float xw[8], xa[8];
#pragma unroll
      for (int j = 0; j < 8; ++j) { xw[j] = w2p[(size_t)(ks * 32 + fq * 8 + j) * 512]; xa[j] = a2p[(size_t)(ks * 32 + fq * 8 + j) * 512]; }
      tw.x = pk2(xw[0], xw[1]); tw.y = pk2(xw[2], xw[3]); tw.z = pk2(xw[4], xw[5]); tw.w = pk2(xw[6], xw[7]);
      ta.x = pk2(xa[0], xa[1]); ta.y = pk2(xa[2], xa[3]); ta.z = pk2(xa[4], xa[5]); ta.w = pk2(xa[6], xa[7]);
      bw[ks] = __builtin_bit_cast(bf16x8, tw);
      ba[ks] = __builtin_bit_cast(bf16x8, ta);
    }
  }
  f32x4 S[2][2];
#pragma unroll
  for (int a = 0; a < 2; ++a)
#pragma unroll
    for (int i = 0; i < 2; ++i) S[a][i] = (f32x4){0.f, 0.f, 0.f, 0.f};
  const int kg = lane & 7, rp = lane >> 3, row0 = 16 * w + rp * 2;
  const int pj = tid >> 4, pcg = tid & 15;
  int goff[5] = {hd * 64, 512 + hd * 64, 1024 + hd * 64, 1536 + dir * 64, 1664 + dir * 64};
  u32x2 raw[5][3];
  auto chunk_tok = [&](int ch, int j, int& rowbase, int& t, int& L) {
    int n0;
    if (ch < 16) { L = TC; n0 = ch * 16; rowbase = NTL + b * TC; } else { L = TL; n0 = (ch - 16) * 16; rowbase = b * TL; }
    const int n = n0 + j;
    t = dir ? L - 1 - n : n;
  };
  auto prefetch = [&](int ch) {
    int rowbase, t, L;
    chunk_tok(ch, pj, rowbase, t, L);
    const bf16_t* q = p.P + (size_t)(rowbase + t) * DPROJ + 768 + pcg * 4;
#pragma unroll
    for (int g = 0; g < 5; ++g) {
      raw[g][1] = *(const u32x2*)(q + goff[g]);
      raw[g][0] = t > 0 ? *(const u32x2*)(q + goff[g] - DPROJ) : (u32x2){0u, 0u};
      raw[g][2] = t < L - 1 ? *(const u32x2*)(q + goff[g] + DPROJ) : (u32x2){0u, 0u};
    }
  };
  prefetch(0);
  __syncthreads();
  for (int ch = 0; ch < 144; ++ch) {
    {
      f32x4 xs[5];
#pragma unroll
      for (int g = 0; g < 5; ++g) {
        const f32x4 x = {bflo(raw[g][1].x), bfhi(raw[g][1].x), bflo(raw[g][1].y), bfhi(raw[g][1].y)};
        const f32x4 xm = {bflo(raw[g][0].x), bfhi(raw[g][0].x), bflo(raw[g][0].y), bfhi(raw[g][0].y)};
        const f32x4 xp = {bflo(raw[g][2].x), bfhi(raw[g][2].x), bflo(raw[g][2].y), bfhi(raw[g][2].y)};
        const f32x4 m0 = *(const f32x4*)(cst + g * 64 + pcg * 4), m1 = *(const f32x4*)(cst + 320 + g * 64 + pcg * 4);
        xs[g] = x + m0 * (xm - x) + m1 * (xp - x);
      }
      float* rj = rec + pj * 384;
      *(f32x4*)(rj + 256 + pcg * 4) = xs[0];
      *(f32x4*)(rj + 320 + pcg * 4) = xs[2];
      const f32x4 kx = xs[1] * *(const f32x4*)(cst + 768 + pcg * 4);
      float ss = (kx[0] * kx[0] + kx[1] * kx[1]) + (kx[2] * kx[2] + kx[3] * kx[3]);
      ss += __shfl_xor(ss, 1); ss += __shfl_xor(ss, 2); ss += __shfl_xor(ss, 4); ss += __shfl_xor(ss, 8);
      const float rn = rsqrtf(ss + 1e-12f);
      *(f32x4*)(rj + 64 + pcg * 4) = kx * rn;
      *(f32x4*)(rj + 192 + pcg * 4) = xs[1];
      f32x4 tw;
#pragma unroll
      for (int j = 0; j < 4; ++j) tw[j] = 1.f - 2.f * __builtin_amdgcn_rcpf(1.f + __expf(2.f * xs[3][j]));
      st4bf(Aw + pj * 72 + pcg * 4, tw);
      st4bf(Aa + pj * 72 + pcg * 4, xs[4]);
    }
    __syncthreads();
    {
      f32x4 aw = {0.f, 0.f, 0.f, 0.f}, aa = {0.f, 0.f, 0.f, 0.f};
#pragma unroll
      for (int ks = 0; ks < 2; ++ks) {
        const bf16x8 fw = *(const bf16x8*)(Aw + fr * 72 + ks * 32 + fq * 8);
        const bf16x8 fa = *(const bf16x8*)(Aa + fr * 72 + ks * 32 + fq * 8);
        aw = __builtin_amdgcn_mfma_f32_16x16x32_bf16(bw[ks], fw, aw, 0, 0, 0);
        aa = __builtin_amdgcn_mfma_f32_16x16x32_bf16(ba[ks], fa, aa, 0, 0, 0);
      }
      const int c = 16 * w + fq * 4;
      float* rj = rec + fr * 384;
      const f32x4 w0v = *(const f32x4*)(cst + 640 + c), a0v = *(const f32x4*)(cst + 704 + c), kav = *(const f32x4*)(cst + 832 + c);
      const f32x4 kkv = *(const f32x4*)(rj + 64 + c), kpv = *(const f32x4*)(rj + 192 + c);
      f32x4 dec, bb, kd;
#pragma unroll
      for (int j = 0; j < 4; ++j) {
        const float z = -(w0v[j] + aw[j]);
        const float sp = fmaxf(z, 0.f) + __logf(1.f + __expf(-fabsf(z)));
        const float wl = -sp - 0.5f;
        dec[j] = __expf(-__expf(wl));
        const float ic = sigmoidf_(a0v[j] + aa[j]);
        bb[j] = kkv[j] * ic;
        kd[j] = kpv[j] * (1.f + (ic - 1.f) * kav[j]);
      }
      *(f32x4*)(rj + c) = dec;
      *(f32x4*)(rj + 128 + c) = bb;
      *(f32x4*)(rj + 192 + c) = kd;
    }
    __syncthreads();
    if (ch + 1 < 144) prefetch(ch + 1);
    {
      ScanOps cur, nxt;
      scan_load(cur, rec, kg, row0);
#pragma unroll 2
      for (int j = 0; j < 16; ++j) {
        if (j + 1 < 16) scan_load(nxt, rec + (j + 1) * 384, kg, row0);
#pragma unroll
        for (int a = 0; a < 2; ++a) {
          f32x4 t0 = S[a][0] * cur.kk[0] + S[a][1] * cur.kk[1];
          float sap = red8((t0[0] + t0[1]) + (t0[2] + t0[3]));
          const float vv = a ? cur.v.y : cur.v.x;
          S[a][0] = S[a][0] * cur.w[0] - cur.b[0] * sap + cur.kd[0] * vv;
          S[a][1] = S[a][1] * cur.w[1] - cur.b[1] * sap + cur.kd[1] * vv;
          f32x4 t1 = S[a][0] * cur.r[0] + S[a][1] * cur.r[1];
          float o = red8((t1[0] + t1[1]) + (t1[2] + t1[3]));
          if (kg == 0) obuf[j * 64 + row0 + a] = o;
        }
        cur = nxt;
      }
    }
    __syncthreads();
    if (ch >= 16 || need_ctx) {
      int rowbase, t, L;
      chunk_tok(ch, pj, rowbase, t, L);
      const f32x4 ov = *(const f32x4*)(obuf + pj * 64 + pcg * 4);
      st4bf(p.Os + ((size_t)dir * NTOK + rowbase + t) * 512 + hd * 64 + pcg * 4, ov);
    }
  }
  __syncthreads();
}

DI bf16x8 pack8(f32x4 a, f32x4 b) {
  u32x4 t; t.x = pk2(a[0], a[1]); t.y = pk2(a[2], a[3]); t.z = pk2(b[0], b[1]); t.w = pk2(b[2], b[3]);
  return __builtin_bit_cast(bf16x8, t);
}
DI bf16x8 pack4z(f32x4 a) {
  u32x4 t; t.x = pk2(a[0], a[1]); t.y = pk2(a[2], a[3]); t.z = 0u; t.w = 0u;
  return __builtin_bit_cast(bf16x8, t);
}
#define MFMA16(a, b, c) __builtin_amdgcn_mfma_f32_16x16x32_bf16((a), (b), (c), 0, 0, 0)

DI void scan_block2(const Params& p, int lyr, int sidx, bool need_ctx, char* lds) {
  const int dir = sidx & 1, hd = (sidx >> 1) & 7, b = sidx >> 4;
  const int tid = tid_(), lane = tid & 63, w = tid >> 6;
  const int fr = lane & 15, fq = lane >> 4;
  float* rec = (float*)lds;
  float* obuf = rec + 16 * 384;
  float* cst = obuf + 16 * 64;
  bf16_t* Aw = (bf16_t*)(cst + 14 * 64);
  bf16_t* Aa = Aw + 16 * 72;
  bf16_t* ARt = Aa + 16 * 72;
  bf16_t* BKm = ARt + 32 * 72;
  bf16_t* BKt = BKm + 32 * 72;
  bf16_t* Vt = BKt + 64 * 40;
  float* WL = (float*)(Vt + 64 * 24);
  float* Gf = WL + 64;
  float* GNt = Gf + 32 * 33;
  float* Yf = GNt + 256;
  __syncthreads();
  for (int i = tid; i < 320; i += NTHREADS) {
    const int g = i >> 6, c = i & 63;
    const int colidx = (g < 3 ? g * 512 + hd * 64 : (g == 3 ? 1536 + dir * 64 : 1664 + dir * 64)) + c;
    cst[i] = p.mu[(size_t)lyr * 3840 + colidx];
    cst[320 + i] = p.mu[(size_t)lyr * 3840 + 1920 + colidx];
  }
  if (tid < 64) {
    cst[640 + tid] = p.w0[(lyr * 2 + dir) * 512 + hd * 64 + tid];
    cst[704 + tid] = p.a0[(lyr * 2 + dir) * 512 + hd * 64 + tid];
    cst[768 + tid] = p.k_k[lyr * 512 + hd * 64 + tid];
    cst[832 + tid] = p.k_a[lyr * 512 + hd * 64 + tid];
  }
  bf16x8 bw[2], ba[2];
  {
    const float* w2p = p.w2 + (size_t)(lyr * 2 + dir) * 64 * 512 + hd * 64 + 16 * w + fr;
    const float* a2p = p.a2 + (size_t)(lyr * 2 + dir) * 64 * 512 + hd * 64 + 16 * w + fr;
#pragma unroll
    for (int ks = 0; ks < 2; ++ks) {
      f32x4 x0, x1, y0, y1;
#pragma unroll
      for (int j = 0; j < 4; ++j) {
        x0[j] = w2p[(size_t)(ks * 32 + fq * 8 + j) * 512]; x1[j] = w2p[(size_t)(ks * 32 + fq * 8 + 4 + j) * 512];
        y0[j] = a2p[(size_t)(ks * 32 + fq * 8 + j) * 512]; y1[j] = a2p[(size_t)(ks * 32 + fq * 8 + 4 + j) * 512];
      }
      bw[ks] = pack8(x0, x1);
      ba[ks] = pack8(y0, y1);
    }
  }
  f32x4 ST[4];
#pragma unroll
  for (int kt = 0; kt < 4; ++kt) ST[kt] = (f32x4){0.f, 0.f, 0.f, 0.f};
  const int pj = tid >> 4, pcg = tid & 15;
  int goff[5] = {hd * 64, 512 + hd * 64, 1024 + hd * 64, 1536 + dir * 64, 1664 + dir * 64};
  u32x2 raw[5][3];
  auto chunk_tok = [&](int ch, int j, int& rowbase, int& t, int& L) {
    int n0;
    if (ch < 16) { L = TC; n0 = ch * 16; rowbase = NTL + b * TC; } else { L = TL; n0 = (ch - 16) * 16; rowbase = b * TL; }
    const int n = n0 + j;
    t = dir ? L - 1 - n : n;
  };
  auto prefetch = [&](int ch) {
    int rowbase, t, L;
    chunk_tok(ch, pj, rowbase, t, L);
    const bf16_t* q = p.P + (size_t)(rowbase + t) * DPROJ + 768 + pcg * 4;
    const bool hp = t > 0, hn = t < L - 1;
    const int om = hp ? -DPROJ : 0, on = hn ? DPROJ : 0;
#pragma unroll
    for (int g = 0; g < 5; ++g) {
      raw[g][1] = *(const u32x2*)(q + goff[g]);
      const u32x2 rm = *(const u32x2*)(q + goff[g] + om), rn = *(const u32x2*)(q + goff[g] + on);
      raw[g][0] = hp ? rm : (u32x2){0u, 0u};
      raw[g][2] = hn ? rn : (u32x2){0u, 0u};
    }
  };
  prefetch(0);
  __syncthreads();
  const bf16x8 zero8 = {0, 0, 0, 0, 0, 0, 0, 0};
#pragma unroll 1
  for (int ch = 0; ch < 144; ++ch) {
    {
      f32x4 xs[5];
#pragma unroll
      for (int g = 0; g < 5; ++g) {
        const f32x4 x = {bflo(raw[g][1].x), bfhi(raw[g][1].x), bflo(raw[g][1].y), bfhi(raw[g][1].y)};
        const f32x4 xm = {bflo(raw[g][0].x), bfhi(raw[g][0].x), bflo(raw[g][0].y), bfhi(raw[g][0].y)};
        const f32x4 xp = {bflo(raw[g][2].x), bfhi(raw[g][2].x), bflo(raw[g][2].y), bfhi(raw[g][2].y)};
        const f32x4 m0 = *(const f32x4*)(cst + g * 64 + pcg * 4), m1 = *(const f32x4*)(cst + 320 + g * 64 + pcg * 4);
        xs[g] = x + m0 * (xm - x) + m1 * (xp - x);
      }
      float* rj = rec + pj * 384;
      *(f32x4*)(rj + 256 + pcg * 4) = xs[0];
#pragma unroll
      for (int e = 0; e < 4; ++e) Vt[(pcg * 4 + e) * 24 + pj] = f2bf(xs[2][e]);
      const f32x4 kx = xs[1] * *(const f32x4*)(cst + 768 + pcg * 4);
      float ss = (kx[0] * kx[0] + kx[1] * kx[1]) + (kx[2] * kx[2] + kx[3] * kx[3]);
      ss = red8(ss); ss += dpp_f<0x140>(ss);
      const float rn = rsqrtf(ss + 1e-12f);
      *(f32x4*)(rj + 64 + pcg * 4) = kx * rn;
      *(f32x4*)(rj + 192 + pcg * 4) = xs[1];
      f32x4 tw;
#pragma unroll
      for (int j = 0; j < 4; ++j) tw[j] = 1.f - 2.f * __builtin_amdgcn_rcpf(1.f + __expf(2.f * xs[3][j]));
      st4bf(Aw + pj * 72 + pcg * 4, tw);
      st4bf(Aa + pj * 72 + pcg * 4, xs[4]);
    }
    if (ch + 1 < 144) prefetch(ch + 1);
    __syncthreads();
    {
      f32x4 aw = {0.f, 0.f, 0.f, 0.f}, aa = {0.f, 0.f, 0.f, 0.f};
#pragma unroll
      for (int ks = 0; ks < 2; ++ks) {
        const bf16x8 fw = *(const bf16x8*)(Aw + fr * 72 + ks * 32 + fq * 8);
        const bf16x8 fa = *(const bf16x8*)(Aa + fr * 72 + ks * 32 + fq * 8);
        aw = MFMA16(bw[ks], fw, aw);
        aa = MFMA16(ba[ks], fa, aa);
      }
      const int c = 16 * w + fq * 4;
      const float* rj = rec + fr * 384;
      const f32x4 w0v = *(const f32x4*)(cst + 640 + c), a0v = *(const f32x4*)(cst + 704 + c), kav = *(const f32x4*)(cst + 832 + c);
      const f32x4 kkv = *(const f32x4*)(rj + 64 + c), kpv = *(const f32x4*)(rj + 192 + c), rpv = *(const f32x4*)(rj + 256 + c);
      f32x4 e, E, ic;
#pragma unroll
      for (int j = 0; j < 4; ++j) {
        const float z = -(w0v[j] + aw[j]);
        const float sp = fmaxf(z, 0.f) + __logf(1.f + __expf(-fabsf(z)));
        e[j] = __expf(-sp - 0.5f);
        ic[j] = sigmoidf_(a0v[j] + aa[j]);
      }
      E = e;
#pragma unroll
      for (int j = 0; j < 4; ++j) {
        E[j] += dpp_f<0x111>(E[j]);
        E[j] += dpp_f<0x112>(E[j]);
        E[j] += dpp_f<0x114>(E[j]);
        E[j] += dpp_f<0x118>(E[j]);
      }
      f32x4 at, rt, bt, kt_;
#pragma unroll
      for (int j = 0; j < 4; ++j) {
        const float wi = __expf(E[j]);
        at[j] = -kkv[j] * __expf(e[j] - E[j]);
        rt[j] = rpv[j] * __expf(-E[j]);
        bt[j] = kkv[j] * ic[j] * wi;
        kt_[j] = kpv[j] * (1.f + (ic[j] - 1.f) * kav[j]) * wi;
      }
      st4bf(ARt + fr * 72 + c, at);
      st4bf(ARt + (16 + fr) * 72 + c, rt);
      st4bf(BKm + fr * 72 + c, bt);
      st4bf(BKm + (16 + fr) * 72 + c, kt_);
#pragma unroll
      for (int j = 0; j < 4; ++j) { BKt[(c + j) * 40 + fr] = f2bf(bt[j]); BKt[(c + j) * 40 + 16 + fr] = f2bf(kt_[j]); }
      if (fr == 15) {
#pragma unroll
        for (int j = 0; j < 4; ++j) WL[c + j] = __expf(-E[j]);
      }
    }
    __syncthreads();
    {
      const int ct = w >> 1, tt = w & 1;
      f32x4 g = {0.f, 0.f, 0.f, 0.f};
#pragma unroll
      for (int ks = 0; ks < 2; ++ks) {
        const bf16x8 A = *(const bf16x8*)(BKm + (ct * 16 + fr) * 72 + ks * 32 + fq * 8);
        const bf16x8 B = *(const bf16x8*)(ARt + (tt * 16 + fr) * 72 + ks * 32 + fq * 8);
        g = MFMA16(A, B, g);
      }
#pragma unroll
      for (int r = 0; r < 4; ++r) Gf[(ct * 16 + fq * 4 + r) * 33 + tt * 16 + fr] = g[r];
      if (w == 0) {
#pragma unroll
        for (int r = 0; r < 4; ++r) GNt[(fq * 4 + r) * 16 + fr] = g[r];
      }
    }
    f32x4 XA = {0.f, 0.f, 0.f, 0.f}, XR = {0.f, 0.f, 0.f, 0.f};
#pragma unroll
    for (int ks = 0; ks < 2; ++ks) {
      const bf16x8 Bs = pack8(ST[2 * ks], ST[2 * ks + 1]);
      {
        const bf16_t* ar = ARt + fr * 72 + fq * 4;
        const s16x4 lo = *(const s16x4*)(ar + (2 * ks) * 16), hi = *(const s16x4*)(ar + (2 * ks + 1) * 16);
        XA = MFMA16(__builtin_shufflevector(lo, hi, 0, 1, 2, 3, 4, 5, 6, 7), Bs, XA);
      }
      {
        const bf16_t* ar = ARt + (16 + fr) * 72 + fq * 4;
        const s16x4 lo = *(const s16x4*)(ar + (2 * ks) * 16), hi = *(const s16x4*)(ar + (2 * ks + 1) * 16);
        XR = MFMA16(__builtin_shufflevector(lo, hi, 0, 1, 2, 3, 4, 5, 6, 7), Bs, XR);
      }
    }
    __syncthreads();
    const bf16x8 vB = fq < 2 ? *(const bf16x8*)(Vt + (16 * w + fr) * 24 + fq * 8) : zero8;
    {
      f32x4 n0, n1;
#pragma unroll
      for (int jj = 0; jj < 4; ++jj) {
        const int i0 = fq * 8 + jj, i1 = fq * 8 + 4 + jj;
        const float g0 = Gf[(16 + (i0 & 15)) * 33 + fr], g1 = Gf[(16 + (i1 & 15)) * 33 + fr];
        n0[jj] = (fq < 2 && i0 < fr) ? g0 : 0.f;
        n1[jj] = (fq < 2 && i1 < fr) ? g1 : 0.f;
      }
      XA = MFMA16(pack8(n0, n1), vB, XA);
    }
    float* yw = Yf + (w * 16 + fr) * 20;
    *(f32x4*)(yw + fq * 4) = XA;
    float u[16];
    {
      const f32x4 y0 = *(const f32x4*)(yw), y1 = *(const f32x4*)(yw + 4), y2 = *(const f32x4*)(yw + 8), y3 = *(const f32x4*)(yw + 12);
#pragma unroll
      for (int j = 0; j < 4; ++j) { u[j] = y0[j]; u[4 + j] = y1[j]; u[8 + j] = y2[j]; u[12 + j] = y3[j]; }
#pragma unroll
      for (int i = 0; i < 15; ++i) {
#pragma unroll
        for (int t4 = (i + 1) / 4; t4 < 4; ++t4) {
          const f32x4 nn = *(const f32x4*)(GNt + i * 16 + t4 * 4);
#pragma unroll
          for (int e2 = 0; e2 < 4; ++e2) if (t4 * 4 + e2 > i) u[t4 * 4 + e2] += u[i] * nn[e2];
        }
      }
    }
    f32x4 uq;
#pragma unroll
    for (int j = 0; j < 4; ++j) uq[j] = fq == 0 ? u[j] : (fq == 1 ? u[4 + j] : (fq == 2 ? u[8 + j] : u[12 + j]));
    const bf16x8 uB = pack4z(uq);
    {
      f32x4 m0, n0, n1;
#pragma unroll
      for (int jj = 0; jj < 4; ++jj) {
        const int i = fq * 4 + jj;
        const float gm = Gf[i * 33 + 16 + fr];
        m0[jj] = i <= fr ? gm : 0.f;
        const int i0 = fq * 8 + jj, i1 = fq * 8 + 4 + jj;
        const float g0 = Gf[(16 + (i0 & 15)) * 33 + 16 + fr], g1 = Gf[(16 + (i1 & 15)) * 33 + 16 + fr];
        n0[jj] = (fq < 2 && i0 <= fr) ? g0 : 0.f;
        n1[jj] = (fq < 2 && i1 <= fr) ? g1 : 0.f;
      }
      XR = MFMA16(pack4z(m0), uB, XR);
      XR = MFMA16(pack8(n0, n1), vB, XR);
#pragma unroll
      for (int r = 0; r < 4; ++r) obuf[(fq * 4 + r) * 64 + 16 * w + fr] = XR[r];
    }
#pragma unroll
    for (int kt = 0; kt < 4; ++kt) {
      const bf16_t* bk = BKt + (kt * 16 + fr) * 40;
      const s16x4 lo = *(const s16x4*)(bk + fq * 4);
      const s16x4 z4 = {0, 0, 0, 0};
      ST[kt] = MFMA16(__builtin_shufflevector(lo, z4, 0, 1, 2, 3, 4, 5, 6, 7), uB, ST[kt]);
      const bf16x8 a5 = fq < 2 ? *(const bf16x8*)(bk + 16 + fq * 8) : zero8;
      ST[kt] = MFMA16(a5, vB, ST[kt]);
      ST[kt] *= *(const f32x4*)(WL + kt * 16 + fq * 4);
    }
    __syncthreads();
    if (ch >= 16 || need_ctx) {
      int rowbase, t, L;
      chunk_tok(ch, pj, rowbase, t, L);
      const f32x4 ov = *(const f32x4*)(obuf + pj * 64 + pcg * 4);
      st4bf(p.Os + ((size_t)dir * NTOK + rowbase + t) * 512 + hd * 64 + pcg * 4, ov);
    }
  }
  __syncthreads();
}

DI void scan_block3(const Params& p, int lyr, int sidx, bool need_ctx, char* lds) {
  const int dir = sidx & 1, hd = (sidx >> 1) & 7, b = sidx >> 4;
  const int tid = tid_(), lane = tid & 63, w = tid >> 6;
  const int fr = lane & 15, fq = lane >> 4;
  float* rec = (float*)lds;
  float* obuf = rec + 16 * 192;
  float* cst = obuf + 16 * 64;
  bf16_t* Aw = (bf16_t*)(cst + 14 * 64);
  bf16_t* Aa = Aw + 16 * 72;
  float* Gf = (float*)(Aa + 16 * 72);
  float* GNt = Gf + 32 * 33;
  float* Yf = GNt + 256;
  bf16_t* OPS = (bf16_t*)(Yf + 4 * 16 * 20);
  constexpr int OPS_STRIDE = 32 * 72 + 32 * 72 + 64 * 40 + 64 * 24 + 128;
  __syncthreads();
  for (int i = tid; i < 320; i += NTHREADS) {
    const int g = i >> 6, c = i & 63;
    const int colidx = (g < 3 ? g * 512 + hd * 64 : (g == 3 ? 1536 + dir * 64 : 1664 + dir * 64)) + c;
    cst[i] = p.mu[(size_t)lyr * 3840 + colidx];
    cst[320 + i] = p.mu[(size_t)lyr * 3840 + 1920 + colidx];
  }
  if (tid < 64) {
    cst[640 + tid] = p.w0[(lyr * 2 + dir) * 512 + hd * 64 + tid];
    cst[704 + tid] = p.a0[(lyr * 2 + dir) * 512 + hd * 64 + tid];
    cst[768 + tid] = p.k_k[lyr * 512 + hd * 64 + tid];
    cst[832 + tid] = p.k_a[lyr * 512 + hd * 64 + tid];
  }
  bf16x8 bw[2], ba[2];
  {
    const float* w2p = p.w2 + (size_t)(lyr * 2 + dir) * 64 * 512 + hd * 64 + 16 * w + fr;
    const float* a2p = p.a2 + (size_t)(lyr * 2 + dir) * 64 * 512 + hd * 64 + 16 * w + fr;
#pragma unroll
    for (int ks = 0; ks < 2; ++ks) {
      f32x4 x0, x1, y0, y1;
#pragma unroll
      for (int j = 0; j < 4; ++j) {
        x0[j] = w2p[(size_t)(ks * 32 + fq * 8 + j) * 512]; x1[j] = w2p[(size_t)(ks * 32 + fq * 8 + 4 + j) * 512];
        y0[j] = a2p[(size_t)(ks * 32 + fq * 8 + j) * 512]; y1[j] = a2p[(size_t)(ks * 32 + fq * 8 + 4 + j) * 512];
      }
      bw[ks] = pack8(x0, x1);
      ba[ks] = pack8(y0, y1);
    }
  }
  f32x4 ST[4];
#pragma unroll
  for (int kt = 0; kt < 4; ++kt) ST[kt] = (f32x4){0.f, 0.f, 0.f, 0.f};
  const int pj = tid >> 4, pcg = tid & 15;
  int goff[5] = {hd * 64, 512 + hd * 64, 1024 + hd * 64, 1536 + dir * 64, 1664 + dir * 64};
  u32x2 raw[5][3];
  auto chunk_tok = [&](int ch, int j, int& rowbase, int& t, int& L) {
    int n0;
    if (ch < 16) { L = TC; n0 = ch * 16; rowbase = NTL + b * TC; } else { L = TL; n0 = (ch - 16) * 16; rowbase = b * TL; }
    const int n = n0 + j;
    t = dir ? L - 1 - n : n;
  };
  auto prefetch = [&](int ch) {
    int rowbase, t, L;
    chunk_tok(ch, pj, rowbase, t, L);
    const bf16_t* q = p.P + (size_t)(rowbase + t) * DPROJ + 768 + pcg * 4;
    const bool hp = t > 0, hn = t < L - 1;
    const int om = hp ? -DPROJ : 0, on = hn ? DPROJ : 0;
#pragma unroll
    for (int g = 0; g < 5; ++g) {
      raw[g][1] = *(const u32x2*)(q + goff[g]);
      const u32x2 rm = *(const u32x2*)(q + goff[g] + om), rn = *(const u32x2*)(q + goff[g] + on);
      raw[g][0] = hp ? rm : (u32x2){0u, 0u};
      raw[g][2] = hn ? rn : (u32x2){0u, 0u};
    }
  };
  const bf16x8 zero8 = {0, 0, 0, 0, 0, 0, 0, 0};
  prefetch(0);
  __syncthreads();
    {
      bf16_t* ARt = OPS + (0) * OPS_STRIDE; bf16_t* BKm = ARt + 32 * 72; bf16_t* BKt = BKm + 32 * 72; bf16_t* Vt = BKt + 64 * 40; float* WL = (float*)(Vt + 64 * 24);
      (void)ARt; (void)BKm; (void)BKt; (void)Vt; (void)WL;
    {
      f32x4 xs[5];
#pragma unroll
      for (int g = 0; g < 5; ++g) {
        const f32x4 x = {bflo(raw[g][1].x), bfhi(raw[g][1].x), bflo(raw[g][1].y), bfhi(raw[g][1].y)};
        const f32x4 xm = {bflo(raw[g][0].x), bfhi(raw[g][0].x), bflo(raw[g][0].y), bfhi(raw[g][0].y)};
        const f32x4 xp = {bflo(raw[g][2].x), bfhi(raw[g][2].x), bflo(raw[g][2].y), bfhi(raw[g][2].y)};
        const f32x4 m0 = *(const f32x4*)(cst + g * 64 + pcg * 4), m1 = *(const f32x4*)(cst + 320 + g * 64 + pcg * 4);
        xs[g] = x + m0 * (xm - x) + m1 * (xp - x);
      }
      float* rj = rec + pj * 192;
      *(f32x4*)(rj + 128 + pcg * 4) = xs[0];
#pragma unroll
      for (int e = 0; e < 4; ++e) Vt[(pcg * 4 + e) * 24 + pj] = f2bf(xs[2][e]);
      const f32x4 kx = xs[1] * *(const f32x4*)(cst + 768 + pcg * 4);
      float ss = (kx[0] * kx[0] + kx[1] * kx[1]) + (kx[2] * kx[2] + kx[3] * kx[3]);
      ss = red8(ss); ss += dpp_f<0x140>(ss);
      const float rn = rsqrtf(ss + 1e-12f);
      *(f32x4*)(rj + 0 + pcg * 4) = kx * rn;
      *(f32x4*)(rj + 64 + pcg * 4) = xs[1];
      f32x4 tw;
#pragma unroll
      for (int j = 0; j < 4; ++j) tw[j] = 1.f - 2.f * __builtin_amdgcn_rcpf(1.f + __expf(2.f * xs[3][j]));
      st4bf(Aw + pj * 72 + pcg * 4, tw);
      st4bf(Aa + pj * 72 + pcg * 4, xs[4]);
    }
    }
  prefetch(1);
  __syncthreads();
    {
      bf16_t* ARt = OPS + (0) * OPS_STRIDE; bf16_t* BKm = ARt + 32 * 72; bf16_t* BKt = BKm + 32 * 72; bf16_t* Vt = BKt + 64 * 40; float* WL = (float*)(Vt + 64 * 24);
      (void)ARt; (void)BKm; (void)BKt; (void)Vt; (void)WL;
    {
      f32x4 aw = {0.f, 0.f, 0.f, 0.f}, aa = {0.f, 0.f, 0.f, 0.f};
#pragma unroll
      for (int ks = 0; ks < 2; ++ks) {
        const bf16x8 fw = *(const bf16x8*)(Aw + fr * 72 + ks * 32 + fq * 8);
        const bf16x8 fa = *(const bf16x8*)(Aa + fr * 72 + ks * 32 + fq * 8);
        aw = MFMA16(bw[ks], fw, aw);
        aa = MFMA16(ba[ks], fa, aa);
      }
      const int c = 16 * w + fq * 4;
      const float* rj = rec + fr * 192;
      const f32x4 w0v = *(const f32x4*)(cst + 640 + c), a0v = *(const f32x4*)(cst + 704 + c), kav = *(const f32x4*)(cst + 832 + c);
      const f32x4 kkv = *(const f32x4*)(rj + 0 + c), kpv = *(const f32x4*)(rj + 64 + c), rpv = *(const f32x4*)(rj + 128 + c);
      f32x4 e, E, ic;
#pragma unroll
      for (int j = 0; j < 4; ++j) {
        const float z = -(w0v[j] + aw[j]);
        const float sp = fmaxf(z, 0.f) + __logf(1.f + __expf(-fabsf(z)));
        e[j] = __expf(-sp - 0.5f);
        ic[j] = sigmoidf_(a0v[j] + aa[j]);
      }
      E = e;
#pragma unroll
      for (int j = 0; j < 4; ++j) {
        E[j] += dpp_f<0x111>(E[j]);
        E[j] += dpp_f<0x112>(E[j]);
        E[j] += dpp_f<0x114>(E[j]);
        E[j] += dpp_f<0x118>(E[j]);
      }
      f32x4 at, rt, bt, kt_;
#pragma unroll
      for (int j = 0; j < 4; ++j) {
        const float wi = __expf(E[j]);
        at[j] = -kkv[j] * __expf(e[j] - E[j]);
        rt[j] = rpv[j] * __expf(-E[j]);
        bt[j] = kkv[j] * ic[j] * wi;
        kt_[j] = kpv[j] * (1.f + (ic[j] - 1.f) * kav[j]) * wi;
      }
      st4bf(ARt + fr * 72 + c, at);
      st4bf(ARt + (16 + fr) * 72 + c, rt);
      st4bf(BKm + fr * 72 + c, bt);
      st4bf(BKm + (16 + fr) * 72 + c, kt_);
#pragma unroll
      for (int j = 0; j < 4; ++j) { BKt[(c + j) * 40 + fr] = f2bf(bt[j]); BKt[(c + j) * 40 + 16 + fr] = f2bf(kt_[j]); }
      if (fr == 15) {
#pragma unroll
        for (int j = 0; j < 4; ++j) WL[c + j] = __expf(-E[j]);
      }
    }
    }
#pragma unroll 1
  for (int ch = 0; ch < 144; ++ch) {
    const int cb = ch & 1, nb = cb ^ 1;
    const bool more = ch + 1 < 144;
    f32x4 XA, XR;
    __syncthreads();
    if (more) {
    {
      bf16_t* ARt = OPS + (nb) * OPS_STRIDE; bf16_t* BKm = ARt + 32 * 72; bf16_t* BKt = BKm + 32 * 72; bf16_t* Vt = BKt + 64 * 40; float* WL = (float*)(Vt + 64 * 24);
      (void)ARt; (void)BKm; (void)BKt; (void)Vt; (void)WL;
    {
      f32x4 xs[5];
#pragma unroll
      for (int g = 0; g < 5; ++g) {
        const f32x4 x = {bflo(raw[g][1].x), bfhi(raw[g][1].x), bflo(raw[g][1].y), bfhi(raw[g][1].y)};
        const f32x4 xm = {bflo(raw[g][0].x), bfhi(raw[g][0].x), bflo(raw[g][0].y), bfhi(raw[g][0].y)};
        const f32x4 xp = {bflo(raw[g][2].x), bfhi(raw[g][2].x), bflo(raw[g][2].y), bfhi(raw[g][2].y)};
        const f32x4 m0 = *(const f32x4*)(cst + g * 64 + pcg * 4), m1 = *(const f32x4*)(cst + 320 + g * 64 + pcg * 4);
        xs[g] = x + m0 * (xm - x) + m1 * (xp - x);
      }
      float* rj = rec + pj * 192;
      *(f32x4*)(rj + 128 + pcg * 4) = xs[0];
#pragma unroll
      for (int e = 0; e < 4; ++e) Vt[(pcg * 4 + e) * 24 + pj] = f2bf(xs[2][e]);
      const f32x4 kx = xs[1] * *(const f32x4*)(cst + 768 + pcg * 4);
      float ss = (kx[0] * kx[0] + kx[1] * kx[1]) + (kx[2] * kx[2] + kx[3] * kx[3]);
      ss = red8(ss); ss += dpp_f<0x140>(ss);
      const float rn = rsqrtf(ss + 1e-12f);
      *(f32x4*)(rj + 0 + pcg * 4) = kx * rn;
      *(f32x4*)(rj + 64 + pcg * 4) = xs[1];
      f32x4 tw;
#pragma unroll
      for (int j = 0; j < 4; ++j) tw[j] = 1.f - 2.f * __builtin_amdgcn_rcpf(1.f + __expf(2.f * xs[3][j]));
      st4bf(Aw + pj * 72 + pcg * 4, tw);
      st4bf(Aa + pj * 72 + pcg * 4, xs[4]);
    }
    }
      if (ch + 2 < 144) prefetch(ch + 2);
    }
    {
      bf16_t* ARt = OPS + (cb) * OPS_STRIDE; bf16_t* BKm = ARt + 32 * 72; bf16_t* BKt = BKm + 32 * 72; bf16_t* Vt = BKt + 64 * 40; float* WL = (float*)(Vt + 64 * 24);
      (void)ARt; (void)BKm; (void)BKt; (void)Vt; (void)WL;
    {
      const int ct = w >> 1, tt = w & 1;
      f32x4 g = {0.f, 0.f, 0.f, 0.f};
#pragma unroll
      for (int ks = 0; ks < 2; ++ks) {
        const bf16x8 A = *(const bf16x8*)(BKm + (ct * 16 + fr) * 72 + ks * 32 + fq * 8);
        const bf16x8 B = *(const bf16x8*)(ARt + (tt * 16 + fr) * 72 + ks * 32 + fq * 8);
        g = MFMA16(A, B, g);
      }
#pragma unroll
      for (int r = 0; r < 4; ++r) Gf[(ct * 16 + fq * 4 + r) * 33 + tt * 16 + fr] = g[r];
      if (w == 0) {
#pragma unroll
        for (int r = 0; r < 4; ++r) GNt[(fq * 4 + r) * 16 + fr] = g[r];
      }
    }
    XA = (f32x4){0.f, 0.f, 0.f, 0.f}; XR = (f32x4){0.f, 0.f, 0.f, 0.f};
#pragma unroll
    for (int ks = 0; ks < 2; ++ks) {
      const bf16x8 Bs = pack8(ST[2 * ks], ST[2 * ks + 1]);
      {
        const bf16_t* ar = ARt + fr * 72 + fq * 4;
        const s16x4 lo = *(const s16x4*)(ar + (2 * ks) * 16), hi = *(const s16x4*)(ar + (2 * ks + 1) * 16);
        XA = MFMA16(__builtin_shufflevector(lo, hi, 0, 1, 2, 3, 4, 5, 6, 7), Bs, XA);
      }
      {
        const bf16_t* ar = ARt + (16 + fr) * 72 + fq * 4;
        const s16x4 lo = *(const s16x4*)(ar + (2 * ks) * 16), hi = *(const s16x4*)(ar + (2 * ks + 1) * 16);
        XR = MFMA16(__builtin_shufflevector(lo, hi, 0, 1, 2, 3, 4, 5, 6, 7), Bs, XR);
      }
    }
    }
    __syncthreads();
    if (more) {
    {
      bf16_t* ARt = OPS + (nb) * OPS_STRIDE; bf16_t* BKm = ARt + 32 * 72; bf16_t* BKt = BKm + 32 * 72; bf16_t* Vt = BKt + 64 * 40; float* WL = (float*)(Vt + 64 * 24);
      (void)ARt; (void)BKm; (void)BKt; (void)Vt; (void)WL;
    {
      f32x4 aw = {0.f, 0.f, 0.f, 0.f}, aa = {0.f, 0.f, 0.f, 0.f};
#pragma unroll
      for (int ks = 0; ks < 2; ++ks) {
        const bf16x8 fw = *(const bf16x8*)(Aw + fr * 72 + ks * 32 + fq * 8);
        const bf16x8 fa = *(const bf16x8*)(Aa + fr * 72 + ks * 32 + fq * 8);
        aw = MFMA16(bw[ks], fw, aw);
        aa = MFMA16(ba[ks], fa, aa);
      }
      const int c = 16 * w + fq * 4;
      const float* rj = rec + fr * 192;
      const f32x4 w0v = *(const f32x4*)(cst + 640 + c), a0v = *(const f32x4*)(cst + 704 + c), kav = *(const f32x4*)(cst + 832 + c);
      const f32x4 kkv = *(const f32x4*)(rj + 0 + c), kpv = *(const f32x4*)(rj + 64 + c), rpv = *(const f32x4*)(rj + 128 + c);
      f32x4 e, E, ic;
#pragma unroll
      for (int j = 0; j < 4; ++j) {
        const float z = -(w0v[j] + aw[j]);
        const float sp = fmaxf(z, 0.f) + __logf(1.f + __expf(-fabsf(z)));
        e[j] = __expf(-sp - 0.5f);
        ic[j] = sigmoidf_(a0v[j] + aa[j]);
      }
      E = e;
#pragma unroll
      for (int j = 0; j < 4; ++j) {
        E[j] += dpp_f<0x111>(E[j]);
        E[j] += dpp_f<0x112>(E[j]);
        E[j] += dpp_f<0x114>(E[j]);
        E[j] += dpp_f<0x118>(E[j]);
      }
      f32x4 at, rt, bt, kt_;
#pragma unroll
      for (int j = 0; j < 4; ++j) {
        const float wi = __expf(E[j]);
        at[j] = -kkv[j] * __expf(e[j] - E[j]);
        rt[j] = rpv[j] * __expf(-E[j]);
        bt[j] = kkv[j] * ic[j] * wi;
        kt_[j] = kpv[j] * (1.f + (ic[j] - 1.f) * kav[j]) * wi;
      }
      st4bf(ARt + fr * 72 + c, at);
      st4bf(ARt + (16 + fr) * 72 + c, rt);
      st4bf(BKm + fr * 72 + c, bt);
      st4bf(BKm + (16 + fr) * 72 + c, kt_);
#pragma unroll
      for (int j = 0; j < 4; ++j) { BKt[(c + j) * 40 + fr] = f2bf(bt[j]); BKt[(c + j) * 40 + 16 + fr] = f2bf(kt_[j]); }
      if (fr == 15) {
#pragma unroll
        for (int j = 0; j < 4; ++j) WL[c + j] = __expf(-E[j]);
      }
    }
    }
    }
    {
      bf16_t* ARt = OPS + (cb) * OPS_STRIDE; bf16_t* BKm = ARt + 32 * 72; bf16_t* BKt = BKm + 32 * 72; bf16_t* Vt = BKt + 64 * 40; float* WL = (float*)(Vt + 64 * 24);
      (void)ARt; (void)BKm; (void)BKt; (void)Vt; (void)WL;
    const bf16x8 vB = fq < 2 ? *(const bf16x8*)(Vt + (16 * w + fr) * 24 + fq * 8) : zero8;
    {
      f32x4 n0, n1;
#pragma unroll
      for (int jj = 0; jj < 4; ++jj) {
        const int i0 = fq * 8 + jj, i1 = fq * 8 + 4 + jj;
        const float g0 = Gf[(16 + (i0 & 15)) * 33 + fr], g1 = Gf[(16 + (i1 & 15)) * 33 + fr];
        n0[jj] = (fq < 2 && i0 < fr) ? g0 : 0.f;
        n1[jj] = (fq < 2 && i1 < fr) ? g1 : 0.f;
      }
      XA = MFMA16(pack8(n0, n1), vB, XA);
    }
    float* yw = Yf + (w * 16 + fr) * 20;
    *(f32x4*)(yw + fq * 4) = XA;
    float u[16];
    {
      const f32x4 y0 = *(const f32x4*)(yw), y1 = *(const f32x4*)(yw + 4), y2 = *(const f32x4*)(yw + 8), y3 = *(const f32x4*)(yw + 12);
#pragma unroll
      for (int j = 0; j < 4; ++j) { u[j] = y0[j]; u[4 + j] = y1[j]; u[8 + j] = y2[j]; u[12 + j] = y3[j]; }
#pragma unroll
      for (int i = 0; i < 15; ++i) {
#pragma unroll
        for (int t4 = (i + 1) / 4; t4 < 4; ++t4) {
          const f32x4 nn = *(const f32x4*)(GNt + i * 16 + t4 * 4);
#pragma unroll
          for (int e2 = 0; e2 < 4; ++e2) if (t4 * 4 + e2 > i) u[t4 * 4 + e2] += u[i] * nn[e2];
        }
      }
    }
    f32x4 uq;
#pragma unroll
    for (int j = 0; j < 4; ++j) uq[j] = fq == 0 ? u[j] : (fq == 1 ? u[4 + j] : (fq == 2 ? u[8 + j] : u[12 + j]));
    const bf16x8 uB = pack4z(uq);
    {
      f32x4 m0, n0, n1;
#pragma unroll
      for (int jj = 0; jj < 4; ++jj) {
        const int i = fq * 4 + jj;
        const float gm = Gf[i * 33 + 16 + fr];
        m0[jj] = i <= fr ? gm : 0.f;
        const int i0 = fq * 8 + jj, i1 = fq * 8 + 4 + jj;
        const float g0 = Gf[(16 + (i0 & 15)) * 33 + 16 + fr], g1 = Gf[(16 + (i1 & 15)) * 33 + 16 + fr];
        n0[jj] = (fq < 2 && i0 <= fr) ? g0 : 0.f;
        n1[jj] = (fq < 2 && i1 <= fr) ? g1 : 0.f;
      }
      XR = MFMA16(pack4z(m0), uB, XR);
      XR = MFMA16(pack8(n0, n1), vB, XR);
#pragma unroll
      for (int r = 0; r < 4; ++r) obuf[(fq * 4 + r) * 64 + 16 * w + fr] = XR[r];
    }
#pragma unroll
    for (int kt = 0; kt < 4; ++kt) {
      const bf16_t* bk = BKt + (kt * 16 + fr) * 40;
      const s16x4 lo = *(const s16x4*)(bk + fq * 4);
      const s16x4 z4 = {0, 0, 0, 0};
      ST[kt] = MFMA16(__builtin_shufflevector(lo, z4, 0, 1, 2, 3, 4, 5, 6, 7), uB, ST[kt]);
      const bf16x8 a5 = fq < 2 ? *(const bf16x8*)(bk + 16 + fq * 8) : zero8;
      ST[kt] = MFMA16(a5, vB, ST[kt]);
      ST[kt] *= *(const f32x4*)(WL + kt * 16 + fq * 4);
    }
    }
    __syncthreads();
    if (ch >= 16 || need_ctx) {
      int rowbase, t, L;
      chunk_tok(ch, pj, rowbase, t, L);
      const f32x4 ov = *(const f32x4*)(obuf + pj * 64 + pcg * 4);
      st4bf(p.Os + ((size_t)dir * NTOK + rowbase + t) * 512 + hd * 64 + pcg * 4, ov);
    }
  }
  __syncthreads();
}

DI void mixer_phase(const Params& p, int l, bool need_ctx, char* lds, long long* scan_t) {
  int& s_item = *(int*)(lds + LDS_WORK + 16);
  sg_phase(p, l);
  { long long t0 = 0; if (PROBE_MASK) t0 = wall_clock64();
    __builtin_amdgcn_s_setprio(3);
    for (int s = blockIdx.x; s < 256; s += gridDim.x) scan_block3(p, l, s, need_ctx, lds);
    __builtin_amdgcn_s_setprio(0);
#ifdef SCAN_ALONE
    if (blockIdx.x < 256) { __syncthreads(); if (tid_() == 0) { __threadfence(); atomicAdd(&p.counters[8 + l], 1u); } }
    else { if (tid_() == 0) { while (atomicAdd(&p.counters[8 + l], 0u) < 256u) __builtin_amdgcn_s_sleep(32); } __syncthreads(); }
#endif
    if ((PROBE_MASK >> 13) & 1) *scan_t += wall_clock64() - t0; }
  const int nitems = 4096 + (need_ctx ? 512 : 0);
  while (true) {
    __syncthreads();
    if (tid_() == 0) s_item = (int)atomicAdd(&p.counters[l], 1u);
    __syncthreads();
    const int it = s_item;
    if (it >= nitems) break;
    if (it < 2048) {
      const int b = it >> 7, head = (it >> 4) & 7, qb = it & 15, kvh = head >> 2;
      dense_item(p, b * TL + qb * 128, head * 64, b * TL, 32, NTL + b * TC, 512 + kvh * 64, 640 + kvh * 64, lds);
    } else if (it < 4096) {
      const int i2 = it - 2048;
      const int b = i2 >> 7, gr = (i2 >> 2) & 31, hp = i2 & 3;
      na_item(p, l, b, gr, hp, lds);
    } else if (it < 4352) {
      const int i2 = it - 4096;
      const int b = i2 >> 4, head = (i2 >> 1) & 7, qb = i2 & 1, kvh = head >> 2;
      dense_item(p, NTL + b * TC + qb * 128, head * 64, 0, 0, NTL + b * TC, 512 + kvh * 64, 640 + kvh * 64, lds);
    } else {
      const int i2 = it - 4352;
      const int b = i2 >> 4, head = (i2 >> 1) & 7, qb = i2 & 1;
      dense_item(p, NTL + b * TC + qb * 128, 2688 + head * 64, 0, 0, NTL + b * TC, 3200 + head * 64, 3712 + head * 64, lds);
    }
  }
}

template <int MI>
DI void merge_phaseT(const Params& p, int l, int M, char* lds) {
  const int ntm = M / (MI * 32), ntn = 8;
  const int lane = tid_() & 63, wid = tid_() >> 6, wr = wid >> 1, wc = wid & 1, fr = lane & 15, fq = lane >> 4;
  const bf16_t* wm = p.WM + (size_t)l * WM_STRIDE;
  int tm, tn;
  for (int it = 0; xcd_tile<2, 8>(it, ntm, ntn, tm, tn); ++it) {
    const size_t grow = (size_t)tm * (MI * 32);
#pragma unroll 1
    for (int z = 0; z < 3; ++z) {
      f32x4 acc[MI][4];
#pragma unroll
      for (int mi = 0; mi < MI; ++mi)
#pragma unroll
        for (int ni = 0; ni < 4; ++ni) acc[mi][ni] = (f32x4){0.f, 0.f, 0.f, 0.f};
      gemm_mainloopT<MI>(p.U + grow * DM, DM, wm + WM_IN + (size_t)(DPROJ + z * DM + tn * 128) * DM, DM, acc, lds);
      {
      bf16_t* prow;
      { const int t2 = tid_(), l2 = t2 & 63, w2 = t2 >> 6; prow = p.P + (grow + (w2 >> 1) * (MI * 16) + (l2 & 15)) * DPROJ + tn * 128 + (w2 & 1) * 64 + (l2 >> 4) * 4; }
#pragma unroll
      for (int mi = 0; mi < MI; ++mi) {
#pragma unroll
        for (int ni = 0; ni < 4; ++ni) {
          f32x4 g;
#pragma unroll
          for (int j = 0; j < 4; ++j) g[j] = sigmoidf_(acc[mi][ni][j]);
          st4bf(prow + (size_t)(mi * 16) * DPROJ + 512 + ni * 16, g);
          acc[mi][ni] = (f32x4){0.f, 0.f, 0.f, 0.f};
        }
        asm volatile("" ::: "memory");
      }
      }
      const bf16_t* Ya = z == 1 ? p.yr : (z == 0 ? p.P : p.P + 2688);
      const int lda = z == 1 ? 512 : DPROJ;
      gemm_mainloopT<MI>(Ya + grow * lda, lda, wm + WM_BR + (size_t)z * 1024 * 512 + (size_t)tn * 128 * 512, 512, acc, lds);
      {
      bf16_t* prow;
      { const int t2 = tid_(), l2 = t2 & 63, w2 = t2 >> 6; prow = p.P + (grow + (w2 >> 1) * (MI * 16) + (l2 & 15)) * DPROJ + tn * 128 + (w2 & 1) * 64 + (l2 >> 4) * 4; }
#pragma unroll
      for (int mi = 0; mi < MI; ++mi) {
#pragma unroll
        for (int ni = 0; ni < 4; ++ni) {
          bf16_t* q = prow + (size_t)(mi * 16) * DPROJ + ni * 16;
          f32x4 mn = ld4bf(q + 512) * acc[mi][ni];
          if (z > 0) mn += ld4bf(q + 3200);
          st4bf(q + 3200, mn);
        }
        asm volatile("" ::: "memory");
      }
      }
    }
  }
}

DI void merge_phase(const Params& p, int l, int row0, int M, char* lds) {
  const int ntm = M >> 7, ntn = 8;
  const int lane = tid_() & 63, wid = tid_() >> 6, wr = wid >> 1, wc = wid & 1, fr = lane & 15, fq = lane >> 4;
  const bf16_t* wm = p.WM + (size_t)l * WM_STRIDE;
  int tm, tn;
  for (int it = 0; xcd_tile<2, 8>(it, ntm, ntn, tm, tn); ++it) {
    const size_t grow = (size_t)row0 + tm * 128;
#pragma unroll 1
    for (int z = 0; z < 3; ++z) {
      u32x2 gp[4][4];
      {
        f32x4 acc[4][4];
        zero_acc(acc);
        gemm_mainloop2(p.U + grow * DM, DM, wm + WM_IN + (size_t)(DPROJ + z * DM + tn * 128) * DM, DM, acc, lds);
#pragma unroll
        for (int mi = 0; mi < 4; ++mi)
#pragma unroll
          for (int ni = 0; ni < 4; ++ni) {
            gp[mi][ni].x = pk2(sigmoidf_(acc[mi][ni][0]), sigmoidf_(acc[mi][ni][1]));
            gp[mi][ni].y = pk2(sigmoidf_(acc[mi][ni][2]), sigmoidf_(acc[mi][ni][3]));
          }
      }
      {
        f32x4 acc[4][4];
        zero_acc(acc);
        const bf16_t* Ya = z == 1 ? p.yr : (z == 0 ? p.P : p.P + 2688);
        const int lda = z == 1 ? 512 : DPROJ;
        gemm_mainloop2(Ya + grow * lda, lda, wm + WM_BR + (size_t)z * 1024 * 512 + (size_t)tn * 128 * 512, 512, acc, lds);
#pragma unroll
        for (int mi = 0; mi < 4; ++mi)
#pragma unroll
          for (int ni = 0; ni < 4; ++ni) asm volatile("" : "+v"(gp[mi][ni].x), "+v"(gp[mi][ni].y));
#pragma unroll
        for (int mi = 0; mi < 4; ++mi) {
          const int row = tm * 128 + wr * 64 + mi * 16 + fr;
#pragma unroll
          for (int ni = 0; ni < 4; ++ni) {
            bf16_t* mp = p.P + (grow + wr * 64 + mi * 16 + fr) * DPROJ + 3200 + tn * 128 + wc * 64 + ni * 16 + fq * 4;
            const f32x4 g = {bflo(gp[mi][ni].x), bfhi(gp[mi][ni].x), bflo(gp[mi][ni].y), bfhi(gp[mi][ni].y)};
            f32x4 mn = g * acc[mi][ni];
            if (z > 0) mn += ld4bf(mp);
            st4bf(mp, mn);
          }
        }
      }
    }
  }
}

#define MAKE_LN_EPI(MI_, e, WHICH, SRC_LAT, SRC_CTX)                                                                    \
  EpiResidLN<MI_> e;                                                                                                        \
  {                                                                                                                    \
    const float* mods_l_ = p.mods + (size_t)l * 17 * NMOD;                                                             \
    e.src_lat = (SRC_LAT); e.src_ctx = (SRC_CTX); e.dst_lat = p.out; e.dst_ctx = p.ctxx;                               \
    e.gate = mods_l_ + ((WHICH) * 3 + 2) * DM;                                                                         \
    e.gmul = (WHICH) == 1 ? 1.f : 0.5f;                                                                                \
    e.lng = p.ln_g + (l * 3 + (WHICH)) * DM; e.lnb = p.ln_b + (l * 3 + (WHICH)) * DM;                                  \
    e.mods_next = (WHICH) < 2 ? mods_l_ : p.mods + (size_t)(l == 0 ? 1 : 0) * 17 * NMOD;                               \
    e.shift_idx = (WHICH) < 2 ? (WHICH) * 3 + 3 : 0;                                                                   \
    e.U = ((WHICH) < 2 || l == 0) ? p.U : nullptr;                                                                     \
    e.stats = p.stats; e.cnt = p.lncnt + (l * 3 + (WHICH)) * 288;                                                      \
  }

template <int S>
DI void layer_step(const Params& p, int l, char* lds, long long* scan_t = nullptr) {
  const bool last = l == 1;
  const bool need_ctx = !last;
  const int Mall = NTOK, Mx = need_ctx ? NTOK : NTL;
  const bf16_t* wm = p.WM + (size_t)l * WM_STRIDE;
  if constexpr (S == 0) {
    EpiAct<8> e; e.H = p.H;
    gemm_phaseT<8, 8, 4>(p.U, DM, Mall, 0, p.WF, DM, 2 * DFF, e, lds);
  } else if constexpr (S == 1) {
    MAKE_LN_EPI(6, e, 0, l == 0 ? p.x_in : p.out, l == 0 ? p.ctx_in : p.ctxx)
    gemm_phaseT<6, 8, 8, true>(p.H, LDH, Mall, 0, p.WF + WF_WO, DFF, DM, e, lds, LDH);
  } else if constexpr (S == 3) {
    EpiProj<8> e; e.p = &p; e.l = l;
    gemm_phaseT<8, 8, 3>(p.U, DM, Mall, 0, wm + WM_IN, DM, DPROJ, e, lds);
  } else if constexpr (S == 4) {
    mixer_phase(p, l, need_ctx, lds, scan_t);
  } else if constexpr (S == 5) {
    EpiReadout e; e.p = &p; e.l = l;
    gemm_phase(p.sg, 128, Mx, p.g2 + (size_t)l * 128 * 512, 512, 128, 512, MapHeadPerm(), e, lds);
  } else if constexpr (S == 9) {
    EpiAct<8> e; e.H = p.H;
    gemm_phaseT<8, 8, 4>(p.U, DM, Mx, 0, p.WF + WF_SLOT, DM, 2 * DFF, e, lds);
  } else if constexpr (S == 10) {
    if (need_ctx) {
      MAKE_LN_EPI(6, e, 2, p.out, p.ctxx)
      gemm_phaseT<6, 8, 8, true>(p.H, LDH, NTOK, 0, p.WF + WF_SLOT + WF_WO, DFF, DM, e, lds, LDH);
    } else {
      MAKE_LN_EPI(8, e, 2, p.out, p.ctxx)
      gemm_phaseT<8, 8, 8, true>(p.H, LDH, NTL, 0, p.WF + WF_SLOT + WF_WO, DFF, DM, e, lds, LDH);
    }
    if (!last) convert_ffn(p, 0, p.ffn1_wi + (size_t)(l + 1) * DM * 2 * DFF, p.ffn1_wo + (size_t)(l + 1) * DFF * DM, lds);
  }
}

template <int S>
DI void merge_step(const Params& p, int l, char* lds) {
  const int Mx = l == 0 ? NTOK : NTL;
  const bf16_t* wm = p.WM + (size_t)l * WM_STRIDE;
  if constexpr (S == 0) {
    if (l == 0) merge_phase(p, l, 0, NTOK, lds); else merge_phaseT<8>(p, l, NTL, lds);
  } else {
    if (l == 0) {
      MAKE_LN_EPI(6, e, 1, p.out, p.ctxx)
      gemm_phaseT<6, 8, 8>(p.P + 3200, DPROJ, NTOK, 0, wm + WM_OUT, DM, DM, e, lds);
    } else {
      MAKE_LN_EPI(8, e, 1, p.out, p.ctxx)
      gemm_phaseT<8, 8, 8>(p.P + 3200, DPROJ, NTL, 0, wm + WM_OUT, DM, DM, e, lds);
    }
    convert_ffn(p, 1, p.ffn2_wi + (size_t)l * DM * 2 * DFF, p.ffn2_wo + (size_t)l * DFF * DM, lds);
  }
}

#define XB_TMO      128
#define XB_XCNT(j)  (256  + 64 * (j))
#define XB_XSUB(j)  (1280 + 64 * (j))
#define XB_XGEN(j)  (2304 + 64 * (j))
#define XB_TOP      3328
#define XB_TOPGEN   3392
#define XCD_BAR_WORDS 3456
#define XB_SPIN_CAP (1u << 18)
DI unsigned xb_ld(unsigned* p) { return __hip_atomic_load(p, __ATOMIC_RELAXED, __HIP_MEMORY_SCOPE_AGENT); }
DI unsigned xb_add(unsigned* p, unsigned v) { return __hip_atomic_fetch_add(p, v, __ATOMIC_RELAXED, __HIP_MEMORY_SCOPE_AGENT); }
DI unsigned xb_xcc_id() { return (unsigned)__builtin_amdgcn_s_getreg((3 << 11) | 20) & 0xFu; }
#define XB_SPIN(cond, bar) do { unsigned _sp = 0; while (cond) { __builtin_amdgcn_s_sleep(1); \
    if ((++_sp & 255u) == 0u) { if (xb_ld(&(bar)[XB_TMO])) break; if (_sp > XB_SPIN_CAP) { atomicAdd(&(bar)[XB_TMO], 1u); break; } } } } while (0)
struct XcdBarrier { unsigned* bar; unsigned x; volatile LAS unsigned* st; };
DI XcdBarrier xcd_barrier_post(unsigned* bar, volatile LAS unsigned* st) {
  XcdBarrier b; b.bar = bar; b.x = xb_xcc_id(); b.st = st;
  if (threadIdx.x == 0) (void)xb_add(&bar[XB_XCNT(b.x)], 1u);
  return b;
}
DI void xcd_barrier_complete(unsigned* bar, unsigned x, unsigned& nloc, unsigned& nx) {
  const unsigned G = gridDim.x * gridDim.y * gridDim.z;
  unsigned sum, cnt, mine, sp = 0u;
  for (;;) {
    sum = 0u; cnt = 0u; mine = 0u;
#pragma unroll
    for (unsigned j = 0; j < 16; ++j) { const unsigned c = xb_ld(&bar[XB_XCNT(j)]); sum += c; cnt += (c > 0u) ? 1u : 0u; mine = (j == x) ? c : mine; }
    if (sum == G) break;
    __builtin_amdgcn_s_sleep(1);
    if ((++sp & 255u) == 0u) { if (xb_ld(&bar[XB_TMO])) break; if (sp > XB_SPIN_CAP) { atomicAdd(&bar[XB_TMO], 1u); break; } }
  }
  nloc = mine > 0u ? mine : 1u; nx = cnt > 0u ? cnt : 1u;
}
DI void xcd_barrier(const XcdBarrier& b) {
  asm volatile("s_waitcnt vmcnt(0)" ::: "memory");
  __syncthreads();
  if (threadIdx.x == 0) {
    unsigned* bar = b.bar;
    __builtin_amdgcn_s_waitcnt(0);
    unsigned nloc = b.st[0], nx = b.st[1];
    if (nloc == 0u) { xcd_barrier_complete(bar, b.x, nloc, nx); b.st[0] = nloc; b.st[1] = nx; }
    const unsigned old = xb_add(&bar[XB_XSUB(b.x)], 1u);
    const unsigned gen = old / nloc;
    if (old + 1u == (gen + 1u) * nloc) {
      __builtin_amdgcn_fence(__ATOMIC_RELEASE, "agent");
      asm volatile("s_waitcnt vmcnt(0)" ::: "memory");
      const unsigned og = xb_add(&bar[XB_TOP], 1u);
      const unsigned tg = og / nx;
      if (og + 1u == (tg + 1u) * nx) xb_add(&bar[XB_TOPGEN], 1u);
      else XB_SPIN(xb_ld(&bar[XB_TOPGEN]) == tg, bar);
      __builtin_amdgcn_fence(__ATOMIC_ACQUIRE, "agent");
      xb_add(&bar[XB_XGEN(b.x)], 1u);
      asm volatile("s_waitcnt vmcnt(0)" ::: "memory");
    } else {
      XB_SPIN(xb_ld(&bar[XB_XGEN(b.x)]) == gen, bar);
      __builtin_amdgcn_fence(__ATOMIC_ACQUIRE, "agent");
      asm volatile("s_waitcnt vmcnt(0)" ::: "memory");
    }
  }
  __syncthreads();
}

#define TIMED(id, ...) { long long _t0 = 0; if (PROBE_MASK) _t0 = wall_clock64(); __VA_ARGS__; if ((PROBE_MASK >> (id)) & 1) probe_t += wall_clock64() - _t0; }
__global__ void __launch_bounds__(NTHREADS, 2) fwd_megakernel(Params p) {
  __shared__ __attribute__((aligned(16))) char lds[LDS_BYTES];
  cg::grid_group grid = cg::this_grid();
  long long probe_t = 0;
  if (threadIdx.x == 0) *(u32x4*)(lds + LDS_WORK) = (u32x4){0u, 0u, 0u, 0u};
  __syncthreads();
  (void)xcd_barrier_post(p.bar, (volatile LAS unsigned*)(LAS char*)(lds + LDS_WORK));
#define GSYNC() do { XcdBarrier xb_; xb_.bar = p.bar; xb_.x = xb_xcc_id(); xb_.st = (volatile LAS unsigned*)(LAS char*)(lds + LDS_WORK); xcd_barrier(xb_); } while (0)
  TIMED(0, mods_phase(p, lds);
  convert_ffn(p, 0, p.ffn1_wi, p.ffn1_wo, lds);
  convert_mixer(p, 0, lds);
  convert_mixer(p, 1, lds);
  if (p.bar == nullptr) grid.sync();
  GSYNC();
  u0_phase(p);
  GSYNC();)
#pragma unroll 1
  for (int l = 0; l < 2; ++l) {
    TIMED(1, layer_step<0>(p, l, lds); GSYNC();)
    TIMED(2, layer_step<1>(p, l, lds); GSYNC();)
    TIMED(4, layer_step<3>(p, l, lds); GSYNC();)
    TIMED(5, layer_step<4>(p, l, lds, &probe_t); GSYNC();)
    TIMED(6, layer_step<5>(p, l, lds); GSYNC();)
    TIMED(7, merge_step<0>(p, l, lds); GSYNC();)
    TIMED(8, merge_step<1>(p, l, lds); GSYNC();)
    TIMED(10, layer_step<9>(p, l, lds); GSYNC();)
    TIMED(11, layer_step<10>(p, l, lds);
    if (l == 0) GSYNC();)
  }
  if (PROBE_MASK) {
    if (blockIdx.x == 0 && threadIdx.x == 0) {
      const long long t1 = wall_clock64();
      while (wall_clock64() - t1 < probe_t) __builtin_amdgcn_s_sleep(8);
    }
  }
}

extern "C" void kernel_launch(void* const* d_in, const int* in_sizes, int n_in, void* d_out, int out_size, void* d_ws, size_t ws_size,
                              hipStream_t stream) {
  static int grid_blocks = 0;
  if (!grid_blocks) {
    int dev = 0, cus = 0, per_cu = 0;
    hipGetDevice(&dev);
    hipDeviceGetAttribute(&cus, hipDeviceAttributeMultiprocessorCount, dev);
    hipOccupancyMaxActiveBlocksPerMultiprocessor(&per_cu, fwd_megakernel, NTHREADS, 0);
    if (per_cu < 1) per_cu = 1;
    grid_blocks = cus * per_cu;
  }
  Params p{};
  const float* const* in = (const float* const*)d_in;
  p.x_in = in[0]; p.c = in[1]; p.ctx_in = in[2]; p.c_ctx = in[3]; p.w_ada = in[4]; p.b_ada = in[5];
  p.ffn1_wi = in[6]; p.ffn1_wo = in[7]; p.ffn2_wi = in[8]; p.ffn2_wo = in[9]; p.ln_g = in[10]; p.ln_b = in[11]; p.w_in = in[12];
  p.q_gain = in[13]; p.k_gain = in[14]; p.mu = in[15]; p.w0 = in[16]; p.w2 = in[17]; p.a0 = in[18]; p.a2 = in[19]; p.g2 = in[20];
  p.k_k = in[21]; p.k_a = in[22]; p.r_k = in[23]; p.gn_g = in[24]; p.gn_b = in[25]; p.rpb = in[26]; p.w_branch = in[27]; p.w_out = in[28];
  p.out = (float*)d_out;
  char* ws = (char*)d_ws;
  const size_t MiB = 1ull << 20;
  p.counters = (unsigned*)ws;
  p.rope = (float*)(ws + 4096);
  p.lncnt = (unsigned*)(ws + 16384);
  p.bar = (unsigned*)(ws + 24576);
  hipMemsetAsync(ws + 24576, 0, XCD_BAR_WORDS * sizeof(unsigned), stream);
  p.stats = (float*)(ws + 507 * MiB);
  p.mods = (float*)(ws + 65536);
  p.ctxx = (float*)(ws + 2 * MiB);
  p.U = (bf16_t*)(ws + 18 * MiB);
  p.H = (bf16_t*)(ws + 90 * MiB);
  p.P = (bf16_t*)(ws + 90 * MiB);
  p.Os = (bf16_t*)(ws + 387 * MiB);
  p.yr = (bf16_t*)(ws + 387 * MiB);
  p.Mg = (bf16_t*)(ws + 423 * MiB);
  p.sg = (bf16_t*)(ws + 459 * MiB);
  p.WM = (bf16_t*)(ws + 468 * MiB);
  p.WF = (bf16_t*)(ws + 423 * MiB);
  if (ws_size < 512 * MiB) fprintf(stderr, "workspace too small: %zu\n", ws_size);
  void* args[] = {&p};
  hipError_t e = hipLaunchCooperativeKernel((void*)fwd_megakernel, dim3(grid_blocks), dim3(NTHREADS), args, 0, stream);
  if (e != hipSuccess) fprintf(stderr, "cooperative launch failed: %s (grid %d)\n", hipGetErrorString(e), grid_blocks);
}
```

```cpp
#include <hip/hip_runtime.h>
#include <hip/hip_cooperative_groups.h>
#include <cstdio>
#include <cstdint>
namespace cg = cooperative_groups;
#ifndef PROBE_MASK
#define PROBE_MASK 0
#endif

#define DI __device__ __forceinline__
typedef unsigned short bf16_t;
typedef short bf16x8 __attribute__((ext_vector_type(8)));
typedef short s16x4 __attribute__((ext_vector_type(4)));
typedef float f32x2 __attribute__((ext_vector_type(2)));
typedef float f32x4 __attribute__((ext_vector_type(4)));
typedef float f32x16 __attribute__((ext_vector_type(16)));
typedef unsigned u32x2 __attribute__((ext_vector_type(2)));
typedef unsigned u32x4 __attribute__((ext_vector_type(4)));
typedef __bf16 nbf16x2 __attribute__((ext_vector_type(2)));

constexpr int DM = 1024, NB = 16, TL = 2048, TC = 256;
constexpr int NTL = NB * TL, NTC = NB * TC, NTOK = NTL + NTC;
constexpr int DFF = 2816, DIN = 7296, DPROJ = 4224;
constexpr int LDH = 2880;
constexpr int NMOD = 9 * DM;
constexpr float LOG2E = 1.4426950408889634f;
constexpr float QSCALE = 0.125f * LOG2E;
constexpr float ALPHA = 1.4142135623730951f;
constexpr int LDS_WORK = 73728;
constexpr int LDS_BYTES = LDS_WORK + 64;
constexpr size_t WM_IN = 0, WM_BR = (size_t)7296 * 1024, WM_OUT = WM_BR + 3 * 1024 * 512, WM_STRIDE = WM_OUT + 1024 * 1024;
constexpr size_t WF_WO = (size_t)2 * 2816 * 1024, WF_SLOT = (size_t)17 * 1024 * 1024 / 2;
constexpr int NTHREADS = 256;

struct Params {
  const float *x_in, *c, *ctx_in, *c_ctx, *w_ada, *b_ada, *ffn1_wi, *ffn1_wo, *ffn2_wi, *ffn2_wo, *ln_g, *ln_b, *w_in,
      *q_gain, *k_gain, *mu, *w0, *w2, *a0, *a2, *g2, *k_k, *k_a, *r_k, *gn_g, *gn_b, *rpb, *w_branch, *w_out;
  float* out;
  float* mods;
  float* rope;
  float* ctxx;
  unsigned* counters;
  bf16_t *U, *H, *P, *Os, *yr, *Mg, *sg, *WF, *WM;
  float* stats;
  unsigned* lncnt;
  unsigned* bar;
};

DI int tid_() { int t = threadIdx.x; asm volatile("" : "+v"(t)); return t; }
DI unsigned pk2(float a, float b) { f32x2 v = {a, b}; nbf16x2 r = __builtin_convertvector(v, nbf16x2); return __builtin_bit_cast(unsigned, r); }
DI bf16_t f2bf(float a) { return (bf16_t)(pk2(a, 0.f) & 0xffffu); }
DI float bflo(unsigned u) { return __uint_as_float(u << 16); }
DI float bfhi(unsigned u) { return __uint_as_float(u & 0xffff0000u); }
DI f32x4 ld4bf(const bf16_t* p) { u32x2 v = *(const u32x2*)p; return (f32x4){bflo(v.x), bfhi(v.x), bflo(v.y), bfhi(v.y)}; }
DI void st4bf(bf16_t* p, f32x4 v) { u32x2 o; o.x = pk2(v[0], v[1]); o.y = pk2(v[2], v[3]); *(u32x2*)p = o; }
DI float sigmoidf_(float x) { return __builtin_amdgcn_rcpf(1.f + __expf(-x)); }
DI float siluf_(float x) { return x * __builtin_amdgcn_rcpf(1.f + __expf(-x)); }
DI int mod_row(int row) { return row < NTL ? (row >> 11) : 16; }

constexpr int LDT = 72;

struct MapPlain { DI int operator()(int tn, int cl) const { return tn * 128 + cl; } };
struct MapHeadPerm { DI int operator()(int tn, int cl) const { return tn * 128 + (cl & 64) + ((cl >> 2) & 3) * 16 + ((cl >> 4) & 3) * 4; } };
struct MapGateUp { DI int operator()(int tn, int cl) const { int sub = cl >> 4, j = cl & 15; return ((sub & 1) ? DFF : 0) + tn * 64 + (sub >> 1) * 16 + j; } };

template <class BMap>
DI void gemm_mainloop(const bf16_t* __restrict__ A, int lda, const float* __restrict__ B, int ldb, int K, int tn, BMap bmap,
                      f32x4 (&acc)[4][4], char* lds) {
  bf16_t* As = (bf16_t*)lds;
  bf16_t* Bs = As + 128 * LDT;
  const int tid = tid_(), lane = tid & 63, wid = tid >> 6, wr = wid >> 1, wc = wid & 1;
  const int fr = lane & 15, fq = lane >> 4;
  const int arow = tid >> 3, akc = tid & 7;
  const int kg = tid >> 5, ng = tid & 31;
  const bf16_t* ap = A + (size_t)arow * lda + akc * 8;
  const float* bp = B + (size_t)(kg * 8) * ldb + bmap(tn, ng * 4);
  u32x4 ra[4];
  f32x4 rb[8];
  const int nk = K >> 6;
#pragma unroll
  for (int i = 0; i < 4; ++i) ra[i] = *(const u32x4*)(ap + (size_t)(i * 32) * lda);
#pragma unroll
  for (int i = 0; i < 8; ++i) rb[i] = *(const f32x4*)(bp + (size_t)i * ldb);
#pragma unroll 1
  for (int kt = 0; kt < nk; ++kt) {
    __syncthreads();
#pragma unroll
    for (int i = 0; i < 4; ++i) *(u32x4*)(As + (arow + i * 32) * LDT + akc * 8) = ra[i];
#pragma unroll
    for (int jn = 0; jn < 4; ++jn) {
      u32x4 w;
      w.x = pk2(rb[0][jn], rb[1][jn]); w.y = pk2(rb[2][jn], rb[3][jn]); w.z = pk2(rb[4][jn], rb[5][jn]); w.w = pk2(rb[6][jn], rb[7][jn]);
      *(u32x4*)(Bs + (ng * 4 + jn) * LDT + kg * 8) = w;
    }
    __syncthreads();
    if (kt + 1 < nk) {
      const bf16_t* ap2 = ap + (kt + 1) * 64;
      const float* bp2 = bp + (size_t)((kt + 1) * 64) * ldb;
#pragma unroll
      for (int i = 0; i < 4; ++i) ra[i] = *(const u32x4*)(ap2 + (size_t)(i * 32) * lda);
#pragma unroll
      for (int i = 0; i < 8; ++i) rb[i] = *(const f32x4*)(bp2 + (size_t)i * ldb);
    }
#pragma unroll
    for (int ks = 0; ks < 2; ++ks) {
      bf16x8 af[4], bfr[4];
#pragma unroll
      for (int mi = 0; mi < 4; ++mi) af[mi] = *(const bf16x8*)(As + (wr * 64 + mi * 16 + fr) * LDT + ks * 32 + fq * 8);
#pragma unroll
      for (int ni = 0; ni < 4; ++ni) bfr[ni] = *(const bf16x8*)(Bs + (wc * 64 + ni * 16 + fr) * LDT + ks * 32 + fq * 8);
#pragma unroll
      for (int mi = 0; mi < 4; ++mi)
#pragma unroll
        for (int ni = 0; ni < 4; ++ni) acc[mi][ni] = __builtin_amdgcn_mfma_f32_16x16x32_bf16(bfr[ni], af[mi], acc[mi][ni], 0, 0, 0);
    }
  }
  __syncthreads();
}

DI void zero_acc(f32x4 (&acc)[4][4]) {
#pragma unroll
  for (int mi = 0; mi < 4; ++mi)
#pragma unroll
    for (int ni = 0; ni < 4; ++ni) acc[mi][ni] = (f32x4){0.f, 0.f, 0.f, 0.f};
}

DI void tile_coords(int tile, int ntm, int ntn, int& tm, int& tn) {
  const int per = 8 * ntn;
  const int g = tile / per, rem = tile - g * per;
  const int gsz = (ntm - g * 8) < 8 ? (ntm - g * 8) : 8;
  tm = g * 8 + rem % gsz;
  tn = rem / gsz;
}

template <class BMap, class Epi>
DI void gemm_phase(const bf16_t* A, int lda, int M, const float* B, int ldb, int K, int N, BMap bmap, const Epi& epi, char* lds) {
  const int ntm = M >> 7, ntn = N >> 7, nt = ntm * ntn;
  const int lane = tid_() & 63, wid = tid_() >> 6;
  for (int tile = blockIdx.x; tile < nt; tile += gridDim.x) {
    int tm, tn;
    tile_coords(tile, ntm, ntn, tm, tn);
    f32x4 acc[4][4];
    zero_acc(acc);
    gemm_mainloop(A + (size_t)tm * 128 * lda, lda, B, ldb, K, tn, bmap, acc, lds);
    epi(tm, tn, wid >> 1, wid & 1, lane, acc);
  }
}

DI int lds_byte(int r, int c) { const int st = (r >> 4) * 2 + (c >> 5), rr = r & 15, cc = c & 31, ob = rr * 64 + cc * 2; return st * 1024 + (ob ^ (((ob >> 9) & 1) << 5)); }
DI void stage_rc(int b, int& R, int& C) { const int st = b >> 10, sb = b & 1023, swz = sb ^ (((sb >> 9) & 1) << 5); R = (st >> 1) * 16 + (swz >> 6); C = (st & 1) * 32 + ((swz & 63) >> 1); }
#define LAS __attribute__((address_space(3)))
DI void glds16(const bf16_t* g, LAS char* l) { __builtin_amdgcn_global_load_lds((const unsigned*)g, (LAS unsigned*)l, 16, 0, 0); }

DI int lds_byte32(int r, int c) { const int ob = (r & 15) * 64 + c * 2; return (r >> 4) * 1024 + (ob ^ (((ob >> 9) & 1) << 5)); }
DI void stage_rc32(int b, int& R, int& C) { const int st = b >> 10, sb = b & 1023, swz = sb ^ (((sb >> 9) & 1) << 5); R = st * 16 + (swz >> 6); C = (swz & 63) >> 1; }

template <int MI>
DI void gemm_mainloopT(const bf16_t* __restrict__ A, int lda, const bf16_t* __restrict__ Bt, int K, f32x4 (&acc)[MI][4], char* lds_generic, int ldb = 0) {
  if (ldb == 0) ldb = K;
  static_assert(MI == 4 || MI == 6 || MI == 8, "MI");
  constexpr int NA = MI / 2;
  constexpr int G = NA + 2;
  constexpr int NST = MI == 4 ? 4 : 3;
  constexpr int ABYTES = MI * 2048, SBYTES = ABYTES + 8192;
  LAS char* lds = (LAS char*)lds_generic;
  const int tid = tid_(), lane = tid & 63, wid = tid >> 6, wr = wid >> 1, wc = wid & 1;
  const int fr = lane & 15, fq = lane >> 4;
  const bf16_t* ap[NA];
  const bf16_t* bp[2];
#pragma unroll
  for (int i = 0; i < NA; ++i) { int R, C; stage_rc32(tid * 16 + i * 4096, R, C); ap[i] = A + (size_t)R * lda + C; }
#pragma unroll
  for (int i = 0; i < 2; ++i) { int R, C; stage_rc32(tid * 16 + i * 4096, R, C); bp[i] = Bt + (size_t)R * ldb + C; }
  LAS char* lt = lds + tid * 16;
  const int nk = K >> 5;
  __syncthreads();
#pragma unroll
  for (int s = 0; s < NST - 1; ++s) {
#pragma unroll
    for (int i = 0; i < NA; ++i) glds16(ap[i] + s * 32, lt + s * SBYTES + i * 4096);
#pragma unroll
    for (int i = 0; i < 2; ++i) glds16(bp[i] + s * 32, lt + s * SBYTES + ABYTES + i * 4096);
  }
  int offA[MI], offB[4];
#pragma unroll
  for (int i = 0; i < MI; ++i) offA[i] = lds_byte32(wr * MI * 16 + i * 16 + fr, fq * 8);
#pragma unroll
  for (int i = 0; i < 4; ++i) offB[i] = ABYTES + lds_byte32(wc * 64 + i * 16 + fr, fq * 8);
  int st_cur = 0, st_nx = NST - 1;
#pragma unroll 1
  for (int kt = 0; kt < nk; ++kt) {
    if (NST == 4) {
      if (kt + 2 < nk) asm volatile("s_waitcnt vmcnt(8)" ::: "memory");
      else if (kt + 1 < nk) asm volatile("s_waitcnt vmcnt(4)" ::: "memory");
      else asm volatile("s_waitcnt vmcnt(0)" ::: "memory");
    } else {
      if (kt + 1 < nk) { if (G == 6) asm volatile("s_waitcnt vmcnt(6)" ::: "memory"); else asm volatile("s_waitcnt vmcnt(5)" ::: "memory"); }
      else asm volatile("s_waitcnt vmcnt(0)" ::: "memory");
    }
    __builtin_amdgcn_s_barrier();
    asm volatile("" ::: "memory");
    if (kt + NST - 1 < nk) {
      LAS char* nx = lt + st_nx * SBYTES;
      const int ko = (kt + NST - 1) * 32;
#pragma unroll
      for (int i = 0; i < NA; ++i) glds16(ap[i] + ko, nx + i * 4096);
#pragma unroll
      for (int i = 0; i < 2; ++i) glds16(bp[i] + ko, nx + ABYTES + i * 4096);
    }
    const LAS char* cur = lds + st_cur * SBYTES;
    st_cur = st_cur + 1 == NST ? 0 : st_cur + 1;
    st_nx = st_nx + 1 == NST ? 0 : st_nx + 1;
    bf16x8 af[MI], bfr[4];
#pragma unroll
    for (int ni = 0; ni < 4; ++ni) bfr[ni] = *(const LAS bf16x8*)(cur + offB[ni]);
#pragma unroll
    for (int mi = 0; mi < MI; ++mi) af[mi] = *(const LAS bf16x8*)(cur + offA[mi]);
    __builtin_amdgcn_s_setprio(1);
#pragma unroll
    for (int mi = 0; mi < MI; ++mi)
#pragma unroll
      for (int ni = 0; ni < 4; ++ni) acc[mi][ni] = __builtin_amdgcn_mfma_f32_16x16x32_bf16(bfr[ni], af[mi], acc[mi][ni], 0, 0, 0);
    __builtin_amdgcn_s_setprio(0);
  }
}
DI void gemm_mainloop2(const bf16_t* __restrict__ A, int lda, const bf16_t* __restrict__ Bt, int K, f32x4 (&acc)[4][4], char* lds) {
  gemm_mainloopT<4>(A, lda, Bt, K, acc, lds);
}

template <int SM_, int SN>
DI bool xcd_tile(int it, int ntm, int ntn, int& tm, int& tn) {
  const int xcd = blockIdx.x & 7, j = blockIdx.x >> 3, per_xcd = gridDim.x >> 3;
  const int SM = (SM_ * SN != 64 || per_xcd % 64 == 0) ? SM_ : 2;
  const int nsn = ntn / SN, ns = (ntm / SM) * nsn;
  const int idx = it * per_xcd + j;
  const int sl = idx / (SM * SN), w = idx - sl * (SM * SN);
  const int s = sl * 8 + xcd;
  if (s >= ns) return false;
  const int sm = s / nsn, sn = s - sm * nsn;
  tm = sm * SM + w % SM;
  tn = sn * SN + w / SM;
  return true;
}

template <int MI, int SM, int SN, bool REV = false, class Epi>
DI void gemm_phaseT(const bf16_t* A, int lda, int M, int tm0, const bf16_t* Bt, int K, int N, const Epi& epi, char* lds, int ldb = 0) {
  if (ldb == 0) ldb = K;
  const int ntm = M / (MI * 32), ntn = N >> 7;
  const int lane = tid_() & 63, wid = tid_() >> 6;
  int tm, tn;
  for (int it = 0; xcd_tile<SM, SN>(it, ntm, ntn, tm, tn); ++it) {
    if (REV) tm = ntm - 1 - tm;
    f32x4 acc[MI][4];
#pragma unroll
    for (int mi = 0; mi < MI; ++mi)
#pragma unroll
      for (int ni = 0; ni < 4; ++ni) acc[mi][ni] = (f32x4){0.f, 0.f, 0.f, 0.f};
    gemm_mainloopT<MI>(A + (size_t)tm * (MI * 32) * lda, lda, Bt + (size_t)tn * 128 * ldb, K, acc, lds, ldb);
    epi(tm + tm0, tn, wid >> 1, wid & 1, lane, acc);
  }
}
template <int SM, int SN, class Epi>
DI void gemm_phase2(const bf16_t* A, int lda, int M, int tm0, const bf16_t* Bt, int K, int N, const Epi& epi, char* lds) {
  gemm_phaseT<4, SM, SN>(A, lda, M, tm0, Bt, K, N, epi, lds);
}

struct CMapPlain { DI int operator()(int n) const { return n; } };
struct CMapGateUp { DI int operator()(int p) const { const int tn = p >> 7, n = p & 127, wc = n >> 6, ni = (n >> 4) & 3, q = (n >> 2) & 3, j = n & 3; return ((ni & 1) ? DFF : 0) + tn * 64 + wc * 32 + q * 8 + (ni >> 1) * 4 + j; } };
template <class CM>
DI void convert_T(const float* __restrict__ W, int ldw, int K, int N, bf16_t* __restrict__ Wt, CM cm, char* lds, int ldo = 0) {
  if (ldo == 0) ldo = K;
  float* tl = (float*)lds;
  const int tid = tid_();
  const int nkt = K >> 6, nnt = N >> 6;
  for (int t = blockIdx.x; t < nkt * nnt; t += gridDim.x) {
    const int kt = t % nkt, nt = t / nkt;
    __syncthreads();
    const int n4 = (tid & 15) * 4;
    const int sc = cm(nt * 64 + n4);
#pragma unroll
    for (int ps = 0; ps < 4; ++ps) {
      const int kk = ps * 16 + (tid >> 4);
      const f32x4 v = *(const f32x4*)(W + (size_t)(kt * 64 + kk) * ldw + sc);
#pragma unroll
      for (int e = 0; e < 4; ++e) tl[kk * 65 + n4 + e] = v[e];
    }
    __syncthreads();
    const int nn = tid >> 2, kc = (tid & 3) * 16;
    u32x4 o0, o1;
    const float* q = tl + kc * 65 + nn;
    o0.x = pk2(q[0 * 65], q[1 * 65]); o0.y = pk2(q[2 * 65], q[3 * 65]); o0.z = pk2(q[4 * 65], q[5 * 65]); o0.w = pk2(q[6 * 65], q[7 * 65]);
    o1.x = pk2(q[8 * 65], q[9 * 65]); o1.y = pk2(q[10 * 65], q[11 * 65]); o1.z = pk2(q[12 * 65], q[13 * 65]); o1.w = pk2(q[14 * 65], q[15 * 65]);
    bf16_t* d = Wt + (size_t)(nt * 64 + nn) * ldo + kt * 64 + kc;
    *(u32x4*)d = o0;
    *(u32x4*)(d + 8) = o1;
  }
  __syncthreads();
}
DI void convert_ffn(const Params& p, int slot, const float* wi, const float* wo, char* lds) {
  bf16_t* wf = p.WF + slot * WF_SLOT;
  convert_T(wi, 2 * DFF, DM, 2 * DFF, wf, CMapGateUp(), lds);
  convert_T(wo, DM, DFF, DM, wf + WF_WO, CMapPlain(), lds, LDH);
}
DI void convert_mixer(const Params& p, int l, char* lds) {
  bf16_t* wm = p.WM + (size_t)l * WM_STRIDE;
  convert_T(p.w_in + (size_t)l * DM * DIN, DIN, DM, DIN, wm + WM_IN, CMapPlain(), lds);
  for (int z = 0; z < 3; ++z) convert_T(p.w_branch + (size_t)(l * 3 + z) * 512 * DM, DM, 512, DM, wm + WM_BR + (size_t)z * 1024 * 512, CMapPlain(), lds);
  convert_T(p.w_out + (size_t)l * DM * DM, DM, DM, DM, wm + WM_OUT, CMapPlain(), lds);
}

template <int MI>
struct EpiAct {
  bf16_t* H;
  DI void operator()(int tm, int tn, int wr, int wc, int lane, f32x4 (&acc)[MI][4]) const {
    const int fr = lane & 15, fq = lane >> 4;
#pragma unroll
    for (int mi = 0; mi < MI; ++mi) {
      const int row = tm * (MI * 32) + wr * (MI * 16) + mi * 16 + fr;
      f32x4 h0, h1;
#pragma unroll
      for (int j = 0; j < 4; ++j) { h0[j] = siluf_(acc[mi][0][j]) * acc[mi][1][j]; h1[j] = siluf_(acc[mi][2][j]) * acc[mi][3][j]; }
      u32x4 o; o.x = pk2(h0[0], h0[1]); o.y = pk2(h0[2], h0[3]); o.z = pk2(h1[0], h1[1]); o.w = pk2(h1[2], h1[3]);
      *(u32x4*)(H + (size_t)row * LDH + tn * 64 + wc * 32 + fq * 8) = o;
    }
  }
};

struct EpiResid {
  const float *src_lat, *src_ctx;
  float *dst_lat, *dst_ctx;
  const float* gate;
  float gmul;
  DI void operator()(int tm, int tn, int wr, int wc, int lane, f32x4 (&acc)[4][4]) const {
    const int fr = lane & 15, fq = lane >> 4;
    const int r0 = tm * 128;
    const bool lat = r0 < NTL;
    const float* s = lat ? src_lat + (size_t)r0 * DM : src_ctx + (size_t)(r0 - NTL) * DM;
    float* d = lat ? dst_lat + (size_t)r0 * DM : dst_ctx + (size_t)(r0 - NTL) * DM;
    const float* g = gate + (size_t)mod_row(r0) * NMOD;
#pragma unroll
    for (int ni = 0; ni < 4; ++ni) {
      const int col = tn * 128 + wc * 64 + ni * 16 + fq * 4;
      const f32x4 gv = *(const f32x4*)(g + col) * gmul;
#pragma unroll
      for (int mi = 0; mi < 4; ++mi) {
        const int rl = wr * 64 + mi * 16 + fr;
        const f32x4 xv = *(const f32x4*)(s + (size_t)rl * DM + col);
        *(f32x4*)(d + (size_t)rl * DM + col) = xv * ALPHA + gv * acc[mi][ni];
      }
    }
  }
};

template <int MI>
struct EpiResidLN {
  const float *src_lat, *src_ctx;
  float *dst_lat, *dst_ctx;
  const float* gate;
  const float *lng, *lnb;
  const float* mods_next;
  bf16_t* U;
  float* stats;
  unsigned* cnt;
  float gmul;
  int shift_idx;
  DI void operator()(int tm, int tn, int wr, int wc, int lane, f32x4 (&acc)[MI][4]) const {
    const int fr = lane & 15, fq = lane >> 4;
    const int rw = tm * (MI * 32) + wr * (MI * 16);
#pragma unroll
    for (int mi = 0; mi < MI; ++mi) {
      const int rg = rw + mi * 16;
      const bool lat = rg < NTL;
      const float* s = (lat ? src_lat + (size_t)rg * DM : src_ctx + (size_t)(rg - NTL) * DM) + (size_t)fr * DM;
      const float* g = gate + (size_t)mod_row(rg) * NMOD;
#pragma unroll
      for (int ni = 0; ni < 4; ++ni) {
        const int col = tn * 128 + wc * 64 + ni * 16 + fq * 4;
        const f32x4 gv = *(const f32x4*)(g + col) * gmul;
        const f32x4 xv = *(const f32x4*)(s + col);
        acc[mi][ni] = xv * ALPHA + gv * acc[mi][ni];
      }
      float sm = 0.f;
#pragma unroll
      for (int ni = 0; ni < 4; ++ni) sm += (acc[mi][ni][0] + acc[mi][ni][1]) + (acc[mi][ni][2] + acc[mi][ni][3]);
      sm += __shfl_xor(sm, 16); sm += __shfl_xor(sm, 32);
      const float mean_i = sm * (1.f / 64.f);
      float q = 0.f;
#pragma unroll
      for (int ni = 0; ni < 4; ++ni) { const f32x4 dd = acc[mi][ni] - mean_i; q += (dd[0] * dd[0] + dd[1] * dd[1]) + (dd[2] * dd[2] + dd[3] * dd[3]); }
      q += __shfl_xor(q, 16); q += __shfl_xor(q, 32);
      if (fq == 0) {
        const unsigned long long pk = ((unsigned long long)__float_as_uint(q) << 32) | (unsigned long long)__float_as_uint(sm);
        __hip_atomic_store((unsigned long long*)(stats + ((size_t)(rg + fr) * 16 + tn * 2 + wc) * 2), pk, __ATOMIC_RELAXED, __HIP_MEMORY_SCOPE_AGENT);
      }
      asm volatile("" ::: "memory");
    }
    asm volatile("s_waitcnt vmcnt(0)" ::: "memory");
    __syncthreads();
    if (tid_() == 0) {
      __hip_atomic_fetch_add(cnt + tm, 1u, __ATOMIC_RELAXED, __HIP_MEMORY_SCOPE_AGENT);
      while (__hip_atomic_load(cnt + tm, __ATOMIC_RELAXED, __HIP_MEMORY_SCOPE_AGENT) < 8u) __builtin_amdgcn_s_sleep(1);
    }
    __syncthreads();
#pragma unroll
    for (int mi = 0; mi < MI; ++mi) {
      const int rg = rw + mi * 16;
      const bool lat = rg < NTL;
      float* d = (lat ? dst_lat + (size_t)rg * DM : dst_ctx + (size_t)(rg - NTL) * DM) + (size_t)fr * DM;
      const float* mr = mods_next + (size_t)mod_row(rg) * NMOD + shift_idx * DM;
      const unsigned long long* sq = (const unsigned long long*)(stats + ((size_t)(rg + fr) * 16 + fq * 4) * 2);
      const unsigned long long u0 = __hip_atomic_load(sq + 0, __ATOMIC_RELAXED, __HIP_MEMORY_SCOPE_AGENT), u1 = __hip_atomic_load(sq + 1, __ATOMIC_RELAXED, __HIP_MEMORY_SCOPE_AGENT);
      const unsigned long long u2 = __hip_atomic_load(sq + 2, __ATOMIC_RELAXED, __HIP_MEMORY_SCOPE_AGENT), u3 = __hip_atomic_load(sq + 3, __ATOMIC_RELAXED, __HIP_MEMORY_SCOPE_AGENT);
      const f32x4 p0 = {__uint_as_float((unsigned)u0), __uint_as_float((unsigned)(u0 >> 32)), __uint_as_float((unsigned)u1), __uint_as_float((unsigned)(u1 >> 32))};
      const f32x4 p1 = {__uint_as_float((unsigned)u2), __uint_as_float((unsigned)(u2 >> 32)), __uint_as_float((unsigned)u3), __uint_as_float((unsigned)(u3 >> 32))};
      float ts = (p0[0] + p0[2]) + (p1[0] + p1[2]);
      ts += __shfl_xor(ts, 16); ts += __shfl_xor(ts, 32);
      const float mean = ts * (1.f / 1024.f);
      const float d0 = p0[0] * (1.f / 64.f) - mean, d1 = p0[2] * (1.f / 64.f) - mean, d2 = p1[0] * (1.f / 64.f) - mean, d3 = p1[2] * (1.f / 64.f) - mean;
      float m2 = (p0[1] + p0[3]) + (p1[1] + p1[3]) + 64.f * ((d0 * d0 + d1 * d1) + (d2 * d2 + d3 * d3));
      m2 += __shfl_xor(m2, 16); m2 += __shfl_xor(m2, 32);
      const float rstd = rsqrtf(m2 * (1.f / 1024.f) + 1e-5f);
#pragma unroll
      for (int ni = 0; ni < 4; ++ni) {
        const int col = tn * 128 + wc * 64 + ni * 16 + fq * 4;
        const f32x4 y = (acc[mi][ni] - mean) * rstd * *(const f32x4*)(lng + col) + *(const f32x4*)(lnb + col);
        *(f32x4*)(d + col) = y;
        if (U) {
          const f32x4 sh = *(const f32x4*)(mr + col), sc = *(const f32x4*)(mr + DM + col);
          st4bf(U + (size_t)(rg + fr) * DM + col, y * (sc + 1.f) + sh);
        }
      }
      asm volatile("" ::: "memory");
    }
  }
};

template <int MI>
struct EpiProj {
  const Params* p;
  int l;
  DI void operator()(int tm, int tn, int wr, int wc, int lane, f32x4 (&acc)[MI][4]) const {
    const int fr = lane & 15, fq = lane >> 4;
    const int col0 = tn * 128 + wc * 64;
    const bool lat = tm * (MI * 32) < NTL;
    bf16_t* P = p->P;
    if (tn < 5) {
      const float* gain = (tn < 4 ? p->q_gain : p->k_gain) + l * 64;
      const float mult = tn < 4 ? QSCALE : 1.f;
      f32x4 gv[4];
#pragma unroll
      for (int ni = 0; ni < 4; ++ni) gv[ni] = *(const f32x4*)(gain + ni * 16 + fq * 4);
#pragma unroll
      for (int mi = 0; mi < MI; ++mi) {
        const int row = tm * (MI * 32) + wr * (MI * 16) + mi * 16 + fr;
        float ss = 0.f;
#pragma unroll
        for (int ni = 0; ni < 4; ++ni)
#pragma unroll
          for (int j = 0; j < 4; ++j) ss += acc[mi][ni][j] * acc[mi][ni][j];
        ss += __shfl_xor(ss, 16);
        ss += __shfl_xor(ss, 32);
        const float rinv = rsqrtf(ss * (1.f / 64.f) + 1e-6f);
        f32x4 v[4];
#pragma unroll
        for (int ni = 0; ni < 4; ++ni) v[ni] = acc[mi][ni] * rinv * gv[ni];
        if (lat) {
          const int t = row & (TL - 1);
          const int pr = t >> 6, pc = t & 63;
#pragma unroll
          for (int a = 0; a < 2; ++a) {
            const float* rt = p->rope + (size_t)((a ? pc : pr) * 16 + fq * 4) * 2;
            const f32x4 cs0 = *(const f32x4*)rt, cs1 = *(const f32x4*)(rt + 4);
            const float cc[4] = {cs0[0], cs0[2], cs1[0], cs1[2]};
            const float sn[4] = {cs0[1], cs0[3], cs1[1], cs1[3]};
#pragma unroll
            for (int j = 0; j < 4; ++j) {
              const float x1 = v[2 * a][j], x2 = v[2 * a + 1][j];
              v[2 * a][j] = x1 * cc[j] - x2 * sn[j];
              v[2 * a + 1][j] = x2 * cc[j] + x1 * sn[j];
            }
          }
        }
#pragma unroll
        for (int ni = 0; ni < 4; ++ni) st4bf(P + (size_t)row * DPROJ + col0 + ni * 16 + fq * 4, v[ni] * mult);
      }
    } else {
      const float mult = (tn >= 21 && tn < 25) ? QSCALE : 1.f;
#pragma unroll
      for (int mi = 0; mi < MI; ++mi) {
        const int row = tm * (MI * 32) + wr * (MI * 16) + mi * 16 + fr;
#pragma unroll
        for (int ni = 0; ni < 4; ++ni) st4bf(P + (size_t)row * DPROJ + col0 + ni * 16 + fq * 4, acc[mi][ni] * mult);
      }
    }
  }
};

DI f32x4 shifted4(const bf16_t* P, int row, bool hp, bool hn, int colidx, const float* mu_l) {
  const bf16_t* q = P + (size_t)row * DPROJ + 768 + colidx;
  const f32x4 x = ld4bf(q);
  const f32x4 xm = hp ? ld4bf(q - DPROJ) : (f32x4){0.f, 0.f, 0.f, 0.f};
  const f32x4 xp = hn ? ld4bf(q + DPROJ) : (f32x4){0.f, 0.f, 0.f, 0.f};
  const f32x4 m0 = *(const f32x4*)(mu_l + colidx), m1 = *(const f32x4*)(mu_l + 1920 + colidx);
  return x + m0 * (xm - x) + m1 * (xp - x);
}

struct EpiReadout {
  const Params* p;
  int l;
  DI void operator()(int tm, int tn, int wr, int wc, int lane, f32x4 (&acc)[4][4]) const {
    const int fr = lane & 15, fq = lane >> 4;
    const int head = tn * 2 + wc, colh = head * 64;
    const float* mu_l = p->mu + (size_t)l * 2 * 1920;
    const float* rk = p->r_k + l * 512 + colh;
    const float* gg = p->gn_g + l * 512 + colh;
    const float* gb = p->gn_b + l * 512 + colh;
    const bf16_t* Of = p->Os;
    const bf16_t* Ob = p->Os + (size_t)NTOK * 512;
    u32x2 gp[4][4];
#pragma unroll
    for (int mi = 0; mi < 4; ++mi)
#pragma unroll
      for (int ni = 0; ni < 4; ++ni) { gp[mi][ni].x = pk2(acc[mi][ni][0], acc[mi][ni][1]); gp[mi][ni].y = pk2(acc[mi][ni][2], acc[mi][ni][3]); }
#pragma unroll
    for (int mi = 0; mi < 4; ++mi) {
      const int row = tm * 128 + wr * 64 + mi * 16 + fr;
      int t, L;
      if (row < NTL) { t = row & (TL - 1); L = TL; } else { t = (row - NTL) & (TC - 1); L = TC; }
      const bool hp = t > 0, hn = t < L - 1;
      f32x4 o[4];
      float s = 0.f, bs = 0.f;
#pragma unroll
      for (int ni = 0; ni < 4; ++ni) {
        const int c = fq * 16 + ni * 4;
        o[ni] = ld4bf(Of + (size_t)row * 512 + colh + c) + ld4bf(Ob + (size_t)row * 512 + colh + c);
        s += (o[ni][0] + o[ni][1]) + (o[ni][2] + o[ni][3]);
      }
#pragma unroll 2
      for (int ni = 0; ni < 4; ++ni) {
        const int c = fq * 16 + ni * 4;
        const f32x4 r4 = shifted4(p->P, row, hp, hn, colh + c, mu_l);
        const f32x4 k4 = shifted4(p->P, row, hp, hn, 512 + colh + c, mu_l);
        const f32x4 rk4 = *(const f32x4*)(rk + c);
        const f32x4 pr = r4 * k4 * rk4;
        bs += (pr[0] + pr[1]) + (pr[2] + pr[3]);
      }
      s += __shfl_xor(s, 16); s += __shfl_xor(s, 32);
      bs += __shfl_xor(bs, 16); bs += __shfl_xor(bs, 32);
      const float mean = s * (1.f / 64.f);
      float q = 0.f;
#pragma unroll
      for (int ni = 0; ni < 4; ++ni) {
        const f32x4 d = o[ni] - mean;
        q += (d[0] * d[0] + d[1] * d[1]) + (d[2] * d[2] + d[3] * d[3]);
      }
      q += __shfl_xor(q, 16); q += __shfl_xor(q, 32);
      const float rstd = rsqrtf(q * (1.f / 64.f) + 64e-5f);
#pragma unroll
      for (int ni = 0; ni < 4; ++ni) {
        const int c = fq * 16 + ni * 4;
        const f32x4 g4 = *(const f32x4*)(gg + c), b4 = *(const f32x4*)(gb + c);
        const f32x4 vv = shifted4(p->P, row, hp, hn, 1024 + colh + c, mu_l);
        const f32x4 gate = {bflo(gp[mi][ni].x), bfhi(gp[mi][ni].x), bflo(gp[mi][ni].y), bfhi(gp[mi][ni].y)};
        const f32x4 y = ((o[ni] - mean) * rstd * g4 + b4 + vv * bs) * gate;
        st4bf(p->yr + (size_t)row * 512 + colh + c, y);
      }
      asm volatile("" ::: "memory");
    }
  }
};

DI float wave_sum(float v) {
#pragma unroll
  for (int o = 32; o > 0; o >>= 1) v += __shfl_xor(v, o);
  return v;
}

DI void ln_phase(float* xl, float* xc, int M, const float* g, const float* b, const float* mods_l, int shift_idx, bf16_t* U) {
  const int lane = tid_() & 63, wid = tid_() >> 6;
  for (int row = blockIdx.x * 4 + wid; row < M; row += gridDim.x * 4) {
    float* xr = row < NTL ? xl + (size_t)row * DM : xc + (size_t)(row - NTL) * DM;
    f32x4 v[4];
    float s = 0.f;
#pragma unroll
    for (int i = 0; i < 4; ++i) { v[i] = *(const f32x4*)(xr + i * 256 + lane * 4); s += (v[i][0] + v[i][1]) + (v[i][2] + v[i][3]); }
    const float mean = wave_sum(s) * (1.f / 1024.f);
    float q = 0.f;
#pragma unroll
    for (int i = 0; i < 4; ++i) { const f32x4 d = v[i] - mean; q += (d[0] * d[0] + d[1] * d[1]) + (d[2] * d[2] + d[3] * d[3]); }
    const float rstd = rsqrtf(wave_sum(q) * (1.f / 1024.f) + 1e-5f);
    const float* mr = mods_l + (size_t)mod_row(row) * NMOD + shift_idx * DM;
#pragma unroll
    for (int i = 0; i < 4; ++i) {
      const int c = i * 256 + lane * 4;
      const f32x4 y = (v[i] - mean) * rstd * *(const f32x4*)(g + c) + *(const f32x4*)(b + c);
      *(f32x4*)(xr + c) = y;
      if (U) {
        const f32x4 sh = *(const f32x4*)(mr + c), sc = *(const f32x4*)(mr + DM + c);
        st4bf(U + (size_t)row * DM + c, y * (sc + 1.f) + sh);
      }
    }
  }
}

DI void u0_phase(const Params& p) {
  const int lane = tid_() & 63, wid = tid_() >> 6;
  for (int row = blockIdx.x * 4 + wid; row < NTOK; row += gridDim.x * 4) {
    const float* xr = row < NTL ? p.x_in + (size_t)row * DM : p.ctx_in + (size_t)(row - NTL) * DM;
    const float* mr = p.mods + (size_t)mod_row(row) * NMOD;
#pragma unroll
    for (int i = 0; i < 4; ++i) {
      const int c = i * 256 + lane * 4;
      const f32x4 y = *(const f32x4*)(xr + c);
      const f32x4 sh = *(const f32x4*)(mr + c), sc = *(const f32x4*)(mr + DM + c);
      st4bf(p.U + (size_t)row * DM + c, y * (sc + 1.f) + sh);
    }
  }
}

DI void mods_phase(const Params& p, char* lds) {
  float* sc = (float*)lds;
  float* red = sc + 256 * 20;
  const int tid = tid_(), lane = tid & 63, wid = tid >> 6;
  if (blockIdx.x == 0) {
    if (tid < 64) p.counters[tid] = 0u;
    for (int i = tid; i < 6 * 288; i += NTHREADS) p.lncnt[i] = 0u;
    for (int i = tid; i < 1024; i += NTHREADS) {
      const int pos = i >> 4, k = i & 15;
      const float inv = exp2f(-(float)k * (1.f / 16.f) * 13.287712379549449f);
      const float ang = (float)pos * inv;
      p.rope[i * 2] = cosf(ang);
      p.rope[i * 2 + 1] = sinf(ang);
    }
  }
  for (int tile = blockIdx.x; tile < 288; tile += gridDim.x) {
    const int l = tile / 144, col0 = (tile % 144) * 64;
    float acc[17];
#pragma unroll
    for (int r = 0; r < 17; ++r) acc[r] = 0.f;
    for (int kc = 0; kc < 4; ++kc) {
      __syncthreads();
      for (int i = tid; i < 17 * 256; i += NTHREADS) {
        const int r = i >> 8, kk = i & 255;
        const float v = r < 16 ? p.c[r * DM + kc * 256 + kk] : p.c_ctx[kc * 256 + kk];
        sc[kk * 20 + r] = siluf_(v);
      }
      __syncthreads();
      const float* wp = p.w_ada + ((size_t)l * DM + kc * 256 + wid * 64) * NMOD + col0 + lane;
      for (int kk = 0; kk < 64; ++kk) {
        const float wv = wp[(size_t)kk * NMOD];
        const float* s = sc + (wid * 64 + kk) * 20;
#pragma unroll
        for (int r = 0; r < 17; ++r) acc[r] += s[r] * wv;
      }
    }
    __syncthreads();
#pragma unroll
    for (int r = 0; r < 17; ++r) red[(wid * 17 + r) * 64 + lane] = acc[r];
    __syncthreads();
    for (int i = tid; i < 17 * 64; i += NTHREADS) {
      const int r = i >> 6, cl = i & 63;
      const float s = red[(0 * 17 + r) * 64 + cl] + red[(1 * 17 + r) * 64 + cl] + red[(2 * 17 + r) * 64 + cl] + red[(3 * 17 + r) * 64 + cl];
      p.mods[((size_t)l * 17 + r) * NMOD + col0 + cl] = s + p.b_ada[l * NMOD + col0 + cl];
    }
  }
  __syncthreads();
}

DI void sg_phase(const Params& p, int l) {
  const int lane = tid_() & 63, wid = tid_() >> 6;
  const float* mu_l = p.mu + (size_t)l * 2 * 1920;
  const int b0 = gridDim.x > 256 ? 256 : 0, nb = gridDim.x - b0;
  if ((int)blockIdx.x < b0) return;
  for (int idx = ((int)blockIdx.x - b0) * NTHREADS + tid_(); idx < NTOK * 32; idx += nb * NTHREADS) {
    const int row = idx >> 5, c = (idx & 31) * 4;
    int t, L;
    if (row < NTL) { t = row & (TL - 1); L = TL; } else { t = (row - NTL) & (TC - 1); L = TC; }
    const f32x4 x = shifted4(p.P, row, t > 0, t < L - 1, 1792 + c, mu_l);
    f32x4 y;
#pragma unroll
    for (int j = 0; j < 4; ++j) y[j] = sigmoidf_(x[j]);
    st4bf(p.sg + (size_t)row * 128 + c, y);
  }
  (void)lane; (void)wid;
}

constexpr int KLD = 72;
constexpr int VLD = 68;

struct NoMask { DI void operator()(f32x16 (&st)[2]) const {} };

struct NaMask {
  const float* rp;
  int c;
  int c0;
  int h;
  DI void operator()(f32x16 (&st)[2]) const {
#pragma unroll
    for (int u = 0; u < 2; ++u)
#pragma unroll
      for (int i = 0; i < 16; ++i) {
        const int kc = u * 32 + (i & 3) + 8 * (i >> 2) + 4 * h;
        const bool ok = (kc >= c0) && (kc < c0 + 16);
        const int bi = ok ? (kc - c + 15) : 15;
        const float bias = rp[bi];
        st[u][i] = ok ? st[u][i] + bias : -1e30f;
      }
  }
};

template <class Mask>
DI void attn_tile(const bf16_t* Ks, const bf16_t* Vt, const bf16x8 (&qf)[4], f32x16 (&ot)[2], float& m, float& l, const Mask& mask, int lane) {
  const int r = lane & 31, h = lane >> 5;
  f32x16 st[2];
#pragma unroll
  for (int u = 0; u < 2; ++u) {
#pragma unroll
    for (int i = 0; i < 16; ++i) st[u][i] = 0.f;
#pragma unroll
    for (int s = 0; s < 4; ++s) {
      const bf16x8 kf = *(const bf16x8*)(Ks + (u * 32 + r) * KLD + s * 16 + h * 8);
      st[u] = __builtin_amdgcn_mfma_f32_32x32x16_bf16(kf, qf[s], st[u], 0, 0, 0);
    }
  }
  mask(st);
  float mx = st[0][0];
#pragma unroll
  for (int u = 0; u < 2; ++u)
#pragma unroll
    for (int i = 0; i < 16; ++i) mx = fmaxf(mx, st[u][i]);
  mx = fmaxf(mx, __shfl_xor(mx, 32));
  const float mnew = fmaxf(m, mx);
  const float alpha = __builtin_amdgcn_exp2f(m - mnew);
  m = mnew;
  float ls = 0.f;
#pragma unroll
  for (int u = 0; u < 2; ++u)
#pragma unroll
    for (int i = 0; i < 16; ++i) { st[u][i] = __builtin_amdgcn_exp2f(st[u][i] - mnew); ls += st[u][i]; }
  l = l * alpha + ls;
#pragma unroll
  for (int dt = 0; dt < 2; ++dt)
#pragma unroll
    for (int i = 0; i < 16; ++i) ot[dt][i] *= alpha;
#pragma unroll
  for (int u = 0; u < 2; ++u)
#pragma unroll
    for (int s = 0; s < 2; ++s) {
      u32x4 pw;
      pw.x = pk2(st[u][8 * s + 0], st[u][8 * s + 1]); pw.y = pk2(st[u][8 * s + 2], st[u][8 * s + 3]);
      pw.z = pk2(st[u][8 * s + 4], st[u][8 * s + 5]); pw.w = pk2(st[u][8 * s + 6], st[u][8 * s + 7]);
      const bf16x8 pb = __builtin_bit_cast(bf16x8, pw);
#pragma unroll
      for (int dt = 0; dt < 2; ++dt) {
        const bf16_t* vp = Vt + (dt * 32 + r) * VLD + u * 32 + 16 * s + 4 * h;
        const s16x4 lo = *(const s16x4*)vp, hi = *(const s16x4*)(vp + 8);
        const bf16x8 va = __builtin_shufflevector(lo, hi, 0, 1, 2, 3, 4, 5, 6, 7);
        ot[dt] = __builtin_amdgcn_mfma_f32_32x32x16_bf16(va, pb, ot[dt], 0, 0, 0);
      }
    }
}

template <int NHB>
DI void kv_load(const bf16_t* kb, const bf16_t* vb, u32x4 (&kr)[NHB * 2], u32x4 (&vr)[NHB * 2]) {
#pragma unroll
  for (int i = 0; i < NHB * 2; ++i) {
    const int c = tid_() + i * NTHREADS;
    const int hh = c >> 9, cc = c & 511, key = cc >> 3, dc = cc & 7;
    const size_t off = (size_t)key * DPROJ + hh * 64 + dc * 8;
    kr[i] = *(const u32x4*)(kb + off);
    vr[i] = *(const u32x4*)(vb + off);
  }
}
template <int NHB>
DI void kv_store(bf16_t* Ks, bf16_t* Vt, const u32x4 (&kr)[NHB * 2], const u32x4 (&vr)[NHB * 2]) {
#pragma unroll
  for (int i = 0; i < NHB * 2; ++i) {
    const int c = tid_() + i * NTHREADS;
    const int hh = c >> 9, cc = c & 511, key = cc >> 3, dc = cc & 7;
    *(u32x4*)(Ks + hh * 64 * KLD + key * KLD + dc * 8) = kr[i];
    bf16_t* vt = Vt + hh * 64 * VLD + (dc * 8) * VLD + key;
    vt[0 * VLD] = (bf16_t)(vr[i].x & 0xffff); vt[1 * VLD] = (bf16_t)(vr[i].x >> 16);
    vt[2 * VLD] = (bf16_t)(vr[i].y & 0xffff); vt[3 * VLD] = (bf16_t)(vr[i].y >> 16);
    vt[4 * VLD] = (bf16_t)(vr[i].z & 0xffff); vt[5 * VLD] = (bf16_t)(vr[i].z >> 16);
    vt[6 * VLD] = (bf16_t)(vr[i].w & 0xffff); vt[7 * VLD] = (bf16_t)(vr[i].w >> 16);
  }
}

DI void attn_finish(bf16_t* outp  , f32x16 (&ot)[2], float l, int lane) {
  const int h = lane >> 5;
  l += __shfl_xor(l, 32);
  const float inv = __builtin_amdgcn_rcpf(l);
#pragma unroll
  for (int dt = 0; dt < 2; ++dt)
#pragma unroll
    for (int g = 0; g < 4; ++g) {
      f32x4 v = {ot[dt][4 * g] * inv, ot[dt][4 * g + 1] * inv, ot[dt][4 * g + 2] * inv, ot[dt][4 * g + 3] * inv};
      st4bf(outp + dt * 32 + 8 * g + 4 * h, v);
    }
}

DI void dense_item(const Params& p, int qrow0, int qcol, int krow_lat0, int ntl, int krow_ctx0, int kcol, int vcol, char* lds) {
  bf16_t* Ks = (bf16_t*)lds;
  bf16_t* Vt = Ks + 2 * 64 * KLD;
  const int lane = tid_() & 63, wid = tid_() >> 6, r = lane & 31, h = lane >> 5;
  bf16_t* qp = p.P + (size_t)(qrow0 + wid * 32 + r) * DPROJ + qcol;
  bf16x8 qf[4];
#pragma unroll
  for (int s = 0; s < 4; ++s) qf[s] = *(const bf16x8*)(qp + s * 16 + h * 8);
  f32x16 ot[2];
#pragma unroll
  for (int dt = 0; dt < 2; ++dt)
#pragma unroll
    for (int i = 0; i < 16; ++i) ot[dt][i] = 0.f;
  float m = -1e30f, l = 0.f;
  const int nt = ntl + 4;
  u32x4 kr[2], vr[2];
  auto tile_row = [&](int jt) { return jt < ntl ? krow_lat0 + jt * 64 : krow_ctx0 + (jt - ntl) * 64; };
  {
    const bf16_t* base = p.P + (size_t)tile_row(0) * DPROJ;
    kv_load<1>(base + kcol, base + vcol, kr, vr);
  }
  for (int jt = 0; jt < nt; ++jt) {
    __syncthreads();
    kv_store<1>(Ks, Vt, kr, vr);
    __syncthreads();
    if (jt + 1 < nt) {
      const bf16_t* base = p.P + (size_t)tile_row(jt + 1) * DPROJ;
      kv_load<1>(base + kcol, base + vcol, kr, vr);
    }
    attn_tile(Ks, Vt, qf, ot, m, l, NoMask(), lane);
  }
  attn_finish(qp, ot, l, lane);
  __syncthreads();
}

DI void na_item(const Params& p, int lyr, int b, int gr, int hp, char* lds) {
  bf16_t* Ks = (bf16_t*)lds;
  bf16_t* Vt = Ks + 2 * 64 * KLD;
  float* rpl = (float*)(Vt + 2 * 64 * VLD);
  const int tid = tid_(), lane = tid & 63, wid = tid >> 6, r = lane & 31, h = lane >> 5;
  const int hl = wid >> 1, head = hp * 2 + hl, qh = wid & 1;
  const int r0 = gr - 4 < 0 ? 0 : (gr - 4 > 24 ? 24 : gr - 4);
  __syncthreads();
  for (int i = tid; i < 2 * 465; i += NTHREADS) {
    const int hh = i / 465, e = i - hh * 465;
    rpl[i] = p.rpb[((size_t)lyr * 8 + hp * 2 + hh) * 465 + e] * LOG2E;
  }
  const int c = qh * 32 + r;
  const int c0 = c - 8 < 0 ? 0 : (c - 8 > 48 ? 48 : c - 8);
  bf16_t* qp = p.P + (size_t)(b * TL + gr * 64 + c) * DPROJ + 2688 + head * 64;
  bf16x8 qf[4];
#pragma unroll
  for (int s = 0; s < 4; ++s) qf[s] = *(const bf16x8*)(qp + s * 16 + h * 8);
  f32x16 ot[2];
#pragma unroll
  for (int dt = 0; dt < 2; ++dt)
#pragma unroll
    for (int i = 0; i < 16; ++i) ot[dt][i] = 0.f;
  float m = -1e30f, l = 0.f;
  u32x4 kr[4], vr[4];
  auto tile_row = [&](int jt) { return jt < 8 ? b * TL + (r0 + jt) * 64 : NTL + b * TC + (jt - 8) * 64; };
  const int kcol = 3200 + hp * 128, vcol = 3712 + hp * 128;
  {
    const bf16_t* base = p.P + (size_t)tile_row(0) * DPROJ;
    kv_load<2>(base + kcol, base + vcol, kr, vr);
  }
  for (int jt = 0; jt < 12; ++jt) {
    __syncthreads();
    kv_store<2>(Ks, Vt, kr, vr);
    __syncthreads();
    if (jt + 1 < 12) {
      const bf16_t* base = p.P + (size_t)tile_row(jt + 1) * DPROJ;
      kv_load<2>(base + kcol, base + vcol, kr, vr);
    }
    if (jt < 8) {
      NaMask mk;
      mk.rp = rpl + hl * 465 + (r0 + jt - gr + 7) * 31;
      mk.c = c; mk.c0 = c0; mk.h = h;
      attn_tile(Ks + hl * 64 * KLD, Vt + hl * 64 * VLD, qf, ot, m, l, mk, lane);
    } else {
      attn_tile(Ks + hl * 64 * KLD, Vt + hl * 64 * VLD, qf, ot, m, l, NoMask(), lane);
    }
  }
  attn_finish(qp, ot, l, lane);
  __syncthreads();
}

template <int CTRL>
DI float dpp_f(float x) { return __int_as_float(__builtin_amdgcn_update_dpp(0, __float_as_int(x), CTRL, 0xF, 0xF, true)); }
DI float red8(float x) {
  x += dpp_f<0xB1>(x);
  x += dpp_f<0x4E>(x);
  x += dpp_f<0x141>(x);
  return x;
}

struct ScanOps { f32x4 w[2], kk[2], b[2], kd[2], r[2]; f32x2 v; };
DI void scan_load(ScanOps& o, const float* base, int kg, int row0) {
#pragma unroll
  for (int i = 0; i < 2; ++i) {
    o.w[i] = *(const f32x4*)(base + kg * 8 + i * 4);
    o.kk[i] = *(const f32x4*)(base + 64 + kg * 8 + i * 4);
    o.b[i] = *(const f32x4*)(base + 128 + kg * 8 + i * 4);
    o.kd[i] = *(const f32x4*)(base + 192 + kg * 8 + i * 4);
    o.r[i] = *(const f32x4*)(base + 256 + kg * 8 + i * 4);
  }
  o.v = *(const f32x2*)(base + 320 + row0);
}

DI void scan_block(const Params& p, int lyr, int sidx, bool need_ctx, char* lds) {
  const int dir = sidx & 1, hd = (sidx >> 1) & 7, b = sidx >> 4;
  const int tid = tid_(), lane = tid & 63, w = tid >> 6;
  float* rec = (float*)lds;
  float* obuf = rec + 16 * 384;
  float* cst = obuf + 16 * 64;
  bf16_t* Aw = (bf16_t*)(cst + 14 * 64);
  bf16_t* Aa = Aw + 16 * 72;
  __syncthreads();
  for (int i = tid; i < 320; i += NTHREADS) {
    const int g = i >> 6, c = i & 63;
    const int colidx = (g < 3 ? g * 512 + hd * 64 : (g == 3 ? 1536 + dir * 64 : 1664 + dir * 64)) + c;
    cst[i] = p.mu[(size_t)lyr * 3840 + colidx];
    cst[320 + i] = p.mu[(size_t)lyr * 3840 + 1920 + colidx];
  }
  if (tid < 64) {
    cst[640 + tid] = p.w0[(lyr * 2 + dir) * 512 + hd * 64 + tid];
    cst[704 + tid] = p.a0[(lyr * 2 + dir) * 512 + hd * 64 + tid];
    cst[768 + tid] = p.k_k[lyr * 512 + hd * 64 + tid];
    cst[832 + tid] = p.k_a[lyr * 512 + hd * 64 + tid];
  }
  const int fr = lane & 15, fq = lane >> 4;
  bf16x8 bw[2], ba[2];
  {
    const float* w2p = p.w2 + (size_t)(lyr * 2 + dir) * 64 * 512 + hd * 64 + 16 * w + fr;
    const float* a2p = p.a2 + (size_t)(lyr * 2 + dir) * 64 * 512 + hd * 64 + 16 * w + fr;
#pragma unroll
    for (int ks = 0; ks < 2; ++ks) {
      u32x4 tw, ta;
      float xw[8], xa[8];
#pragma unroll
      for (int j = 0; j < 8; ++j) { xw[j] = w2p[(size_t)(ks * 32 + fq * 8 + j) * 512]; xa[j] = a2p[(size_t)(ks * 32 + fq * 8 + j) * 512]; }
      tw.x = pk2(xw[0], xw[1]); tw.y = pk2(xw[2], xw[3]); tw.z = pk2(xw[4], xw[5]); tw.w = pk2(xw[6], xw[7]);
      ta.x = pk2(xa[0], xa[1]); ta.y = pk2(xa[2], xa[3]); ta.z = pk2(xa[4], xa[5]); ta.w = pk2(xa[6], xa[7]);
      bw[ks] = __builtin_bit_cast(bf16x8, tw);
      ba[ks] = __builtin_bit_cast(bf16x8, ta);
    }
  }
  f32x4 S[2][2];
#pragma unroll
  for (int a = 0; a < 2; ++a)
#pragma unroll
    for (int i = 0; i < 2; ++i) S[a][i] = (f32x4){0.f, 0.f, 0.f, 0.f};
  const int kg = lane & 7, rp = lane >> 3, row0 = 16 * w + rp * 2;
  const int pj = tid >> 4, pcg = tid & 15;
  int goff[5] = {hd * 64, 512 + hd * 64, 1024 + hd * 64, 1536 + dir * 64, 1664 + dir * 64};
  u32x2 raw[5][3];
  auto chunk_tok = [&](int ch, int j, int& rowbase, int& t, int& L) {
    int n0;
    if (ch < 16) { L = TC; n0 = ch * 16; rowbase = NTL + b * TC; } else { L = TL; n0 = (ch - 16) * 16; rowbase = b * TL; }
    const int n = n0 + j;
    t = dir ? L - 1 - n : n;
  };
  auto prefetch = [&](int ch) {
    int rowbase, t, L;
    chunk_tok(ch, pj, rowbase, t, L);
    const bf16_t* q = p.P + (size_t)(rowbase + t) * DPROJ + 768 + pcg * 4;
#pragma unroll
    for (int g = 0; g < 5; ++g) {
      raw[g][1] = *(const u32x2*)(q + goff[g]);
      raw[g][0] = t > 0 ? *(const u32x2*)(q + goff[g] - DPROJ) : (u32x2){0u, 0u};
      raw[g][2] = t < L - 1 ? *(const u32x2*)(q + goff[g] + DPROJ) : (u32x2){0u, 0u};
    }
  };
  prefetch(0);
  __syncthreads();
  for (int ch = 0; ch < 144; ++ch) {
    {
      f32x4 xs[5];
#pragma unroll
      for (int g = 0; g < 5; ++g) {
        const f32x4 x = {bflo(raw[g][1].x), bfhi(raw[g][1].x), bflo(raw[g][1].y), bfhi(raw[g][1].y)};
        const f32x4 xm = {bflo(raw[g][0].x), bfhi(raw[g][0].x), bflo(raw[g][0].y), bfhi(raw[g][0].y)};
        const f32x4 xp = {bflo(raw[g][2].x), bfhi(raw[g][2].x), bflo(raw[g][2].y), bfhi(raw[g][2].y)};
        const f32x4 m0 = *(const f32x4*)(cst + g * 64 + pcg * 4), m1 = *(const f32x4*)(cst + 320 + g * 64 + pcg * 4);
        xs[g] = x + m0 * (xm - x) + m1 * (xp - x);
      }
      float* rj = rec + pj * 384;
      *(f32x4*)(rj + 256 + pcg * 4) = xs[0];
      *(f32x4*)(rj + 320 + pcg * 4) = xs[2];
      const f32x4 kx = xs[1] * *(const f32x4*)(cst + 768 + pcg * 4);
      float ss = (kx[0] * kx[0] + kx[1] * kx[1]) + (kx[2] * kx[2] + kx[3] * kx[3]);
      ss += __shfl_xor(ss, 1); ss += __shfl_xor(ss, 2); ss += __shfl_xor(ss, 4); ss += __shfl_xor(ss, 8);
      const float rn = rsqrtf(ss + 1e-12f);
      *(f32x4*)(rj + 64 + pcg * 4) = kx * rn;
      *(f32x4*)(rj + 192 + pcg * 4) = xs[1];
      f32x4 tw;
#pragma unroll
      for (int j = 0; j < 4; ++j) tw[j] = 1.f - 2.f * __builtin_amdgcn_rcpf(1.f + __expf(2.f * xs[3][j]));
      st4bf(Aw + pj * 72 + pcg * 4, tw);
      st4bf(Aa + pj * 72 + pcg * 4, xs[4]);
    }
    __syncthreads();
    {
      f32x4 aw = {0.f, 0.f, 0.f, 0.f}, aa = {0.f, 0.f, 0.f, 0.f};
#pragma unroll
      for (int ks = 0; ks < 2; ++ks) {
        const bf16x8 fw = *(const bf16x8*)(Aw + fr * 72 + ks * 32 + fq * 8);
        const bf16x8 fa = *(const bf16x8*)(Aa + fr * 72 + ks * 32 + fq * 8);
        aw = __builtin_amdgcn_mfma_f32_16x16x32_bf16(bw[ks], fw, aw, 0, 0, 0);
        aa = __builtin_amdgcn_mfma_f32_16x16x32_bf16(ba[ks], fa, aa, 0, 0, 0);
      }
      const int c = 16 * w + fq * 4;
      float* rj = rec + fr * 384;
      const f32x4 w0v = *(const f32x4*)(cst + 640 + c), a0v = *(const f32x4*)(cst + 704 + c), kav = *(const f32x4*)(cst + 832 + c);
      const f32x4 kkv = *(const f32x4*)(rj + 64 + c), kpv = *(const f32x4*)(rj + 192 + c);
      f32x4 dec, bb, kd;
#pragma unroll
      for (int j = 0; j < 4; ++j) {
        const float z = -(w0v[j] + aw[j]);
        const float sp = fmaxf(z, 0.f) + __logf(1.f + __expf(-fabsf(z)));
        const float wl = -sp - 0.5f;
        dec[j] = __expf(-__expf(wl));
        const float ic = sigmoidf_(a0v[j] + aa[j]);
        bb[j] = kkv[j] * ic;
        kd[j] = kpv[j] * (1.f + (ic - 1.f) * kav[j]);
      }
      *(f32x4*)(rj + c) = dec;
      *(f32x4*)(rj + 128 + c) = bb;
      *(f32x4*)(rj + 192 + c) = kd;
    }
    __syncthreads();
    if (ch + 1 < 144) prefetch(ch + 1);
    {
      ScanOps cur, nxt;
      scan_load(cur, rec, kg, row0);
#pragma unroll 2
      for (int j = 0; j < 16; ++j) {
        if (j + 1 < 16) scan_load(nxt, rec + (j + 1) * 384, kg, row0);
#pragma unroll
        for (int a = 0; a < 2; ++a) {
          f32x4 t0 = S[a][0] * cur.kk[0] + S[a][1] * cur.kk[1];
          float sap = red8((t0[0] + t0[1]) + (t0[2] + t0[3]));
          const float vv = a ? cur.v.y : cur.v.x;
          S[a][0] = S[a][0] * cur.w[0] - cur.b[0] * sap + cur.kd[0] * vv;
          S[a][1] = S[a][1] * cur.w[1] - cur.b[1] * sap + cur.kd[1] * vv;
          f32x4 t1 = S[a][0] * cur.r[0] + S[a][1] * cur.r[1];
          float o = red8((t1[0] + t1[1]) + (t1[2] + t1[3]));
          if (kg == 0) obuf[j * 64 + row0 + a] = o;
        }
        cur = nxt;
      }
    }
    __syncthreads();
    if (ch >= 16 || need_ctx) {
      int rowbase, t, L;
      chunk_tok(ch, pj, rowbase, t, L);
      const f32x4 ov = *(const f32x4*)(obuf + pj * 64 + pcg * 4);
      st4bf(p.Os + ((size_t)dir * NTOK + rowbase + t) * 512 + hd * 64 + pcg * 4, ov);
    }
  }
  __syncthreads();
}

DI bf16x8 pack8(f32x4 a, f32x4 b) {
  u32x4 t; t.x = pk2(a[0], a[1]); t.y = pk2(a[2], a[3]); t.z = pk2(b[0], b[1]); t.w = pk2(b[2], b[3]);
  return __builtin_bit_cast(bf16x8, t);
}
DI bf16x8 pack4z(f32x4 a) {
  u32x4 t; t.x = pk2(a[0], a[1]); t.y = pk2(a[2], a[3]); t.z = 0u; t.w = 0u;
  return __builtin_bit_cast(bf16x8, t);
}
#define MFMA16(a, b, c) __builtin_amdgcn_mfma_f32_16x16x32_bf16((a), (b), (c), 0, 0, 0)

DI void scan_block2(const Params& p, int lyr, int sidx, bool need_ctx, char* lds) {
  const int dir = sidx & 1, hd = (sidx >> 1) & 7, b = sidx >> 4;
  const int tid = tid_(), lane = tid & 63, w = tid >> 6;
  const int fr = lane & 15, fq = lane >> 4;
  float* rec = (float*)lds;
  float* obuf = rec + 16 * 384;
  float* cst = obuf + 16 * 64;
  bf16_t* Aw = (bf16_t*)(cst + 14 * 64);
  bf16_t* Aa = Aw + 16 * 72;
  bf16_t* ARt = Aa + 16 * 72;
  bf16_t* BKm = ARt + 32 * 72;
  bf16_t* BKt = BKm + 32 * 72;
  bf16_t* Vt = BKt + 64 * 40;
  float* WL = (float*)(Vt + 64 * 24);
  float* Gf = WL + 64;
  float* GNt = Gf + 32 * 33;
  float* Yf = GNt + 256;
  __syncthreads();
  for (int i = tid; i < 320; i += NTHREADS) {
    const int g = i >> 6, c = i & 63;
    const int colidx = (g < 3 ? g * 512 + hd * 64 : (g == 3 ? 1536 + dir * 64 : 1664 + dir * 64)) + c;
    cst[i] = p.mu[(size_t)lyr * 3840 + colidx];
    cst[320 + i] = p.mu[(size_t)lyr * 3840 + 1920 + colidx];
  }
  if (tid < 64) {
    cst[640 + tid] = p.w0[(lyr * 2 + dir) * 512 + hd * 64 + tid];
    cst[704 + tid] = p.a0[(lyr * 2 + dir) * 512 + hd * 64 + tid];
    cst[768 + tid] = p.k_k[lyr * 512 + hd * 64 + tid];
    cst[832 + tid] = p.k_a[lyr * 512 + hd * 64 + tid];
  }
  bf16x8 bw[2], ba[2];
  {
    const float* w2p = p.w2 + (size_t)(lyr * 2 + dir) * 64 * 512 + hd * 64 + 16 * w + fr;
    const float* a2p = p.a2 + (size_t)(lyr * 2 + dir) * 64 * 512 + hd * 64 + 16 * w + fr;
#pragma unroll
    for (int ks = 0; ks < 2; ++ks) {
      f32x4 x0, x1, y0, y1;
#pragma unroll
      for (int j = 0; j < 4; ++j) {
        x0[j] = w2p[(size_t)(ks * 32 + fq * 8 + j) * 512]; x1[j] = w2p[(size_t)(ks * 32 + fq * 8 + 4 + j) * 512];
        y0[j] = a2p[(size_t)(ks * 32 + fq * 8 + j) * 512]; y1[j] = a2p[(size_t)(ks * 32 + fq * 8 + 4 + j) * 512];
      }
      bw[ks] = pack8(x0, x1);
      ba[ks] = pack8(y0, y1);
    }
  }
  f32x4 ST[4];
#pragma unroll
  for (int kt = 0; kt < 4; ++kt) ST[kt] = (f32x4){0.f, 0.f, 0.f, 0.f};
  const int pj = tid >> 4, pcg = tid & 15;
  int goff[5] = {hd * 64, 512 + hd * 64, 1024 + hd * 64, 1536 + dir * 64, 1664 + dir * 64};
  u32x2 raw[5][3];
  auto chunk_tok = [&](int ch, int j, int& rowbase, int& t, int& L) {
    int n0;
    if (ch < 16) { L = TC; n0 = ch * 16; rowbase = NTL + b * TC; } else { L = TL; n0 = (ch - 16) * 16; rowbase = b * TL; }
    const int n = n0 + j;
    t = dir ? L - 1 - n : n;
  };
  auto prefetch = [&](int ch) {
    int rowbase, t, L;
    chunk_tok(ch, pj, rowbase, t, L);
    const bf16_t* q = p.P + (size_t)(rowbase + t) * DPROJ + 768 + pcg * 4;
    const bool hp = t > 0, hn = t < L - 1;
    const int om = hp ? -DPROJ : 0, on = hn ? DPROJ : 0;
#pragma unroll
    for (int g = 0; g < 5; ++g) {
      raw[g][1] = *(const u32x2*)(q + goff[g]);
      const u32x2 rm = *(const u32x2*)(q + goff[g] + om), rn = *(const u32x2*)(q + goff[g] + on);
      raw[g][0] = hp ? rm : (u32x2){0u, 0u};
      raw[g][2] = hn ? rn : (u32x2){0u, 0u};
    }
  };
  prefetch(0);
  __syncthreads();
  const bf16x8 zero8 = {0, 0, 0, 0, 0, 0, 0, 0};
#pragma unroll 1
  for (int ch = 0; ch < 144; ++ch) {
    {
      f32x4 xs[5];
#pragma unroll
      for (int g = 0; g < 5; ++g) {
        const f32x4 x = {bflo(raw[g][1].x), bfhi(raw[g][1].x), bflo(raw[g][1].y), bfhi(raw[g][1].y)};
        const f32x4 xm = {bflo(raw[g][0].x), bfhi(raw[g][0].x), bflo(raw[g][0].y), bfhi(raw[g][0].y)};
        const f32x4 xp = {bflo(raw[g][2].x), bfhi(raw[g][2].x), bflo(raw[g][2].y), bfhi(raw[g][2].y)};
        const f32x4 m0 = *(const f32x4*)(cst + g * 64 + pcg * 4), m1 = *(const f32x4*)(cst + 320 + g * 64 + pcg * 4);
        xs[g] = x + m0 * (xm - x) + m1 * (xp - x);
      }
      float* rj = rec + pj * 384;
      *(f32x4*)(rj + 256 + pcg * 4) = xs[0];
#pragma unroll
      for (int e = 0; e < 4; ++e) Vt[(pcg * 4 + e) * 24 + pj] = f2bf(xs[2][e]);
      const f32x4 kx = xs[1] * *(const f32x4*)(cst + 768 + pcg * 4);
      float ss = (kx[0] * kx[0] + kx[1] * kx[1]) + (kx[2] * kx[2] + kx[3] * kx[3]);
      ss = red8(ss); ss += dpp_f<0x140>(ss);
      const float rn = rsqrtf(ss + 1e-12f);
      *(f32x4*)(rj + 64 + pcg * 4) = kx * rn;
      *(f32x4*)(rj + 192 + pcg * 4) = xs[1];
      f32x4 tw;
#pragma unroll
      for (int j = 0; j < 4; ++j) tw[j] = 1.f - 2.f * __builtin_amdgcn_rcpf(1.f + __expf(2.f * xs[3][j]));
      st4bf(Aw + pj * 72 + pcg * 4, tw);
      st4bf(Aa + pj * 72 + pcg * 4, xs[4]);
    }
    if (ch + 1 < 144) prefetch(ch + 1);
    __syncthreads();
    {
      f32x4 aw = {0.f, 0.f, 0.f, 0.f}, aa = {0.f, 0.f, 0.f, 0.f};
#pragma unroll
      for (int ks = 0; ks < 2; ++ks) {
        const bf16x8 fw = *(const bf16x8*)(Aw + fr * 72 + ks * 32 + fq * 8);
        const bf16x8 fa = *(const bf16x8*)(Aa + fr * 72 + ks * 32 + fq * 8);
        aw = MFMA16(bw[ks], fw, aw);
        aa = MFMA16(ba[ks], fa, aa);
      }
      const int c = 16 * w + fq * 4;
      const float* rj = rec + fr * 384;
      const f32x4 w0v = *(const f32x4*)(cst + 640 + c), a0v = *(const f32x4*)(cst + 704 + c), kav = *(const f32x4*)(cst + 832 + c);
      const f32x4 kkv = *(const f32x4*)(rj + 64 + c), kpv = *(const f32x4*)(rj + 192 + c), rpv = *(const f32x4*)(rj + 256 + c);
      f32x4 e, E, ic;
#pragma unroll
      for (int j = 0; j < 4; ++j) {
        const float z = -(w0v[j] + aw[j]);
        const float sp = fmaxf(z, 0.f) + __logf(1.f + __expf(-fabsf(z)));
        e[j] = __expf(-sp - 0.5f);
        ic[j] = sigmoidf_(a0v[j] + aa[j]);
      }
      E = e;
#pragma unroll
      for (int j = 0; j < 4; ++j) {
        E[j] += dpp_f<0x111>(E[j]);
        E[j] += dpp_f<0x112>(E[j]);
        E[j] += dpp_f<0x114>(E[j]);
        E[j] += dpp_f<0x118>(E[j]);
      }
      f32x4 at, rt, bt, kt_;
#pragma unroll
      for (int j = 0; j < 4; ++j) {
        const float wi = __expf(E[j]);
        at[j] = -kkv[j] * __expf(e[j] - E[j]);
        rt[j] = rpv[j] * __expf(-E[j]);
        bt[j] = kkv[j] * ic[j] * wi;
        kt_[j] = kpv[j] * (1.f + (ic[j] - 1.f) * kav[j]) * wi;
      }
      st4bf(ARt + fr * 72 + c, at);
      st4bf(ARt + (16 + fr) * 72 + c, rt);
      st4bf(BKm + fr * 72 + c, bt);
      st4bf(BKm + (16 + fr) * 72 + c, kt_);
#pragma unroll
      for (int j = 0; j < 4; ++j) { BKt[(c + j) * 40 + fr] = f2bf(bt[j]); BKt[(c + j) * 40 + 16 + fr] = f2bf(kt_[j]); }
      if (fr == 15) {
#pragma unroll
        for (int j = 0; j < 4; ++j) WL[c + j] = __expf(-E[j]);
      }
    }
    __syncthreads();
    {
      const int ct = w >> 1, tt = w & 1;
      f32x4 g = {0.f, 0.f, 0.f, 0.f};
#pragma unroll
      for (int ks = 0; ks < 2; ++ks) {
        const bf16x8 A = *(const bf16x8*)(BKm + (ct * 16 + fr) * 72 + ks * 32 + fq * 8);
        const bf16x8 B = *(const bf16x8*)(ARt + (tt * 16 + fr) * 72 + ks * 32 + fq * 8);
        g = MFMA16(A, B, g);
      }
#pragma unroll
      for (int r = 0; r < 4; ++r) Gf[(ct * 16 + fq * 4 + r) * 33 + tt * 16 + fr] = g[r];
      if (w == 0) {
#pragma unroll
        for (int r = 0; r < 4; ++r) GNt[(fq * 4 + r) * 16 + fr] = g[r];
      }
    }
    f32x4 XA = {0.f, 0.f, 0.f, 0.f}, XR = {0.f, 0.f, 0.f, 0.f};
#pragma unroll
    for (int ks = 0; ks < 2; ++ks) {
      const bf16x8 Bs = pack8(ST[2 * ks], ST[2 * ks + 1]);
      {
        const bf16_t* ar = ARt + fr * 72 + fq * 4;
        const s16x4 lo = *(const s16x4*)(ar + (2 * ks) * 16), hi = *(const s16x4*)(ar + (2 * ks + 1) * 16);
        XA = MFMA16(__builtin_shufflevector(lo, hi, 0, 1, 2, 3, 4, 5, 6, 7), Bs, XA);
      }
      {
        const bf16_t* ar = ARt + (16 + fr) * 72 + fq * 4;
        const s16x4 lo = *(const s16x4*)(ar + (2 * ks) * 16), hi = *(const s16x4*)(ar + (2 * ks + 1) * 16);
        XR = MFMA16(__builtin_shufflevector(lo, hi, 0, 1, 2, 3, 4, 5, 6, 7), Bs, XR);
      }
    }
    __syncthreads();
    const bf16x8 vB = fq < 2 ? *(const bf16x8*)(Vt + (16 * w + fr) * 24 + fq * 8) : zero8;
    {
      f32x4 n0, n1;
#pragma unroll
      for (int jj = 0; jj < 4; ++jj) {
        const int i0 = fq * 8 + jj, i1 = fq * 8 + 4 + jj;
        const float g0 = Gf[(16 + (i0 & 15)) * 33 + fr], g1 = Gf[(16 + (i1 & 15)) * 33 + fr];
        n0[jj] = (fq < 2 && i0 < fr) ? g0 : 0.f;
        n1[jj] = (fq < 2 && i1 < fr) ? g1 : 0.f;
      }
      XA = MFMA16(pack8(n0, n1), vB, XA);
    }
    float* yw = Yf + (w * 16 + fr) * 20;
    *(f32x4*)(yw + fq * 4) = XA;
    float u[16];
    {
      const f32x4 y0 = *(const f32x4*)(yw), y1 = *(const f32x4*)(yw + 4), y2 = *(const f32x4*)(yw + 8), y3 = *(const f32x4*)(yw + 12);
#pragma unroll
      for (int j = 0; j < 4; ++j) { u[j] = y0[j]; u[4 + j] = y1[j]; u[8 + j] = y2[j]; u[12 + j] = y3[j]; }
#pragma unroll
      for (int i = 0; i < 15; ++i) {
#pragma unroll
        for (int t4 = (i + 1) / 4; t4 < 4; ++t4) {
          const f32x4 nn = *(const f32x4*)(GNt + i * 16 + t4 * 4);
#pragma unroll
          for (int e2 = 0; e2 < 4; ++e2) if (t4 * 4 + e2 > i) u[t4 * 4 + e2] += u[i] * nn[e2];
        }
      }
    }
    f32x4 uq;
#pragma unroll
    for (int j = 0; j < 4; ++j) uq[j] = fq == 0 ? u[j] : (fq == 1 ? u[4 + j] : (fq == 2 ? u[8 + j] : u[12 + j]));
    const bf16x8 uB = pack4z(uq);
    {
      f32x4 m0, n0, n1;
#pragma unroll
      for (int jj = 0; jj < 4; ++jj) {
        const int i = fq * 4 + jj;
        const float gm = Gf[i * 33 + 16 + fr];
        m0[jj] = i <= fr ? gm : 0.f;
        const int i0 = fq * 8 + jj, i1 = fq * 8 + 4 + jj;
        const float g0 = Gf[(16 + (i0 & 15)) * 33 + 16 + fr], g1 = Gf[(16 + (i1 & 15)) * 33 + 16 + fr];
        n0[jj] = (fq < 2 && i0 <= fr) ? g0 : 0.f;
        n1[jj] = (fq < 2 && i1 <= fr) ? g1 : 0.f;
      }
      XR = MFMA16(pack4z(m0), uB, XR);
      XR = MFMA16(pack8(n0, n1), vB, XR);
#pragma unroll
      for (int r = 0; r < 4; ++r) obuf[(fq * 4 + r) * 64 + 16 * w + fr] = XR[r];
    }
#pragma unroll
    for (int kt = 0; kt < 4; ++kt) {
      const bf16_t* bk = BKt + (kt * 16 + fr) * 40;
      const s16x4 lo = *(const s16x4*)(bk + fq * 4);
      const s16x4 z4 = {0, 0, 0, 0};
      ST[kt] = MFMA16(__builtin_shufflevector(lo, z4, 0, 1, 2, 3, 4, 5, 6, 7), uB, ST[kt]);
      const bf16x8 a5 = fq < 2 ? *(const bf16x8*)(bk + 16 + fq * 8) : zero8;
      ST[kt] = MFMA16(a5, vB, ST[kt]);
      ST[kt] *= *(const f32x4*)(WL + kt * 16 + fq * 4);
    }
    __syncthreads();
    if (ch >= 16 || need_ctx) {
      int rowbase, t, L;
      chunk_tok(ch, pj, rowbase, t, L);
      const f32x4 ov = *(const f32x4*)(obuf + pj * 64 + pcg * 4);
      st4bf(p.Os + ((size_t)dir * NTOK + rowbase + t) * 512 + hd * 64 + pcg * 4, ov);
    }
  }
  __syncthreads();
}

DI void scan_block3(const Params& p, int lyr, int sidx, bool need_ctx, char* lds) {
  const int dir = sidx & 1, hd = (sidx >> 1) & 7, b = sidx >> 4;
  const int tid = tid_(), lane = tid & 63, w = tid >> 6;
  const int fr = lane & 15, fq = lane >> 4;
  float* rec = (float*)lds;
  float* obuf = rec + 16 * 192;
  float* cst = obuf + 16 * 64;
  bf16_t* Aw = (bf16_t*)(cst + 14 * 64);
  bf16_t* Aa = Aw + 16 * 72;
  float* Gf = (float*)(Aa + 16 * 72);
  float* GNt = Gf + 32 * 33;
  float* Yf = GNt + 256;
  bf16_t* OPS = (bf16_t*)(Yf + 4 * 16 * 20);
  constexpr int OPS_STRIDE = 32 * 72 + 32 * 72 + 64 * 40 + 64 * 24 + 128;
  __syncthreads();
  for (int i = tid; i < 320; i += NTHREADS) {
    const int g = i >> 6, c = i & 63;
    const int colidx = (g < 3 ? g * 512 + hd * 64 : (g == 3 ? 1536 + dir * 64 : 1664 + dir * 64)) + c;
    cst[i] = p.mu[(size_t)lyr * 3840 + colidx];
    cst[320 + i] = p.mu[(size_t)lyr * 3840 + 1920 + colidx];
  }
  if (tid < 64) {
    cst[640 + tid] = p.w0[(lyr * 2 + dir) * 512 + hd * 64 + tid];
    cst[704 + tid] = p.a0[(lyr * 2 + dir) * 512 + hd * 64 + tid];
    cst[768 + tid] = p.k_k[lyr * 512 + hd * 64 + tid];
    cst[832 + tid] = p.k_a[lyr * 512 + hd * 64 + tid];
  }
  bf16x8 bw[2], ba[2];
  {
    const float* w2p = p.w2 + (size_t)(lyr * 2 + dir) * 64 * 512 + hd * 64 + 16 * w + fr;
    const float* a2p = p.a2 + (size_t)(lyr * 2 + dir) * 64 * 512 + hd * 64 + 16 * w + fr;
#pragma unroll
    for (int ks = 0; ks < 2; ++ks) {
      f32x4 x0, x1, y0, y1;
#pragma unroll
      for (int j = 0; j < 4; ++j) {
        x0[j] = w2p[(size_t)(ks * 32 + fq * 8 + j) * 512]; x1[j] = w2p[(size_t)(ks * 32 + fq * 8 + 4 + j) * 512];
        y0[j] = a2p[(size_t)(ks * 32 + fq * 8 + j) * 512]; y1[j] = a2p[(size_t)(ks * 32 + fq * 8 + 4 + j) * 512];
      }
      bw[ks] = pack8(x0, x1);
      ba[ks] = pack8(y0, y1);
    }
  }
  f32x4 ST[4];
#pragma unroll
  for (int kt = 0; kt < 4; ++kt) ST[kt] = (f32x4){0.f, 0.f, 0.f, 0.f};
  const int pj = tid >> 4, pcg = tid & 15;
  int goff[5] = {hd * 64, 512 + hd * 64, 1024 + hd * 64, 1536 + dir * 64, 1664 + dir * 64};
  u32x2 raw[5][3];
  auto chunk_tok = [&](int ch, int j, int& rowbase, int& t, int& L) {
    int n0;
    if (ch < 16) { L = TC; n0 = ch * 16; rowbase = NTL + b * TC; } else { L = TL; n0 = (ch - 16) * 16; rowbase = b * TL; }
    const int n = n0 + j;
    t = dir ? L - 1 - n : n;
  };
  auto prefetch = [&](int ch) {
    int rowbase, t, L;
    chunk_tok(ch, pj, rowbase, t, L);
    const bf16_t* q = p.P + (size_t)(rowbase + t) * DPROJ + 768 + pcg * 4;
    const bool hp = t > 0, hn = t < L - 1;
    const int om = hp ? -DPROJ : 0, on = hn ? DPROJ : 0;
#pragma unroll
    for (int g = 0; g < 5; ++g) {
      raw[g][1] = *(const u32x2*)(q + goff[g]);
      const u32x2 rm = *(const u32x2*)(q + goff[g] + om), rn = *(const u32x2*)(q + goff[g] + on);
      raw[g][0] = hp ? rm : (u32x2){0u, 0u};
      raw[g][2] = hn ? rn : (u32x2){0u, 0u};
    }
  };
  const bf16x8 zero8 = {0, 0, 0, 0, 0, 0, 0, 0};
  prefetch(0);
  __syncthreads();
    {
      bf16_t* ARt = OPS + (0) * OPS_STRIDE; bf16_t* BKm = ARt + 32 * 72; bf16_t* BKt = BKm + 32 * 72; bf16_t* Vt = BKt + 64 * 40; float* WL = (float*)(Vt + 64 * 24);
      (void)ARt; (void)BKm; (void)BKt; (void)Vt; (void)WL;
    {
      f32x4 xs[5];
#pragma unroll
      for (int g = 0; g < 5; ++g) {
        const f32x4 x = {bflo(raw[g][1].x), bfhi(raw[g][1].x), bflo(raw[g][1].y), bfhi(raw[g][1].y)};
        const f32x4 xm = {bflo(raw[g][0].x), bfhi(raw[g][0].x), bflo(raw[g][0].y), bfhi(raw[g][0].y)};
        const f32x4 xp = {bflo(raw[g][2].x), bfhi(raw[g][2].x), bflo(raw[g][2].y), bfhi(raw[g][2].y)};
        const f32x4 m0 = *(const f32x4*)(cst + g * 64 + pcg * 4), m1 = *(const f32x4*)(cst + 320 + g * 64 + pcg * 4);
        xs[g] = x + m0 * (xm - x) + m1 * (xp - x);
      }
      float* rj = rec + pj * 192;
      *(f32x4*)(rj + 128 + pcg * 4) = xs[0];
#pragma unroll
      for (int e = 0; e < 4; ++e) Vt[(pcg * 4 + e) * 24 + pj] = f2bf(xs[2][e]);
      const f32x4 kx = xs[1] * *(const f32x4*)(cst + 768 + pcg * 4);
      float ss = (kx[0] * kx[0] + kx[1] * kx[1]) + (kx[2] * kx[2] + kx[3] * kx[3]);
      ss = red8(ss); ss += dpp_f<0x140>(ss);
      const float rn = rsqrtf(ss + 1e-12f);
      *(f32x4*)(rj + 0 + pcg * 4) = kx * rn;
      *(f32x4*)(rj + 64 + pcg * 4) = xs[1];
      f32x4 tw;
#pragma unroll
      for (int j = 0; j < 4; ++j) tw[j] = 1.f - 2.f * __builtin_amdgcn_rcpf(1.f + __expf(2.f * xs[3][j]));
      st4bf(Aw + pj * 72 + pcg * 4, tw);
      st4bf(Aa + pj * 72 + pcg * 4, xs[4]);
    }
    }
  prefetch(1);
  __syncthreads();
    {
      bf16_t* ARt = OPS + (0) * OPS_STRIDE; bf16_t* BKm = ARt + 32 * 72; bf16_t* BKt = BKm + 32 * 72; bf16_t* Vt = BKt + 64 * 40; float* WL = (float*)(Vt + 64 * 24);
      (void)ARt; (void)BKm; (void)BKt; (void)Vt; (void)WL;
    {
      f32x4 aw = {0.f, 0.f, 0.f, 0.f}, aa = {0.f, 0.f, 0.f, 0.f};
#pragma unroll
      for (int ks = 0; ks < 2; ++ks) {
        const bf16x8 fw = *(const bf16x8*)(Aw + fr * 72 + ks * 32 + fq * 8);
        const bf16x8 fa = *(const bf16x8*)(Aa + fr * 72 + ks * 32 + fq * 8);
        aw = MFMA16(bw[ks], fw, aw);
        aa = MFMA16(ba[ks], fa, aa);
      }
      const int c = 16 * w + fq * 4;
      const float* rj = rec + fr * 192;
      const f32x4 w0v = *(const f32x4*)(cst + 640 + c), a0v = *(const f32x4*)(cst + 704 + c), kav = *(const f32x4*)(cst + 832 + c);
      const f32x4 kkv = *(const f32x4*)(rj + 0 + c), kpv = *(const f32x4*)(rj + 64 + c), rpv = *(const f32x4*)(rj + 128 + c);
      f32x4 e, E, ic;
#pragma unroll
      for (int j = 0; j < 4; ++j) {
        const float z = -(w0v[j] + aw[j]);
        const float sp = fmaxf(z, 0.f) + __logf(1.f + __expf(-fabsf(z)));
        e[j] = __expf(-sp - 0.5f);
        ic[j] = sigmoidf_(a0v[j] + aa[j]);
      }
      E = e;
#pragma unroll
      for (int j = 0; j < 4; ++j) {
        E[j] += dpp_f<0x111>(E[j]);
        E[j] += dpp_f<0x112>(E[j]);
        E[j] += dpp_f<0x114>(E[j]);
        E[j] += dpp_f<0x118>(E[j]);
      }
      f32x4 at, rt, bt, kt_;
#pragma unroll
      for (int j = 0; j < 4; ++j) {
        const float wi = __expf(E[j]);
        at[j] = -kkv[j] * __expf(e[j] - E[j]);
        rt[j] = rpv[j] * __expf(-E[j]);
        bt[j] = kkv[j] * ic[j] * wi;
        kt_[j] = kpv[j] * (1.f + (ic[j] - 1.f) * kav[j]) * wi;
      }
      st4bf(ARt + fr * 72 + c, at);
      st4bf(ARt + (16 + fr) * 72 + c, rt);
      st4bf(BKm + fr * 72 + c, bt);
      st4bf(BKm + (16 + fr) * 72 + c, kt_);
#pragma unroll
      for (int j = 0; j < 4; ++j) { BKt[(c + j) * 40 + fr] = f2bf(bt[j]); BKt[(c + j) * 40 + 16 + fr] = f2bf(kt_[j]); }
      if (fr == 15) {
#pragma unroll
        for (int j = 0; j < 4; ++j) WL[c + j] = __expf(-E[j]);
      }
    }
    }
#pragma unroll 1
  for (int ch = 0; ch < 144; ++ch) {
    const int cb = ch & 1, nb = cb ^ 1;
    const bool more = ch + 1 < 144;
    f32x4 XA, XR;
    __syncthreads();
    if (more) {
    {
      bf16_t* ARt = OPS + (nb) * OPS_STRIDE; bf16_t* BKm = ARt + 32 * 72; bf16_t* BKt = BKm + 32 * 72; bf16_t* Vt = BKt + 64 * 40; float* WL = (float*)(Vt + 64 * 24);
      (void)ARt; (void)BKm; (void)BKt; (void)Vt; (void)WL;
    {
      f32x4 xs[5];
#pragma unroll
      for (int g = 0; g < 5; ++g) {
        const f32x4 x = {bflo(raw[g][1].x), bfhi(raw[g][1].x), bflo(raw[g][1].y), bfhi(raw[g][1].y)};
        const f32x4 xm = {bflo(raw[g][0].x), bfhi(raw[g][0].x), bflo(raw[g][0].y), bfhi(raw[g][0].y)};
        const f32x4 xp = {bflo(raw[g][2].x), bfhi(raw[g][2].x), bflo(raw[g][2].y), bfhi(raw[g][2].y)};
        const f32x4 m0 = *(const f32x4*)(cst + g * 64 + pcg * 4), m1 = *(const f32x4*)(cst + 320 + g * 64 + pcg * 4);
        xs[g] = x + m0 * (xm - x) + m1 * (xp - x);
      }
      float* rj = rec + pj * 192;
      *(f32x4*)(rj + 128 + pcg * 4) = xs[0];
#pragma unroll
      for (int e = 0; e < 4; ++e) Vt[(pcg * 4 + e) * 24 + pj] = f2bf(xs[2][e]);
      const f32x4 kx = xs[1] * *(const f32x4*)(cst + 768 + pcg * 4);
      float ss = (kx[0] * kx[0] + kx[1] * kx[1]) + (kx[2] * kx[2] + kx[3] * kx[3]);
      ss = red8(ss); ss += dpp_f<0x140>(ss);
      const float rn = rsqrtf(ss + 1e-12f);
      *(f32x4*)(rj + 0 + pcg * 4) = kx * rn;
      *(f32x4*)(rj + 64 + pcg * 4) = xs[1];
      f32x4 tw;
#pragma unroll
      for (int j = 0; j < 4; ++j) tw[j] = 1.f - 2.f * __builtin_amdgcn_rcpf(1.f + __expf(2.f * xs[3][j]));
      st4bf(Aw + pj * 72 + pcg * 4, tw);
      st4bf(Aa + pj * 72 + pcg * 4, xs[4]);
    }
    }
      if (ch + 2 < 144) prefetch(ch + 2);
    }
    {
      bf16_t* ARt = OPS + (cb) * OPS_STRIDE; bf16_t* BKm = ARt + 32 * 72; bf16_t* BKt = BKm + 32 * 72; bf16_t* Vt = BKt + 64 * 40; float* WL = (float*)(Vt + 64 * 24);
      (void)ARt; (void)BKm; (void)BKt; (void)Vt; (void)WL;
    {
      const int ct = w >> 1, tt = w & 1;
      f32x4 g = {0.f, 0.f, 0.f, 0.f};
#pragma unroll
      for (int ks = 0; ks < 2; ++ks) {
        const bf16x8 A = *(const bf16x8*)(BKm + (ct * 16 + fr) * 72 + ks * 32 + fq * 8);
        const bf16x8 B = *(const bf16x8*)(ARt + (tt * 16 + fr) * 72 + ks * 32 + fq * 8);
        g = MFMA16(A, B, g);
      }
#pragma unroll
      for (int r = 0; r < 4; ++r) Gf[(ct * 16 + fq * 4 + r) * 33 + tt * 16 + fr] = g[r];
      if (w == 0) {
#pragma unroll
        for (int r = 0; r < 4; ++r) GNt[(fq * 4 + r) * 16 + fr] = g[r];
      }
    }
    XA = (f32x4){0.f, 0.f, 0.f, 0.f}; XR = (f32x4){0.f, 0.f, 0.f, 0.f};
#pragma unroll
    for (int ks = 0; ks < 2; ++ks) {
      const bf16x8 Bs = pack8(ST[2 * ks], ST[2 * ks + 1]);
      {
        const bf16_t* ar = ARt + fr * 72 + fq * 4;
        const s16x4 lo = *(const s16x4*)(ar + (2 * ks) * 16), hi = *(const s16x4*)(ar + (2 * ks + 1) * 16);
        XA = MFMA16(__builtin_shufflevector(lo, hi, 0, 1, 2, 3, 4, 5, 6, 7), Bs, XA);
      }
      {
        const bf16_t* ar = ARt + (16 + fr) * 72 + fq * 4;
        const s16x4 lo = *(const s16x4*)(ar + (2 * ks) * 16), hi = *(const s16x4*)(ar + (2 * ks + 1) * 16);
        XR = MFMA16(__builtin_shufflevector(lo, hi, 0, 1, 2, 3, 4, 5, 6, 7), Bs, XR);
      }
    }
    }
    __syncthreads();
    if (more) {
    {
      bf16_t* ARt = OPS + (nb) * OPS_STRIDE; bf16_t* BKm = ARt + 32 * 72; bf16_t* BKt = BKm + 32 * 72; bf16_t* Vt = BKt + 64 * 40; float* WL = (float*)(Vt + 64 * 24);
      (void)ARt; (void)BKm; (void)BKt; (void)Vt; (void)WL;
    {
      f32x4 aw = {0.f, 0.f, 0.f, 0.f}, aa = {0.f, 0.f, 0.f, 0.f};
#pragma unroll
      for (int ks = 0; ks < 2; ++ks) {
        const bf16x8 fw = *(const bf16x8*)(Aw + fr * 72 + ks * 32 + fq * 8);
        const bf16x8 fa = *(const bf16x8*)(Aa + fr * 72 + ks * 32 + fq * 8);
        aw = MFMA16(bw[ks], fw, aw);
        aa = MFMA16(ba[ks], fa, aa);
      }
      const int c = 16 * w + fq * 4;
      const float* rj = rec + fr * 192;
      const f32x4 w0v = *(const f32x4*)(cst + 640 + c), a0v = *(const f32x4*)(cst + 704 + c), kav = *(const f32x4*)(cst + 832 + c);
      const f32x4 kkv = *(const f32x4*)(rj + 0 + c), kpv = *(const f32x4*)(rj + 64 + c), rpv = *(const f32x4*)(rj + 128 + c);
      f32x4 e, E, ic;
#pragma unroll
      for (int j = 0; j < 4; ++j) {
        const float z = -(w0v[j] + aw[j]);
        const float sp = fmaxf(z, 0.f) + __logf(1.f + __expf(-fabsf(z)));
        e[j] = __expf(-sp - 0.5f);
        ic[j] = sigmoidf_(a0v[j] + aa[j]);
      }
      E = e;
#pragma unroll
      for (int j = 0; j < 4; ++j) {
        E[j] += dpp_f<0x111>(E[j]);
        E[j] += dpp_f<0x112>(E[j]);
        E[j] += dpp_f<0x114>(E[j]);
        E[j] += dpp_f<0x118>(E[j]);
      }
      f32x4 at, rt, bt, kt_;
#pragma unroll
      for (int j = 0; j < 4; ++j) {
        const float wi = __expf(E[j]);
        at[j] = -kkv[j] * __expf(e[j] - E[j]);
        rt[j] = rpv[j] * __expf(-E[j]);
        bt[j] = kkv[j] * ic[j] * wi;
        kt_[j] = kpv[j] * (1.f + (ic[j] - 1.f) * kav[j]) * wi;
      }
      st4bf(ARt + fr * 72 + c, at);
      st4bf(ARt + (16 + fr) * 72 + c, rt);
      st4bf(BKm + fr * 72 + c, bt);
      st4bf(BKm + (16 + fr) * 72 + c, kt_);
#pragma unroll
      for (int j = 0; j < 4; ++j) { BKt[(c + j) * 40 + fr] = f2bf(bt[j]); BKt[(c + j) * 40 + 16 + fr] = f2bf(kt_[j]); }
      if (fr == 15) {
#pragma unroll
        for (int j = 0; j < 4; ++j) WL[c + j] = __expf(-E[j]);
      }
    }
    }
    }
    {
      bf16_t* ARt = OPS + (cb) * OPS_STRIDE; bf16_t* BKm = ARt + 32 * 72; bf16_t* BKt = BKm + 32 * 72; bf16_t* Vt = BKt + 64 * 40; float* WL = (float*)(Vt + 64 * 24);
      (void)ARt; (void)BKm; (void)BKt; (void)Vt; (void)WL;
    const bf16x8 vB = fq < 2 ? *(const bf16x8*)(Vt + (16 * w + fr) * 24 + fq * 8) : zero8;
    {
      f32x4 n0, n1;
#pragma unroll
      for (int jj = 0; jj < 4; ++jj) {
        const int i0 = fq * 8 + jj, i1 = fq * 8 + 4 + jj;
        const float g0 = Gf[(16 + (i0 & 15)) * 33 + fr], g1 = Gf[(16 + (i1 & 15)) * 33 + fr];
        n0[jj] = (fq < 2 && i0 < fr) ? g0 : 0.f;
        n1[jj] = (fq < 2 && i1 < fr) ? g1 : 0.f;
      }
      XA = MFMA16(pack8(n0, n1), vB, XA);
    }
    float* yw = Yf + (w * 16 + fr) * 20;
    *(f32x4*)(yw + fq * 4) = XA;
    float u[16];
    {
      const f32x4 y0 = *(const f32x4*)(yw), y1 = *(const f32x4*)(yw + 4), y2 = *(const f32x4*)(yw + 8), y3 = *(const f32x4*)(yw + 12);
#pragma unroll
      for (int j = 0; j < 4; ++j) { u[j] = y0[j]; u[4 + j] = y1[j]; u[8 + j] = y2[j]; u[12 + j] = y3[j]; }
#pragma unroll
      for (int i = 0; i < 15; ++i) {
#pragma unroll
        for (int t4 = (i + 1) / 4; t4 < 4; ++t4) {
          const f32x4 nn = *(const f32x4*)(GNt + i * 16 + t4 * 4);
#pragma unroll
          for (int e2 = 0; e2 < 4; ++e2) if (t4 * 4 + e2 > i) u[t4 * 4 + e2] += u[i] * nn[e2];
        }
      }
    }
    f32x4 uq;
#pragma unroll
    for (int j = 0; j < 4; ++j) uq[j] = fq == 0 ? u[j] : (fq == 1 ? u[4 + j] : (fq == 2 ? u[8 + j] : u[12 + j]));
    const bf16x8 uB = pack4z(uq);
    {
      f32x4 m0, n0, n1;
#pragma unroll
      for (int jj = 0; jj < 4; ++jj) {
        const int i = fq * 4 + jj;
        const float gm = Gf[i * 33 + 16 + fr];
        m0[jj] = i <= fr ? gm : 0.f;
        const int i0 = fq * 8 + jj, i1 = fq * 8 + 4 + jj;
        const float g0 = Gf[(16 + (i0 & 15)) * 33 + 16 + fr], g1 = Gf[(16 + (i1 & 15)) * 33 + 16 + fr];
        n0[jj] = (fq < 2 && i0 <= fr) ? g0 : 0.f;
        n1[jj] = (fq < 2 && i1 <= fr) ? g1 : 0.f;
      }
      XR = MFMA16(pack4z(m0), uB, XR);
      XR = MFMA16(pack8(n0, n1), vB, XR);
#pragma unroll
      for (int r = 0; r < 4; ++r) obuf[(fq * 4 + r) * 64 + 16 * w + fr] = XR[r];
    }
#pragma unroll
    for (int kt = 0; kt < 4; ++kt) {
      const bf16_t* bk = BKt + (kt * 16 + fr) * 40;
      const s16x4 lo = *(const s16x4*)(bk + fq * 4);
      const s16x4 z4 = {0, 0, 0, 0};
      ST[kt] = MFMA16(__builtin_shufflevector(lo, z4, 0, 1, 2, 3, 4, 5, 6, 7), uB, ST[kt]);
      const bf16x8 a5 = fq < 2 ? *(const bf16x8*)(bk + 16 + fq * 8) : zero8;
      ST[kt] = MFMA16(a5, vB, ST[kt]);
      ST[kt] *= *(const f32x4*)(WL + kt * 16 + fq * 4);
    }
    }
    __syncthreads();
    if (ch >= 16 || need_ctx) {
      int rowbase, t, L;
      chunk_tok(ch, pj, rowbase, t, L);
      const f32x4 ov = *(const f32x4*)(obuf + pj * 64 + pcg * 4);
      st4bf(p.Os + ((size_t)dir * NTOK + rowbase + t) * 512 + hd * 64 + pcg * 4, ov);
    }
  }
  __syncthreads();
}

DI void mixer_phase(const Params& p, int l, bool need_ctx, char* lds, long long* scan_t) {
  int& s_item = *(int*)(lds + LDS_WORK + 16);
  sg_phase(p, l);
  { long long t0 = 0; if (PROBE_MASK) t0 = wall_clock64();
    __builtin_amdgcn_s_setprio(3);
    for (int s = blockIdx.x; s < 256; s += gridDim.x) scan_block3(p, l, s, need_ctx, lds);
    __builtin_amdgcn_s_setprio(0);
#ifdef SCAN_ALONE
    if (blockIdx.x < 256) { __syncthreads(); if (tid_() == 0) { __threadfence(); atomicAdd(&p.counters[8 + l], 1u); } }
    else { if (tid_() == 0) { while (atomicAdd(&p.counters[8 + l], 0u) < 256u) __builtin_amdgcn_s_sleep(32); } __syncthreads(); }
#endif
    if ((PROBE_MASK >> 13) & 1) *scan_t += wall_clock64() - t0; }
  const int nitems = 4096 + (need_ctx ? 512 : 0);
  while (true) {
    __syncthreads();
    if (tid_() == 0) s_item = (int)atomicAdd(&p.counters[l], 1u);
    __syncthreads();
    const int it = s_item;
    if (it >= nitems) break;
    if (it < 2048) {
      const int b = it >> 7, head = (it >> 4) & 7, qb = it & 15, kvh = head >> 2;
      dense_item(p, b * TL + qb * 128, head * 64, b * TL, 32, NTL + b * TC, 512 + kvh * 64, 640 + kvh * 64, lds);
    } else if (it < 4096) {
      const int i2 = it - 2048;
      const int b = i2 >> 7, gr = (i2 >> 2) & 31, hp = i2 & 3;
      na_item(p, l, b, gr, hp, lds);
    } else if (it < 4352) {
      const int i2 = it - 4096;
      const int b = i2 >> 4, head = (i2 >> 1) & 7, qb = i2 & 1, kvh = head >> 2;
      dense_item(p, NTL + b * TC + qb * 128, head * 64, 0, 0, NTL + b * TC, 512 + kvh * 64, 640 + kvh * 64, lds);
    } else {
      const int i2 = it - 4352;
      const int b = i2 >> 4, head = (i2 >> 1) & 7, qb = i2 & 1;
      dense_item(p, NTL + b * TC + qb * 128, 2688 + head * 64, 0, 0, NTL + b * TC, 3200 + head * 64, 3712 + head * 64, lds);
    }
  }
}

template <int MI>
DI void merge_phaseT(const Params& p, int l, int M, char* lds) {
  const int ntm = M / (MI * 32), ntn = 8;
  const int lane = tid_() & 63, wid = tid_() >> 6, wr = wid >> 1, wc = wid & 1, fr = lane & 15, fq = lane >> 4;
  const bf16_t* wm = p.WM + (size_t)l * WM_STRIDE;
  int tm, tn;
  for (int it = 0; xcd_tile<2, 8>(it, ntm, ntn, tm, tn); ++it) {
    const size_t grow = (size_t)tm * (MI * 32);
#pragma unroll 1
    for (int z = 0; z < 3; ++z) {
      f32x4 acc[MI][4];
#pragma unroll
      for (int mi = 0; mi < MI; ++mi)
#pragma unroll
        for (int ni = 0; ni < 4; ++ni) acc[mi][ni] = (f32x4){0.f, 0.f, 0.f, 0.f};
      gemm_mainloopT<MI>(p.U + grow * DM, DM, wm + WM_IN + (size_t)(DPROJ + z * DM + tn * 128) * DM, DM, acc, lds);
      {
      bf16_t* prow;
      { const int t2 = tid_(), l2 = t2 & 63, w2 = t2 >> 6; prow = p.P + (grow + (w2 >> 1) * (MI * 16) + (l2 & 15)) * DPROJ + tn * 128 + (w2 & 1) * 64 + (l2 >> 4) * 4; }
#pragma unroll
      for (int mi = 0; mi < MI; ++mi) {
#pragma unroll
        for (int ni = 0; ni < 4; ++ni) {
          f32x4 g;
#pragma unroll
          for (int j = 0; j < 4; ++j) g[j] = sigmoidf_(acc[mi][ni][j]);
          st4bf(prow + (size_t)(mi * 16) * DPROJ + 512 + ni * 16, g);
          acc[mi][ni] = (f32x4){0.f, 0.f, 0.f, 0.f};
        }
        asm volatile("" ::: "memory");
      }
      }
      const bf16_t* Ya = z == 1 ? p.yr : (z == 0 ? p.P : p.P + 2688);
      const int lda = z == 1 ? 512 : DPROJ;
      gemm_mainloopT<MI>(Ya + grow * lda, lda, wm + WM_BR + (size_t)z * 1024 * 512 + (size_t)tn * 128 * 512, 512, acc, lds);
      {
      bf16_t* prow;
      { const int t2 = tid_(), l2 = t2 & 63, w2 = t2 >> 6; prow = p.P + (grow + (w2 >> 1) * (MI * 16) + (l2 & 15)) * DPROJ + tn * 128 + (w2 & 1) * 64 + (l2 >> 4) * 4; }
#pragma unroll
      for (int mi = 0; mi < MI; ++mi) {
#pragma unroll
        for (int ni = 0; ni < 4; ++ni) {
          bf16_t* q = prow + (size_t)(mi * 16) * DPROJ + ni * 16;
          f32x4 mn = ld4bf(q + 512) * acc[mi][ni];
          if (z > 0) mn += ld4bf(q + 3200);
          st4bf(q + 3200, mn);
        }
        asm volatile("" ::: "memory");
      }
      }
    }
  }
}

DI void merge_phase(const Params& p, int l, int row0, int M, char* lds) {
  const int ntm = M >> 7, ntn = 8;
  const int lane = tid_() & 63, wid = tid_() >> 6, wr = wid >> 1, wc = wid & 1, fr = lane & 15, fq = lane >> 4;
  const bf16_t* wm = p.WM + (size_t)l * WM_STRIDE;
  int tm, tn;
  for (int it = 0; xcd_tile<2, 8>(it, ntm, ntn, tm, tn); ++it) {
    const size_t grow = (size_t)row0 + tm * 128;
#pragma unroll 1
    for (int z = 0; z < 3; ++z) {
      u32x2 gp[4][4];
      {
        f32x4 acc[4][4];
        zero_acc(acc);
        gemm_mainloop2(p.U + grow * DM, DM, wm + WM_IN + (size_t)(DPROJ + z * DM + tn * 128) * DM, DM, acc, lds);
#pragma unroll
        for (int mi = 0; mi < 4; ++mi)
#pragma unroll
          for (int ni = 0; ni < 4; ++ni) {
            gp[mi][ni].x = pk2(sigmoidf_(acc[mi][ni][0]), sigmoidf_(acc[mi][ni][1]));
            gp[mi][ni].y = pk2(sigmoidf_(acc[mi][ni][2]), sigmoidf_(acc[mi][ni][3]));
          }
      }
      {
        f32x4 acc[4][4];
        zero_acc(acc);
        const bf16_t* Ya = z == 1 ? p.yr : (z == 0 ? p.P : p.P + 2688);
        const int lda = z == 1 ? 512 : DPROJ;
        gemm_mainloop2(Ya + grow * lda, lda, wm + WM_BR + (size_t)z * 1024 * 512 + (size_t)tn * 128 * 512, 512, acc, lds);
#pragma unroll
        for (int mi = 0; mi < 4; ++mi)
#pragma unroll
          for (int ni = 0; ni < 4; ++ni) asm volatile("" : "+v"(gp[mi][ni].x), "+v"(gp[mi][ni].y));
#pragma unroll
        for (int mi = 0; mi < 4; ++mi) {
          const int row = tm * 128 + wr * 64 + mi * 16 + fr;
#pragma unroll
          for (int ni = 0; ni < 4; ++ni) {
            bf16_t* mp = p.P + (grow + wr * 64 + mi * 16 + fr) * DPROJ + 3200 + tn * 128 + wc * 64 + ni * 16 + fq * 4;
            const f32x4 g = {bflo(gp[mi][ni].x), bfhi(gp[mi][ni].x), bflo(gp[mi][ni].y), bfhi(gp[mi][ni].y)};
            f32x4 mn = g * acc[mi][ni];
            if (z > 0) mn += ld4bf(mp);
            st4bf(mp, mn);
          }
        }
      }
    }
  }
}

#define MAKE_LN_EPI(MI_, e, WHICH, SRC_LAT, SRC_CTX)                                                                    \
  EpiResidLN<MI_> e;                                                                                                        \
  {                                                                                                                    \
    const float* mods_l_ = p.mods + (size_t)l * 17 * NMOD;                                                             \
    e.src_lat = (SRC_LAT); e.src_ctx = (SRC_CTX); e.dst_lat = p.out; e.dst_ctx = p.ctxx;                               \
    e.gate = mods_l_ + ((WHICH) * 3 + 2) * DM;                                                                         \
    e.gmul = (WHICH) == 1 ? 1.f : 0.5f;                                                                                \
    e.lng = p.ln_g + (l * 3 + (WHICH)) * DM; e.lnb = p.ln_b + (l * 3 + (WHICH)) * DM;                                  \
    e.mods_next = (WHICH) < 2 ? mods_l_ : p.mods + (size_t)(l == 0 ? 1 : 0) * 17 * NMOD;                               \
    e.shift_idx = (WHICH) < 2 ? (WHICH) * 3 + 3 : 0;                                                                   \
    e.U = ((WHICH) < 2 || l == 0) ? p.U : nullptr;                                                                     \
    e.stats = p.stats; e.cnt = p.lncnt + (l * 3 + (WHICH)) * 288;                                                      \
  }

template <int S>
DI void layer_step(const Params& p, int l, char* lds, long long* scan_t = nullptr) {
  const bool last = l == 1;
  const bool need_ctx = !last;
  const int Mall = NTOK, Mx = need_ctx ? NTOK : NTL;
  const bf16_t* wm = p.WM + (size_t)l * WM_STRIDE;
  if constexpr (S == 0) {
    EpiAct<8> e; e.H = p.H;
    gemm_phaseT<8, 8, 4>(p.U, DM, Mall, 0, p.WF, DM, 2 * DFF, e, lds);
  } else if constexpr (S == 1) {
    MAKE_LN_EPI(6, e, 0, l == 0 ? p.x_in : p.out, l == 0 ? p.ctx_in : p.ctxx)
    gemm_phaseT<6, 8, 8, true>(p.H, LDH, Mall, 0, p.WF + WF_WO, DFF, DM, e, lds, LDH);
  } else if constexpr (S == 3) {
    EpiProj<8> e; e.p = &p; e.l = l;
    gemm_phaseT<8, 8, 3>(p.U, DM, Mall, 0, wm + WM_IN, DM, DPROJ, e, lds);
  } else if constexpr (S == 4) {
    mixer_phase(p, l, need_ctx, lds, scan_t);
  } else if constexpr (S == 5) {
    EpiReadout e; e.p = &p; e.l = l;
    gemm_phase(p.sg, 128, Mx, p.g2 + (size_t)l * 128 * 512, 512, 128, 512, MapHeadPerm(), e, lds);
  } else if constexpr (S == 9) {
    EpiAct<8> e; e.H = p.H;
    gemm_phaseT<8, 8, 4>(p.U, DM, Mx, 0, p.WF + WF_SLOT, DM, 2 * DFF, e, lds);
  } else if constexpr (S == 10) {
    if (need_ctx) {
      MAKE_LN_EPI(6, e, 2, p.out, p.ctxx)
      gemm_phaseT<6, 8, 8, true>(p.H, LDH, NTOK, 0, p.WF + WF_SLOT + WF_WO, DFF, DM, e, lds, LDH);
    } else {
      MAKE_LN_EPI(8, e, 2, p.out, p.ctxx)
      gemm_phaseT<8, 8, 8, true>(p.H, LDH, NTL, 0, p.WF + WF_SLOT + WF_WO, DFF, DM, e, lds, LDH);
    }
    if (!last) convert_ffn(p, 0, p.ffn1_wi + (size_t)(l + 1) * DM * 2 * DFF, p.ffn1_wo + (size_t)(l + 1) * DFF * DM, lds);
  }
}

template <int S>
DI void merge_step(const Params& p, int l, char* lds) {
  const int Mx = l == 0 ? NTOK : NTL;
  const bf16_t* wm = p.WM + (size_t)l * WM_STRIDE;
  if constexpr (S == 0) {
    if (l == 0) merge_phase(p, l, 0, NTOK, lds); else merge_phaseT<8>(p, l, NTL, lds);
  } else {
    if (l == 0) {
      MAKE_LN_EPI(6, e, 1, p.out, p.ctxx)
      gemm_phaseT<6, 8, 8>(p.P + 3200, DPROJ, NTOK, 0, wm + WM_OUT, DM, DM, e, lds);
    } else {
      MAKE_LN_EPI(8, e, 1, p.out, p.ctxx)
      gemm_phaseT<8, 8, 8>(p.P + 3200, DPROJ, NTL, 0, wm + WM_OUT, DM, DM, e, lds);
    }
    convert_ffn(p, 1, p.ffn2_wi + (size_t)l * DM * 2 * DFF, p.ffn2_wo + (size_t)l * DFF * DM, lds);
  }
}

#define XB_TMO      128
#define XB_XCNT(j)  (256  + 64 * (j))
#define XB_XSUB(j)  (1280 + 64 * (j))
#define XB_XGEN(j)  (2304 + 64 * (j))
#define XB_TOP      3328
#define XB_TOPGEN   3392
#define XCD_BAR_WORDS 3456
#define XB_SPIN_CAP (1u << 18)
DI unsigned xb_ld(unsigned* p) { return __hip_atomic_load(p, __ATOMIC_RELAXED, __HIP_MEMORY_SCOPE_AGENT); }
DI unsigned xb_add(unsigned* p, unsigned v) { return __hip_atomic_fetch_add(p, v, __ATOMIC_RELAXED, __HIP_MEMORY_SCOPE_AGENT); }
DI unsigned xb_xcc_id() { return (unsigned)__builtin_amdgcn_s_getreg((3 << 11) | 20) & 0xFu; }
#define XB_SPIN(cond, bar) do { unsigned _sp = 0; while (cond) { __builtin_amdgcn_s_sleep(1); \
    if ((++_sp & 255u) == 0u) { if (xb_ld(&(bar)[XB_TMO])) break; if (_sp > XB_SPIN_CAP) { atomicAdd(&(bar)[XB_TMO], 1u); break; } } } } while (0)
struct XcdBarrier { unsigned* bar; unsigned x; volatile LAS unsigned* st; };
DI XcdBarrier xcd_barrier_post(unsigned* bar, volatile LAS unsigned* st) {
  XcdBarrier b; b.bar = bar; b.x = xb_xcc_id(); b.st = st;
  if (threadIdx.x == 0) (void)xb_add(&bar[XB_XCNT(b.x)], 1u);
  return b;
}
DI void xcd_barrier_complete(unsigned* bar, unsigned x, unsigned& nloc, unsigned& nx) {
  const unsigned G = gridDim.x * gridDim.y * gridDim.z;
  unsigned sum, cnt, mine, sp = 0u;
  for (;;) {
    sum = 0u; cnt = 0u; mine = 0u;
#pragma unroll
    for (unsigned j = 0; j < 16; ++j) { const unsigned c = xb_ld(&bar[XB_XCNT(j)]); sum += c; cnt += (c > 0u) ? 1u : 0u; mine = (j == x) ? c : mine; }
    if (sum == G) break;
    __builtin_amdgcn_s_sleep(1);
    if ((++sp & 255u) == 0u) { if (xb_ld(&bar[XB_TMO])) break; if (sp > XB_SPIN_CAP) { atomicAdd(&bar[XB_TMO], 1u); break; } }
  }
  nloc = mine > 0u ? mine : 1u; nx = cnt > 0u ? cnt : 1u;
}
DI void xcd_barrier(const XcdBarrier& b) {
  asm volatile("s_waitcnt vmcnt(0)" ::: "memory");
  __syncthreads();
  if (threadIdx.x == 0) {
    unsigned* bar = b.bar;
    __builtin_amdgcn_s_waitcnt(0);
    unsigned nloc = b.st[0], nx = b.st[1];
    if (nloc == 0u) { xcd_barrier_complete(bar, b.x, nloc, nx); b.st[0] = nloc; b.st[1] = nx; }
    const unsigned old = xb_add(&bar[XB_XSUB(b.x)], 1u);
    const unsigned gen = old / nloc;
    if (old + 1u == (gen + 1u) * nloc) {
      __builtin_amdgcn_fence(__ATOMIC_RELEASE, "agent");
      asm volatile("s_waitcnt vmcnt(0)" ::: "memory");
      const unsigned og = xb_add(&bar[XB_TOP], 1u);
      const unsigned tg = og / nx;
      if (og + 1u == (tg + 1u) * nx) xb_add(&bar[XB_TOPGEN], 1u);
      else XB_SPIN(xb_ld(&bar[XB_TOPGEN]) == tg, bar);
      __builtin_amdgcn_fence(__ATOMIC_ACQUIRE, "agent");
      xb_add(&bar[XB_XGEN(b.x)], 1u);
      asm volatile("s_waitcnt vmcnt(0)" ::: "memory");
    } else {
      XB_SPIN(xb_ld(&bar[XB_XGEN(b.x)]) == gen, bar);
      __builtin_amdgcn_fence(__ATOMIC_ACQUIRE, "agent");
      asm volatile("s_waitcnt vmcnt(0)" ::: "memory");
    }
  }
  __syncthreads();
}

#define TIMED(id, ...) { long long _t0 = 0; if (PROBE_MASK) _t0 = wall_clock64(); __VA_ARGS__; if ((PROBE_MASK >> (id)) & 1) probe_t += wall_clock64() - _t0; }
__global__ void __launch_bounds__(NTHREADS, 2) fwd_megakernel(Params p) {
  __shared__ __attribute__((aligned(16))) char lds[LDS_BYTES];
  cg::grid_group grid = cg::this_grid();
  long long probe_t = 0;
  if (threadIdx.x == 0) *(u32x4*)(lds + LDS_WORK) = (u32x4){0u, 0u, 0u, 0u};
  __syncthreads();
  (void)xcd_barrier_post(p.bar, (volatile LAS unsigned*)(LAS char*)(lds + LDS_WORK));
#define GSYNC() do { XcdBarrier xb_; xb_.bar = p.bar; xb_.x = xb_xcc_id(); xb_.st = (volatile LAS unsigned*)(LAS char*)(lds + LDS_WORK); xcd_barrier(xb_); } while (0)
  TIMED(0, mods_phase(p, lds);
  convert_ffn(p, 0, p.ffn1_wi, p.ffn1_wo, lds);
  convert_mixer(p, 0, lds);
  convert_mixer(p, 1, lds);
  if (p.bar == nullptr) grid.sync();
  GSYNC();
  u0_phase(p);
  GSYNC();)
#pragma unroll 1
  for (int l = 0; l < 2; ++l) {
    TIMED(1, layer_step<0>(p, l, lds); GSYNC();)
    TIMED(2, layer_step<1>(p, l, lds); GSYNC();)
    TIMED(4, layer_step<3>(p, l, lds); GSYNC();)
    TIMED(5, layer_step<4>(p, l, lds, &probe_t); GSYNC();)
    TIMED(6, layer_step<5>(p, l, lds); GSYNC();)
    TIMED(7, merge_step<0>(p, l, lds); GSYNC();)
    TIMED(8, merge_step<1>(p, l, lds); GSYNC();)
    TIMED(10, layer_step<9>(p, l, lds); GSYNC();)
    TIMED(11, layer_step<10>(p, l, lds);
    if (l == 0) GSYNC();)
  }
  if (PROBE_MASK) {
    if (blockIdx.x == 0 && threadIdx.x == 0) {
      const long long t1 = wall_clock64();
      while (wall_clock64() - t1 < probe_t) __builtin_amdgcn_s_sleep(8);
    }
  }
}

extern "C" void kernel_launch(void* const* d_in, const int* in_sizes, int n_in, void* d_out, int out_size, void* d_ws, size_t ws_size,
                              hipStream_t stream) {
  static int grid_blocks = 0;
  if (!grid_blocks) {
    int dev = 0, cus = 0, per_cu = 0;
    hipGetDevice(&dev);
    hipDeviceGetAttribute(&cus, hipDeviceAttributeMultiprocessorCount, dev);
    hipOccupancyMaxActiveBlocksPerMultiprocessor(&per_cu, fwd_megakernel, NTHREADS, 0);
    if (per_cu < 1) per_cu = 1;
    grid_blocks = cus * per_cu;
  }
  Params p{};
  const float* const* in = (const float* const*)d_in;
  p.x_in = in[0]; p.c = in[1]; p.ctx_in = in[2]; p.c_ctx = in[3]; p.w_ada = in[4]; p.b_ada = in[5];
  p.ffn1_wi = in[6]; p.ffn1_wo = in[7]; p.ffn2_wi = in[8]; p.ffn2_wo = in[9]; p.ln_g = in[10]; p.ln_b = in[11]; p.w_in = in[12];
  p.q_gain = in[13]; p.k_gain = in[14]; p.mu = in[15]; p.w0 = in[16]; p.w2 = in[17]; p.a0 = in[18]; p.a2 = in[19]; p.g2 = in[20];
  p.k_k = in[21]; p.k_a = in[22]; p.r_k = in[23]; p.gn_g = in[24]; p.gn_b = in[25]; p.rpb = in[26]; p.w_branch = in[27]; p.w_out = in[28];
  p.out = (float*)d_out;
  char* ws = (char*)d_ws;
  const size_t MiB = 1ull << 20;
  p.counters = (unsigned*)ws;
  p.rope = (float*)(ws + 4096);
  p.lncnt = (unsigned*)(ws + 16384);
  p.bar = (unsigned*)(ws + 24576);
  hipMemsetAsync(ws + 24576, 0, XCD_BAR_WORDS * sizeof(unsigned), stream);
  p.stats = (float*)(ws + 507 * MiB);
  p.mods = (float*)(ws + 65536);
  p.ctxx = (float*)(ws + 2 * MiB);
  p.U = (bf16_t*)(ws + 18 * MiB);
  p.H = (bf16_t*)(ws + 90 * MiB);
  p.P = (bf16_t*)(ws + 90 * MiB);
  p.Os = (bf16_t*)(ws + 387 * MiB);
  p.yr = (bf16_t*)(ws + 387 * MiB);
  p.Mg = (bf16_t*)(ws + 423 * MiB);
  p.sg = (bf16_t*)(ws + 459 * MiB);
  p.WM = (bf16_t*)(ws + 468 * MiB);
  p.WF = (bf16_t*)(ws + 423 * MiB);
  if (ws_size < 512 * MiB) fprintf(stderr, "workspace too small: %zu\n", ws_size);
  void* args[] = {&p};
  hipError_t e = hipLaunchCooperativeKernel((void*)fwd_megakernel, dim3(grid_blocks), dim3(NTHREADS), args, 0, stream);
  if (e != hipSuccess) fprintf(stderr, "cooperative launch failed: %s (grid %d)\n", hipGetErrorString(e), grid_blocks);
}
```

```cpp
#include <hip/hip_runtime.h>
#include <hip/hip_cooperative_groups.h>
#include <cstdio>
#include <cstdint>
namespace cg = cooperative_groups;
#ifndef PROBE_MASK
#define PROBE_MASK 0
#endif

#define DI __device__ __forceinline__
typedef unsigned short bf16_t;
typedef short bf16x8 __attribute__((ext_vector_type(8)));
typedef short s16x4 __attribute__((ext_vector_type(4)));
typedef float f32x2 __attribute__((ext_vector_type(2)));
typedef float f32x4 __attribute__((ext_vector_type(4)));
typedef float f32x16 __attribute__((ext_vector_type(16)));
typedef unsigned u32x2 __attribute__((ext_vector_type(2)));
typedef unsigned u32x4 __attribute__((ext_vector_type(4)));
typedef __bf16 nbf16x2 __attribute__((ext_vector_type(2)));

constexpr int DM = 1024, NB = 16, TL = 2048, TC = 256;
constexpr int NTL = NB * TL, NTC = NB * TC, NTOK = NTL + NTC;
constexpr int DFF = 2816, DIN = 7296, DPROJ = 4224;
constexpr int LDH = 2880;
constexpr int NMOD = 9 * DM;
constexpr float LOG2E = 1.4426950408889634f;
constexpr float QSCALE = 0.125f * LOG2E;
constexpr float ALPHA = 1.4142135623730951f;
constexpr int LDS_WORK = 73728;
constexpr int LDS_BYTES = LDS_WORK + 64;
constexpr size_t WM_IN = 0, WM_BR = (size_t)7296 * 1024, WM_OUT = WM_BR + 3 * 1024 * 512, WM_STRIDE = WM_OUT + 1024 * 1024;
constexpr size_t WF_WO = (size_t)2 * 2816 * 1024, WF_SLOT = (size_t)17 * 1024 * 1024 / 2;
constexpr int NTHREADS = 256;

struct Params {
  const float *x_in, *c, *ctx_in, *c_ctx, *w_ada, *b_ada, *ffn1_wi, *ffn1_wo, *ffn2_wi, *ffn2_wo, *ln_g, *ln_b, *w_in,
      *q_gain, *k_gain, *mu, *w0, *w2, *a0, *a2, *g2, *k_k, *k_a, *r_k, *gn_g, *gn_b, *rpb, *w_branch, *w_out;
  float* out;
  float* mods;
  float* rope;
  float* ctxx;
  unsigned* counters;
  bf16_t *U, *H, *P, *Os, *yr, *Mg, *sg, *WF, *WM;
  float* stats;
  unsigned* lncnt;
  unsigned* bar;
};

DI int tid_() { int t = threadIdx.x; asm volatile("" : "+v"(t)); return t; }
DI unsigned pk2(float a, float b) { f32x2 v = {a, b}; nbf16x2 r = __builtin_convertvector(v, nbf16x2); return __builtin_bit_cast(unsigned, r); }
DI bf16_t f2bf(float a) { return (bf16_t)(pk2(a, 0.f) & 0xffffu); }
DI float bflo(unsigned u) { return __uint_as_float(u << 16); }
DI float bfhi(unsigned u) { return __uint_as_float(u & 0xffff0000u); }
DI f32x4 ld4bf(const bf16_t* p) { u32x2 v = *(const u32x2*)p; return (f32x4){bflo(v.x), bfhi(v.x), bflo(v.y), bfhi(v.y)}; }
DI void st4bf(bf16_t* p, f32x4 v) { u32x2 o; o.x = pk2(v[0], v[1]); o.y = pk2(v[2], v[3]); *(u32x2*)p = o; }
DI float sigmoidf_(float x) { return __builtin_amdgcn_rcpf(1.f + __expf(-x)); }
DI float siluf_(float x) { return x * __builtin_amdgcn_rcpf(1.f + __expf(-x)); }
DI int mod_row(int row) { return row < NTL ? (row >> 11) : 16; }

constexpr int LDT = 72;

struct MapPlain { DI int operator()(int tn, int cl) const { return tn * 128 + cl; } };
struct MapHeadPerm { DI int operator()(int tn, int cl) const { return tn * 128 + (cl & 64) + ((cl >> 2) & 3) * 16 + ((cl >> 4) & 3) * 4; } };
struct MapGateUp { DI int operator()(int tn, int cl) const { int sub = cl >> 4, j = cl & 15; return ((sub & 1) ? DFF : 0) + tn * 64 + (sub >> 1) * 16 + j; } };

template <class BMap>
DI void gemm_mainloop(const bf16_t* __restrict__ A, int lda, const float* __restrict__ B, int ldb, int K, int tn, BMap bmap,
                      f32x4 (&acc)[4][4], char* lds) {
  bf16_t* As = (bf16_t*)lds;
  bf16_t* Bs = As + 128 * LDT;
  const int tid = tid_(), lane = tid & 63, wid = tid >> 6, wr = wid >> 1, wc = wid & 1;
  const int fr = lane & 15, fq = lane >> 4;
  const int arow = tid >> 3, akc = tid & 7;
  const int kg = tid >> 5, ng = tid & 31;
  const bf16_t* ap = A + (size_t)arow * lda + akc * 8;
  const float* bp = B + (size_t)(kg * 8) * ldb + bmap(tn, ng * 4);
  u32x4 ra[4];
  f32x4 rb[8];
  const int nk = K >> 6;
#pragma unroll
  for (int i = 0; i < 4; ++i) ra[i] = *(const u32x4*)(ap + (size_t)(i * 32) * lda);
#pragma unroll
  for (int i = 0; i < 8; ++i) rb[i] = *(const f32x4*)(bp + (size_t)i * ldb);
#pragma unroll 1
  for (int kt = 0; kt < nk; ++kt) {
    __syncthreads();
#pragma unroll
    for (int i = 0; i < 4; ++i) *(u32x4*)(As + (arow + i * 32) * LDT + akc * 8) = ra[i];
#pragma unroll
    for (int jn = 0; jn < 4; ++jn) {
      u32x4 w;
      w.x = pk2(rb[0][jn], rb[1][jn]); w.y = pk2(rb[2][jn], rb[3][jn]); w.z = pk2(rb[4][jn], rb[5][jn]); w.w = pk2(rb[6][jn], rb[7][jn]);
      *(u32x4*)(Bs + (ng * 4 + jn) * LDT + kg * 8) = w;
    }
    __syncthreads();
    if (kt + 1 < nk) {
      const bf16_t* ap2 = ap + (kt + 1) * 64;
      const float* bp2 = bp + (size_t)((kt + 1) * 64) * ldb;
#pragma unroll
      for (int i = 0; i < 4; ++i) ra[i] = *(const u32x4*)(ap2 + (size_t)(i * 32) * lda);
#pragma unroll
      for (int i = 0; i < 8; ++i) rb[i] = *(const f32x4*)(bp2 + (size_t)i * ldb);
    }
#pragma unroll
    for (int ks = 0; ks < 2; ++ks) {
      bf16x8 af[4], bfr[4];
#pragma unroll
      for (int mi = 0; mi < 4; ++mi) af[mi] = *(const bf16x8*)(As + (wr * 64 + mi * 16 + fr) * LDT + ks * 32 + fq * 8);
#pragma unroll
      for (int ni = 0; ni < 4; ++ni) bfr[ni] = *(const bf16x8*)(Bs + (wc * 64 + ni * 16 + fr) * LDT + ks * 32 + fq * 8);
#pragma unroll
      for (int mi = 0; mi < 4; ++mi)
#pragma unroll
        for (int ni = 0; ni < 4; ++ni) acc[mi][ni] = __builtin_amdgcn_mfma_f32_16x16x32_bf16(bfr[ni], af[mi], acc[mi][ni], 0, 0, 0);
    }
  }
  __syncthreads();
}

DI void zero_acc(f32x4 (&acc)[4][4]) {
#pragma unroll
  for (int mi = 0; mi < 4; ++mi)
#pragma unroll
    for (int ni = 0; ni < 4; ++ni) acc[mi][ni] = (f32x4){0.f, 0.f, 0.f, 0.f};
}

DI void tile_coords(int tile, int ntm, int ntn, int& tm, int& tn) {
  const int per = 8 * ntn;
  const int g = tile / per, rem = tile - g * per;
  const int gsz = (ntm - g * 8) < 8 ? (ntm - g * 8) : 8;
  tm = g * 8 + rem % gsz;
  tn = rem / gsz;
}

template <class BMap, class Epi>
DI void gemm_phase(const bf16_t* A, int lda, int M, const float* B, int ldb, int K, int N, BMap bmap, const Epi& epi, char* lds) {
  const int ntm = M >> 7, ntn = N >> 7, nt = ntm * ntn;
  const int lane = tid_() & 63, wid = tid_() >> 6;
  for (int tile = blockIdx.x; tile < nt; tile += gridDim.x) {
    int tm, tn;
    tile_coords(tile, ntm, ntn, tm, tn);
    f32x4 acc[4][4];
    zero_acc(acc);
    gemm_mainloop(A + (size_t)tm * 128 * lda, lda, B, ldb, K, tn, bmap, acc, lds);
    epi(tm, tn, wid >> 1, wid & 1, lane, acc);
  }
}

DI int lds_byte(int r, int c) { const int st = (r >> 4) * 2 + (c >> 5), rr = r & 15, cc = c & 31, ob = rr * 64 + cc * 2; return st * 1024 + (ob ^ (((ob >> 9) & 1) << 5)); }
DI void stage_rc(int b, int& R, int& C) { const int st = b >> 10, sb = b & 1023, swz = sb ^ (((sb >> 9) & 1) << 5); R = (st >> 1) * 16 + (swz >> 6); C = (st & 1) * 32 + ((swz & 63) >> 1); }
#define LAS __attribute__((address_space(3)))
DI void glds16(const bf16_t* g, LAS char* l) { __builtin_amdgcn_global_load_lds((const unsigned*)g, (LAS unsigned*)l, 16, 0, 0); }

DI int lds_byte32(int r, int c) { const int ob = (r & 15) * 64 + c * 2; return (r >> 4) * 1024 + (ob ^ (((ob >> 9) & 1) << 5)); }
DI void stage_rc32(int b, int& R, int& C) { const int st = b >> 10, sb = b & 1023, swz = sb ^ (((sb >> 9) & 1) << 5); R = st * 16 + (swz >> 6); C = (swz & 63) >> 1; }

template <int MI>
DI void gemm_mainloopT(const bf16_t* __restrict__ A, int lda, const bf16_t* __restrict__ Bt, int K, f32x4 (&acc)[MI][4], char* lds_generic, int ldb = 0) {
  if (ldb == 0) ldb = K;
  static_assert(MI == 4 || MI == 6 || MI == 8, "MI");
  constexpr int NA = MI / 2;
  constexpr int G = NA + 2;
  constexpr int NST = MI == 4 ? 4 : 3;
  constexpr int ABYTES = MI * 2048, SBYTES = ABYTES + 8192;
  LAS char* lds = (LAS char*)lds_generic;
  const int tid = tid_(), lane = tid & 63, wid = tid >> 6, wr = wid >> 1, wc = wid & 1;
  const int fr = lane & 15, fq = lane >> 4;
  const bf16_t* ap[NA];
  const bf16_t* bp[2];
#pragma unroll
  for (int i = 0; i < NA; ++i) { int R, C; stage_rc32(tid * 16 + i * 4096, R, C); ap[i] = A + (size_t)R * lda + C; }
#pragma unroll
  for (int i = 0; i < 2; ++i) { int R, C; stage_rc32(tid * 16 + i * 4096, R, C); bp[i] = Bt + (size_t)R * ldb + C; }
  LAS char* lt = lds + tid * 16;
  const int nk = K >> 5;
  __syncthreads();
#pragma unroll
  for (int s = 0; s < NST - 1; ++s) {
#pragma unroll
    for (int i = 0; i < NA; ++i) glds16(ap[i] + s * 32, lt + s * SBYTES + i * 4096);
#pragma unroll
    for (int i = 0; i < 2; ++i) glds16(bp[i] + s * 32, lt + s * SBYTES + ABYTES + i * 4096);
  }
  int offA[MI], offB[4];
#pragma unroll
  for (int i = 0; i < MI; ++i) offA[i] = lds_byte32(wr * MI * 16 + i * 16 + fr, fq * 8);
#pragma unroll
  for (int i = 0; i < 4; ++i) offB[i] = ABYTES + lds_byte32(wc * 64 + i * 16 + fr, fq * 8);
  int st_cur = 0, st_nx = NST - 1;
#pragma unroll 1
  for (int kt = 0; kt < nk; ++kt) {
    if (NST == 4) {
      if (kt + 2 < nk) asm volatile("s_waitcnt vmcnt(8)" ::: "memory");
      else if (kt + 1 < nk) asm volatile("s_waitcnt vmcnt(4)" ::: "memory");
      else asm volatile("s_waitcnt vmcnt(0)" ::: "memory");
    } else {
      if (kt + 1 < nk) { if (G == 6) asm volatile("s_waitcnt vmcnt(6)" ::: "memory"); else asm volatile("s_waitcnt vmcnt(5)" ::: "memory"); }
      else asm volatile("s_waitcnt vmcnt(0)" ::: "memory");
    }
    __builtin_amdgcn_s_barrier();
    asm volatile("" ::: "memory");
    if (kt + NST - 1 < nk) {
      LAS char* nx = lt + st_nx * SBYTES;
      const int ko = (kt + NST - 1) * 32;
#pragma unroll
      for (int i = 0; i < NA; ++i) glds16(ap[i] + ko, nx + i * 4096);
#pragma unroll
      for (int i = 0; i < 2; ++i) glds16(bp[i] + ko, nx + ABYTES + i * 4096);
    }
    const LAS char* cur = lds + st_cur * SBYTES;
    st_cur = st_cur + 1 == NST ? 0 : st_cur + 1;
    st_nx = st_nx + 1 == NST ? 0 : st_nx + 1;
    bf16x8 af[MI], bfr[4];
#pragma unroll
    for (int ni = 0; ni < 4; ++ni) bfr[ni] = *(const LAS bf16x8*)(cur + offB[ni]);
#pragma unroll
    for (int mi = 0; mi < MI; ++mi) af[mi] = *(const LAS bf16x8*)(cur + offA[mi]);
    __builtin_amdgcn_s_setprio(1);
#pragma unroll
    for (int mi = 0; mi < MI; ++mi)
#pragma unroll
      for (int ni = 0; ni < 4; ++ni) acc[mi][ni] = __builtin_amdgcn_mfma_f32_16x16x32_bf16(bfr[ni], af[mi], acc[mi][ni], 0, 0, 0);
    __builtin_amdgcn_s_setprio(0);
  }
}
DI void gemm_mainloop2(const bf16_t* __restrict__ A, int lda, const bf16_t* __restrict__ Bt, int K, f32x4 (&acc)[4][4], char* lds) {
  gemm_mainloopT<4>(A, lda, Bt, K, acc, lds);
}

template <int SM_, int SN>
DI bool xcd_tile(int it, int ntm, int ntn, int& tm, int& tn) {
  const int xcd = blockIdx.x & 7, j = blockIdx.x >> 3, per_xcd = gridDim.x >> 3;
  const int SM = (SM_ * SN != 64 || per_xcd % 64 == 0) ? SM_ : 2;
  const int nsn = ntn / SN, ns = (ntm / SM) * nsn;
  const int idx = it * per_xcd + j;
  const int sl = idx / (SM * SN), w = idx - sl * (SM * SN);
  const int s = sl * 8 + xcd;
  if (s >= ns) return false;
  const int sm = s / nsn, sn = s - sm * nsn;
  tm = sm * SM + w % SM;
  tn = sn * SN + w / SM;
  return true;
}

template <int MI, int SM, int SN, bool REV = false, class Epi>
DI void gemm_phaseT(const bf16_t* A, int lda, int M, int tm0, const bf16_t* Bt, int K, int N, const Epi& epi, char* lds, int ldb = 0) {
  if (ldb == 0) ldb = K;
  const int ntm = M / (MI * 32), ntn = N >> 7;
  const int lane = tid_() & 63, wid = tid_() >> 6;
  int tm, tn;
  for (int it = 0; xcd_tile<SM, SN>(it, ntm, ntn, tm, tn); ++it) {
    if (REV) tm = ntm - 1 - tm;
    f32x4 acc[MI][4];
#pragma unroll
    for (int mi = 0; mi < MI; ++mi)
#pragma unroll
      for (int ni = 0; ni < 4; ++ni) acc[mi][ni] = (f32x4){0.f, 0.f, 0.f, 0.f};
    gemm_mainloopT<MI>(A + (size_t)tm * (MI * 32) * lda, lda, Bt + (size_t)tn * 128 * ldb, K, acc, lds, ldb);
    epi(tm + tm0, tn, wid >> 1, wid & 1, lane, acc);
  }
}
template <int SM, int SN, class Epi>
DI void gemm_phase2(const bf16_t* A, int lda, int M, int tm0, const bf16_t* Bt, int K, int N, const Epi& epi, char* lds) {
  gemm_phaseT<4, SM, SN>(A, lda, M, tm0, Bt, K, N, epi, lds);
}

struct CMapPlain { DI int operator()(int n) const { return n; } };
struct CMapProj { DI int operator()(int p) const { if (p < 640 || p >= DPROJ) return p; const int n = p & 63, ni = (n >> 4) & 3, q = (n >> 2) & 3, j = n & 3; return (p & ~63) + q * 16 + ni * 4 + j; } };
struct CMapGateUp { DI int operator()(int p) const { const int tn = p >> 7, n = p & 127, wc = n >> 6, ni = (n >> 4) & 3, q = (n >> 2) & 3, j = n & 3; return ((ni & 1) ? DFF : 0) + tn * 64 + wc * 32 + q * 8 + (ni >> 1) * 4 + j; } };
template <class CM>
DI void convert_T(const float* __restrict__ W, int ldw, int K, int N, bf16_t* __restrict__ Wt, CM cm, char* lds, int ldo = 0) {
  if (ldo == 0) ldo = K;
  float* tl = (float*)lds;
  const int tid = tid_();
  const int nkt = K >> 6, nnt = N >> 6;
  for (int t = blockIdx.x; t < nkt * nnt; t += gridDim.x) {
    const int kt = t % nkt, nt = t / nkt;
    __syncthreads();
    const int n4 = (tid & 15) * 4;
    const int sc = cm(nt * 64 + n4);
#pragma unroll
    for (int ps = 0; ps < 4; ++ps) {
      const int kk = ps * 16 + (tid >> 4);
      const f32x4 v = *(const f32x4*)(W + (size_t)(kt * 64 + kk) * ldw + sc);
#pragma unroll
      for (int e = 0; e < 4; ++e) tl[kk * 65 + n4 + e] = v[e];
    }
    __syncthreads();
    const int nn = tid >> 2, kc = (tid & 3) * 16;
    u32x4 o0, o1;
    const float* q = tl + kc * 65 + nn;
    o0.x = pk2(q[0 * 65], q[1 * 65]); o0.y = pk2(q[2 * 65], q[3 * 65]); o0.z = pk2(q[4 * 65], q[5 * 65]); o0.w = pk2(q[6 * 65], q[7 * 65]);
    o1.x = pk2(q[8 * 65], q[9 * 65]); o1.y = pk2(q[10 * 65], q[11 * 65]); o1.z = pk2(q[12 * 65], q[13 * 65]); o1.w = pk2(q[14 * 65], q[15 * 65]);
    bf16_t* d = Wt + (size_t)(nt * 64 + nn) * ldo + kt * 64 + kc;
    *(u32x4*)d = o0;
    *(u32x4*)(d + 8) = o1;
  }
  __syncthreads();
}
DI void convert_ffn(const Params& p, int slot, const float* wi, const float* wo, char* lds) {
  bf16_t* wf = p.WF + slot * WF_SLOT;
  convert_T(wi, 2 * DFF, DM, 2 * DFF, wf, CMapGateUp(), lds);
  convert_T(wo, DM, DFF, DM, wf + WF_WO, CMapPlain(), lds, LDH);
}
DI void convert_mixer(const Params& p, int l, char* lds) {
  bf16_t* wm = p.WM + (size_t)l * WM_STRIDE;
  convert_T(p.w_in + (size_t)l * DM * DIN, DIN, DM, DIN, wm + WM_IN, CMapProj(), lds);
  for (int z = 0; z < 3; ++z) convert_T(p.w_branch + (size_t)(l * 3 + z) * 512 * DM, DM, 512, DM, wm + WM_BR + (size_t)z * 1024 * 512, CMapPlain(), lds);
  convert_T(p.w_out + (size_t)l * DM * DM, DM, DM, DM, wm + WM_OUT, CMapPlain(), lds);
}

template <int MI>
struct EpiAct {
  bf16_t* H;
  DI void operator()(int tm, int tn, int wr, int wc, int lane, f32x4 (&acc)[MI][4]) const {
    const int fr = lane & 15, fq = lane >> 4;
#pragma unroll
    for (int mi = 0; mi < MI; ++mi) {
      const int row = tm * (MI * 32) + wr * (MI * 16) + mi * 16 + fr;
      f32x4 h0, h1;
#pragma unroll
      for (int j = 0; j < 4; ++j) { h0[j] = siluf_(acc[mi][0][j]) * acc[mi][1][j]; h1[j] = siluf_(acc[mi][2][j]) * acc[mi][3][j]; }
      u32x4 o; o.x = pk2(h0[0], h0[1]); o.y = pk2(h0[2], h0[3]); o.z = pk2(h1[0], h1[1]); o.w = pk2(h1[2], h1[3]);
      *(u32x4*)(H + (size_t)row * LDH + tn * 64 + wc * 32 + fq * 8) = o;
    }
  }
};

struct EpiResid {
  const float *src_lat, *src_ctx;
  float *dst_lat, *dst_ctx;
  const float* gate;
  float gmul;
  DI void operator()(int tm, int tn, int wr, int wc, int lane, f32x4 (&acc)[4][4]) const {
    const int fr = lane & 15, fq = lane >> 4;
    const int r0 = tm * 128;
    const bool lat = r0 < NTL;
    const float* s = lat ? src_lat + (size_t)r0 * DM : src_ctx + (size_t)(r0 - NTL) * DM;
    float* d = lat ? dst_lat + (size_t)r0 * DM : dst_ctx + (size_t)(r0 - NTL) * DM;
    const float* g = gate + (size_t)mod_row(r0) * NMOD;
#pragma unroll
    for (int ni = 0; ni < 4; ++ni) {
      const int col = tn * 128 + wc * 64 + ni * 16 + fq * 4;
      const f32x4 gv = *(const f32x4*)(g + col) * gmul;
#pragma unroll
      for (int mi = 0; mi < 4; ++mi) {
        const int rl = wr * 64 + mi * 16 + fr;
        const f32x4 xv = *(const f32x4*)(s + (size_t)rl * DM + col);
        *(f32x4*)(d + (size_t)rl * DM + col) = xv * ALPHA + gv * acc[mi][ni];
      }
    }
  }
};

template <int MI>
struct EpiResidLN {
  const float *src_lat, *src_ctx;
  float *dst_lat, *dst_ctx;
  const float* gate;
  const float *lng, *lnb;
  const float* mods_next;
  bf16_t* U;
  float* stats;
  unsigned* cnt;
  float gmul;
  int shift_idx;
  DI void operator()(int tm, int tn, int wr, int wc, int lane, f32x4 (&acc)[MI][4]) const {
    const int fr = lane & 15, fq = lane >> 4;
    const int rw = tm * (MI * 32) + wr * (MI * 16);
#pragma unroll
    for (int mi = 0; mi < MI; ++mi) {
      const int rg = rw + mi * 16;
      const bool lat = rg < NTL;
      const float* s = (lat ? src_lat + (size_t)rg * DM : src_ctx + (size_t)(rg - NTL) * DM) + (size_t)fr * DM;
      const float* g = gate + (size_t)mod_row(rg) * NMOD;
#pragma unroll
      for (int ni = 0; ni < 4; ++ni) {
        const int col = tn * 128 + wc * 64 + ni * 16 + fq * 4;
        const f32x4 gv = *(const f32x4*)(g + col) * gmul;
        const f32x4 xv = *(const f32x4*)(s + col);
        acc[mi][ni] = xv * ALPHA + gv * acc[mi][ni];
      }
      float sm = 0.f;
#pragma unroll
      for (int ni = 0; ni < 4; ++ni) sm += (acc[mi][ni][0] + acc[mi][ni][1]) + (acc[mi][ni][2] + acc[mi][ni][3]);
      sm += __shfl_xor(sm, 16); sm += __shfl_xor(sm, 32);
      const float mean_i = sm * (1.f / 64.f);
      float q = 0.f;
#pragma unroll
      for (int ni = 0; ni < 4; ++ni) { const f32x4 dd = acc[mi][ni] - mean_i; q += (dd[0] * dd[0] + dd[1] * dd[1]) + (dd[2] * dd[2] + dd[3] * dd[3]); }
      q += __shfl_xor(q, 16); q += __shfl_xor(q, 32);
      if (fq == 0) {
        const unsigned long long pk = ((unsigned long long)__float_as_uint(q) << 32) | (unsigned long long)__float_as_uint(sm);
        __hip_atomic_store((unsigned long long*)(stats + ((size_t)(rg + fr) * 16 + tn * 2 + wc) * 2), pk, __ATOMIC_RELAXED, __HIP_MEMORY_SCOPE_AGENT);
      }
      asm volatile("" ::: "memory");
    }
    asm volatile("s_waitcnt vmcnt(0)" ::: "memory");
    __syncthreads();
    if (tid_() == 0) {
      __hip_atomic_fetch_add(cnt + tm, 1u, __ATOMIC_RELAXED, __HIP_MEMORY_SCOPE_AGENT);
      while (__hip_atomic_load(cnt + tm, __ATOMIC_RELAXED, __HIP_MEMORY_SCOPE_AGENT) < 8u) __builtin_amdgcn_s_sleep(1);
    }
    __syncthreads();
#pragma unroll
    for (int mi = 0; mi < MI; ++mi) {
      const int rg = rw + mi * 16;
      const bool lat = rg < NTL;
      float* d = (lat ? dst_lat + (size_t)rg * DM : dst_ctx + (size_t)(rg - NTL) * DM) + (size_t)fr * DM;
      const float* mr = mods_next + (size_t)mod_row(rg) * NMOD + shift_idx * DM;
      const unsigned long long* sq = (const unsigned long long*)(stats + ((size_t)(rg + fr) * 16 + fq * 4) * 2);
      const unsigned long long u0 = __hip_atomic_load(sq + 0, __ATOMIC_RELAXED, __HIP_MEMORY_SCOPE_AGENT), u1 = __hip_atomic_load(sq + 1, __ATOMIC_RELAXED, __HIP_MEMORY_SCOPE_AGENT);
      const unsigned long long u2 = __hip_atomic_load(sq + 2, __ATOMIC_RELAXED, __HIP_MEMORY_SCOPE_AGENT), u3 = __hip_atomic_load(sq + 3, __ATOMIC_RELAXED, __HIP_MEMORY_SCOPE_AGENT);
      const f32x4 p0 = {__uint_as_float((unsigned)u0), __uint_as_float((unsigned)(u0 >> 32)), __uint_as_float((unsigned)u1), __uint_as_float((unsigned)(u1 >> 32))};
      const f32x4 p1 = {__uint_as_float((unsigned)u2), __uint_as_float((unsigned)(u2 >> 32)), __uint_as_float((unsigned)u3), __uint_as_float((unsigned)(u3 >> 32))};
      float ts = (p0[0] + p0[2]) + (p1[0] + p1[2]);
      ts += __shfl_xor(ts, 16); ts += __shfl_xor(ts, 32);
      const float mean = ts * (1.f / 1024.f);
      const float d0 = p0[0] * (1.f / 64.f) - mean, d1 = p0[2] * (1.f / 64.f) - mean, d2 = p1[0] * (1.f / 64.f) - mean, d3 = p1[2] * (1.f / 64.f) - mean;
      float m2 = (p0[1] + p0[3]) + (p1[1] + p1[3]) + 64.f * ((d0 * d0 + d1 * d1) + (d2 * d2 + d3 * d3));
      m2 += __shfl_xor(m2, 16); m2 += __shfl_xor(m2, 32);
      const float rstd = rsqrtf(m2 * (1.f / 1024.f) + 1e-5f);
#pragma unroll
      for (int ni = 0; ni < 4; ++ni) {
        const int col = tn * 128 + wc * 64 + ni * 16 + fq * 4;
        const f32x4 y = (acc[mi][ni] - mean) * rstd * *(const f32x4*)(lng + col) + *(const f32x4*)(lnb + col);
        *(f32x4*)(d + col) = y;
        if (U) {
          const f32x4 sh = *(const f32x4*)(mr + col), sc = *(const f32x4*)(mr + DM + col);
          st4bf(U + (size_t)(rg + fr) * DM + col, y * (sc + 1.f) + sh);
        }
      }
      asm volatile("" ::: "memory");
    }
  }
};

template <int MI>
struct EpiProj {
  const Params* p;
  int l;
  DI void operator()(int tm, int tn, int wr, int wc, int lane, f32x4 (&acc)[MI][4]) const {
    const int fr = lane & 15, fq = lane >> 4;
    const int col0 = tn * 128 + wc * 64;
    const bool lat = tm * (MI * 32) < NTL;
    bf16_t* P = p->P;
    if (tn < 5) {
      const float* gain = (tn < 4 ? p->q_gain : p->k_gain) + l * 64;
      const float mult = tn < 4 ? QSCALE : 1.f;
      f32x4 gv[4];
#pragma unroll
      for (int ni = 0; ni < 4; ++ni) gv[ni] = *(const f32x4*)(gain + ni * 16 + fq * 4);
#pragma unroll
      for (int mi = 0; mi < MI; ++mi) {
        const int row = tm * (MI * 32) + wr * (MI * 16) + mi * 16 + fr;
        float ss = 0.f;
#pragma unroll
        for (int ni = 0; ni < 4; ++ni)
#pragma unroll
          for (int j = 0; j < 4; ++j) ss += acc[mi][ni][j] * acc[mi][ni][j];
        ss += __shfl_xor(ss, 16);
        ss += __shfl_xor(ss, 32);
        const float rinv = rsqrtf(ss * (1.f / 64.f) + 1e-6f);
        f32x4 v[4];
#pragma unroll
        for (int ni = 0; ni < 4; ++ni) v[ni] = acc[mi][ni] * rinv * gv[ni];
        if (lat) {
          const int t = row & (TL - 1);
          const int pr = t >> 6, pc = t & 63;
#pragma unroll
          for (int a = 0; a < 2; ++a) {
            const float* rt = p->rope + (size_t)((a ? pc : pr) * 16 + fq * 4) * 2;
            const f32x4 cs0 = *(const f32x4*)rt, cs1 = *(const f32x4*)(rt + 4);
            const float cc[4] = {cs0[0], cs0[2], cs1[0], cs1[2]};
            const float sn[4] = {cs0[1], cs0[3], cs1[1], cs1[3]};
#pragma unroll
            for (int j = 0; j < 4; ++j) {
              const float x1 = v[2 * a][j], x2 = v[2 * a + 1][j];
              v[2 * a][j] = x1 * cc[j] - x2 * sn[j];
              v[2 * a + 1][j] = x2 * cc[j] + x1 * sn[j];
            }
          }
        }
#pragma unroll
        for (int ni = 0; ni < 4; ++ni) st4bf(P + (size_t)row * DPROJ + col0 + ni * 16 + fq * 4, v[ni] * mult);
      }
    } else {
      const float mult = (tn >= 21 && tn < 25) ? QSCALE : 1.f;
#pragma unroll
      for (int mi = 0; mi < MI; ++mi) {
        const int row = tm * (MI * 32) + wr * (MI * 16) + mi * 16 + fr;
        const f32x4 a0 = acc[mi][0] * mult, a1 = acc[mi][1] * mult, a2 = acc[mi][2] * mult, a3 = acc[mi][3] * mult;
        u32x4 o0, o1;
        o0.x = pk2(a0[0], a0[1]); o0.y = pk2(a0[2], a0[3]); o0.z = pk2(a1[0], a1[1]); o0.w = pk2(a1[2], a1[3]);
        o1.x = pk2(a2[0], a2[1]); o1.y = pk2(a2[2], a2[3]); o1.z = pk2(a3[0], a3[1]); o1.w = pk2(a3[2], a3[3]);
        bf16_t* dst = P + (size_t)row * DPROJ + col0 + fq * 16;
        *(u32x4*)dst = o0;
        *(u32x4*)(dst + 8) = o1;
      }
    }
  }
};

DI f32x4 shifted4(const bf16_t* P, int row, bool hp, bool hn, int colidx, const float* mu_l) {
  const bf16_t* q = P + (size_t)row * DPROJ + 768 + colidx;
  const f32x4 x = ld4bf(q);
  const f32x4 xm = hp ? ld4bf(q - DPROJ) : (f32x4){0.f, 0.f, 0.f, 0.f};
  const f32x4 xp = hn ? ld4bf(q + DPROJ) : (f32x4){0.f, 0.f, 0.f, 0.f};
  const f32x4 m0 = *(const f32x4*)(mu_l + colidx), m1 = *(const f32x4*)(mu_l + 1920 + colidx);
  return x + m0 * (xm - x) + m1 * (xp - x);
}

struct EpiReadout {
  const Params* p;
  int l;
  DI void operator()(int tm, int tn, int wr, int wc, int lane, f32x4 (&acc)[4][4]) const {
    const int fr = lane & 15, fq = lane >> 4;
    const int head = tn * 2 + wc, colh = head * 64;
    const float* mu_l = p->mu + (size_t)l * 2 * 1920;
    const float* rk = p->r_k + l * 512 + colh;
    const float* gg = p->gn_g + l * 512 + colh;
    const float* gb = p->gn_b + l * 512 + colh;
    const bf16_t* Of = p->Os;
    const bf16_t* Ob = p->Os + (size_t)NTOK * 512;
    u32x2 gp[4][4];
#pragma unroll
    for (int mi = 0; mi < 4; ++mi)
#pragma unroll
      for (int ni = 0; ni < 4; ++ni) { gp[mi][ni].x = pk2(acc[mi][ni][0], acc[mi][ni][1]); gp[mi][ni].y = pk2(acc[mi][ni][2], acc[mi][ni][3]); }
#pragma unroll
    for (int mi = 0; mi < 4; ++mi) {
      const int row = tm * 128 + wr * 64 + mi * 16 + fr;
      int t, L;
      if (row < NTL) { t = row & (TL - 1); L = TL; } else { t = (row - NTL) & (TC - 1); L = TC; }
      const bool hp = t > 0, hn = t < L - 1;
      f32x4 o[4];
      float s = 0.f, bs = 0.f;
#pragma unroll
      for (int ni = 0; ni < 4; ++ni) {
        const int c = fq * 16 + ni * 4;
        o[ni] = ld4bf(Of + (size_t)row * 512 + colh + c) + ld4bf(Ob + (size_t)row * 512 + colh + c);
        s += (o[ni][0] + o[ni][1]) + (o[ni][2] + o[ni][3]);
      }
#pragma unroll 2
      for (int ni = 0; ni < 4; ++ni) {
        const int c = fq * 16 + ni * 4;
        const f32x4 r4 = shifted4(p->P, row, hp, hn, colh + c, mu_l);
        const f32x4 k4 = shifted4(p->P, row, hp, hn, 512 + colh + c, mu_l);
        const f32x4 rk4 = *(const f32x4*)(rk + c);
        const f32x4 pr = r4 * k4 * rk4;
        bs += (pr[0] + pr[1]) + (pr[2] + pr[3]);
      }
      s += __shfl_xor(s, 16); s += __shfl_xor(s, 32);
      bs += __shfl_xor(bs, 16); bs += __shfl_xor(bs, 32);
      const float mean = s * (1.f / 64.f);
      float q = 0.f;
#pragma unroll
      for (int ni = 0; ni < 4; ++ni) {
        const f32x4 d = o[ni] - mean;
        q += (d[0] * d[0] + d[1] * d[1]) + (d[2] * d[2] + d[3] * d[3]);
      }
      q += __shfl_xor(q, 16); q += __shfl_xor(q, 32);
      const float rstd = rsqrtf(q * (1.f / 64.f) + 64e-5f);
#pragma unroll
      for (int ni = 0; ni < 4; ++ni) {
        const int c = fq * 16 + ni * 4;
        const f32x4 g4 = *(const f32x4*)(gg + c), b4 = *(const f32x4*)(gb + c);
        const f32x4 vv = shifted4(p->P, row, hp, hn, 1024 + colh + c, mu_l);
        const f32x4 gate = {bflo(gp[mi][ni].x), bfhi(gp[mi][ni].x), bflo(gp[mi][ni].y), bfhi(gp[mi][ni].y)};
        const f32x4 y = ((o[ni] - mean) * rstd * g4 + b4 + vv * bs) * gate;
        st4bf(p->yr + (size_t)row * 512 + colh + c, y);
      }
      asm volatile("" ::: "memory");
    }
  }
};

DI float wave_sum(float v) {
#pragma unroll
  for (int o = 32; o > 0; o >>= 1) v += __shfl_xor(v, o);
  return v;
}

DI void ln_phase(float* xl, float* xc, int M, const float* g, const float* b, const float* mods_l, int shift_idx, bf16_t* U) {
  const int lane = tid_() & 63, wid = tid_() >> 6;
  for (int row = blockIdx.x * 4 + wid; row < M; row += gridDim.x * 4) {
    float* xr = row < NTL ? xl + (size_t)row * DM : xc + (size_t)(row - NTL) * DM;
    f32x4 v[4];
    float s = 0.f;
#pragma unroll
    for (int i = 0; i < 4; ++i) { v[i] = *(const f32x4*)(xr + i * 256 + lane * 4); s += (v[i][0] + v[i][1]) + (v[i][2] + v[i][3]); }
    const float mean = wave_sum(s) * (1.f / 1024.f);
    float q = 0.f;
#pragma unroll
    for (int i = 0; i < 4; ++i) { const f32x4 d = v[i] - mean; q += (d[0] * d[0] + d[1] * d[1]) + (d[2] * d[2] + d[3] * d[3]); }
    const float rstd = rsqrtf(wave_sum(q) * (1.f / 1024.f) + 1e-5f);
    const float* mr = mods_l + (size_t)mod_row(row) * NMOD + shift_idx * DM;
#pragma unroll
    for (int i = 0; i < 4; ++i) {
      const int c = i * 256 + lane * 4;
      const f32x4 y = (v[i] - mean) * rstd * *(const f32x4*)(g + c) + *(const f32x4*)(b + c);
      *(f32x4*)(xr + c) = y;
      if (U) {
        const f32x4 sh = *(const f32x4*)(mr + c), sc = *(const f32x4*)(mr + DM + c);
        st4bf(U + (size_t)row * DM + c, y * (sc + 1.f) + sh);
      }
    }
  }
}

DI void u0_phase(const Params& p) {
  const int lane = tid_() & 63, wid = tid_() >> 6;
  for (int row = blockIdx.x * 4 + wid; row < NTOK; row += gridDim.x * 4) {
    const float* xr = row < NTL ? p.x_in + (size_t)row * DM : p.ctx_in + (size_t)(row - NTL) * DM;
    const float* mr = p.mods + (size_t)mod_row(row) * NMOD;
#pragma unroll
    for (int i = 0; i < 4; ++i) {
      const int c = i * 256 + lane * 4;
      const f32x4 y = *(const f32x4*)(xr + c);
      const f32x4 sh = *(const f32x4*)(mr + c), sc = *(const f32x4*)(mr + DM + c);
      st4bf(p.U + (size_t)row * DM + c, y * (sc + 1.f) + sh);
    }
  }
}

DI void mods_phase(const Params& p, char* lds) {
  float* sc = (float*)lds;
  float* red = sc + 256 * 20;
  const int tid = tid_(), lane = tid & 63, wid = tid >> 6;
  if (blockIdx.x == 0) {
    if (tid < 64) p.counters[tid] = 0u;
    for (int i = tid; i < 6 * 288; i += NTHREADS) p.lncnt[i] = 0u;
    for (int i = tid; i < 1024; i += NTHREADS) {
      const int pos = i >> 4, k = i & 15;
      const float inv = exp2f(-(float)k * (1.f / 16.f) * 13.287712379549449f);
      const float ang = (float)pos * inv;
      p.rope[i * 2] = cosf(ang);
      p.rope[i * 2 + 1] = sinf(ang);
    }
  }
  for (int tile = blockIdx.x; tile < 288; tile += gridDim.x) {
    const int l = tile / 144, col0 = (tile % 144) * 64;
    float acc[17];
#pragma unroll
    for (int r = 0; r < 17; ++r) acc[r] = 0.f;
    for (int kc = 0; kc < 4; ++kc) {
      __syncthreads();
      for (int i = tid; i < 17 * 256; i += NTHREADS) {
        const int r = i >> 8, kk = i & 255;
        const float v = r < 16 ? p.c[r * DM + kc * 256 + kk] : p.c_ctx[kc * 256 + kk];
        sc[kk * 20 + r] = siluf_(v);
      }
      __syncthreads();
      const float* wp = p.w_ada + ((size_t)l * DM + kc * 256 + wid * 64) * NMOD + col0 + lane;
      for (int kk = 0; kk < 64; ++kk) {
        const float wv = wp[(size_t)kk * NMOD];
        const float* s = sc + (wid * 64 + kk) * 20;
#pragma unroll
        for (int r = 0; r < 17; ++r) acc[r] += s[r] * wv;
      }
    }
    __syncthreads();
#pragma unroll
    for (int r = 0; r < 17; ++r) red[(wid * 17 + r) * 64 + lane] = acc[r];
    __syncthreads();
    for (int i = tid; i < 17 * 64; i += NTHREADS) {
      const int r = i >> 6, cl = i & 63;
      const float s = red[(0 * 17 + r) * 64 + cl] + red[(1 * 17 + r) * 64 + cl] + red[(2 * 17 + r) * 64 + cl] + red[(3 * 17 + r) * 64 + cl];
      p.mods[((size_t)l * 17 + r) * NMOD + col0 + cl] = s + p.b_ada[l * NMOD + col0 + cl];
    }
  }
  __syncthreads();
}

DI void sg_phase(const Params& p, int l) {
  const int lane = tid_() & 63, wid = tid_() >> 6;
  const float* mu_l = p.mu + (size_t)l * 2 * 1920;
  const int b0 = gridDim.x > 256 ? 256 : 0, nb = gridDim.x - b0;
  if ((int)blockIdx.x < b0) return;
  for (int idx = ((int)blockIdx.x - b0) * NTHREADS + tid_(); idx < NTOK * 32; idx += nb * NTHREADS) {
    const int row = idx >> 5, c = (idx & 31) * 4;
    int t, L;
    if (row < NTL) { t = row & (TL - 1); L = TL; } else { t = (row - NTL) & (TC - 1); L = TC; }
    const f32x4 x = shifted4(p.P, row, t > 0, t < L - 1, 1792 + c, mu_l);
    f32x4 y;
#pragma unroll
    for (int j = 0; j < 4; ++j) y[j] = sigmoidf_(x[j]);
    st4bf(p.sg + (size_t)row * 128 + c, y);
  }
  (void)lane; (void)wid;
}

constexpr int KLD = 72;
constexpr int VLD = 68;

struct NoMask { DI void operator()(f32x16 (&st)[2]) const {} };

struct NaMask {
  const float* rp;
  int c;
  int c0;
  int h;
  DI void operator()(f32x16 (&st)[2]) const {
#pragma unroll
    for (int u = 0; u < 2; ++u)
#pragma unroll
      for (int i = 0; i < 16; ++i) {
        const int kc = u * 32 + (i & 3) + 8 * (i >> 2) + 4 * h;
        const bool ok = (kc >= c0) && (kc < c0 + 16);
        const int bi = ok ? (kc - c + 15) : 15;
        const float bias = rp[bi];
        st[u][i] = ok ? st[u][i] + bias : -1e30f;
      }
  }
};

template <class Mask>
DI void attn_tile(const bf16_t* Ks, const bf16_t* Vt, const bf16x8 (&qf)[4], f32x16 (&ot)[2], float& m, float& l, const Mask& mask, int lane) {
  const int r = lane & 31, h = lane >> 5;
  f32x16 st[2];
#pragma unroll
  for (int u = 0; u < 2; ++u) {
#pragma unroll
    for (int i = 0; i < 16; ++i) st[u][i] = 0.f;
#pragma unroll
    for (int s = 0; s < 4; ++s) {
      const bf16x8 kf = *(const bf16x8*)(Ks + (u * 32 + r) * KLD + s * 16 + h * 8);
      st[u] = __builtin_amdgcn_mfma_f32_32x32x16_bf16(kf, qf[s], st[u], 0, 0, 0);
    }
  }
  mask(st);
  float mx = st[0][0];
#pragma unroll
  for (int u = 0; u < 2; ++u)
#pragma unroll
    for (int i = 0; i < 16; ++i) mx = fmaxf(mx, st[u][i]);
  mx = fmaxf(mx, __shfl_xor(mx, 32));
  const float mnew = fmaxf(m, mx);
  const float alpha = __builtin_amdgcn_exp2f(m - mnew);
  m = mnew;
  float ls = 0.f;
#pragma unroll
  for (int u = 0; u < 2; ++u)
#pragma unroll
    for (int i = 0; i < 16; ++i) { st[u][i] = __builtin_amdgcn_exp2f(st[u][i] - mnew); ls += st[u][i]; }
  l = l * alpha + ls;
#pragma unroll
  for (int dt = 0; dt < 2; ++dt)
#pragma unroll
    for (int i = 0; i < 16; ++i) ot[dt][i] *= alpha;
#pragma unroll
  for (int u = 0; u < 2; ++u)
#pragma unroll
    for (int s = 0; s < 2; ++s) {
      u32x4 pw;
      pw.x = pk2(st[u][8 * s + 0], st[u][8 * s + 1]); pw.y = pk2(st[u][8 * s + 2], st[u][8 * s + 3]);
      pw.z = pk2(st[u][8 * s + 4], st[u][8 * s + 5]); pw.w = pk2(st[u][8 * s + 6], st[u][8 * s + 7]);
      const bf16x8 pb = __builtin_bit_cast(bf16x8, pw);
#pragma unroll
      for (int dt = 0; dt < 2; ++dt) {
        const bf16_t* vp = Vt + (dt * 32 + r) * VLD + u * 32 + 16 * s + 4 * h;
        const s16x4 lo = *(const s16x4*)vp, hi = *(const s16x4*)(vp + 8);
        const bf16x8 va = __builtin_shufflevector(lo, hi, 0, 1, 2, 3, 4, 5, 6, 7);
        ot[dt] = __builtin_amdgcn_mfma_f32_32x32x16_bf16(va, pb, ot[dt], 0, 0, 0);
      }
    }
}

template <int NHB>
DI void kv_load(const bf16_t* kb, const bf16_t* vb, u32x4 (&kr)[NHB * 2], u32x4 (&vr)[NHB * 2]) {
#pragma unroll
  for (int i = 0; i < NHB * 2; ++i) {
    const int c = tid_() + i * NTHREADS;
    const int hh = c >> 9, cc = c & 511, key = cc >> 3, dc = cc & 7;
    const size_t off = (size_t)key * DPROJ + hh * 64 + dc * 8;
    kr[i] = *(const u32x4*)(kb + off);
    vr[i] = *(const u32x4*)(vb + off);
  }
}
template <int NHB>
DI void kv_store(bf16_t* Ks, bf16_t* Vt, const u32x4 (&kr)[NHB * 2], const u32x4 (&vr)[NHB * 2]) {
#pragma unroll
  for (int i = 0; i < NHB * 2; ++i) {
    const int c = tid_() + i * NTHREADS;
    const int hh = c >> 9, cc = c & 511, key = cc >> 3, dc = cc & 7;
    *(u32x4*)(Ks + hh * 64 * KLD + key * KLD + dc * 8) = kr[i];
    bf16_t* vt = Vt + hh * 64 * VLD + (dc * 8) * VLD + key;
    vt[0 * VLD] = (bf16_t)(vr[i].x & 0xffff); vt[1 * VLD] = (bf16_t)(vr[i].x >> 16);
    vt[2 * VLD] = (bf16_t)(vr[i].y & 0xffff); vt[3 * VLD] = (bf16_t)(vr[i].y >> 16);
    vt[4 * VLD] = (bf16_t)(vr[i].z & 0xffff); vt[5 * VLD] = (bf16_t)(vr[i].z >> 16);
    vt[6 * VLD] = (bf16_t)(vr[i].w & 0xffff); vt[7 * VLD] = (bf16_t)(vr[i].w >> 16);
  }
}

DI void attn_finish(bf16_t* outp  , f32x16 (&ot)[2], float l, int lane) {
  const int h = lane >> 5;
  l += __shfl_xor(l, 32);
  const float inv = __builtin_amdgcn_rcpf(l);
#pragma unroll
  for (int dt = 0; dt < 2; ++dt)
#pragma unroll
    for (int g = 0; g < 4; ++g) {
      f32x4 v = {ot[dt][4 * g] * inv, ot[dt][4 * g + 1] * inv, ot[dt][4 * g + 2] * inv, ot[dt][4 * g + 3] * inv};
      st4bf(outp + dt * 32 + 8 * g + 4 * h, v);
    }
}

DI void dense_item(const Params& p, int qrow0, int qcol, int krow_lat0, int ntl, int krow_ctx0, int kcol, int vcol, char* lds) {
  bf16_t* Ks = (bf16_t*)lds;
  bf16_t* Vt = Ks + 2 * 64 * KLD;
  const int lane = tid_() & 63, wid = tid_() >> 6, r = lane & 31, h = lane >> 5;
  bf16_t* qp = p.P + (size_t)(qrow0 + wid * 32 + r) * DPROJ + qcol;
  bf16x8 qf[4];
#pragma unroll
  for (int s = 0; s < 4; ++s) qf[s] = *(const bf16x8*)(qp + s * 16 + h * 8);
  f32x16 ot[2];
#pragma unroll
  for (int dt = 0; dt < 2; ++dt)
#pragma unroll
    for (int i = 0; i < 16; ++i) ot[dt][i] = 0.f;
  float m = -1e30f, l = 0.f;
  const int nt = ntl + 4;
  u32x4 kr[2], vr[2];
  auto tile_row = [&](int jt) { return jt < ntl ? krow_lat0 + jt * 64 : krow_ctx0 + (jt - ntl) * 64; };
  {
    const bf16_t* base = p.P + (size_t)tile_row(0) * DPROJ;
    kv_load<1>(base + kcol, base + vcol, kr, vr);
  }
  for (int jt = 0; jt < nt; ++jt) {
    __syncthreads();
    kv_store<1>(Ks, Vt, kr, vr);
    __syncthreads();
    if (jt + 1 < nt) {
      const bf16_t* base = p.P + (size_t)tile_row(jt + 1) * DPROJ;
      kv_load<1>(base + kcol, base + vcol, kr, vr);
    }
    attn_tile(Ks, Vt, qf, ot, m, l, NoMask(), lane);
  }
  attn_finish(qp, ot, l, lane);
  __syncthreads();
}

DI void na_item(const Params& p, int lyr, int b, int gr, int hp, char* lds) {
  bf16_t* Ks = (bf16_t*)lds;
  bf16_t* Vt = Ks + 2 * 64 * KLD;
  float* rpl = (float*)(Vt + 2 * 64 * VLD);
  const int tid = tid_(), lane = tid & 63, wid = tid >> 6, r = lane & 31, h = lane >> 5;
  const int hl = wid >> 1, head = hp * 2 + hl, qh = wid & 1;
  const int r0 = gr - 4 < 0 ? 0 : (gr - 4 > 24 ? 24 : gr - 4);
  __syncthreads();
  for (int i = tid; i < 2 * 465; i += NTHREADS) {
    const int hh = i / 465, e = i - hh * 465;
    rpl[i] = p.rpb[((size_t)lyr * 8 + hp * 2 + hh) * 465 + e] * LOG2E;
  }
  const int c = qh * 32 + r;
  const int c0 = c - 8 < 0 ? 0 : (c - 8 > 48 ? 48 : c - 8);
  bf16_t* qp = p.P + (size_t)(b * TL + gr * 64 + c) * DPROJ + 2688 + head * 64;
  bf16x8 qf[4];
#pragma unroll
  for (int s = 0; s < 4; ++s) qf[s] = *(const bf16x8*)(qp + s * 16 + h * 8);
  f32x16 ot[2];
#pragma unroll
  for (int dt = 0; dt < 2; ++dt)
#pragma unroll
    for (int i = 0; i < 16; ++i) ot[dt][i] = 0.f;
  float m = -1e30f, l = 0.f;
  u32x4 kr[4], vr[4];
  auto tile_row = [&](int jt) { return jt < 8 ? b * TL + (r0 + jt) * 64 : NTL + b * TC + (jt - 8) * 64; };
  const int kcol = 3200 + hp * 128, vcol = 3712 + hp * 128;
  {
    const bf16_t* base = p.P + (size_t)tile_row(0) * DPROJ;
    kv_load<2>(base + kcol, base + vcol, kr, vr);
  }
  for (int jt = 0; jt < 12; ++jt) {
    __syncthreads();
    kv_store<2>(Ks, Vt, kr, vr);
    __syncthreads();
    if (jt + 1 < 12) {
      const bf16_t* base = p.P + (size_t)tile_row(jt + 1) * DPROJ;
      kv_load<2>(base + kcol, base + vcol, kr, vr);
    }
    if (jt < 8) {
      NaMask mk;
      mk.rp = rpl + hl * 465 + (r0 + jt - gr + 7) * 31;
      mk.c = c; mk.c0 = c0; mk.h = h;
      attn_tile(Ks + hl * 64 * KLD, Vt + hl * 64 * VLD, qf, ot, m, l, mk, lane);
    } else {
      attn_tile(Ks + hl * 64 * KLD, Vt + hl * 64 * VLD, qf, ot, m, l, NoMask(), lane);
    }
  }
  attn_finish(qp, ot, l, lane);
  __syncthreads();
}

template <int CTRL>
DI float dpp_f(float x) { return __int_as_float(__builtin_amdgcn_update_dpp(0, __float_as_int(x), CTRL, 0xF, 0xF, true)); }
DI float red8(float x) {
  x += dpp_f<0xB1>(x);
  x += dpp_f<0x4E>(x);
  x += dpp_f<0x141>(x);
  return x;
}

struct ScanOps { f32x4 w[2], kk[2], b[2], kd[2], r[2]; f32x2 v; };
DI void scan_load(ScanOps& o, const float* base, int kg, int row0) {
#pragma unroll
  for (int i = 0; i < 2; ++i) {
    o.w[i] = *(const f32x4*)(base + kg * 8 + i * 4);
    o.kk[i] = *(const f32x4*)(base + 64 + kg * 8 + i * 4);
    o.b[i] = *(const f32x4*)(base + 128 + kg * 8 + i * 4);
    o.kd[i] = *(const f32x4*)(base + 192 + kg * 8 + i * 4);
    o.r[i] = *(const f32x4*)(base + 256 + kg * 8 + i * 4);
  }
  o.v = *(const f32x2*)(base + 320 + row0);
}

DI void scan_block(const Params& p, int lyr, int sidx, bool need_ctx, char* lds) {
  const int dir = sidx & 1, hd = (sidx >> 1) & 7, b = sidx >> 4;
  const int tid = tid_(), lane = tid & 63, w = tid >> 6;
  float* rec = (float*)lds;
  float* obuf = rec + 16 * 384;
  float* cst = obuf + 16 * 64;
  bf16_t* Aw = (bf16_t*)(cst + 14 * 64);
  bf16_t* Aa = Aw + 16 * 72;
  __syncthreads();
  for (int i = tid; i < 320; i += NTHREADS) {
    const int g = i >> 6, c = i & 63;
    const int colidx = (g < 3 ? g * 512 + hd * 64 : (g == 3 ? 1536 + dir * 64 : 1664 + dir * 64)) + c;
    cst[i] = p.mu[(size_t)lyr * 3840 + colidx];
    cst[320 + i] = p.mu[(size_t)lyr * 3840 + 1920 + colidx];
  }
  if (tid < 64) {
    cst[640 + tid] = p.w0[(lyr * 2 + dir) * 512 + hd * 64 + tid];
    cst[704 + tid] = p.a0[(lyr * 2 + dir) * 512 + hd * 64 + tid];
    cst[768 + tid] = p.k_k[lyr * 512 + hd * 64 + tid];
    cst[832 + tid] = p.k_a[lyr * 512 + hd * 64 + tid];
  }
  const int fr = lane & 15, fq = lane >> 4;
  bf16x8 bw[2], ba[2];
  {
    const float* w2p = p.w2 + (size_t)(lyr * 2 + dir) * 64 * 512 + hd * 64 + 16 * w + fr;
    const float* a2p = p.a2 + (size_t)(lyr * 2 + dir) * 64 * 512 + hd * 64 + 16 * w + fr;
#pragma unroll
    for (int ks = 0; ks < 2; ++ks) {
      u32x4 tw, ta;
      float xw[8], xa[8];
#pragma unroll
      for (int j = 0; j < 8; ++j) { xw[j] = w2p[(size_t)(ks * 32 + fq * 8 + j) * 512]; xa[j] = a2p[(size_t)(ks * 32 + fq * 8 + j) * 512]; }
      tw.x = pk2(xw[0], xw[1]); tw.y = pk2(xw[2], xw[3]); tw.z = pk2(xw[4], xw[5]); tw.w = pk2(xw[6], xw[7]);
      ta.x = pk2(xa[0], xa[1]); ta.y = pk2(xa[2], xa[3]); ta.z = pk2(xa[4], xa[5]); ta.w = pk2(xa[6], xa[7]);
      bw[ks] = __builtin_bit_cast(bf16x8, tw);
      ba[ks] = __builtin_bit_cast(bf16x8, ta);
    }
  }
  f32x4 S[2][2];
#pragma unroll
  for (int a = 0; a < 2; ++a)
#pragma unroll
    for (int i = 0; i < 2; ++i) S[a][i] = (f32x4){0.f, 0.f, 0.f, 0.f};
  const int kg = lane & 7, rp = lane >> 3, row0 = 16 * w + rp * 2;
  const int pj = tid >> 4, pcg = tid & 15;
  int goff[5] = {hd * 64, 512 + hd * 64, 1024 + hd * 64, 1536 + dir * 64, 1664 + dir * 64};
  u32x2 raw[5][3];
  auto chunk_tok = [&](int ch, int j, int& rowbase, int& t, int& L) {
    int n0;
    if (ch < 16) { L = TC; n0 = ch * 16; rowbase = NTL + b * TC; } else { L = TL; n0 = (ch - 16) * 16; rowbase = b * TL; }
    const int n = n0 + j;
    t = dir ? L - 1 - n : n;
  };
  auto prefetch = [&](int ch) {
    int rowbase, t, L;
    chunk_tok(ch, pj, rowbase, t, L);
    const bf16_t* q = p.P + (size_t)(rowbase + t) * DPROJ + 768 + pcg * 4;
#pragma unroll
    for (int g = 0; g < 5; ++g) {
      raw[g][1] = *(const u32x2*)(q + goff[g]);
      raw[g][0] = t > 0 ? *(const u32x2*)(q + goff[g] - DPROJ) : (u32x2){0u, 0u};
      raw[g][2] = t < L - 1 ? *(const u32x2*)(q + goff[g] + DPROJ) : (u32x2){0u, 0u};
    }
  };
  prefetch(0);
  __syncthreads();
  for (int ch = 0; ch < 144; ++ch) {
    {
      f32x4 xs[5];
#pragma unroll
      for (int g = 0; g < 5; ++g) {
        const f32x4 x = {bflo(raw[g][1].x), bfhi(raw[g][1].x), bflo(raw[g][1].y), bfhi(raw[g][1].y)};
        const f32x4 xm = {bflo(raw[g][0].x), bfhi(raw[g][0].x), bflo(raw[g][0].y), bfhi(raw[g][0].y)};
        const f32x4 xp = {bflo(raw[g][2].x), bfhi(raw[g][2].x), bflo(raw[g][2].y), bfhi(raw[g][2].y)};
        const f32x4 m0 = *(const f32x4*)(cst + g * 64 + pcg * 4), m1 = *(const f32x4*)(cst + 320 + g * 64 + pcg * 4);
        xs[g] = x + m0 * (xm - x) + m1 * (xp - x);
      }
      float* rj = rec + pj * 384;
      *(f32x4*)(rj + 256 + pcg * 4) = xs[0];
      *(f32x4*)(rj + 320 + pcg * 4) = xs[2];
      const f32x4 kx = xs[1] * *(const f32x4*)(cst + 768 + pcg * 4);
      float ss = (kx[0] * kx[0] + kx[1] * kx[1]) + (kx[2] * kx[2] + kx[3] * kx[3]);
      ss += __shfl_xor(ss, 1); ss += __shfl_xor(ss, 2); ss += __shfl_xor(ss, 4); ss += __shfl_xor(ss, 8);
      const float rn = rsqrtf(ss + 1e-12f);
      *(f32x4*)(rj + 64 + pcg * 4) = kx * rn;
      *(f32x4*)(rj + 192 + pcg * 4) = xs[1];
      f32x4 tw;
#pragma unroll
      for (int j = 0; j < 4; ++j) tw[j] = 1.f - 2.f * __builtin_amdgcn_rcpf(1.f + __expf(2.f * xs[3][j]));
      st4bf(Aw + pj * 72 + pcg * 4, tw);
      st4bf(Aa + pj * 72 + pcg * 4, xs[4]);
    }
    __syncthreads();
    {
      f32x4 aw = {0.f, 0.f, 0.f, 0.f}, aa = {0.f, 0.f, 0.f, 0.f};
#pragma unroll
      for (int ks = 0; ks < 2; ++ks) {
        const bf16x8 fw = *(const bf16x8*)(Aw + fr * 72 + ks * 32 + fq * 8);
        const bf16x8 fa = *(const bf16x8*)(Aa + fr * 72 + ks * 32 + fq * 8);
        aw = __builtin_amdgcn_mfma_f32_16x16x32_bf16(bw[ks], fw, aw, 0, 0, 0);
        aa = __builtin_amdgcn_mfma_f32_16x16x32_bf16(ba[ks], fa, aa, 0, 0, 0);
      }
      const int c = 16 * w + fq * 4;
      float* rj = rec + fr * 384;
      const f32x4 w0v = *(const f32x4*)(cst + 640 + c), a0v = *(const f32x4*)(cst + 704 + c), kav = *(const f32x4*)(cst + 832 + c);
      const f32x4 kkv = *(const f32x4*)(rj + 64 + c), kpv = *(const f32x4*)(rj + 192 + c);
      f32x4 dec, bb, kd;
#pragma unroll
      for (int j = 0; j < 4; ++j) {
        const float z = -(w0v[j] + aw[j]);
        const float sp = fmaxf(z, 0.f) + __logf(1.f + __expf(-fabsf(z)));
        const float wl = -sp - 0.5f;
        dec[j] = __expf(-__expf(wl));
        const float ic = sigmoidf_(a0v[j] + aa[j]);
        bb[j] = kkv[j] * ic;
        kd[j] = kpv[j] * (1.f + (ic - 1.f) * kav[j]);
      }
      *(f32x4*)(rj + c) = dec;
      *(f32x4*)(rj + 128 + c) = bb;
      *(f32x4*)(rj + 192 + c) = kd;
    }
    __syncthreads();
    if (ch + 1 < 144) prefetch(ch + 1);
    {
      ScanOps cur, nxt;
      scan_load(cur, rec, kg, row0);
#pragma unroll 2
      for (int j = 0; j < 16; ++j) {
        if (j + 1 < 16) scan_load(nxt, rec + (j + 1) * 384, kg, row0);
#pragma unroll
        for (int a = 0; a < 2; ++a) {
          f32x4 t0 = S[a][0] * cur.kk[0] + S[a][1] * cur.kk[1];
          float sap = red8((t0[0] + t0[1]) + (t0[2] + t0[3]));
          const float vv = a ? cur.v.y : cur.v.x;
          S[a][0] = S[a][0] * cur.w[0] - cur.b[0] * sap + cur.kd[0] * vv;
          S[a][1] = S[a][1] * cur.w[1] - cur.b[1] * sap + cur.kd[1] * vv;
          f32x4 t1 = S[a][0] * cur.r[0] + S[a][1] * cur.r[1];
          float o = red8((t1[0] + t1[1]) + (t1[2] + t1[3]));
          if (kg == 0) obuf[j * 64 + row0 + a] = o;
        }
        cur = nxt;
      }
    }
    __syncthreads();
    if (ch >= 16 || need_ctx) {
      int rowbase, t, L;
      chunk_tok(ch, pj, rowbase, t, L);
      const f32x4 ov = *(const f32x4*)(obuf + pj * 64 + pcg * 4);
      st4bf(p.Os + ((size_t)dir * NTOK + rowbase + t) * 512 + hd * 64 + pcg * 4, ov);
    }
  }
  __syncthreads();
}

DI bf16x8 pack8(f32x4 a, f32x4 b) {
  u32x4 t; t.x = pk2(a[0], a[1]); t.y = pk2(a[2], a[3]); t.z = pk2(b[0], b[1]); t.w = pk2(b[2], b[3]);
  return __builtin_bit_cast(bf16x8, t);
}
DI bf16x8 pack4z(f32x4 a) {
  u32x4 t; t.x = pk2(a[0], a[1]); t.y = pk2(a[2], a[3]); t.z = 0u; t.w = 0u;
  return __builtin_bit_cast(bf16x8, t);
}
#define MFMA16(a, b, c) __builtin_amdgcn_mfma_f32_16x16x32_bf16((a), (b), (c), 0, 0, 0)

DI void scan_block2(const Params& p, int lyr, int sidx, bool need_ctx, char* lds) {
  const int dir = sidx & 1, hd = (sidx >> 1) & 7, b = sidx >> 4;
  const int tid = tid_(), lane = tid & 63, w = tid >> 6;
  const int fr = lane & 15, fq = lane >> 4;
  float* rec = (float*)lds;
  float* obuf = rec + 16 * 384;
  float* cst = obuf + 16 * 64;
  bf16_t* Aw = (bf16_t*)(cst + 14 * 64);
  bf16_t* Aa = Aw + 16 * 72;
  bf16_t* ARt = Aa + 16 * 72;
  bf16_t* BKm = ARt + 32 * 72;
  bf16_t* BKt = BKm + 32 * 72;
  bf16_t* Vt = BKt + 64 * 40;
  float* WL = (float*)(Vt + 64 * 24);
  float* Gf = WL + 64;
  float* GNt = Gf + 32 * 33;
  float* Yf = GNt + 256;
  __syncthreads();
  for (int i = tid; i < 320; i += NTHREADS) {
    const int g = i >> 6, c = i & 63;
    const int colidx = (g < 3 ? g * 512 + hd * 64 : (g == 3 ? 1536 + dir * 64 : 1664 + dir * 64)) + c;
    cst[i] = p.mu[(size_t)lyr * 3840 + colidx];
    cst[320 + i] = p.mu[(size_t)lyr * 3840 + 1920 + colidx];
  }
  if (tid < 64) {
    cst[640 + tid] = p.w0[(lyr * 2 + dir) * 512 + hd * 64 + tid];
    cst[704 + tid] = p.a0[(lyr * 2 + dir) * 512 + hd * 64 + tid];
    cst[768 + tid] = p.k_k[lyr * 512 + hd * 64 + tid];
    cst[832 + tid] = p.k_a[lyr * 512 + hd * 64 + tid];
  }
  bf16x8 bw[2], ba[2];
  {
    const float* w2p = p.w2 + (size_t)(lyr * 2 + dir) * 64 * 512 + hd * 64 + 16 * w + fr;
    const float* a2p = p.a2 + (size_t)(lyr * 2 + dir) * 64 * 512 + hd * 64 + 16 * w + fr;
#pragma unroll
    for (int ks = 0; ks < 2; ++ks) {
      f32x4 x0, x1, y0, y1;
#pragma unroll
      for (int j = 0; j < 4; ++j) {
        x0[j] = w2p[(size_t)(ks * 32 + fq * 8 + j) * 512]; x1[j] = w2p[(size_t)(ks * 32 + fq * 8 + 4 + j) * 512];
        y0[j] = a2p[(size_t)(ks * 32 + fq * 8 + j) * 512]; y1[j] = a2p[(size_t)(ks * 32 + fq * 8 + 4 + j) * 512];
      }
      bw[ks] = pack8(x0, x1);
      ba[ks] = pack8(y0, y1);
    }
  }
  f32x4 ST[4];
#pragma unroll
  for (int kt = 0; kt < 4; ++kt) ST[kt] = (f32x4){0.f, 0.f, 0.f, 0.f};
  const int pj = tid >> 4, pcg = tid & 15;
  int goff[5] = {hd * 64, 512 + hd * 64, 1024 + hd * 64, 1536 + dir * 64, 1664 + dir * 64};
  u32x2 raw[5][3];
  auto chunk_tok = [&](int ch, int j, int& rowbase, int& t, int& L) {
    int n0;
    if (ch < 16) { L = TC; n0 = ch * 16; rowbase = NTL + b * TC; } else { L = TL; n0 = (ch - 16) * 16; rowbase = b * TL; }
    const int n = n0 + j;
    t = dir ? L - 1 - n : n;
  };
  auto prefetch = [&](int ch) {
    int rowbase, t, L;
    chunk_tok(ch, pj, rowbase, t, L);
    const bf16_t* q = p.P + (size_t)(rowbase + t) * DPROJ + 768 + pcg * 4;
    const bool hp = t > 0, hn = t < L - 1;
    const int om = hp ? -DPROJ : 0, on = hn ? DPROJ : 0;
#pragma unroll
    for (int g = 0; g < 5; ++g) {
      raw[g][1] = *(const u32x2*)(q + goff[g]);
      const u32x2 rm = *(const u32x2*)(q + goff[g] + om), rn = *(const u32x2*)(q + goff[g] + on);
      raw[g][0] = hp ? rm : (u32x2){0u, 0u};
      raw[g][2] = hn ? rn : (u32x2){0u, 0u};
    }
  };
  prefetch(0);
  __syncthreads();
  const bf16x8 zero8 = {0, 0, 0, 0, 0, 0, 0, 0};
#pragma unroll 1
  for (int ch = 0; ch < 144; ++ch) {
    {
      f32x4 xs[5];
#pragma unroll
      for (int g = 0; g < 5; ++g) {
        const f32x4 x = {bflo(raw[g][1].x), bfhi(raw[g][1].x), bflo(raw[g][1].y), bfhi(raw[g][1].y)};
        const f32x4 xm = {bflo(raw[g][0].x), bfhi(raw[g][0].x), bflo(raw[g][0].y), bfhi(raw[g][0].y)};
        const f32x4 xp = {bflo(raw[g][2].x), bfhi(raw[g][2].x), bflo(raw[g][2].y), bfhi(raw[g][2].y)};
        const f32x4 m0 = *(const f32x4*)(cst + g * 64 + pcg * 4), m1 = *(const f32x4*)(cst + 320 + g * 64 + pcg * 4);
        xs[g] = x + m0 * (xm - x) + m1 * (xp - x);
      }
      float* rj = rec + pj * 384;
      *(f32x4*)(rj + 256 + pcg * 4) = xs[0];
#pragma unroll
      for (int e = 0; e < 4; ++e) Vt[(pcg * 4 + e) * 24 + pj] = f2bf(xs[2][e]);
      const f32x4 kx = xs[1] * *(const f32x4*)(cst + 768 + pcg * 4);
      float ss = (kx[0] * kx[0] + kx[1] * kx[1]) + (kx[2] * kx[2] + kx[3] * kx[3]);
      ss = red8(ss); ss += dpp_f<0x140>(ss);
      const float rn = rsqrtf(ss + 1e-12f);
      *(f32x4*)(rj + 64 + pcg * 4) = kx * rn;
      *(f32x4*)(rj + 192 + pcg * 4) = xs[1];
      f32x4 tw;
#pragma unroll
      for (int j = 0; j < 4; ++j) tw[j] = 1.f - 2.f * __builtin_amdgcn_rcpf(1.f + __expf(2.f * xs[3][j]));
      st4bf(Aw + pj * 72 + pcg * 4, tw);
      st4bf(Aa + pj * 72 + pcg * 4, xs[4]);
    }
    if (ch + 1 < 144) prefetch(ch + 1);
    __syncthreads();
    {
      f32x4 aw = {0.f, 0.f, 0.f, 0.f}, aa = {0.f, 0.f, 0.f, 0.f};
#pragma unroll
      for (int ks = 0; ks < 2; ++ks) {
        const bf16x8 fw = *(const bf16x8*)(Aw + fr * 72 + ks * 32 + fq * 8);
        const bf16x8 fa = *(const bf16x8*)(Aa + fr * 72 + ks * 32 + fq * 8);
        aw = MFMA16(bw[ks], fw, aw);
        aa = MFMA16(ba[ks], fa, aa);
      }
      const int c = 16 * w + fq * 4;
      const float* rj = rec + fr * 384;
      const f32x4 w0v = *(const f32x4*)(cst + 640 + c), a0v = *(const f32x4*)(cst + 704 + c), kav = *(const f32x4*)(cst + 832 + c);
      const f32x4 kkv = *(const f32x4*)(rj + 64 + c), kpv = *(const f32x4*)(rj + 192 + c), rpv = *(const f32x4*)(rj + 256 + c);
      f32x4 e, E, ic;
#pragma unroll
      for (int j = 0; j < 4; ++j) {
        const float z = -(w0v[j] + aw[j]);
        const float sp = fmaxf(z, 0.f) + __logf(1.f + __expf(-fabsf(z)));
        e[j] = __expf(-sp - 0.5f);
        ic[j] = sigmoidf_(a0v[j] + aa[j]);
      }
      E = e;
#pragma unroll
      for (int j = 0; j < 4; ++j) {
        E[j] += dpp_f<0x111>(E[j]);
        E[j] += dpp_f<0x112>(E[j]);
        E[j] += dpp_f<0x114>(E[j]);
        E[j] += dpp_f<0x118>(E[j]);
      }
      f32x4 at, rt, bt, kt_;
#pragma unroll
      for (int j = 0; j < 4; ++j) {
        const float wi = __expf(E[j]);
        at[j] = -kkv[j] * __expf(e[j] - E[j]);
        rt[j] = rpv[j] * __expf(-E[j]);
        bt[j] = kkv[j] * ic[j] * wi;
        kt_[j] = kpv[j] * (1.f + (ic[j] - 1.f) * kav[j]) * wi;
      }
      st4bf(ARt + fr * 72 + c, at);
      st4bf(ARt + (16 + fr) * 72 + c, rt);
      st4bf(BKm + fr * 72 + c, bt);
      st4bf(BKm + (16 + fr) * 72 + c, kt_);
#pragma unroll
      for (int j = 0; j < 4; ++j) { BKt[(c + j) * 40 + fr] = f2bf(bt[j]); BKt[(c + j) * 40 + 16 + fr] = f2bf(kt_[j]); }
      if (fr == 15) {
#pragma unroll
        for (int j = 0; j < 4; ++j) WL[c + j] = __expf(-E[j]);
      }
    }
    __syncthreads();
    {
      const int ct = w >> 1, tt = w & 1;
      f32x4 g = {0.f, 0.f, 0.f, 0.f};
#pragma unroll
      for (int ks = 0; ks < 2; ++ks) {
        const bf16x8 A = *(const bf16x8*)(BKm + (ct * 16 + fr) * 72 + ks * 32 + fq * 8);
        const bf16x8 B = *(const bf16x8*)(ARt + (tt * 16 + fr) * 72 + ks * 32 + fq * 8);
        g = MFMA16(A, B, g);
      }
#pragma unroll
      for (int r = 0; r < 4; ++r) Gf[(ct * 16 + fq * 4 + r) * 33 + tt * 16 + fr] = g[r];
      if (w == 0) {
#pragma unroll
        for (int r = 0; r < 4; ++r) GNt[(fq * 4 + r) * 16 + fr] = g[r];
      }
    }
    f32x4 XA = {0.f, 0.f, 0.f, 0.f}, XR = {0.f, 0.f, 0.f, 0.f};
#pragma unroll
    for (int ks = 0; ks < 2; ++ks) {
      const bf16x8 Bs = pack8(ST[2 * ks], ST[2 * ks + 1]);
      {
        const bf16_t* ar = ARt + fr * 72 + fq * 4;
        const s16x4 lo = *(const s16x4*)(ar + (2 * ks) * 16), hi = *(const s16x4*)(ar + (2 * ks + 1) * 16);
        XA = MFMA16(__builtin_shufflevector(lo, hi, 0, 1, 2, 3, 4, 5, 6, 7), Bs, XA);
      }
      {
        const bf16_t* ar = ARt + (16 + fr) * 72 + fq * 4;
        const s16x4 lo = *(const s16x4*)(ar + (2 * ks) * 16), hi = *(const s16x4*)(ar + (2 * ks + 1) * 16);
        XR = MFMA16(__builtin_shufflevector(lo, hi, 0, 1, 2, 3, 4, 5, 6, 7), Bs, XR);
      }
    }
    __syncthreads();
    const bf16x8 vB = fq < 2 ? *(const bf16x8*)(Vt + (16 * w + fr) * 24 + fq * 8) : zero8;
    {
      f32x4 n0, n1;
#pragma unroll
      for (int jj = 0; jj < 4; ++jj) {
        const int i0 = fq * 8 + jj, i1 = fq * 8 + 4 + jj;
        const float g0 = Gf[(16 + (i0 & 15)) * 33 + fr], g1 = Gf[(16 + (i1 & 15)) * 33 + fr];
        n0[jj] = (fq < 2 && i0 < fr) ? g0 : 0.f;
        n1[jj] = (fq < 2 && i1 < fr) ? g1 : 0.f;
      }
      XA = MFMA16(pack8(n0, n1), vB, XA);
    }
    float* yw = Yf + (w * 16 + fr) * 20;
    *(f32x4*)(yw + fq * 4) = XA;
    float u[16];
    {
      const f32x4 y0 = *(const f32x4*)(yw), y1 = *(const f32x4*)(yw + 4), y2 = *(const f32x4*)(yw + 8), y3 = *(const f32x4*)(yw + 12);
#pragma unroll
      for (int j = 0; j < 4; ++j) { u[j] = y0[j]; u[4 + j] = y1[j]; u[8 + j] = y2[j]; u[12 + j] = y3[j]; }
#pragma unroll
      for (int i = 0; i < 15; ++i) {
#pragma unroll
        for (int t4 = (i + 1) / 4; t4 < 4; ++t4) {
          const f32x4 nn = *(const f32x4*)(GNt + i * 16 + t4 * 4);
#pragma unroll
          for (int e2 = 0; e2 < 4; ++e2) if (t4 * 4 + e2 > i) u[t4 * 4 + e2] += u[i] * nn[e2];
        }
      }
    }
    f32x4 uq;
#pragma unroll
    for (int j = 0; j < 4; ++j) uq[j] = fq == 0 ? u[j] : (fq == 1 ? u[4 + j] : (fq == 2 ? u[8 + j] : u[12 + j]));
    const bf16x8 uB = pack4z(uq);
    {
      f32x4 m0, n0, n1;
#pragma unroll
      for (int jj = 0; jj < 4; ++jj) {
        const int i = fq * 4 + jj;
        const float gm = Gf[i * 33 + 16 + fr];
        m0[jj] = i <= fr ? gm : 0.f;
        const int i0 = fq * 8 + jj, i1 = fq * 8 + 4 + jj;
        const float g0 = Gf[(16 + (i0 & 15)) * 33 + 16 + fr], g1 = Gf[(16 + (i1 & 15)) * 33 + 16 + fr];
        n0[jj] = (fq < 2 && i0 <= fr) ? g0 : 0.f;
        n1[jj] = (fq < 2 && i1 <= fr) ? g1 : 0.f;
      }
      XR = MFMA16(pack4z(m0), uB, XR);
      XR = MFMA16(pack8(n0, n1), vB, XR);
#pragma unroll
      for (int r = 0; r < 4; ++r) obuf[(fq * 4 + r) * 64 + 16 * w + fr] = XR[r];
    }
#pragma unroll
    for (int kt = 0; kt < 4; ++kt) {
      const bf16_t* bk = BKt + (kt * 16 + fr) * 40;
      const s16x4 lo = *(const s16x4*)(bk + fq * 4);
      const s16x4 z4 = {0, 0, 0, 0};
      ST[kt] = MFMA16(__builtin_shufflevector(lo, z4, 0, 1, 2, 3, 4, 5, 6, 7), uB, ST[kt]);
      const bf16x8 a5 = fq < 2 ? *(const bf16x8*)(bk + 16 + fq * 8) : zero8;
      ST[kt] = MFMA16(a5, vB, ST[kt]);
      ST[kt] *= *(const f32x4*)(WL + kt * 16 + fq * 4);
    }
    __syncthreads();
    if (ch >= 16 || need_ctx) {
      int rowbase, t, L;
      chunk_tok(ch, pj, rowbase, t, L);
      const f32x4 ov = *(const f32x4*)(obuf + pj * 64 + pcg * 4);
      st4bf(p.Os + ((size_t)dir * NTOK + rowbase + t) * 512 + hd * 64 + pcg * 4, ov);
    }
  }
  __syncthreads();
}

DI void scan_block3(const Params& p, int lyr, int sidx, bool need_ctx, char* lds) {
  const int dir = sidx & 1, hd = (sidx >> 1) & 7, b = sidx >> 4;
  const int tid = tid_(), lane = tid & 63, w = tid >> 6;
  const int fr = lane & 15, fq = lane >> 4;
  float* rec = (float*)lds;
  float* obuf = rec + 16 * 192;
  float* cst = obuf + 16 * 64;
  bf16_t* Aw = (bf16_t*)(cst + 14 * 64);
  bf16_t* Aa = Aw + 16 * 72;
  float* Gf = (float*)(Aa + 16 * 72);
  float* GNt = Gf + 32 * 33;
  float* Yf = GNt + 256;
  bf16_t* OPS = (bf16_t*)(Yf + 4 * 16 * 20);
  constexpr int OPS_STRIDE = 32 * 72 + 32 * 72 + 64 * 40 + 64 * 24 + 128;
  __syncthreads();
  for (int i = tid; i < 320; i += NTHREADS) {
    const int g = i >> 6, c = i & 63;
    const int colidx = (g < 3 ? g * 512 + hd * 64 : (g == 3 ? 1536 + dir * 64 : 1664 + dir * 64)) + c;
    cst[i] = p.mu[(size_t)lyr * 3840 + colidx];
    cst[320 + i] = p.mu[(size_t)lyr * 3840 + 1920 + colidx];
  }
  if (tid < 64) {
    cst[640 + tid] = p.w0[(lyr * 2 + dir) * 512 + hd * 64 + tid];
    cst[704 + tid] = p.a0[(lyr * 2 + dir) * 512 + hd * 64 + tid];
    cst[768 + tid] = p.k_k[lyr * 512 + hd * 64 + tid];
    cst[832 + tid] = p.k_a[lyr * 512 + hd * 64 + tid];
  }
  bf16x8 bw[2], ba[2];
  {
    const float* w2p = p.w2 + (size_t)(lyr * 2 + dir) * 64 * 512 + hd * 64 + 16 * w + fr;
    const float* a2p = p.a2 + (size_t)(lyr * 2 + dir) * 64 * 512 + hd * 64 + 16 * w + fr;
#pragma unroll
    for (int ks = 0; ks < 2; ++ks) {
      f32x4 x0, x1, y0, y1;
#pragma unroll
      for (int j = 0; j < 4; ++j) {
        x0[j] = w2p[(size_t)(ks * 32 + fq * 8 + j) * 512]; x1[j] = w2p[(size_t)(ks * 32 + fq * 8 + 4 + j) * 512];
        y0[j] = a2p[(size_t)(ks * 32 + fq * 8 + j) * 512]; y1[j] = a2p[(size_t)(ks * 32 + fq * 8 + 4 + j) * 512];
      }
      bw[ks] = pack8(x0, x1);
      ba[ks] = pack8(y0, y1);
    }
  }
  f32x4 ST[4];
#pragma unroll
  for (int kt = 0; kt < 4; ++kt) ST[kt] = (f32x4){0.f, 0.f, 0.f, 0.f};
  const int pj = tid >> 4, pcg = tid & 15;
  int goff[5] = {hd * 64, 512 + hd * 64, 1024 + hd * 64, 1536 + dir * 64, 1664 + dir * 64};
  u32x2 raw[5][3];
  auto chunk_tok = [&](int ch, int j, int& rowbase, int& t, int& L) {
    int n0;
    if (ch < 16) { L = TC; n0 = ch * 16; rowbase = NTL + b * TC; } else { L = TL; n0 = (ch - 16) * 16; rowbase = b * TL; }
    const int n = n0 + j;
    t = dir ? L - 1 - n : n;
  };
  auto prefetch = [&](int ch) {
    int rowbase, t, L;
    chunk_tok(ch, pj, rowbase, t, L);
    const bf16_t* q = p.P + (size_t)(rowbase + t) * DPROJ + 768 + pcg * 4;
    const bool hp = t > 0, hn = t < L - 1;
    const int om = hp ? -DPROJ : 0, on = hn ? DPROJ : 0;
#pragma unroll
    for (int g = 0; g < 5; ++g) {
      raw[g][1] = *(const u32x2*)(q + goff[g]);
      const u32x2 rm = *(const u32x2*)(q + goff[g] + om), rn = *(const u32x2*)(q + goff[g] + on);
      raw[g][0] = hp ? rm : (u32x2){0u, 0u};
      raw[g][2] = hn ? rn : (u32x2){0u, 0u};
    }
  };
  const bf16x8 zero8 = {0, 0, 0, 0, 0, 0, 0, 0};
  prefetch(0);
  __syncthreads();
    {
      bf16_t* ARt = OPS + (0) * OPS_STRIDE; bf16_t* BKm = ARt + 32 * 72; bf16_t* BKt = BKm + 32 * 72; bf16_t* Vt = BKt + 64 * 40; float* WL = (float*)(Vt + 64 * 24);
      (void)ARt; (void)BKm; (void)BKt; (void)Vt; (void)WL;
    {
      f32x4 xs[5];
#pragma unroll
      for (int g = 0; g < 5; ++g) {
        const f32x4 x = {bflo(raw[g][1].x), bfhi(raw[g][1].x), bflo(raw[g][1].y), bfhi(raw[g][1].y)};
        const f32x4 xm = {bflo(raw[g][0].x), bfhi(raw[g][0].x), bflo(raw[g][0].y), bfhi(raw[g][0].y)};
        const f32x4 xp = {bflo(raw[g][2].x), bfhi(raw[g][2].x), bflo(raw[g][2].y), bfhi(raw[g][2].y)};
        const f32x4 m0 = *(const f32x4*)(cst + g * 64 + pcg * 4), m1 = *(const f32x4*)(cst + 320 + g * 64 + pcg * 4);
        xs[g] = x + m0 * (xm - x) + m1 * (xp - x);
      }
      float* rj = rec + pj * 192;
      *(f32x4*)(rj + 128 + pcg * 4) = xs[0];
#pragma unroll
      for (int e = 0; e < 4; ++e) Vt[(pcg * 4 + e) * 24 + pj] = f2bf(xs[2][e]);
      const f32x4 kx = xs[1] * *(const f32x4*)(cst + 768 + pcg * 4);
      float ss = (kx[0] * kx[0] + kx[1] * kx[1]) + (kx[2] * kx[2] + kx[3] * kx[3]);
      ss = red8(ss); ss += dpp_f<0x140>(ss);
      const float rn = rsqrtf(ss + 1e-12f);
      *(f32x4*)(rj + 0 + pcg * 4) = kx * rn;
      *(f32x4*)(rj + 64 + pcg * 4) = xs[1];
      f32x4 tw;
#pragma unroll
      for (int j = 0; j < 4; ++j) tw[j] = 1.f - 2.f * __builtin_amdgcn_rcpf(1.f + __expf(2.f * xs[3][j]));
      st4bf(Aw + pj * 72 + pcg * 4, tw);
      st4bf(Aa + pj * 72 + pcg * 4, xs[4]);
    }
    }
  prefetch(1);
  __syncthreads();
    {
      bf16_t* ARt = OPS + (0) * OPS_STRIDE; bf16_t* BKm = ARt + 32 * 72; bf16_t* BKt = BKm + 32 * 72; bf16_t* Vt = BKt + 64 * 40; float* WL = (float*)(Vt + 64 * 24);
      (void)ARt; (void)BKm; (void)BKt; (void)Vt; (void)WL;
    {
      f32x4 aw = {0.f, 0.f, 0.f, 0.f}, aa = {0.f, 0.f, 0.f, 0.f};
#pragma unroll
      for (int ks = 0; ks < 2; ++ks) {
        const bf16x8 fw = *(const bf16x8*)(Aw + fr * 72 + ks * 32 + fq * 8);
        const bf16x8 fa = *(const bf16x8*)(Aa + fr * 72 + ks * 32 + fq * 8);
        aw = MFMA16(bw[ks], fw, aw);
        aa = MFMA16(ba[ks], fa, aa);
      }
      const int c = 16 * w + fq * 4;
      const float* rj = rec + fr * 192;
      const f32x4 w0v = *(const f32x4*)(cst + 640 + c), a0v = *(const f32x4*)(cst + 704 + c), kav = *(const f32x4*)(cst + 832 + c);
      const f32x4 kkv = *(const f32x4*)(rj + 0 + c), kpv = *(const f32x4*)(rj + 64 + c), rpv = *(const f32x4*)(rj + 128 + c);
      f32x4 e, E, ic;
#pragma unroll
      for (int j = 0; j < 4; ++j) {
        const float z = -(w0v[j] + aw[j]);
        const float sp = fmaxf(z, 0.f) + __logf(1.f + __expf(-fabsf(z)));
        e[j] = __expf(-sp - 0.5f);
        ic[j] = sigmoidf_(a0v[j] + aa[j]);
      }
      E = e;
#pragma unroll
      for (int j = 0; j < 4; ++j) {
        E[j] += dpp_f<0x111>(E[j]);
        E[j] += dpp_f<0x112>(E[j]);
        E[j] += dpp_f<0x114>(E[j]);
        E[j] += dpp_f<0x118>(E[j]);
      }
      f32x4 at, rt, bt, kt_;
#pragma unroll
      for (int j = 0; j < 4; ++j) {
        const float wi = __expf(E[j]);
        at[j] = -kkv[j] * __expf(e[j] - E[j]);
        rt[j] = rpv[j] * __expf(-E[j]);
        bt[j] = kkv[j] * ic[j] * wi;
        kt_[j] = kpv[j] * (1.f + (ic[j] - 1.f) * kav[j]) * wi;
      }
      st4bf(ARt + fr * 72 + c, at);
      st4bf(ARt + (16 + fr) * 72 + c, rt);
      st4bf(BKm + fr * 72 + c, bt);
      st4bf(BKm + (16 + fr) * 72 + c, kt_);
#pragma unroll
      for (int j = 0; j < 4; ++j) { BKt[(c + j) * 40 + fr] = f2bf(bt[j]); BKt[(c + j) * 40 + 16 + fr] = f2bf(kt_[j]); }
      if (fr == 15) {
#pragma unroll
        for (int j = 0; j < 4; ++j) WL[c + j] = __expf(-E[j]);
      }
    }
    }
#pragma unroll 1
  for (int ch = 0; ch < 144; ++ch) {
    const int cb = ch & 1, nb = cb ^ 1;
    const bool more = ch + 1 < 144;
    f32x4 XA, XR;
    __syncthreads();
    if (more) {
    {
      bf16_t* ARt = OPS + (nb) * OPS_STRIDE; bf16_t* BKm = ARt + 32 * 72; bf16_t* BKt = BKm + 32 * 72; bf16_t* Vt = BKt + 64 * 40; float* WL = (float*)(Vt + 64 * 24);
      (void)ARt; (void)BKm; (void)BKt; (void)Vt; (void)WL;
    {
      f32x4 xs[5];
#pragma unroll
      for (int g = 0; g < 5; ++g) {
        const f32x4 x = {bflo(raw[g][1].x), bfhi(raw[g][1].x), bflo(raw[g][1].y), bfhi(raw[g][1].y)};
        const f32x4 xm = {bflo(raw[g][0].x), bfhi(raw[g][0].x), bflo(raw[g][0].y), bfhi(raw[g][0].y)};
        const f32x4 xp = {bflo(raw[g][2].x), bfhi(raw[g][2].x), bflo(raw[g][2].y), bfhi(raw[g][2].y)};
        const f32x4 m0 = *(const f32x4*)(cst + g * 64 + pcg * 4), m1 = *(const f32x4*)(cst + 320 + g * 64 + pcg * 4);
        xs[g] = x + m0 * (xm - x) + m1 * (xp - x);
      }
      float* rj = rec + pj * 192;
      *(f32x4*)(rj + 128 + pcg * 4) = xs[0];
#pragma unroll
      for (int e = 0; e < 4; ++e) Vt[(pcg * 4 + e) * 24 + pj] = f2bf(xs[2][e]);
      const f32x4 kx = xs[1] * *(const f32x4*)(cst + 768 + pcg * 4);
      float ss = (kx[0] * kx[0] + kx[1] * kx[1]) + (kx[2] * kx[2] + kx[3] * kx[3]);
      ss = red8(ss); ss += dpp_f<0x140>(ss);
      const float rn = rsqrtf(ss + 1e-12f);
      *(f32x4*)(rj + 0 + pcg * 4) = kx * rn;
      *(f32x4*)(rj + 64 + pcg * 4) = xs[1];
      f32x4 tw;
#pragma unroll
      for (int j = 0; j < 4; ++j) tw[j] = 1.f - 2.f * __builtin_amdgcn_rcpf(1.f + __expf(2.f * xs[3][j]));
      st4bf(Aw + pj * 72 + pcg * 4, tw);
      st4bf(Aa + pj * 72 + pcg * 4, xs[4]);
    }
    }
      if (ch + 2 < 144) prefetch(ch + 2);
    }
    {
      bf16_t* ARt = OPS + (cb) * OPS_STRIDE; bf16_t* BKm = ARt + 32 * 72; bf16_t* BKt = BKm + 32 * 72; bf16_t* Vt = BKt + 64 * 40; float* WL = (float*)(Vt + 64 * 24);
      (void)ARt; (void)BKm; (void)BKt; (void)Vt; (void)WL;
    {
      const int ct = w >> 1, tt = w & 1;
      f32x4 g = {0.f, 0.f, 0.f, 0.f};
#pragma unroll
      for (int ks = 0; ks < 2; ++ks) {
        const bf16x8 A = *(const bf16x8*)(BKm + (ct * 16 + fr) * 72 + ks * 32 + fq * 8);
        const bf16x8 B = *(const bf16x8*)(ARt + (tt * 16 + fr) * 72 + ks * 32 + fq * 8);
        g = MFMA16(A, B, g);
      }
#pragma unroll
      for (int r = 0; r < 4; ++r) Gf[(ct * 16 + fq * 4 + r) * 33 + tt * 16 + fr] = g[r];
      if (w == 0) {
#pragma unroll
        for (int r = 0; r < 4; ++r) GNt[(fq * 4 + r) * 16 + fr] = g[r];
      }
    }
    XA = (f32x4){0.f, 0.f, 0.f, 0.f}; XR = (f32x4){0.f, 0.f, 0.f, 0.f};
#pragma unroll
    for (int ks = 0; ks < 2; ++ks) {
      const bf16x8 Bs = pack8(ST[2 * ks], ST[2 * ks + 1]);
      {
        const bf16_t* ar = ARt + fr * 72 + fq * 4;
        const s16x4 lo = *(const s16x4*)(ar + (2 * ks) * 16), hi = *(const s16x4*)(ar + (2 * ks + 1) * 16);
        XA = MFMA16(__builtin_shufflevector(lo, hi, 0, 1, 2, 3, 4, 5, 6, 7), Bs, XA);
      }
      {
        const bf16_t* ar = ARt + (16 + fr) * 72 + fq * 4;
        const s16x4 lo = *(const s16x4*)(ar + (2 * ks) * 16), hi = *(const s16x4*)(ar + (2 * ks + 1) * 16);
        XR = MFMA16(__builtin_shufflevector(lo, hi, 0, 1, 2, 3, 4, 5, 6, 7), Bs, XR);
      }
    }
    }
    __syncthreads();
    if (more) {
    {
      bf16_t* ARt = OPS + (nb) * OPS_STRIDE; bf16_t* BKm = ARt + 32 * 72; bf16_t* BKt = BKm + 32 * 72; bf16_t* Vt = BKt + 64 * 40; float* WL = (float*)(Vt + 64 * 24);
      (void)ARt; (void)BKm; (void)BKt; (void)Vt; (void)WL;
    {
      f32x4 aw = {0.f, 0.f, 0.f, 0.f}, aa = {0.f, 0.f, 0.f, 0.f};
#pragma unroll
      for (int ks = 0; ks < 2; ++ks) {
        const bf16x8 fw = *(const bf16x8*)(Aw + fr * 72 + ks * 32 + fq * 8);
        const bf16x8 fa = *(const bf16x8*)(Aa + fr * 72 + ks * 32 + fq * 8);
        aw = MFMA16(bw[ks], fw, aw);
        aa = MFMA16(ba[ks], fa, aa);
      }
      const int c = 16 * w + fq * 4;
      const float* rj = rec + fr * 192;
      const f32x4 w0v = *(const f32x4*)(cst + 640 + c), a0v = *(const f32x4*)(cst + 704 + c), kav = *(const f32x4*)(cst + 832 + c);
      const f32x4 kkv = *(const f32x4*)(rj + 0 + c), kpv = *(const f32x4*)(rj + 64 + c), rpv = *(const f32x4*)(rj + 128 + c);
      f32x4 e, E, ic;
#pragma unroll
      for (int j = 0; j < 4; ++j) {
        const float z = -(w0v[j] + aw[j]);
        const float sp = fmaxf(z, 0.f) + __logf(1.f + __expf(-fabsf(z)));
        e[j] = __expf(-sp - 0.5f);
        ic[j] = sigmoidf_(a0v[j] + aa[j]);
      }
      E = e;
#pragma unroll
      for (int j = 0; j < 4; ++j) {
        E[j] += dpp_f<0x111>(E[j]);
        E[j] += dpp_f<0x112>(E[j]);
        E[j] += dpp_f<0x114>(E[j]);
        E[j] += dpp_f<0x118>(E[j]);
      }
      f32x4 at, rt, bt, kt_;
#pragma unroll
      for (int j = 0; j < 4; ++j) {
        const float wi = __expf(E[j]);
        at[j] = -kkv[j] * __expf(e[j] - E[j]);
        rt[j] = rpv[j] * __expf(-E[j]);
        bt[j] = kkv[j] * ic[j] * wi;
        kt_[j] = kpv[j] * (1.f + (ic[j] - 1.f) * kav[j]) * wi;
      }
      st4bf(ARt + fr * 72 + c, at);
      st4bf(ARt + (16 + fr) * 72 + c, rt);
      st4bf(BKm + fr * 72 + c, bt);
      st4bf(BKm + (16 + fr) * 72 + c, kt_);
#pragma unroll
      for (int j = 0; j < 4; ++j) { BKt[(c + j) * 40 + fr] = f2bf(bt[j]); BKt[(c + j) * 40 + 16 + fr] = f2bf(kt_[j]); }
      if (fr == 15) {
#pragma unroll
        for (int j = 0; j < 4; ++j) WL[c + j] = __expf(-E[j]);
      }
    }
    }
    }
    {
      bf16_t* ARt = OPS + (cb) * OPS_STRIDE; bf16_t* BKm = ARt + 32 * 72; bf16_t* BKt = BKm + 32 * 72; bf16_t* Vt = BKt + 64 * 40; float* WL = (float*)(Vt + 64 * 24);
      (void)ARt; (void)BKm; (void)BKt; (void)Vt; (void)WL;
    const bf16x8 vB = fq < 2 ? *(const bf16x8*)(Vt + (16 * w + fr) * 24 + fq * 8) : zero8;
    {
      f32x4 n0, n1;
#pragma unroll
      for (int jj = 0; jj < 4; ++jj) {
        const int i0 = fq * 8 + jj, i1 = fq * 8 + 4 + jj;
        const float g0 = Gf[(16 + (i0 & 15)) * 33 + fr], g1 = Gf[(16 + (i1 & 15)) * 33 + fr];
        n0[jj] = (fq < 2 && i0 < fr) ? g0 : 0.f;
        n1[jj] = (fq < 2 && i1 < fr) ? g1 : 0.f;
      }
      XA = MFMA16(pack8(n0, n1), vB, XA);
    }
    float* yw = Yf + (w * 16 + fr) * 20;
    *(f32x4*)(yw + fq * 4) = XA;
    float u[16];
    {
      const f32x4 y0 = *(const f32x4*)(yw), y1 = *(const f32x4*)(yw + 4), y2 = *(const f32x4*)(yw + 8), y3 = *(const f32x4*)(yw + 12);
#pragma unroll
      for (int j = 0; j < 4; ++j) { u[j] = y0[j]; u[4 + j] = y1[j]; u[8 + j] = y2[j]; u[12 + j] = y3[j]; }
#pragma unroll
      for (int i = 0; i < 15; ++i) {
#pragma unroll
        for (int t4 = (i + 1) / 4; t4 < 4; ++t4) {
          const f32x4 nn = *(const f32x4*)(GNt + i * 16 + t4 * 4);
#pragma unroll
          for (int e2 = 0; e2 < 4; ++e2) if (t4 * 4 + e2 > i) u[t4 * 4 + e2] += u[i] * nn[e2];
        }
      }
    }
    f32x4 uq;
#pragma unroll
    for (int j = 0; j < 4; ++j) uq[j] = fq == 0 ? u[j] : (fq == 1 ? u[4 + j] : (fq == 2 ? u[8 + j] : u[12 + j]));
    const bf16x8 uB = pack4z(uq);
    {
      f32x4 m0, n0, n1;
#pragma unroll
      for (int jj = 0; jj < 4; ++jj) {
        const int i = fq * 4 + jj;
        const float gm = Gf[i * 33 + 16 + fr];
        m0[jj] = i <= fr ? gm : 0.f;
        const int i0 = fq * 8 + jj, i1 = fq * 8 + 4 + jj;
        const float g0 = Gf[(16 + (i0 & 15)) * 33 + 16 + fr], g1 = Gf[(16 + (i1 & 15)) * 33 + 16 + fr];
        n0[jj] = (fq < 2 && i0 <= fr) ? g0 : 0.f;
        n1[jj] = (fq < 2 && i1 <= fr) ? g1 : 0.f;
      }
      XR = MFMA16(pack4z(m0), uB, XR);
      XR = MFMA16(pack8(n0, n1), vB, XR);
#pragma unroll
      for (int r = 0; r < 4; ++r) obuf[(fq * 4 + r) * 64 + 16 * w + fr] = XR[r];
    }
#pragma unroll
    for (int kt = 0; kt < 4; ++kt) {
      const bf16_t* bk = BKt + (kt * 16 + fr) * 40;
      const s16x4 lo = *(const s16x4*)(bk + fq * 4);
      const s16x4 z4 = {0, 0, 0, 0};
      ST[kt] = MFMA16(__builtin_shufflevector(lo, z4, 0, 1, 2, 3, 4, 5, 6, 7), uB, ST[kt]);
      const bf16x8 a5 = fq < 2 ? *(const bf16x8*)(bk + 16 + fq * 8) : zero8;
      ST[kt] = MFMA16(a5, vB, ST[kt]);
      ST[kt] *= *(const f32x4*)(WL + kt * 16 + fq * 4);
    }
    }
    __syncthreads();
    if (ch >= 16 || need_ctx) {
      int rowbase, t, L;
      chunk_tok(ch, pj, rowbase, t, L);
      const f32x4 ov = *(const f32x4*)(obuf + pj * 64 + pcg * 4);
      st4bf(p.Os + ((size_t)dir * NTOK + rowbase + t) * 512 + hd * 64 + pcg * 4, ov);
    }
  }
  __syncthreads();
}

DI void mixer_phase(const Params& p, int l, bool need_ctx, char* lds, long long* scan_t) {
  int& s_item = *(int*)(lds + LDS_WORK + 16);
  sg_phase(p, l);
  { long long t0 = 0; if (PROBE_MASK) t0 = wall_clock64();
    __builtin_amdgcn_s_setprio(3);
    for (int s = blockIdx.x; s < 256; s += gridDim.x) scan_block3(p, l, s, need_ctx, lds);
    __builtin_amdgcn_s_setprio(0);
#ifdef SCAN_ALONE
    if (blockIdx.x < 256) { __syncthreads(); if (tid_() == 0) { __threadfence(); atomicAdd(&p.counters[8 + l], 1u); } }
    else { if (tid_() == 0) { while (atomicAdd(&p.counters[8 + l], 0u) < 256u) __builtin_amdgcn_s_sleep(32); } __syncthreads(); }
#endif
    if ((PROBE_MASK >> 13) & 1) *scan_t += wall_clock64() - t0; }
  const int nitems = 4096 + (need_ctx ? 512 : 0);
  while (true) {
    __syncthreads();
    if (tid_() == 0) s_item = (int)atomicAdd(&p.counters[l], 1u);
    __syncthreads();
    const int it = s_item;
    if (it >= nitems) break;
    if (it < 2048) {
      const int b = it >> 7, head = (it >> 4) & 7, qb = it & 15, kvh = head >> 2;
      dense_item(p, b * TL + qb * 128, head * 64, b * TL, 32, NTL + b * TC, 512 + kvh * 64, 640 + kvh * 64, lds);
    } else if (it < 4096) {
      const int i2 = it - 2048;
      const int b = i2 >> 7, gr = (i2 >> 2) & 31, hp = i2 & 3;
      na_item(p, l, b, gr, hp, lds);
    } else if (it < 4352) {
      const int i2 = it - 4096;
      const int b = i2 >> 4, head = (i2 >> 1) & 7, qb = i2 & 1, kvh = head >> 2;
      dense_item(p, NTL + b * TC + qb * 128, head * 64, 0, 0, NTL + b * TC, 512 + kvh * 64, 640 + kvh * 64, lds);
    } else {
      const int i2 = it - 4352;
      const int b = i2 >> 4, head = (i2 >> 1) & 7, qb = i2 & 1;
      dense_item(p, NTL + b * TC + qb * 128, 2688 + head * 64, 0, 0, NTL + b * TC, 3200 + head * 64, 3712 + head * 64, lds);
    }
  }
}

template <int MI>
DI void merge_phaseT(const Params& p, int l, int M, char* lds) {
  const int ntm = M / (MI * 32), ntn = 8;
  const int lane = tid_() & 63, wid = tid_() >> 6, wr = wid >> 1, wc = wid & 1, fr = lane & 15, fq = lane >> 4;
  const bf16_t* wm = p.WM + (size_t)l * WM_STRIDE;
  int tm, tn;
  for (int it = 0; xcd_tile<2, 8>(it, ntm, ntn, tm, tn); ++it) {
    const size_t grow = (size_t)tm * (MI * 32);
#pragma unroll 1
    for (int z = 0; z < 3; ++z) {
      f32x4 acc[MI][4];
#pragma unroll
      for (int mi = 0; mi < MI; ++mi)
#pragma unroll
        for (int ni = 0; ni < 4; ++ni) acc[mi][ni] = (f32x4){0.f, 0.f, 0.f, 0.f};
      gemm_mainloopT<MI>(p.U + grow * DM, DM, wm + WM_IN + (size_t)(DPROJ + z * DM + tn * 128) * DM, DM, acc, lds);
      {
      bf16_t* prow;
      { const int t2 = tid_(), l2 = t2 & 63, w2 = t2 >> 6; prow = p.P + (grow + (w2 >> 1) * (MI * 16) + (l2 & 15)) * DPROJ + tn * 128 + (w2 & 1) * 64 + (l2 >> 4) * 4; }
#pragma unroll
      for (int mi = 0; mi < MI; ++mi) {
#pragma unroll
        for (int ni = 0; ni < 4; ++ni) {
          f32x4 g;
#pragma unroll
          for (int j = 0; j < 4; ++j) g[j] = sigmoidf_(acc[mi][ni][j]);
          st4bf(prow + (size_t)(mi * 16) * DPROJ + 512 + ni * 16, g);
          acc[mi][ni] = (f32x4){0.f, 0.f, 0.f, 0.f};
        }
        asm volatile("" ::: "memory");
      }
      }
      const bf16_t* Ya = z == 1 ? p.yr : (z == 0 ? p.P : p.P + 2688);
      const int lda = z == 1 ? 512 : DPROJ;
      gemm_mainloopT<MI>(Ya + grow * lda, lda, wm + WM_BR + (size_t)z * 1024 * 512 + (size_t)tn * 128 * 512, 512, acc, lds);
      {
      bf16_t* prow;
      { const int t2 = tid_(), l2 = t2 & 63, w2 = t2 >> 6; prow = p.P + (grow + (w2 >> 1) * (MI * 16) + (l2 & 15)) * DPROJ + tn * 128 + (w2 & 1) * 64 + (l2 >> 4) * 4; }
#pragma unroll
      for (int mi = 0; mi < MI; ++mi) {
#pragma unroll
        for (int ni = 0; ni < 4; ++ni) {
          bf16_t* q = prow + (size_t)(mi * 16) * DPROJ + ni * 16;
          f32x4 mn = ld4bf(q + 512) * acc[mi][ni];
          if (z > 0) mn += ld4bf(q + 3200);
          st4bf(q + 3200, mn);
        }
        asm volatile("" ::: "memory");
      }
      }
    }
  }
}

DI void merge_phase(const Params& p, int l, int row0, int M, char* lds) {
  const int ntm = M >> 7, ntn = 8;
  const int lane = tid_() & 63, wid = tid_() >> 6, wr = wid >> 1, wc = wid & 1, fr = lane & 15, fq = lane >> 4;
  const bf16_t* wm = p.WM + (size_t)l * WM_STRIDE;
  int tm, tn;
  for (int it = 0; xcd_tile<2, 8>(it, ntm, ntn, tm, tn); ++it) {
    const size_t grow = (size_t)row0 + tm * 128;
#pragma unroll 1
    for (int z = 0; z < 3; ++z) {
      u32x2 gp[4][4];
      {
        f32x4 acc[4][4];
        zero_acc(acc);
        gemm_mainloop2(p.U + grow * DM, DM, wm + WM_IN + (size_t)(DPROJ + z * DM + tn * 128) * DM, DM, acc, lds);
#pragma unroll
        for (int mi = 0; mi < 4; ++mi)
#pragma unroll
          for (int ni = 0; ni < 4; ++ni) {
            gp[mi][ni].x = pk2(sigmoidf_(acc[mi][ni][0]), sigmoidf_(acc[mi][ni][1]));
            gp[mi][ni].y = pk2(sigmoidf_(acc[mi][ni][2]), sigmoidf_(acc[mi][ni][3]));
          }
      }
      {
        f32x4 acc[4][4];
        zero_acc(acc);
        const bf16_t* Ya = z == 1 ? p.yr : (z == 0 ? p.P : p.P + 2688);
        const int lda = z == 1 ? 512 : DPROJ;
        gemm_mainloop2(Ya + grow * lda, lda, wm + WM_BR + (size_t)z * 1024 * 512 + (size_t)tn * 128 * 512, 512, acc, lds);
#pragma unroll
        for (int mi = 0; mi < 4; ++mi)
#pragma unroll
          for (int ni = 0; ni < 4; ++ni) asm volatile("" : "+v"(gp[mi][ni].x), "+v"(gp[mi][ni].y));
#pragma unroll
        for (int mi = 0; mi < 4; ++mi) {
          const int row = tm * 128 + wr * 64 + mi * 16 + fr;
#pragma unroll
          for (int ni = 0; ni < 4; ++ni) {
            bf16_t* mp = p.P + (grow + wr * 64 + mi * 16 + fr) * DPROJ + 3200 + tn * 128 + wc * 64 + ni * 16 + fq * 4;
            const f32x4 g = {bflo(gp[mi][ni].x), bfhi(gp[mi][ni].x), bflo(gp[mi][ni].y), bfhi(gp[mi][ni].y)};
            f32x4 mn = g * acc[mi][ni];
            if (z > 0) mn += ld4bf(mp);
            st4bf(mp, mn);
          }
        }
      }
    }
  }
}

#define MAKE_LN_EPI(MI_, e, WHICH, SRC_LAT, SRC_CTX)                                                                    \
  EpiResidLN<MI_> e;                                                                                                        \
  {                                                                                                                    \
    const float* mods_l_ = p.mods + (size_t)l * 17 * NMOD;                                                             \
    e.src_lat = (SRC_LAT); e.src_ctx = (SRC_CTX); e.dst_lat = p.out; e.dst_ctx = p.ctxx;                               \
    e.gate = mods_l_ + ((WHICH) * 3 + 2) * DM;                                                                         \
    e.gmul = (WHICH) == 1 ? 1.f : 0.5f;                                                                                \
    e.lng = p.ln_g + (l * 3 + (WHICH)) * DM; e.lnb = p.ln_b + (l * 3 + (WHICH)) * DM;                                  \
    e.mods_next = (WHICH) < 2 ? mods_l_ : p.mods + (size_t)(l == 0 ? 1 : 0) * 17 * NMOD;                               \
    e.shift_idx = (WHICH) < 2 ? (WHICH) * 3 + 3 : 0;                                                                   \
    e.U = ((WHICH) < 2 || l == 0) ? p.U : nullptr;                                                                     \
    e.stats = p.stats; e.cnt = p.lncnt + (l * 3 + (WHICH)) * 288;                                                      \
  }

template <int S>
DI void layer_step(const Params& p, int l, char* lds, long long* scan_t = nullptr) {
  const bool last = l == 1;
  const bool need_ctx = !last;
  const int Mall = NTOK, Mx = need_ctx ? NTOK : NTL;
  const bf16_t* wm = p.WM + (size_t)l * WM_STRIDE;
  if constexpr (S == 0) {
    EpiAct<8> e; e.H = p.H;
    gemm_phaseT<8, 8, 4>(p.U, DM, Mall, 0, p.WF, DM, 2 * DFF, e, lds);
  } else if constexpr (S == 1) {
    MAKE_LN_EPI(6, e, 0, l == 0 ? p.x_in : p.out, l == 0 ? p.ctx_in : p.ctxx)
    gemm_phaseT<6, 8, 8, true>(p.H, LDH, Mall, 0, p.WF + WF_WO, DFF, DM, e, lds, LDH);
  } else if constexpr (S == 3) {
    EpiProj<8> e; e.p = &p; e.l = l;
    gemm_phaseT<8, 8, 3>(p.U, DM, Mall, 0, wm + WM_IN, DM, DPROJ, e, lds);
  } else if constexpr (S == 4) {
    mixer_phase(p, l, need_ctx, lds, scan_t);
  } else if constexpr (S == 5) {
    EpiReadout e; e.p = &p; e.l = l;
    gemm_phase(p.sg, 128, Mx, p.g2 + (size_t)l * 128 * 512, 512, 128, 512, MapHeadPerm(), e, lds);
  } else if constexpr (S == 9) {
    EpiAct<8> e; e.H = p.H;
    gemm_phaseT<8, 8, 4>(p.U, DM, Mx, 0, p.WF + WF_SLOT, DM, 2 * DFF, e, lds);
  } else if constexpr (S == 10) {
    if (need_ctx) {
      MAKE_LN_EPI(6, e, 2, p.out, p.ctxx)
      gemm_phaseT<6, 8, 8, true>(p.H, LDH, NTOK, 0, p.WF + WF_SLOT + WF_WO, DFF, DM, e, lds, LDH);
    } else {
      MAKE_LN_EPI(8, e, 2, p.out, p.ctxx)
      gemm_phaseT<8, 8, 8, true>(p.H, LDH, NTL, 0, p.WF + WF_SLOT + WF_WO, DFF, DM, e, lds, LDH);
    }
    if (!last) convert_ffn(p, 0, p.ffn1_wi + (size_t)(l + 1) * DM * 2 * DFF, p.ffn1_wo + (size_t)(l + 1) * DFF * DM, lds);
  }
}

template <int S>
DI void merge_step(const Params& p, int l, char* lds) {
  const int Mx = l == 0 ? NTOK : NTL;
  const bf16_t* wm = p.WM + (size_t)l * WM_STRIDE;
  if constexpr (S == 0) {
    if (l == 0) merge_phase(p, l, 0, NTOK, lds); else merge_phaseT<8>(p, l, NTL, lds);
  } else {
    if (l == 0) {
      MAKE_LN_EPI(6, e, 1, p.out, p.ctxx)
      gemm_phaseT<6, 8, 8>(p.P + 3200, DPROJ, NTOK, 0, wm + WM_OUT, DM, DM, e, lds);
    } else {
      MAKE_LN_EPI(8, e, 1, p.out, p.ctxx)
      gemm_phaseT<8, 8, 8>(p.P + 3200, DPROJ, NTL, 0, wm + WM_OUT, DM, DM, e, lds);
    }
    convert_ffn(p, 1, p.ffn2_wi + (size_t)l * DM * 2 * DFF, p.ffn2_wo + (size_t)l * DFF * DM, lds);
  }
}

#define XB_TMO      128
#define XB_XCNT(j)  (256  + 64 * (j))
#define XB_XSUB(j)  (1280 + 64 * (j))
#define XB_XGEN(j)  (2304 + 64 * (j))
#define XB_TOP      3328
#define XB_TOPGEN   3392
#define XCD_BAR_WORDS 3456
#define XB_SPIN_CAP (1u << 18)
DI unsigned xb_ld(unsigned* p) { return __hip_atomic_load(p, __ATOMIC_RELAXED, __HIP_MEMORY_SCOPE_AGENT); }
DI unsigned xb_add(unsigned* p, unsigned v) { return __hip_atomic_fetch_add(p, v, __ATOMIC_RELAXED, __HIP_MEMORY_SCOPE_AGENT); }
DI unsigned xb_xcc_id() { return (unsigned)__builtin_amdgcn_s_getreg((3 << 11) | 20) & 0xFu; }
#define XB_SPIN(cond, bar) do { unsigned _sp = 0; while (cond) { __builtin_amdgcn_s_sleep(1); \
    if ((++_sp & 255u) == 0u) { if (xb_ld(&(bar)[XB_TMO])) break; if (_sp > XB_SPIN_CAP) { atomicAdd(&(bar)[XB_TMO], 1u); break; } } } } while (0)
struct XcdBarrier { unsigned* bar; unsigned x; volatile LAS unsigned* st; };
DI XcdBarrier xcd_barrier_post(unsigned* bar, volatile LAS unsigned* st) {
  XcdBarrier b; b.bar = bar; b.x = xb_xcc_id(); b.st = st;
  if (threadIdx.x == 0) (void)xb_add(&bar[XB_XCNT(b.x)], 1u);
  return b;
}
DI void xcd_barrier_complete(unsigned* bar, unsigned x, unsigned& nloc, unsigned& nx) {
  const unsigned G = gridDim.x * gridDim.y * gridDim.z;
  unsigned sum, cnt, mine, sp = 0u;
  for (;;) {
    sum = 0u; cnt = 0u; mine = 0u;
#pragma unroll
    for (unsigned j = 0; j < 16; ++j) { const unsigned c = xb_ld(&bar[XB_XCNT(j)]); sum += c; cnt += (c > 0u) ? 1u : 0u; mine = (j == x) ? c : mine; }
    if (sum == G) break;
    __builtin_amdgcn_s_sleep(1);
    if ((++sp & 255u) == 0u) { if (xb_ld(&bar[XB_TMO])) break; if (sp > XB_SPIN_CAP) { atomicAdd(&bar[XB_TMO], 1u); break; } }
  }
  nloc = mine > 0u ? mine : 1u; nx = cnt > 0u ? cnt : 1u;
}
DI void xcd_barrier(const XcdBarrier& b) {
  asm volatile("s_waitcnt vmcnt(0)" ::: "memory");
  __syncthreads();
  if (threadIdx.x == 0) {
    unsigned* bar = b.bar;
    __builtin_amdgcn_s_waitcnt(0);
    unsigned nloc = b.st[0], nx = b.st[1];
    if (nloc == 0u) { xcd_barrier_complete(bar, b.x, nloc, nx); b.st[0] = nloc; b.st[1] = nx; }
    const unsigned old = xb_add(&bar[XB_XSUB(b.x)], 1u);
    const unsigned gen = old / nloc;
    if (old + 1u == (gen + 1u) * nloc) {
      __builtin_amdgcn_fence(__ATOMIC_RELEASE, "agent");
      asm volatile("s_waitcnt vmcnt(0)" ::: "memory");
      const unsigned og = xb_add(&bar[XB_TOP], 1u);
      const unsigned tg = og / nx;
      if (og + 1u == (tg + 1u) * nx) xb_add(&bar[XB_TOPGEN], 1u);
      else XB_SPIN(xb_ld(&bar[XB_TOPGEN]) == tg, bar);
      __builtin_amdgcn_fence(__ATOMIC_ACQUIRE, "agent");
      xb_add(&bar[XB_XGEN(b.x)], 1u);
      asm volatile("s_waitcnt vmcnt(0)" ::: "memory");
    } else {
      XB_SPIN(xb_ld(&bar[XB_XGEN(b.x)]) == gen, bar);
      __builtin_amdgcn_fence(__ATOMIC_ACQUIRE, "agent");
      asm volatile("s_waitcnt vmcnt(0)" ::: "memory");
    }
  }
  __syncthreads();
}

#define TIMED(id, ...) { long long _t0 = 0; if (PROBE_MASK) _t0 = wall_clock64(); __VA_ARGS__; if ((PROBE_MASK >> (id)) & 1) probe_t += wall_clock64() - _t0; }
__global__ void __launch_bounds__(NTHREADS, 2) fwd_megakernel(Params p) {
  __shared__ __attribute__((aligned(16))) char lds[LDS_BYTES];
  cg::grid_group grid = cg::this_grid();
  long long probe_t = 0;
  if (threadIdx.x == 0) *(u32x4*)(lds + LDS_WORK) = (u32x4){0u, 0u, 0u, 0u};
  __syncthreads();
  (void)xcd_barrier_post(p.bar, (volatile LAS unsigned*)(LAS char*)(lds + LDS_WORK));
#define GSYNC() do { XcdBarrier xb_; xb_.bar = p.bar; xb_.x = xb_xcc_id(); xb_.st = (volatile LAS unsigned*)(LAS char*)(lds + LDS_WORK); xcd_barrier(xb_); } while (0)
  TIMED(0, mods_phase(p, lds);
  convert_ffn(p, 0, p.ffn1_wi, p.ffn1_wo, lds);
  convert_mixer(p, 0, lds);
  convert_mixer(p, 1, lds);
  if (p.bar == nullptr) grid.sync();
  GSYNC();
  u0_phase(p);
  GSYNC();)
#pragma unroll 1
  for (int l = 0; l < 2; ++l) {
    TIMED(1, layer_step<0>(p, l, lds); GSYNC();)
    TIMED(2, layer_step<1>(p, l, lds); GSYNC();)
    TIMED(4, layer_step<3>(p, l, lds); GSYNC();)
    TIMED(5, layer_step<4>(p, l, lds, &probe_t); GSYNC();)
    TIMED(6, layer_step<5>(p, l, lds); GSYNC();)
    TIMED(7, merge_step<0>(p, l, lds); GSYNC();)
    TIMED(8, merge_step<1>(p, l, lds); GSYNC();)
    TIMED(10, layer_step<9>(p, l, lds); GSYNC();)
    TIMED(11, layer_step<10>(p, l, lds);
    if (l == 0) GSYNC();)
  }
  if (PROBE_MASK) {
    if (blockIdx.x == 0 && threadIdx.x == 0) {
      const long long t1 = wall_clock64();
      while (wall_clock64() - t1 < probe_t) __builtin_amdgcn_s_sleep(8);
    }
  }
}

extern "C" void kernel_launch(void* const* d_in, const int* in_sizes, int n_in, void* d_out, int out_size, void* d_ws, size_t ws_size,
                              hipStream_t stream) {
  static int grid_blocks = 0;
  if (!grid_blocks) {
    int dev = 0, cus = 0, per_cu = 0;
    hipGetDevice(&dev);
    hipDeviceGetAttribute(&cus, hipDeviceAttributeMultiprocessorCount, dev);
    hipOccupancyMaxActiveBlocksPerMultiprocessor(&per_cu, fwd_megakernel, NTHREADS, 0);
    if (per_cu < 1) per_cu = 1;
    grid_blocks = cus * per_cu;
  }
  Params p{};
  const float* const* in = (const float* const*)d_in;
  p.x_in = in[0]; p.c = in[1]; p.ctx_in = in[2]; p.c_ctx = in[3]; p.w_ada = in[4]; p.b_ada = in[5];
  p.ffn1_wi = in[6]; p.ffn1_wo = in[7]; p.ffn2_wi = in[8]; p.ffn2_wo = in[9]; p.ln_g = in[10]; p.ln_b = in[11]; p.w_in = in[12];
  p.q_gain = in[13]; p.k_gain = in[14]; p.mu = in[15]; p.w0 = in[16]; p.w2 = in[17]; p.a0 = in[18]; p.a2 = in[19]; p.g2 = in[20];
  p.k_k = in[21]; p.k_a = in[22]; p.r_k = in[23]; p.gn_g = in[24]; p.gn_b = in[25]; p.rpb = in[26]; p.w_branch = in[27]; p.w_out = in[28];
  p.out = (float*)d_out;
  char* ws = (char*)d_ws;
  const size_t MiB = 1ull << 20;
  p.counters = (unsigned*)ws;
  p.rope = (float*)(ws + 4096);
  p.lncnt = (unsigned*)(ws + 16384);
  p.bar = (unsigned*)(ws + 24576);
  hipMemsetAsync(ws + 24576, 0, XCD_BAR_WORDS * sizeof(unsigned), stream);
  p.stats = (float*)(ws + 507 * MiB);
  p.mods = (float*)(ws + 65536);
  p.ctxx = (float*)(ws + 2 * MiB);
  p.U = (bf16_t*)(ws + 18 * MiB);
  p.H = (bf16_t*)(ws + 90 * MiB);
  p.P = (bf16_t*)(ws + 90 * MiB);
  p.Os = (bf16_t*)(ws + 387 * MiB);
  p.yr = (bf16_t*)(ws + 387 * MiB);
  p.Mg = (bf16_t*)(ws + 423 * MiB);
  p.sg = (bf16_t*)(ws + 459 * MiB);
  p.WM = (bf16_t*)(ws + 468 * MiB);
  p.WF = (bf16_t*)(ws + 423 * MiB);
  if (ws_size < 512 * MiB) fprintf(stderr, "workspace too small: %zu\n", ws_size);
  void* args[] = {&p};
  hipError_t e = hipLaunchCooperativeKernel((void*)fwd_megakernel, dim3(grid_blocks), dim3(NTHREADS), args, 0, stream);
  if (e != hipSuccess) fprintf(stderr, "cooperative launch failed: %s (grid %d)\n", hipGetErrorString(e), grid_blocks);
}
```
